# Optimizing an MI355X kernel written in HIP

```python
import math
import jax, jax.numpy as jnp
from jax import lax
import numpy as np

D_MODEL = 1024
BATCH = 8
SEQ = 4096
DEPTH = 1

D_CONV = 512
CONV_K = 3
N_HEADS = 8
HEAD_DIM = 64
D_ATTN = N_HEADS * HEAD_DIM
N_IDX_HEADS = 8
IDX_DIM = 64
TOPK_MAX = 256
Q_BLOCK = 128
N_BUCKETS = 32
MAX_EXACT = 16
MAX_DISTANCE = 128
D_FF = -(-8 * D_MODEL // (3 * 256)) * 256
EPS = 1e-6

PROJ_SIZES = (
    D_CONV, D_CONV, D_CONV,
    D_ATTN, HEAD_DIM, HEAD_DIM,
    N_IDX_HEADS * IDX_DIM, IDX_DIM,
    N_IDX_HEADS,
    D_MODEL, D_MODEL,
)
N_PROJ = int(sum(PROJ_SIZES))
PROJ_SPLITS = [int(v) for v in np.cumsum(PROJ_SIZES)[:-1]]

kernel_name = "hybrid_shortconv_dsa_gated_block"


def rms_norm(x, g):
    xf = x.astype(jnp.float32)
    y = xf * lax.rsqrt(jnp.mean(xf * xf, axis=-1, keepdims=True) + EPS)
    return (y * g.astype(jnp.float32)).astype(x.dtype)


def rel_bucket(dist):
    n = jnp.maximum(dist, 0)
    large = MAX_EXACT + (jnp.log(jnp.maximum(n, 1).astype(jnp.float32) / MAX_EXACT)
                         / math.log(MAX_DISTANCE / MAX_EXACT)
                         * (N_BUCKETS - MAX_EXACT)).astype(jnp.int32)
    large = jnp.minimum(large, N_BUCKETS - 1)
    return jnp.where(n < MAX_EXACT, n, large)


def short_conv_mixer(gate_b, gate_c, x_a, conv_w):
    u = gate_c * x_a
    rhs = conv_w[:, None, :].astype(u.dtype)
    y = lax.conv_general_dilated(u, rhs, window_strides=(1,), padding=[(CONV_K - 1, 0)],
                                 dimension_numbers=("NWC", "WIO", "NWC"),
                                 feature_group_count=D_CONV)
    return gate_b * y


def dsa_attention(q, k, v, iq, ik, iw, rel_bias):
    bsz, seq_len = q.shape[0], q.shape[1]
    k_top = min(TOPK_MAX, seq_len // 4)
    n_blk = seq_len // Q_BLOCK
    iw = iw * (N_IDX_HEADS ** -0.5 * IDX_DIM ** -0.5)
    s_pos = jnp.arange(seq_len, dtype=jnp.int32)
    t_blocks = s_pos.reshape(n_blk, Q_BLOCK)

    def to_blocks(a):
        return jnp.moveaxis(a.reshape(bsz, n_blk, Q_BLOCK, *a.shape[2:]), 1, 0)

    gather = jax.vmap(lambda arr, ind: arr[ind])

    def block_fn(args):
        q_b, iq_b, iw_b, t_b = args
        dots = jnp.einsum("bthd,bsd->bths", iq_b, ik)
        score = jnp.einsum("bth,bths->bts", iw_b, jax.nn.relu(dots)).astype(jnp.float32)
        causal = s_pos[None, :] <= t_b[:, None]
        score = jnp.where(causal[None], score, -jnp.inf)
        _, idx = lax.top_k(score, k_top)
        valid = idx <= t_b[None, :, None]
        k_sel = gather(k, idx)
        v_sel = gather(v, idx)
        logits = jnp.einsum("bthd,btkd->bhtk", q_b, k_sel).astype(jnp.float32) * (HEAD_DIM ** -0.5)
        bias = rel_bias[rel_bucket(t_b[None, :, None] - idx)]
        logits = logits + jnp.moveaxis(bias, -1, 1).astype(jnp.float32)
        logits = jnp.where(valid[:, None], logits, -jnp.inf)
        p = jax.nn.softmax(logits, axis=-1).astype(v.dtype)
        o = jnp.einsum("bhtk,btkd->bthd", p, v_sel)
        return o.reshape(bsz, Q_BLOCK, D_ATTN)

    out = lax.map(block_fn, (to_blocks(q), to_blocks(iq), to_blocks(iw), t_blocks))
    return jnp.moveaxis(out, 0, 1).reshape(bsz, seq_len, D_ATTN)


def setup_inputs(seed: int = 0) -> dict:
    key = jax.random.key(seed)
    ks = jax.random.split(key, 16)
    f32 = jnp.float32
    nrm = lambda k, shape, scale: jax.random.normal(k, shape, f32) * scale
    return {
        "x": nrm(ks[0], (BATCH, SEQ, D_MODEL), 1.0),
        "g_mix": 1.0 + nrm(ks[1], (DEPTH, D_MODEL), 0.02),
        "w_in": nrm(ks[2], (DEPTH, D_MODEL, N_PROJ), D_MODEL ** -0.5),
        "b_gate": nrm(ks[3], (DEPTH, 2 * D_MODEL), 0.02),
        "conv_w": nrm(ks[4], (DEPTH, CONV_K, D_CONV), CONV_K ** -0.5),
        "w_branch_a": nrm(ks[5], (DEPTH, D_CONV, D_MODEL), D_CONV ** -0.5),
        "w_branch_b": nrm(ks[6], (DEPTH, D_ATTN, D_MODEL), D_ATTN ** -0.5),
        "w_out": nrm(ks[7], (DEPTH, D_MODEL, D_MODEL), D_MODEL ** -0.5),
        "rel_bias": nrm(ks[8], (N_BUCKETS, N_HEADS), 0.5),
        "g_ffn": 1.0 + nrm(ks[9], (DEPTH, D_MODEL), 0.02),
        "w_ffn_gate": nrm(ks[10], (DEPTH, D_MODEL, D_FF), D_MODEL ** -0.5),
        "w_ffn_up": nrm(ks[11], (DEPTH, D_MODEL, D_FF), D_MODEL ** -0.5),
        "w_ffn_down": nrm(ks[12], (DEPTH, D_FF, D_MODEL), D_FF ** -0.5),
        "g_final": 1.0 + nrm(ks[13], (D_MODEL,), 0.02),
    }


def reference(x, g_mix, w_in, b_gate, conv_w, w_branch_a, w_branch_b, w_out, rel_bias,
              g_ffn, w_ffn_gate, w_ffn_up, w_ffn_down, g_final):
    bsz, seq_len, _ = x.shape
    for layer in range(DEPTH):
        h = rms_norm(x, g_mix[layer])
        proj = h @ w_in[layer]
        (c_b, c_c, c_x, q, k, v, iq, ik, iw, g_a, g_b) = jnp.split(proj, PROJ_SPLITS, axis=-1)
        y_a = short_conv_mixer(c_b, c_c, c_x, conv_w[layer]) @ w_branch_a[layer]
        attn = dsa_attention(q.reshape(bsz, seq_len, N_HEADS, HEAD_DIM), k, v,
                             iq.reshape(bsz, seq_len, N_IDX_HEADS, IDX_DIM), ik, iw, rel_bias)
        y_b = attn @ w_branch_b[layer]
        gates = jax.nn.sigmoid(jnp.concatenate([g_a, g_b], axis=-1) + b_gate[layer])
        merged = gates[..., :D_MODEL] * y_a + gates[..., D_MODEL:] * y_b
        x = x + merged @ w_out[layer]
        h2 = rms_norm(x, g_ffn[layer])
        x = x + (jax.nn.silu(h2 @ w_ffn_gate[layer]) * (h2 @ w_ffn_up[layer])) @ w_ffn_down[layer]
    return rms_norm(x, g_final)
```

```cpp
#include <hip/hip_runtime.h>
#include <cstdio>
#include <cstdint>
namespace pg8 {
#define PG8_LAS __attribute__((address_space(3)))
typedef unsigned short bf16_t;
typedef short bf16x8 __attribute__((ext_vector_type(8)));
typedef float f32x4 __attribute__((ext_vector_type(4)));
typedef unsigned u32x4 __attribute__((ext_vector_type(4)));
constexpr int BM = 256, BK = 64, HALF = 128, HTB = HALF * BK * 2  , STAGE_BYTES = 8 * HTB, NXCD = 8, WGM = 8;

__host__ __device__ __forceinline__ int lds_byte(int r, int c) { const int st = (r >> 4) * 2 + (c >> 5), rr = r & 15, cc = c & 31, ob = rr * 64 + cc * 2; return st * 1024 + (ob ^ (((ob >> 9) & 1) << 5)); }
__host__ __device__ __forceinline__ void stage_rc(int b, int& R, int& C) { const int st = b / 1024, sb = b % 1024, swz = sb ^ (((sb >> 9) & 1) << 5); R = (st >> 1) * 16 + swz / 64; C = (st & 1) * 32 + (swz % 64) / 2; }
__host__ __device__ __forceinline__ int perm32(int rho) { const int n = rho >> 4, i = rho & 15; return 8 * (i >> 2) + 4 * n + (i & 3); }

struct Unit { int pm, pn; };
struct Gemm { const bf16_t* A; const bf16_t* Bt; int M, N, K; };

struct StaticOrder {
    int nM, nN, nwg, G, c;
    __host__ __device__ void init(int M, int N, int G_, int c_) { nM = M / BM; nN = N / BM; nwg = nM * nN; G = G_; c = c_; }
    __host__ __device__ bool next(int i, Unit& u) const {
        const long L = (long)i * G + c; if (L >= nwg) return false;
        int wgid = (int)L; { const int q = nwg / NXCD, r = nwg % NXCD, xcd = wgid % NXCD, off = wgid / NXCD; wgid = (xcd < r ? xcd * (q + 1) : r * (q + 1) + (xcd - r) * q) + off; }
        const int nig = WGM * nN, gid = wgid / nig, fm = gid * WGM, gsz = (nM - fm) < WGM ? (nM - fm) : WGM;
        u.pm = fm + ((wgid % nig) % gsz); u.pn = (wgid % nig) / gsz; return true;
    }
    __device__ __forceinline__ void a_ready(const Unit&) const {}
    __device__ __forceinline__ void done(const Unit&) const {}
};

__device__ __forceinline__ unsigned cvt_pk_bf16(float lo, float hi) { unsigned r; asm volatile("v_cvt_pk_bf16_f32 %0, %1, %2" : "=v"(r) : "v"(lo), "v"(hi)); return r; }
typedef float f32x2 __attribute__((ext_vector_type(2)));
__device__ __forceinline__ f32x2 gelu_pk(f32x2 v) {
    const f32x2 av = __builtin_elementwise_abs(v), d = av * 0.2316418882f + 1.0f;
    f32x2 t; t.x = __builtin_amdgcn_rcpf(d.x); t.y = __builtin_amdgcn_rcpf(d.y);
    f32x2 q = t * 0.5307027145f + (-0.7265760135f); q = q * t + 0.7107068705f; q = q * t + (-0.142248368f); q = q * t + 0.127414796f; q = q * t;
    const f32x2 s = (v * v) * (-0.72134752044f);
    f32x2 e; e.x = __builtin_amdgcn_exp2f(s.x); e.y = __builtin_amdgcn_exp2f(s.y);
    const f32x2 m = v * (q * e), r = v - m;
    f32x2 o; o.x = v.x < 0.f ? m.x : r.x; o.y = v.y < 0.f ? m.y : r.y; return o;
}

template <int ACT  > struct EpiBf16 {
    static constexpr bool PERM = true, AFTER_DRAIN = false; static_assert(ACT == 0 || ACT == 1, "EpiBf16: ACT is 0 (none) or 1 (gelu_pk)");
    bf16_t* O; int ldc; const float* bias; int split_cols; size_t split_stride; float scale0;
    __device__ __forceinline__ void operator()(const f32x4 (&acc)[2][2][4][2], const Unit& u, int wr, int wc, int fr, int fq) const {
        const int row0 = u.pm * BM + wr * 64 + fr; int colt = u.pn * BM; bf16_t* base = O;
        float sc = 1.f; if (split_cols) { const int t = colt / split_cols; base += (size_t)t * split_stride; colt -= t * split_cols; if (t == 0) sc = scale0; }
        const int col0 = colt + wc * 32 + 8 * fq, bcol0 = u.pn * BM + wc * 32 + 8 * fq;
        f32x4 bv[2][2];
#pragma unroll
        for (int bj = 0; bj < 2; ++bj)
#pragma unroll
            for (int n = 0; n < 2; ++n) bv[bj][n] = bias ? *(const f32x4*)(bias + bcol0 + bj * HALF + 4 * n) : (f32x4){0.f, 0.f, 0.f, 0.f};
#pragma unroll
        for (int ai = 0; ai < 2; ++ai)
#pragma unroll
            for (int m = 0; m < 4; ++m) { bf16_t* rowp = base + (size_t)(row0 + ai * HALF + m * 16) * ldc + col0;
#pragma unroll
                for (int bj = 0; bj < 2; ++bj) { f32x4 v0 = acc[ai][bj][m][0] + bv[bj][0], v1 = acc[ai][bj][m][1] + bv[bj][1];
                    if (ACT == 1) { f32x2 a = gelu_pk((f32x2){v0[0], v0[1]}), b = gelu_pk((f32x2){v0[2], v0[3]}), c = gelu_pk((f32x2){v1[0], v1[1]}), d = gelu_pk((f32x2){v1[2], v1[3]});
                        v0 = (f32x4){a.x, a.y, b.x, b.y}; v1 = (f32x4){c.x, c.y, d.x, d.y}; }
                    v0 = v0 * sc; v1 = v1 * sc; u32x4 w; w.x = cvt_pk_bf16(v0[0], v0[1]); w.y = cvt_pk_bf16(v0[2], v0[3]); w.z = cvt_pk_bf16(v1[0], v1[1]); w.w = cvt_pk_bf16(v1[2], v1[3]);
                    *(u32x4*)(rowp + bj * HALF) = w; } }
    }
};

template <class Epi, class Sched, bool ALIGN_EPI = false, bool SP2 = false>
__device__ __forceinline__ void gemm_phase(PG8_LAS unsigned char* lds, const Gemm g, const Sched& S, const Epi& E) {
    const int tid = threadIdx.x, wid = __builtin_amdgcn_readfirstlane(tid >> 6), lane = tid & 63, wr = wid >> 2, wc = wid & 3, fr = lane & 15, fq = lane >> 4;
    const int K = g.K, nt = K / BK;
    unsigned voffA[2], voffB[2];
#pragma unroll
    for (int i = 0; i < 2; ++i) { int R, C; stage_rc(tid * 16 + i * 8192, R, C); const int Rb = Epi::PERM ? ((R & ~31) + perm32(R & 31)) : R;
        voffA[i] = (unsigned)(R * K + C) * 2u; voffB[i] = (unsigned)(Rb * K + C) * 2u; }
    const size_t kstep = (size_t)(BK * 2);
    const size_t hstep = (size_t)HALF * K * 2;
    const size_t tstep = 2 * hstep;
    const unsigned ldsw = (unsigned)wid * 1024u;
    const int aoff = lds_byte(wr * 64 + fr, fq * 8), boff = lds_byte(wc * 32 + fr, fq * 8);
#define PG8_SA(b, h) (((b) * 2 + (h)) * HTB)
#define PG8_SB(b, h) ((4 + (b) * 2 + (h)) * HTB)
#define PG8_STAGE(bufoff, gbase, voff) do { _Pragma("unroll") for (int _i = 0; _i < 2; ++_i) \
        __builtin_amdgcn_global_load_lds((const unsigned*)((const char*)(gbase) + (voff)[_i]), (PG8_LAS unsigned*)(lds + (bufoff) + ldsw + _i * 8192), 16, 0, 0); } while (0)
#define PG8_LDA(dst, b, h) do { _Pragma("unroll") for (int m = 0; m < 4; ++m) _Pragma("unroll") for (int k = 0; k < 2; ++k) dst[m][k] = *(const PG8_LAS bf16x8*)(lds + PG8_SA(b, h) + aoff + m * 2048 + k * 1024); } while (0)
#define PG8_LDB(dst, b, h) do { _Pragma("unroll") for (int n = 0; n < 2; ++n) _Pragma("unroll") for (int k = 0; k < 2; ++k) dst[n][k] = *(const PG8_LAS bf16x8*)(lds + PG8_SB(b, h) + boff + n * 2048 + k * 1024); } while (0)
#define PG8_MMA(ai, bj, At, Bt) do { __builtin_amdgcn_s_setprio(1); _Pragma("unroll") for (int m = 0; m < 4; ++m) _Pragma("unroll") for (int n = 0; n < 2; ++n) _Pragma("unroll") for (int k = 0; k < 2; ++k) \
        acc[ai][bj][m][n] = __builtin_amdgcn_mfma_f32_16x16x32_bf16(Bt[n][k], At[m][k], acc[ai][bj][m][n], 0, 0, 0); __builtin_amdgcn_s_setprio(0); } while (0)
#define PG8_WAIT_V(n) asm volatile("s_waitcnt vmcnt(" #n ")" ::: "memory")
#define PG8_WAIT_L(n) asm volatile("s_waitcnt lgkmcnt(" #n ")" ::: "memory")
#define PG8_BAR __builtin_amdgcn_s_barrier()
#define PG8_SCHED __builtin_amdgcn_sched_barrier(0)
    Unit cur, nxt; int ui = 0;
    if (!S.next(0, cur)) return;
    f32x4 acc[2][2][4][2];
#pragma unroll
    for (int a = 0; a < 2; ++a)
#pragma unroll
        for (int b = 0; b < 2; ++b)
#pragma unroll
            for (int m = 0; m < 4; ++m)
#pragma unroll
                for (int n = 0; n < 2; ++n) acc[a][b][m][n] = (f32x4){0.f, 0.f, 0.f, 0.f};
    bf16x8 At[4][2], B0[2][2], B1[2][2];
    const char* cA = (const char*)g.A + (size_t)cur.pm * tstep; const char* cB = (const char*)g.Bt + (size_t)cur.pn * tstep;
    S.a_ready(cur);
    if constexpr (SP2) {
        PG8_STAGE(PG8_SB(0, 0), cB, voffB); PG8_STAGE(PG8_SB(0, 1), cB + hstep, voffB); PG8_STAGE(PG8_SA(0, 0), cA, voffA); PG8_STAGE(PG8_SA(0, 1), cA + hstep, voffA);
        if (wr == 1) PG8_BAR;
        PG8_WAIT_V(2); PG8_BAR;
        PG8_STAGE(PG8_SB(1, 0), cB + kstep, voffB); PG8_STAGE(PG8_SA(1, 0), cA + kstep, voffA); PG8_STAGE(PG8_SB(1, 1), cB + hstep + kstep, voffB);
        PG8_WAIT_V(6); PG8_BAR;
    } else {
        PG8_STAGE(PG8_SB(0, 0), cB, voffB); PG8_STAGE(PG8_SA(0, 0), cA, voffA); PG8_STAGE(PG8_SB(0, 1), cB + hstep, voffB); PG8_STAGE(PG8_SA(0, 1), cA + hstep, voffA);
        if (wr == 1) PG8_BAR;
        PG8_WAIT_V(4); PG8_BAR;
        PG8_STAGE(PG8_SB(1, 0), cB + kstep, voffB); PG8_STAGE(PG8_SA(1, 0), cA + kstep, voffA); PG8_STAGE(PG8_SB(1, 1), cB + hstep + kstep, voffB);
        PG8_WAIT_V(6); PG8_BAR;
    }
    for (;;) {
        const bool has_next = S.next(ui + 1, nxt);
        const char* nA = has_next ? (const char*)g.A + (size_t)nxt.pm * tstep : cA; const char* nB = has_next ? (const char*)g.Bt + (size_t)nxt.pn * tstep : cB;
        for (int t = 0; t < nt; t += 2) {
            const bool last = (t == nt - 2);
            const char* a1 = cA + (size_t)(t + 1) * kstep;
            const char* a2 = last ? nA : cA + (size_t)(t + 2) * kstep; const char* b2 = last ? nB : cB + (size_t)(t + 2) * kstep;
            const char* a3 = a2 + kstep; const char* b3 = b2 + kstep;
            if (last && has_next) S.a_ready(nxt);
            if constexpr (SP2) {
            PG8_LDB(B0, 0, 0); PG8_LDB(B1, 0, 1); PG8_SCHED; PG8_LDA(At, 0, 0); PG8_STAGE(PG8_SA(1, 1), a1 + hstep, voffA);
            PG8_WAIT_V(8); PG8_WAIT_L(0); PG8_BAR; PG8_MMA(0, 0, At, B0); PG8_MMA(0, 1, At, B1); PG8_BAR; PG8_SCHED;
            PG8_LDA(At, 0, 1); PG8_STAGE(PG8_SB(0, 0), b2, voffB); PG8_STAGE(PG8_SB(0, 1), b2 + hstep, voffB); PG8_STAGE(PG8_SA(0, 0), a2, voffA);
            PG8_WAIT_V(8); PG8_WAIT_L(0); PG8_BAR; PG8_MMA(1, 0, At, B0); PG8_MMA(1, 1, At, B1); PG8_BAR; PG8_SCHED;
            PG8_LDB(B0, 1, 0); PG8_LDB(B1, 1, 1); PG8_SCHED; PG8_LDA(At, 1, 0); PG8_STAGE(PG8_SA(0, 1), a2 + hstep, voffA);
            PG8_WAIT_V(8); PG8_WAIT_L(0); PG8_BAR; PG8_MMA(0, 0, At, B0); PG8_MMA(0, 1, At, B1); PG8_BAR; PG8_SCHED;
            PG8_LDA(At, 1, 1); PG8_STAGE(PG8_SB(1, 0), b3, voffB); PG8_STAGE(PG8_SB(1, 1), b3 + hstep, voffB); PG8_STAGE(PG8_SA(1, 0), a3, voffA);
            PG8_WAIT_V(8); PG8_WAIT_L(0); PG8_BAR; PG8_MMA(1, 0, At, B0); PG8_MMA(1, 1, At, B1); PG8_BAR; PG8_SCHED;
            } else {
            PG8_LDB(B0, 0, 0); PG8_SCHED; PG8_LDA(At, 0, 0); PG8_STAGE(PG8_SA(1, 1), a1 + hstep, voffA);
            PG8_WAIT_L(8); PG8_BAR; PG8_WAIT_L(0); PG8_MMA(0, 0, At, B0); PG8_BAR; PG8_SCHED;
            PG8_LDB(B1, 0, 1); PG8_STAGE(PG8_SB(0, 0), b2, voffB);
            PG8_BAR; PG8_WAIT_L(0); PG8_MMA(0, 1, At, B1); PG8_BAR;
            PG8_LDA(At, 0, 1); PG8_STAGE(PG8_SA(0, 0), a2, voffA);
            PG8_BAR; PG8_WAIT_L(0); PG8_MMA(1, 0, At, B0); PG8_BAR; PG8_SCHED;
            PG8_STAGE(PG8_SB(0, 1), b2 + hstep, voffB);
            PG8_WAIT_V(6); PG8_BAR; PG8_MMA(1, 1, At, B1); PG8_BAR;
            PG8_LDB(B0, 1, 0); PG8_SCHED; PG8_LDA(At, 1, 0); PG8_STAGE(PG8_SA(0, 1), a2 + hstep, voffA);
            PG8_WAIT_L(8); PG8_BAR; PG8_WAIT_L(0); PG8_MMA(0, 0, At, B0); PG8_BAR; PG8_SCHED;
            PG8_LDB(B1, 1, 1); PG8_STAGE(PG8_SB(1, 0), b3, voffB);
            PG8_BAR; PG8_WAIT_L(0); PG8_MMA(0, 1, At, B1); PG8_BAR;
            PG8_LDA(At, 1, 1); PG8_STAGE(PG8_SA(1, 0), a3, voffA);
            PG8_BAR; PG8_WAIT_L(0); PG8_MMA(1, 0, At, B0); PG8_BAR; PG8_SCHED;
            PG8_STAGE(PG8_SB(1, 1), b3 + hstep, voffB);
            PG8_WAIT_V(6); PG8_BAR; PG8_MMA(1, 1, At, B1); PG8_BAR;
            }
        }
        if constexpr (ALIGN_EPI) { if (wr == 0) PG8_BAR; }
        if constexpr (!Epi::AFTER_DRAIN) { E(acc, cur, wr, wc, fr, fq); S.done(cur); }
        if (!has_next) break;
#pragma unroll
        for (int a = 0; a < 2; ++a)
#pragma unroll
            for (int b = 0; b < 2; ++b)
#pragma unroll
                for (int m = 0; m < 4; ++m)
#pragma unroll
                    for (int n = 0; n < 2; ++n) acc[a][b][m][n] = (f32x4){0.f, 0.f, 0.f, 0.f};
        cur = nxt; cA = nA; cB = nB; ++ui;
        if constexpr (ALIGN_EPI) { if (wr == 1) PG8_BAR; }
    }
    PG8_WAIT_V(0);
    if constexpr (!ALIGN_EPI) { if (wr == 0) PG8_BAR; }
    PG8_BAR;
    if constexpr (Epi::AFTER_DRAIN) { E.fused(acc, cur, wr, wc, fr, fq, lds, wid, lane); S.done(cur); }
#undef PG8_SA
#undef PG8_SB
#undef PG8_STAGE
#undef PG8_LDA
#undef PG8_LDB
#undef PG8_MMA
#undef PG8_WAIT_V
#undef PG8_WAIT_L
#undef PG8_BAR
#undef PG8_SCHED
}
}

#ifndef PG8_SP2
#define PG8_SP2 true
#endif
#ifndef PG8_ALIGN
#define PG8_ALIGN true
#endif
#define GAS __attribute__((address_space(1)))
#define LAS __attribute__((address_space(3)))
typedef unsigned short bf16;
typedef unsigned v4u __attribute__((ext_vector_type(4)));
typedef float f32x4 __attribute__((ext_vector_type(4)));
typedef short bf16x8 __attribute__((ext_vector_type(8)));
typedef GAS unsigned gu32;
typedef GAS unsigned long long gu64;
#define RLX_AGENT __ATOMIC_RELAXED, __HIP_MEMORY_SCOPE_AGENT
#define LDS_WAIT() asm volatile("s_waitcnt lgkmcnt(0)" ::: "memory")
#define VM_WAIT() asm volatile("s_waitcnt vmcnt(0)" ::: "memory")
__device__ __forceinline__ unsigned long long rt() { return __builtin_amdgcn_s_memrealtime(); }
__device__ __forceinline__ unsigned f2bf(float f) { unsigned u = __builtin_bit_cast(unsigned, f); return (u + 0x7fffu + ((u >> 16) & 1u)) >> 16; }
__device__ __forceinline__ unsigned pk2(float lo, float hi) { return f2bf(lo) | (f2bf(hi) << 16); }

#define XB_TMO      128
#define XB_XCNT(j)  (256  + 64 * (j))
#define XB_XSUB(j)  (1280 + 64 * (j))
#define XB_XGEN(j)  (2304 + 64 * (j))
#define XB_TOP      3328
#define XB_TOPGEN   3392
#define XCD_BAR_WORDS 3456
#define XB_SPIN_CAP (1u << 18)

__device__ __forceinline__ unsigned xb_ld(unsigned* p)              { return __hip_atomic_load(p, __ATOMIC_RELAXED, __HIP_MEMORY_SCOPE_AGENT); }
__device__ __forceinline__ unsigned xb_add(unsigned* p, unsigned v) { return __hip_atomic_fetch_add(p, v, __ATOMIC_RELAXED, __HIP_MEMORY_SCOPE_AGENT); }
__device__ __forceinline__ unsigned xb_xcc_id() { return (unsigned)__builtin_amdgcn_s_getreg((3 << 11) | 20) & 0xFu; }
#define XB_SPIN(cond, bar) do { unsigned _sp = 0; while (cond) { __builtin_amdgcn_s_sleep(1); \
    if ((++_sp & 255u) == 0u) { if (xb_ld(&(bar)[XB_TMO])) break; if (_sp > XB_SPIN_CAP) { atomicAdd(&(bar)[XB_TMO], 1u); break; } } } } while (0)

struct XcdBarrier {
    unsigned* bar; unsigned x;
    volatile LAS unsigned* st;
};

__device__ __forceinline__ XcdBarrier xcd_barrier_post(unsigned* bar, volatile LAS unsigned* st) {
    XcdBarrier b; b.bar = bar; b.x = xb_xcc_id(); b.st = st;
    if (threadIdx.x == 0) (void)xb_add(&bar[XB_XCNT(b.x)], 1u);
    return b;
}
__device__ __forceinline__ void xcd_barrier_complete(unsigned* bar, unsigned x, unsigned& nloc, unsigned& nx) {
    const unsigned G = gridDim.x * gridDim.y * gridDim.z;
    unsigned sum, cnt, mine, sp = 0u;
    for (;;) {
        sum = 0u; cnt = 0u; mine = 0u;
#pragma unroll
        for (unsigned j = 0; j < 16; ++j) { const unsigned c = xb_ld(&bar[XB_XCNT(j)]); sum += c; cnt += (c > 0u) ? 1u : 0u; mine = (j == x) ? c : mine; }
        if (sum == G) break;
        __builtin_amdgcn_s_sleep(1);
        if ((++sp & 255u) == 0u) { if (xb_ld(&bar[XB_TMO])) break; if (sp > XB_SPIN_CAP) { atomicAdd(&bar[XB_TMO], 1u); break; } }
    }
    nloc = mine > 0u ? mine : 1u; nx = cnt > 0u ? cnt : 1u;
}

__device__ __forceinline__ void xcd_barrier(const XcdBarrier& b) {
    asm volatile("s_waitcnt vmcnt(0)" ::: "memory");
    __syncthreads();
    if (threadIdx.x == 0) {
        unsigned* bar = b.bar;
        __builtin_amdgcn_s_waitcnt(0);
        unsigned nloc = b.st[0], nx = b.st[1];
        if (nloc == 0u) { xcd_barrier_complete(bar, b.x, nloc, nx); b.st[0] = nloc; b.st[1] = nx; }
        const unsigned old = xb_add(&bar[XB_XSUB(b.x)], 1u);
        const unsigned gen = old / nloc;
        if (old + 1u == (gen + 1u) * nloc) {
            __builtin_amdgcn_fence(__ATOMIC_RELEASE, "agent");
            asm volatile("s_waitcnt vmcnt(0)" ::: "memory");
            const unsigned og = xb_add(&bar[XB_TOP], 1u);
            const unsigned tg = og / nx;
            if (og + 1u == (tg + 1u) * nx) xb_add(&bar[XB_TOPGEN], 1u);
            else XB_SPIN(xb_ld(&bar[XB_TOPGEN]) == tg, bar);
            __builtin_amdgcn_fence(__ATOMIC_ACQUIRE, "agent");
            xb_add(&bar[XB_XGEN(b.x)], 1u);
            asm volatile("s_waitcnt vmcnt(0)" ::: "memory");
        } else {
            XB_SPIN(xb_ld(&bar[XB_XGEN(b.x)]) == gen, bar);
            __builtin_amdgcn_fence(__ATOMIC_ACQUIRE, "agent");
            asm volatile("s_waitcnt vmcnt(0)" ::: "memory");
        }
    }
    __syncthreads();
}

constexpr int NWAVES = 8;
#ifndef MK_N_LAUNCHES
#define MK_N_LAUNCHES 1
#endif
constexpr int PER_PHASE = 9;
constexpr int N_LAUNCHES = MK_N_LAUNCHES;
static_assert(N_LAUNCHES == 1 || N_LAUNCHES == PER_PHASE, "MK_N_LAUNCHES is 1 or 9");

constexpr int BATCH = 8, SEQ = 4096, D = 1024, M = BATCH * SEQ;
constexpr int DCONV = 512, DATT = 512, NH = 8, HD = 64, FF = 2816, NGU = 2 * FF;
constexpr int NPROJ_SRC = 4808, NPROJ = 4864;
constexpr int PC_CB = 0, PC_CC = 512, PC_CX = 1024, PC_Q = 1536, PC_K = 2048, PC_V = 2112, PC_IQ = 2176, PC_IK = 2688, PC_IW = 2752, PC_GA = 2816, PC_GB = 3840;
constexpr float EPS = 1e-6f;
constexpr int TOPK = 256;

constexpr size_t MiB = 1u << 20;
constexpr size_t WS_CTL = 0, CTL_ZERO_BYTES = 1 * MiB;
constexpr size_t WS_SSQ1 = 1 * MiB, WS_SSQ2 = 3 * MiB;
constexpr size_t WS_WIN = 6 * MiB, WS_WA = 16 * MiB, WS_WB = 17 * MiB, WS_WOUT = 18 * MiB, WS_WGU = 20 * MiB, WS_WD = 31 * MiB;
constexpr size_t WS_XN = 40 * MiB;
constexpr size_t WS_CONV = 104 * MiB, WS_ATTN = 136 * MiB;
constexpr size_t WS_PROJ = 168 * MiB;
constexpr size_t WS_END = 472 * MiB;
static_assert(WS_WIN + (size_t)NPROJ * D * 2 <= WS_WA && WS_WGU + (size_t)NGU * D * 2 <= WS_WD && WS_WD + (size_t)D * FF * 2 <= WS_XN, "weights map");
static_assert(WS_PROJ + (size_t)M * NPROJ * 2 <= WS_END && WS_XN + (size_t)M * D * 2 <= WS_CONV && WS_ATTN + (size_t)M * 512 * 2 <= WS_PROJ, "activation map");
constexpr int CW_BAR = 4096;

constexpr int RING_OFF = 0, RING_BYTES = 131072;
constexpr int LDSCTL_OFF = RING_BYTES, MISC_OFF = LDSCTL_OFF + 320;
constexpr int TAB_OFF = RING_BYTES + 1024;
constexpr int LDS_BYTES = 147456;
static_assert(MISC_OFF + 128 <= TAB_OFF && TAB_OFF + 4096 <= LDS_BYTES, "LDS map");

struct Frame {
    LAS unsigned char* lds;
    volatile LAS unsigned* MISC;
    gu32* ctl;
    int tid, lane, wave;
    int vcu, G;
};

__device__ __forceinline__ float wave_sum(float v) {
#pragma unroll
    for (int o = 1; o < 64; o <<= 1) v += __shfl_xor(v, o);
    return v;
}
__device__ __forceinline__ float bf_lo(unsigned w) { return __builtin_bit_cast(float, w << 16); }
__device__ __forceinline__ float bf_hi(unsigned w) { return __builtin_bit_cast(float, w & 0xffff0000u); }
__device__ __forceinline__ float fast_sigmoid(float z) { return __builtin_amdgcn_rcpf(1.0f + __builtin_amdgcn_exp2f(-1.4426950408889634f * z)); }

__device__ __forceinline__ void p0_transpose_item(const float* W, int K, int N, int k0, int scol0, int nvalid, bf16* WT, int drow0, const float* kscale, LAS float* scr, int lane) {
    const int j = lane & 31;
#pragma unroll 8
    for (int i = 0; i < 32; ++i) { const int kk = 2 * i + (lane >> 5); float v = 0.f;
        if (j < nvalid) v = W[(size_t)(k0 + kk) * N + scol0 + j];
        if (kscale) v *= kscale[k0 + kk];
        scr[kk * 33 + j] = v; }
    LDS_WAIT(); asm volatile("" ::: "memory");
    const int c = lane & 7;
#pragma unroll
    for (int jj = 0; jj < 4; ++jj) { const int n = (lane >> 3) + 8 * jj; const LAS float* s = scr + (8 * c) * 33 + n;
        v4u o; o.x = pk2(s[0 * 33], s[1 * 33]); o.y = pk2(s[2 * 33], s[3 * 33]); o.z = pk2(s[4 * 33], s[5 * 33]); o.w = pk2(s[6 * 33], s[7 * 33]);
        *(GAS v4u*)(WT + (size_t)(drow0 + n) * K + k0 + 8 * c) = o; }
    LDS_WAIT(); asm volatile("" ::: "memory");
}
__device__ __forceinline__ void rms_row_to_bf16(int lane, const float* xrow, const float* g, bf16* orow) {
    const GAS f32x4* xr = (const GAS f32x4*)xrow + lane; const GAS f32x4* gr = (const GAS f32x4*)g + lane;
    f32x4 v[4]; float s = 0.f;
#pragma unroll
    for (int j = 0; j < 4; ++j) { v[j] = xr[64 * j]; s += (v[j].x * v[j].x + v[j].y * v[j].y) + (v[j].z * v[j].z + v[j].w * v[j].w); }
    const float rstd = 1.f / sqrtf(wave_sum(s) * (1.f / D) + EPS);
    GAS unsigned long long* o8 = (GAS unsigned long long*)orow + lane;
#pragma unroll
    for (int j = 0; j < 4; ++j) { const f32x4 gg = gr[64 * j];
        o8[64 * j] = (unsigned long long)pk2(v[j].x * rstd * gg.x, v[j].y * rstd * gg.y) | ((unsigned long long)pk2(v[j].z * rstd * gg.z, v[j].w * rstd * gg.w) << 32); }
}

struct Ptrs {
    const float *x, *g_mix, *w_in, *b_gate, *conv_w, *w_a, *w_b, *w_out, *rel_bias, *g_ffn, *w_g, *w_u, *w_d, *g_final;
    float* out; unsigned char* ws;
};

__device__ __forceinline__ void p0_prologue(Frame& F, const Ptrs& P) {
    LAS float* scr = (LAS float*)(F.lds + RING_OFF + F.wave * 16384);
    const int gw = F.vcu * NWAVES + F.wave, NGW = F.G * NWAVES;
    bf16* WinT = (bf16*)(P.ws + WS_WIN); bf16* WaT = (bf16*)(P.ws + WS_WA); bf16* WbT = (bf16*)(P.ws + WS_WB); bf16* WoutT = (bf16*)(P.ws + WS_WOUT);
    bf16* WguT = (bf16*)(P.ws + WS_WGU); bf16* WdT = (bf16*)(P.ws + WS_WD);
    constexpr int I_IN = (NPROJ / 32) * (D / 64), I_A = (D / 32) * (DCONV / 64), I_B = (D / 32) * (DATT / 64), I_O = (D / 32) * (D / 64), I_GU = (NGU / 32) * (D / 64), I_D = (D / 32) * (FF / 64);
    constexpr int NITEMS = I_IN + I_A + I_B + I_O + I_GU + I_D;
    for (int it = gw; it < NITEMS; it += NGW) {
        int r = it;
        if (r < I_IN) { const int db = r / (D / 64), kb = r % (D / 64), drow0 = 32 * db; int scol0, nvalid;
            if (drow0 < PC_IW) { scol0 = drow0; nvalid = 32; } else if (drow0 == PC_IW) { scol0 = 2752; nvalid = 8; } else if (drow0 < PC_GA) { scol0 = 0; nvalid = 0; } else { scol0 = drow0 - 56; nvalid = 32; }
            p0_transpose_item(P.w_in, D, NPROJ_SRC, 64 * kb, scol0, nvalid, WinT, drow0, nullptr, scr, F.lane); continue; } r -= I_IN;
        if (r < I_A) { const int db = r / (DCONV / 64), kb = r % (DCONV / 64); p0_transpose_item(P.w_a, DCONV, D, 64 * kb, 32 * db, 32, WaT, 32 * db, nullptr, scr, F.lane); continue; } r -= I_A;
        if (r < I_B) { const int db = r / (DATT / 64), kb = r % (DATT / 64); p0_transpose_item(P.w_b, DATT, D, 64 * kb, 32 * db, 32, WbT, 32 * db, nullptr, scr, F.lane); continue; } r -= I_B;
        if (r < I_O) { const int db = r / (D / 64), kb = r % (D / 64); p0_transpose_item(P.w_out, D, D, 64 * kb, 32 * db, 32, WoutT, 32 * db, nullptr, scr, F.lane); continue; } r -= I_O;
        if (r < I_GU) { const int db = r / (D / 64), kb = r % (D / 64), drow0 = 32 * db, p = drow0 >> 8, bj = (drow0 >> 7) & 1, q = (drow0 >> 5) & 3;
            p0_transpose_item(bj ? P.w_u : P.w_g, D, FF, 64 * kb, 128 * p + 32 * q, 32, WguT, drow0, P.g_ffn, scr, F.lane); continue; } r -= I_GU;
        { const int db = r / (FF / 64), kb = r % (FF / 64); p0_transpose_item(P.w_d, FF, D, 64 * kb, 32 * db, 32, WdT, 32 * db, nullptr, scr, F.lane); }
    }
    bf16* XN = (bf16*)(P.ws + WS_XN);
    for (int m = gw; m < M; m += NGW) rms_row_to_bf16(F.lane, P.x + (size_t)m * D, P.g_mix, XN + (size_t)m * D);
}

namespace pg8 {
template <bool ACCUM> struct EpiGate {
    static constexpr bool PERM = true, AFTER_DRAIN = false;
    bf16_t* O; const bf16_t* G; int ldg; const float* bg;
    __device__ __forceinline__ void operator()(const f32x4 (&acc)[2][2][4][2], const Unit& u, int wr, int wc, int fr, int fq) const {
        const int row0 = u.pm * BM + wr * 64 + fr, col0 = u.pn * BM + wc * 32 + 8 * fq;
        f32x4 bv[2][2];
#pragma unroll
        for (int bj = 0; bj < 2; ++bj)
#pragma unroll
            for (int n = 0; n < 2; ++n) bv[bj][n] = *(const f32x4*)(bg + col0 + bj * HALF + 4 * n);
#pragma unroll
        for (int ai = 0; ai < 2; ++ai)
#pragma unroll
            for (int m = 0; m < 4; ++m) { const size_t row = (size_t)(row0 + ai * HALF + m * 16);
#pragma unroll
                for (int bj = 0; bj < 2; ++bj) { const int c = col0 + bj * HALF;
                    const u32x4 gv = *(const u32x4*)(G + row * ldg + c);
                    float g[8] = {bf_lo(gv.x), bf_hi(gv.x), bf_lo(gv.y), bf_hi(gv.y), bf_lo(gv.z), bf_hi(gv.z), bf_lo(gv.w), bf_hi(gv.w)};
                    float o[8];
#pragma unroll
                    for (int k = 0; k < 4; ++k) { o[k] = fast_sigmoid(g[k] + bv[bj][0][k]) * acc[ai][bj][m][0][k]; o[4 + k] = fast_sigmoid(g[4 + k] + bv[bj][1][k]) * acc[ai][bj][m][1][k]; }
                    bf16_t* op = O + row * D + c;
                    if (ACCUM) { const u32x4 ov = *(const u32x4*)op;
                        o[0] += bf_lo(ov.x); o[1] += bf_hi(ov.x); o[2] += bf_lo(ov.y); o[3] += bf_hi(ov.y); o[4] += bf_lo(ov.z); o[5] += bf_hi(ov.z); o[6] += bf_lo(ov.w); o[7] += bf_hi(ov.w); }
                    u32x4 w; w.x = cvt_pk_bf16(o[0], o[1]); w.y = cvt_pk_bf16(o[2], o[3]); w.z = cvt_pk_bf16(o[4], o[5]); w.w = cvt_pk_bf16(o[6], o[7]);
                    *(u32x4*)op = w; }
                asm volatile("" ::: "memory"); }
    }
};
struct EpiResid {
    static constexpr bool PERM = false, AFTER_DRAIN = false;
    const float* base; float* out; bf16_t* XB; float* SSQ;
    __device__ __forceinline__ void operator()(const f32x4 (&acc)[2][2][4][2], const Unit& u, int wr, int wc, int fr, int fq) const {
        typedef unsigned u32x2v __attribute__((ext_vector_type(2)));
        const int row0 = u.pm * BM + wr * 64 + fr, col0 = u.pn * BM + wc * 32 + 4 * fq;
#pragma unroll
        for (int ai = 0; ai < 2; ++ai)
#pragma unroll
            for (int m = 0; m < 4; ++m) { const size_t row = (size_t)(row0 + ai * HALF + m * 16); float ss = 0.f;
#pragma unroll
                for (int bj = 0; bj < 2; ++bj)
#pragma unroll
                    for (int n = 0; n < 2; ++n) { const size_t off = row * D + col0 + bj * HALF + n * 16;
                        const f32x4 o = *(const f32x4*)(base + off) + acc[ai][bj][m][n];
                        *(f32x4*)(out + off) = o;
                        if (XB) { u32x2v w; w.x = cvt_pk_bf16(o[0], o[1]); w.y = cvt_pk_bf16(o[2], o[3]); *(u32x2v*)(XB + off) = w; }
                        ss += (o[0] * o[0] + o[1] * o[1]) + (o[2] * o[2] + o[3] * o[3]); }
                ss += __shfl_xor(ss, 16); ss += __shfl_xor(ss, 32);
                if (fq == 0) SSQ[row * 16 + u.pn * 4 + wc] = ss;
                asm volatile("" ::: "memory"); }
    }
};
struct EpiSwiGLU {
    static constexpr bool PERM = true, AFTER_DRAIN = false;
    bf16_t* O; int ldc; const float* SSQ;
    __device__ __forceinline__ void operator()(const f32x4 (&acc)[2][2][4][2], const Unit& u, int wr, int wc, int fr, int fq) const {
        const int row0 = u.pm * BM + wr * 64 + fr, col0 = u.pn * HALF + wc * 32 + 8 * fq;
#pragma unroll
        for (int ai = 0; ai < 2; ++ai)
#pragma unroll
            for (int m = 0; m < 4; ++m) { const size_t row = (size_t)(row0 + ai * HALF + m * 16);
                const f32x4* sp = (const f32x4*)(SSQ + row * 16); const f32x4 s0 = sp[0], s1 = sp[1], s2 = sp[2], s3 = sp[3];
                const float tot = ((s0[0] + s0[1]) + (s0[2] + s0[3])) + ((s1[0] + s1[1]) + (s1[2] + s1[3])) + ((s2[0] + s2[1]) + (s2[2] + s2[3])) + ((s3[0] + s3[1]) + (s3[2] + s3[3]));
                const float rstd = 1.0f / sqrtf(tot * (1.0f / D) + 1e-6f);
                float o[8];
#pragma unroll
                for (int n = 0; n < 2; ++n)
#pragma unroll
                    for (int k = 0; k < 4; ++k) { const float g = acc[ai][0][m][n][k] * rstd, up = acc[ai][1][m][n][k] * rstd; o[4 * n + k] = g * fast_sigmoid(g) * up; }
                u32x4 w; w.x = cvt_pk_bf16(o[0], o[1]); w.y = cvt_pk_bf16(o[2], o[3]); w.z = cvt_pk_bf16(o[4], o[5]); w.w = cvt_pk_bf16(o[6], o[7]);
                *(u32x4*)(O + row * ldc + col0) = w; }
    }
};
}

__device__ __forceinline__ void p2_conv(Frame& F, const Ptrs& P) {
    const bf16* PROJ = (const bf16*)(P.ws + WS_PROJ); bf16* CONV = (bf16*)(P.ws + WS_CONV);
    const int gt = F.vcu * (NWAVES * 64) + F.tid, NT = F.G * NWAVES * 64;
    for (int item = gt; item < (M / 16) * (DCONV / 8); item += NT) {
        const int cg = item & 63, rb = item >> 6, c0 = 8 * cg, m0 = 16 * rb, t0 = m0 & (SEQ - 1);
        float w[3][8];
#pragma unroll
        for (int j = 0; j < 3; ++j) { const f32x4 a = *(const GAS f32x4*)(P.conv_w + j * DCONV + c0), b = *(const GAS f32x4*)(P.conv_w + j * DCONV + c0 + 4);
            w[j][0] = a.x; w[j][1] = a.y; w[j][2] = a.z; w[j][3] = a.w; w[j][4] = b.x; w[j][5] = b.y; w[j][6] = b.z; w[j][7] = b.w; }
        float u2[8], u1[8];
#pragma unroll
        for (int k = 0; k < 8; ++k) { u2[k] = 0.f; u1[k] = 0.f; }
        if (t0 >= 2) {
#pragma unroll
            for (int d = 0; d < 2; ++d) { const bf16* rp = PROJ + (size_t)(m0 - 2 + d) * NPROJ;
                const v4u cc = *(const GAS v4u*)(rp + PC_CC + c0), cx = *(const GAS v4u*)(rp + PC_CX + c0);
                float* dst = d ? u1 : u2;
                dst[0] = bf_lo(cc.x) * bf_lo(cx.x); dst[1] = bf_hi(cc.x) * bf_hi(cx.x); dst[2] = bf_lo(cc.y) * bf_lo(cx.y); dst[3] = bf_hi(cc.y) * bf_hi(cx.y);
                dst[4] = bf_lo(cc.z) * bf_lo(cx.z); dst[5] = bf_hi(cc.z) * bf_hi(cx.z); dst[6] = bf_lo(cc.w) * bf_lo(cx.w); dst[7] = bf_hi(cc.w) * bf_hi(cx.w); }
        }
#pragma unroll 4
        for (int i = 0; i < 16; ++i) { const bf16* rp = PROJ + (size_t)(m0 + i) * NPROJ;
            const v4u cb = *(const GAS v4u*)(rp + PC_CB + c0), cc = *(const GAS v4u*)(rp + PC_CC + c0), cx = *(const GAS v4u*)(rp + PC_CX + c0);
            float u0[8], b[8];
            u0[0] = bf_lo(cc.x) * bf_lo(cx.x); u0[1] = bf_hi(cc.x) * bf_hi(cx.x); u0[2] = bf_lo(cc.y) * bf_lo(cx.y); u0[3] = bf_hi(cc.y) * bf_hi(cx.y);
            u0[4] = bf_lo(cc.z) * bf_lo(cx.z); u0[5] = bf_hi(cc.z) * bf_hi(cx.z); u0[6] = bf_lo(cc.w) * bf_lo(cx.w); u0[7] = bf_hi(cc.w) * bf_hi(cx.w);
            b[0] = bf_lo(cb.x); b[1] = bf_hi(cb.x); b[2] = bf_lo(cb.y); b[3] = bf_hi(cb.y); b[4] = bf_lo(cb.z); b[5] = bf_hi(cb.z); b[6] = bf_lo(cb.w); b[7] = bf_hi(cb.w);
            float o[8];
#pragma unroll
            for (int k = 0; k < 8; ++k) { o[k] = b[k] * (w[0][k] * u2[k] + w[1][k] * u1[k] + w[2][k] * u0[k]); u2[k] = u1[k]; u1[k] = u0[k]; }
            v4u ov; ov.x = pk2(o[0], o[1]); ov.y = pk2(o[2], o[3]); ov.z = pk2(o[4], o[5]); ov.w = pk2(o[6], o[7]);
            *(GAS v4u*)(CONV + (size_t)(m0 + i) * DCONV + c0) = ov; }
    }
}

typedef float f32x16 __attribute__((ext_vector_type(16)));
typedef short v4i16_t __attribute__((ext_vector_type(4)));
__device__ __forceinline__ int mbcnt64(unsigned long long m) { return (int)__builtin_amdgcn_mbcnt_hi((unsigned)(m >> 32), __builtin_amdgcn_mbcnt_lo((unsigned)m, 0u)); }
__device__ __forceinline__ int wave_sum_i32(int c) {
    c += __builtin_amdgcn_update_dpp(0, c, 0xB1, 0xf, 0xf, true);
    c += __builtin_amdgcn_update_dpp(0, c, 0x4E, 0xf, 0xf, true);
    c += __builtin_amdgcn_update_dpp(0, c, 0x141, 0xf, 0xf, true);
    c += __builtin_amdgcn_update_dpp(0, c, 0x140, 0xf, 0xf, true);
    return __builtin_amdgcn_readlane(c, 0) + __builtin_amdgcn_readlane(c, 16) + __builtin_amdgcn_readlane(c, 32) + __builtin_amdgcn_readlane(c, 48);
}
__device__ __forceinline__ float z_upper(float p) {
    const bool fl = p > 0.5f; const float pp = fl ? 1.0f - p : p;
    const float t = sqrtf(-2.0f * __logf(pp)); const float z = t - (2.30753f + 0.27061f * t) / (1.0f + t * (0.99229f + 0.04481f * t));
    return fl ? -z : z;
}
constexpr int VP = 160;
constexpr int SCR_IDX = 0, SCR_VST = 1024;

__device__ __forceinline__ void p2_attn(Frame& F, const Ptrs& P) {
    const bf16* PROJ = (const bf16*)(P.ws + WS_PROJ); bf16* ATTN = (bf16*)(P.ws + WS_ATTN);
    const int wave = F.wave;
    LAS float* SC = (LAS float*)(F.lds + RING_OFF);
    LAS float* TAB = (LAS float*)(F.lds + TAB_OFF);
    for (int e = F.tid; e < 128 * 8; e += NWAVES * 64) { const int d = e >> 3, h = e & 7; int bk;
        if (d < 16) bk = d; else { bk = 16 + (int)(logf((float)d / 16.0f) / 2.0794415416798357f * 16.0f); bk = bk < 31 ? bk : 31; }
        TAB[e] = P.rel_bias[bk * 8 + h] * 1.4426950408889634f; }
    __syncthreads();
    LAS unsigned char* myrow = F.lds + RING_OFF + wave * 16384;
    LAS unsigned* IDX = (LAS unsigned*)(myrow + SCR_IDX);
    const int nunits = BATCH * (SEQ / 8), per = nunits / F.G;
    for (int j = 0; j < per; ++j) {
        int lane = F.lane; asm volatile("" : "+v"(lane));
        const int r32 = lane & 31, hh = lane >> 5, fr = lane & 15, fq = lane >> 4;
        const int qrho = ((r32 >> 4) & 1) + 2 * ((r32 >> 2) & 1), hrho = (r32 & 3) + 4 * ((r32 >> 3) & 1);
        int b, u8;
        if (F.G == 256) { b = F.vcu >> 5; const int wl = F.vcu & 31; u8 = (j & 1) ? 32 * j + 31 - wl : 32 * j + wl; }
        else { const int unit = j * F.G + F.vcu; b = unit / (SEQ / 8); u8 = unit % (SEQ / 8); }
        const int t0 = 8 * u8;
        const bf16* PB = PROJ + (size_t)b * SEQ * NPROJ;
        {
            bf16x8 afr[2][4]; float w[2][16];
#pragma unroll
            for (int mt = 0; mt < 2; ++mt) { const bf16* qp = PB + (size_t)(t0 + 4 * mt + qrho) * NPROJ + PC_IQ + hrho * 64 + 8 * hh;
#pragma unroll
                for (int ks = 0; ks < 4; ++ks) afr[mt][ks] = *(const GAS bf16x8*)(qp + 16 * ks);
#pragma unroll
                for (int qq = 0; qq < 2; ++qq) { const v4u wv = *(const GAS v4u*)(PB + (size_t)(t0 + 4 * mt + 2 * hh + qq) * NPROJ + PC_IW);
                    const float sc = 0.04419417382415922f;
                    w[mt][8 * qq + 0] = bf_lo(wv.x) * sc; w[mt][8 * qq + 1] = bf_hi(wv.x) * sc; w[mt][8 * qq + 2] = bf_lo(wv.y) * sc; w[mt][8 * qq + 3] = bf_hi(wv.y) * sc;
                    w[mt][8 * qq + 4] = bf_lo(wv.z) * sc; w[mt][8 * qq + 5] = bf_hi(wv.z) * sc; w[mt][8 * qq + 6] = bf_lo(wv.w) * sc; w[mt][8 * qq + 7] = bf_hi(wv.w) * sc; } }
            const int nkt = (t0 + 8 + 31) >> 5;
            for (int kt = wave; kt < nkt; kt += NWAVES) {
                const int s = 32 * kt + r32; const bf16* kp = PB + (size_t)s * NPROJ + PC_IK + 8 * hh;
                bf16x8 bfr[4];
#pragma unroll
                for (int ks = 0; ks < 4; ++ks) bfr[ks] = *(const GAS bf16x8*)(kp + 16 * ks);
#pragma unroll
                for (int mt = 0; mt < 2; ++mt) { f32x16 acc = {};
#pragma unroll
                    for (int ks = 0; ks < 4; ++ks) acc = __builtin_amdgcn_mfma_f32_32x32x16_bf16(afr[mt][ks], bfr[ks], acc, 0, 0, 0);
                    float s0 = 0.f, s1 = 0.f;
#pragma unroll
                    for (int e = 0; e < 8; ++e) { s0 += w[mt][e] * fmaxf(acc[e], 0.f); s1 += w[mt][8 + e] * fmaxf(acc[8 + e], 0.f); }
                    SC[(4 * mt + 2 * hh) * 4096 + s] = s0; SC[(4 * mt + 2 * hh + 1) * 4096 + s] = s1; }
            }
        }
        __syncthreads();
        const int t = t0 + wave, nv = t + 1;
        float hi, lo; int need = 0;
        {
            float v[64]; float s1 = 0.f, s2 = 0.f;
#pragma unroll
            for (int i = 0; i < 16; ++i) { const f32x4 x = *(const LAS f32x4*)(SC + wave * 4096 + 256 * i + 4 * lane);
#pragma unroll
                for (int c = 0; c < 4; ++c) { const bool ok = (256 * i + 4 * lane + c) <= t; const float val = ok ? x[c] : 0.f; s1 += val; s2 += val * val; v[4 * i + c] = ok ? x[c] : -INFINITY; } }
            LDS_WAIT(); asm volatile("" ::: "memory");
            if (nv <= TOPK) { hi = -INFINITY; lo = -INFINITY; }
            else {
                s1 = wave_sum(s1); s2 = wave_sum(s2);
                const float mu = s1 / (float)nv, var = fmaxf(s2 / (float)nv - mu * mu, 0.f), sg = sqrtf(var);
                float tau = mu + z_upper((float)TOPK / (float)nv) * sg;
                float step = fmaxf(0.25f * sg, 1e-6f * (fabsf(mu) + 1e-6f));
                lo = -INFINITY; hi = INFINITY; int clo = nv, chi = 0; float wlo = 1.f, whi = 1.f; int side = 0; bool found = false;
                for (int it = 0; it < 64; ++it) {
                    int c0 = 0, c1 = 0, c2 = 0, c3 = 0;
#pragma unroll
                    for (int i = 0; i < 64; i += 4) { c0 += (v[i] > tau) ? 1 : 0; c1 += (v[i + 1] > tau) ? 1 : 0; c2 += (v[i + 2] > tau) ? 1 : 0; c3 += (v[i + 3] > tau) ? 1 : 0; }
                    const int c = wave_sum_i32((c0 + c1) + (c2 + c3));
                    if (c == TOPK) { found = true; break; }
                    if (c > TOPK) { lo = tau; clo = c; wlo = (float)(c - TOPK); if (side == 1) whi *= 0.5f; side = 1; }
                    else          { hi = tau; chi = c; whi = (float)(TOPK - c); if (side == -1) wlo *= 0.5f; side = -1; }
                    if (lo == -INFINITY) { tau = hi - step; step *= 2.f; }
                    else if (hi == INFINITY) { tau = lo + step; step *= 2.f; }
                    else { float nt = (lo * whi + hi * wlo) / (wlo + whi);
                        if (!(nt > lo && nt < hi)) nt = 0.5f * (lo + hi);
                        if (!(nt > lo && nt < hi)) break;
                        tau = nt; }
                }
                if (found) { hi = tau; lo = tau; need = 0; } else { need = TOPK - chi; (void)clo; }
            }
            int base = 0;
            if (need == 0) {
#pragma unroll
                for (int i = 0; i < 64; ++i) { const bool a = v[i] > hi; const unsigned long long mk = __ballot(a);
                    if (a) IDX[base + mbcnt64(mk)] = (unsigned)(256 * (i >> 2) + 4 * lane + (i & 3));
                    base += __popcll(mk); if ((i & 3) == 3) __builtin_amdgcn_sched_barrier(0); }
            } else {
                int extra = need;
#pragma unroll
                for (int i = 0; i < 64; ++i) { const bool a = v[i] > hi; const bool c = !a && (v[i] > lo);
                    const unsigned long long mc = __ballot(c); const bool take = a || (c && mbcnt64(mc) < extra);
                    const int pc = __popcll(mc); extra -= (pc < extra ? pc : extra);
                    const unsigned long long mk = __ballot(take);
                    if (take) IDX[base + mbcnt64(mk)] = (unsigned)(256 * (i >> 2) + 4 * lane + (i & 3));
                    base += __popcll(mk); if ((i & 3) == 3) __builtin_amdgcn_sched_barrier(0); }
            }
            need = base;
        }
        const int nsel = need;
#pragma unroll
        for (int k = 0; k < 4; ++k) { const int jx = lane + 64 * k; if (jx >= nsel) IDX[jx] = 0u; }
        LDS_WAIT(); asm volatile("" ::: "memory");
        {
            const float c2 = 0.125f * 1.4426950408889634f;
            bf16x8 qf[2];
            { const bf16* qp = PB + (size_t)t * NPROJ + PC_Q + (fr & 7) * 64 + 8 * fq; qf[0] = *(const GAS bf16x8*)qp; qf[1] = *(const GAS bf16x8*)(qp + 32); }
            f32x4 S[16];
#pragma unroll
            for (int jt = 0; jt < 16; ++jt) { const unsigned kidx = IDX[16 * jt + fr]; const bf16* kp = PB + (size_t)kidx * NPROJ + PC_K + 8 * fq;
                const bf16x8 k0 = *(const GAS bf16x8*)kp, k1 = *(const GAS bf16x8*)(kp + 32);
                f32x4 a = {0.f, 0.f, 0.f, 0.f};
                a = __builtin_amdgcn_mfma_f32_16x16x32_bf16(k0, qf[0], a, 0, 0, 0);
                a = __builtin_amdgcn_mfma_f32_16x16x32_bf16(k1, qf[1], a, 0, 0, 0);
                S[jt] = a; if ((jt & 3) == 3) __builtin_amdgcn_sched_barrier(0); }
            float mx = -INFINITY;
#pragma unroll
            for (int jt = 0; jt < 16; ++jt) { const v4u kk = *(const LAS v4u*)(IDX + 16 * jt + 4 * fq);
#pragma unroll
                for (int r = 0; r < 4; ++r) { const int slot = 16 * jt + 4 * fq + r; int dist = t - (int)kk[r]; dist = dist < 127 ? dist : 127; dist = dist > 0 ? dist : 0;
                    const float bias = TAB[dist * 8 + (fr & 7)];
                    const float l2 = (slot < nsel) ? S[jt][r] * c2 + bias : -INFINITY; S[jt][r] = l2; mx = fmaxf(mx, l2); } }
            mx = fmaxf(mx, __shfl_xor(mx, 16)); mx = fmaxf(mx, __shfl_xor(mx, 32));
            float sum = 0.f;
#pragma unroll
            for (int jt = 0; jt < 16; ++jt)
#pragma unroll
                for (int r = 0; r < 4; ++r) { const float p = __builtin_amdgcn_exp2f(S[jt][r] - mx); S[jt][r] = p; sum += p; }
            sum += __shfl_xor(sum, 16); sum += __shfl_xor(sum, 32);
            const float rinv = 1.0f / sum;
            f32x4 O[4];
#pragma unroll
            for (int mt = 0; mt < 4; ++mt) O[mt] = (f32x4){0.f, 0.f, 0.f, 0.f};
            const int R = lane >> 1, half = lane & 1;
            const int fqR = 2 * (R >> 4) + ((R >> 2) & 1), slotR = 16 * ((R >> 3) & 1) + 4 * fqR + (R & 3);
            LAS unsigned char* vst = myrow + SCR_VST;
            const int qq = fr >> 2, pp = fr & 3;
            const int rbase = (16 * (fq >> 1) + 4 * (fq & 1) + qq) * VP + 8 * pp;
#pragma unroll
            for (int kb = 0; kb < 8; ++kb) {
                LAS unsigned char* vb = vst + (kb & 1) * (32 * VP);
                { const unsigned kidx = IDX[32 * kb + slotR]; const bf16* vp = PB + (size_t)kidx * NPROJ + PC_V + 32 * half;
                  const v4u a0 = *(const GAS v4u*)vp, a1 = *(const GAS v4u*)(vp + 8), a2 = *(const GAS v4u*)(vp + 16), a3 = *(const GAS v4u*)(vp + 24);
                  LAS v4u* dst = (LAS v4u*)(vb + R * VP + 64 * half); dst[0] = a0; dst[1] = a1; dst[2] = a2; dst[3] = a3; }
                LDS_WAIT(); asm volatile("" ::: "memory");
                bf16x8 pf;
                { const unsigned p0 = pg8::cvt_pk_bf16(S[2 * kb][0], S[2 * kb][1]), p1 = pg8::cvt_pk_bf16(S[2 * kb][2], S[2 * kb][3]);
                  const unsigned p2 = pg8::cvt_pk_bf16(S[2 * kb + 1][0], S[2 * kb + 1][1]), p3 = pg8::cvt_pk_bf16(S[2 * kb + 1][2], S[2 * kb + 1][3]);
                  pf = __builtin_bit_cast(bf16x8, (v4u){p0, p1, p2, p3}); }
#pragma unroll
                for (int mt = 0; mt < 4; ++mt) {
                    const v4i16_t lo4 = __builtin_amdgcn_ds_read_tr16_b64_v4i16((LAS v4i16_t*)(vb + rbase + 32 * mt));
                    const v4i16_t hi4 = __builtin_amdgcn_ds_read_tr16_b64_v4i16((LAS v4i16_t*)(vb + rbase + 8 * VP + 32 * mt));
                    const bf16x8 vf = (bf16x8){lo4[0], lo4[1], lo4[2], lo4[3], hi4[0], hi4[1], hi4[2], hi4[3]};
                    O[mt] = __builtin_amdgcn_mfma_f32_16x16x32_bf16(vf, pf, O[mt], 0, 0, 0); }
                asm volatile("" ::: "memory");
            }
            if (fr < 8) { bf16* op = ATTN + (size_t)(b * SEQ + t) * DATT + fr * 64 + 4 * fq;
#pragma unroll
                for (int mt = 0; mt < 4; ++mt) { typedef unsigned u32x2v __attribute__((ext_vector_type(2)));
                    u32x2v wv; wv.x = pg8::cvt_pk_bf16(O[mt][0] * rinv, O[mt][1] * rinv); wv.y = pg8::cvt_pk_bf16(O[mt][2] * rinv, O[mt][3] * rinv);
                    *(GAS u32x2v*)(op + 16 * mt) = wv; } }
        }
        LDS_WAIT();
        __syncthreads();
    }
}

__device__ __forceinline__ void p8_final_norm(Frame& F, const Ptrs& P) {
    const int gw = F.vcu * NWAVES + F.wave, NGW = F.G * NWAVES; const float* SSQ = (const float*)(P.ws + WS_SSQ2);
    for (int m = gw; m < M; m += NGW) {
        const float part = (F.lane < 16) ? SSQ[(size_t)m * 16 + F.lane] : 0.f;
        const float rstd = 1.f / sqrtf(wave_sum(part) * (1.f / D) + EPS);
        GAS f32x4* xr = (GAS f32x4*)(P.out + (size_t)m * D) + F.lane; const GAS f32x4* gr = (const GAS f32x4*)P.g_final + F.lane;
#pragma unroll
        for (int j = 0; j < 4; ++j) { const f32x4 v = xr[64 * j], gg = gr[64 * j]; xr[64 * j] = v * rstd * gg; }
    }
}

struct Args { const float* in[14]; float* out; unsigned char* ws; int ph_lo, ph_hi, li, pad; };
__global__ void __launch_bounds__(NWAVES * 64, 2) skel_fwd(Args args) {
    extern __shared__ __attribute__((aligned(16))) unsigned char lds[];
    Frame F;
    F.lds = (LAS unsigned char*)lds;
    F.MISC = (volatile LAS unsigned*)(F.lds + MISC_OFF);
    F.tid = threadIdx.x; F.lane = F.tid & 63; F.wave = __builtin_amdgcn_readfirstlane(F.tid >> 6);
    F.G = gridDim.x; { const int bx = blockIdx.x; F.vcu = (F.G % 8 == 0) ? (bx % 8) * (F.G / 8) + bx / 8 : bx; }
    Ptrs P;
    P.x = args.in[0]; P.g_mix = args.in[1]; P.w_in = args.in[2]; P.b_gate = args.in[3]; P.conv_w = args.in[4]; P.w_a = args.in[5]; P.w_b = args.in[6]; P.w_out = args.in[7];
    P.rel_bias = args.in[8]; P.g_ffn = args.in[9]; P.w_g = args.in[10]; P.w_u = args.in[11]; P.w_d = args.in[12]; P.g_final = args.in[13];
    P.out = args.out; P.ws = args.ws;
    unsigned char* ws = args.ws;
    F.ctl = (gu32*)(ws + WS_CTL);
    for (int u = F.tid; u < (TAB_OFF - LDSCTL_OFF) / 4; u += NWAVES * 64) ((LAS unsigned*)(F.lds + LDSCTL_OFF))[u] = 0u;
    __syncthreads();
    XcdBarrier bar; bar.bar = (unsigned*)(F.ctl + CW_BAR); bar.x = 0; bar.st = nullptr;
    if (N_LAUNCHES == 1) bar = xcd_barrier_post((unsigned*)(F.ctl + CW_BAR), F.MISC + 8);
#define GRID_BAR() do { if (N_LAUNCHES == 1) { xcd_barrier(bar); } } while (0)
    const int lo = args.ph_lo, hi = args.ph_hi;
#define IN(k) (lo <= (k) && (k) < hi)
#define BOTH(k) (IN(k) && IN((k) + 1))
    bf16* XN = (bf16*)(ws + WS_XN); bf16* PROJ = (bf16*)(ws + WS_PROJ); bf16* CONV = (bf16*)(ws + WS_CONV); bf16* ATTN = (bf16*)(ws + WS_ATTN);
    bf16* MERGED = XN; bf16* X1B = CONV; bf16* ACT = PROJ;
    float* SSQ1 = (float*)(ws + WS_SSQ1); float* SSQ2 = (float*)(ws + WS_SSQ2);

    if (IN(0)) { p0_prologue(F, P); if (BOTH(0)) GRID_BAR(); }
    if (IN(1)) {
        pg8::Gemm g{XN, (const bf16*)(ws + WS_WIN), M, NPROJ, D}; pg8::StaticOrder S; S.init(M, NPROJ, F.G, (int)blockIdx.x);
        pg8::EpiBf16<0> E{PROJ, NPROJ, nullptr, 0, 0, 1.f};
        pg8::gemm_phase<pg8::EpiBf16<0>, pg8::StaticOrder, PG8_ALIGN, PG8_SP2>(F.lds + RING_OFF, g, S, E);
        if (BOTH(1)) GRID_BAR();
    }
    if (IN(2)) { p2_conv(F, P); p2_attn(F, P); if (BOTH(2)) GRID_BAR(); }
    if (IN(3)) {
        pg8::Gemm g{CONV, (const bf16*)(ws + WS_WA), M, D, DCONV}; pg8::StaticOrder S; S.init(M, D, F.G, (int)blockIdx.x);
        pg8::EpiGate<false> E{MERGED, PROJ + PC_GA, NPROJ, P.b_gate};
        pg8::gemm_phase<pg8::EpiGate<false>, pg8::StaticOrder, PG8_ALIGN, PG8_SP2>(F.lds + RING_OFF, g, S, E);
        VM_WAIT();
    }
    if (IN(4)) {
        pg8::Gemm g{ATTN, (const bf16*)(ws + WS_WB), M, D, DATT}; pg8::StaticOrder S; S.init(M, D, F.G, (int)blockIdx.x);
        pg8::EpiGate<true> E{MERGED, PROJ + PC_GB, NPROJ, P.b_gate + D};
        pg8::gemm_phase<pg8::EpiGate<true>, pg8::StaticOrder, PG8_ALIGN, PG8_SP2>(F.lds + RING_OFF, g, S, E);
        if (BOTH(4)) GRID_BAR();
    }
    if (IN(5)) {
        pg8::Gemm g{MERGED, (const bf16*)(ws + WS_WOUT), M, D, D}; pg8::StaticOrder S; S.init(M, D, F.G, (int)blockIdx.x);
        pg8::EpiResid E{P.x, P.out, X1B, SSQ1};
        pg8::gemm_phase<pg8::EpiResid, pg8::StaticOrder, PG8_ALIGN, PG8_SP2>(F.lds + RING_OFF, g, S, E);
        if (BOTH(5)) GRID_BAR();
    }
    if (IN(6)) {
        pg8::Gemm g{X1B, (const bf16*)(ws + WS_WGU), M, NGU, D}; pg8::StaticOrder S; S.init(M, NGU, F.G, (int)blockIdx.x);
        pg8::EpiSwiGLU E{ACT, FF, SSQ1};
        pg8::gemm_phase<pg8::EpiSwiGLU, pg8::StaticOrder, PG8_ALIGN, PG8_SP2>(F.lds + RING_OFF, g, S, E);
        if (BOTH(6)) GRID_BAR();
    }
    if (IN(7)) {
        pg8::Gemm g{ACT, (const bf16*)(ws + WS_WD), M, D, FF}; pg8::StaticOrder S; S.init(M, D, F.G, (int)blockIdx.x);
        pg8::EpiResid E{P.out, P.out, nullptr, SSQ2};
        pg8::gemm_phase<pg8::EpiResid, pg8::StaticOrder, PG8_ALIGN, PG8_SP2>(F.lds + RING_OFF, g, S, E);
        if (BOTH(7)) GRID_BAR();
    }
    if (IN(8)) { p8_final_norm(F, P); }
#undef IN
#undef BOTH
#undef GRID_BAR
}

extern "C" void kernel_launch(void* const* d_in, const int* in_sizes, int n_in, void* d_out, int out_size, void* d_ws, size_t ws_size, hipStream_t stream) {
    static int grid = 0;
    if (grid == 0) {
        if (n_in != 14 || in_sizes[0] != M * D || out_size != M * D || ws_size < WS_END) { fprintf(stderr, "kernel_launch: shape/workspace mismatch: n_in %d in0 %d out %d ws %zu (need %zu); nothing launched\n", n_in, n_in > 0 ? in_sizes[0] : -1, out_size, ws_size, (size_t)WS_END); grid = -1; return; }
        int dev = 0, cus = 0, per_cu = 0;
        if (hipGetDevice(&dev) != hipSuccess || hipDeviceGetAttribute(&cus, hipDeviceAttributeMultiprocessorCount, dev) != hipSuccess) { grid = -1; return; }
        if (hipFuncSetAttribute((const void*)skel_fwd, hipFuncAttributeMaxDynamicSharedMemorySize, LDS_BYTES) != hipSuccess) { fprintf(stderr, "kernel_launch: hipFuncSetAttribute failed\n"); grid = -1; return; }
        if (hipOccupancyMaxActiveBlocksPerMultiprocessor(&per_cu, (const void*)skel_fwd, NWAVES * 64, LDS_BYTES) != hipSuccess || per_cu < 1)
            fprintf(stderr, "kernel_launch: note: occupancy query reports %d workgroups per CU\n", per_cu);
        (void)hipGetLastError();
        grid = cus;
    }
    if (grid < 0) return;
    if (hipMemsetAsync((char*)d_ws + WS_CTL, 0, CTL_ZERO_BYTES, stream) != hipSuccess) { fprintf(stderr, "kernel_launch: hipMemsetAsync failed\n"); return; }
    Args a{};
    for (int i = 0; i < 14; ++i) a.in[i] = (const float*)d_in[i];
    a.out = (float*)d_out; a.ws = (unsigned char*)d_ws;
    for (int li = 0; li < N_LAUNCHES; ++li) {
        a.ph_lo = (N_LAUNCHES == PER_PHASE) ? li : 0; a.ph_hi = (N_LAUNCHES == PER_PHASE) ? li + 1 : PER_PHASE; a.li = li;
        hipLaunchKernelGGL(skel_fwd, dim3(grid), dim3(NWAVES * 64), LDS_BYTES, stream, a);
        const hipError_t le = hipPeekAtLastError();
        if (le != hipSuccess) { fprintf(stderr, "kernel_launch: launch %d failed: %s\n", li, hipGetErrorName(le)); break; }
    }
}
```

```cpp
#include <hip/hip_runtime.h>
#include <cstdio>
#include <cstdint>
namespace pg8 {
#define PG8_LAS __attribute__((address_space(3)))
typedef unsigned short bf16_t;
typedef short bf16x8 __attribute__((ext_vector_type(8)));
typedef float f32x4 __attribute__((ext_vector_type(4)));
typedef unsigned u32x4 __attribute__((ext_vector_type(4)));
constexpr int BM = 256, BK = 64, HALF = 128, HTB = HALF * BK * 2  , STAGE_BYTES = 8 * HTB, NXCD = 8, WGM = 8;

__host__ __device__ __forceinline__ int lds_byte(int r, int c) { const int st = (r >> 4) * 2 + (c >> 5), rr = r & 15, cc = c & 31, ob = rr * 64 + cc * 2; return st * 1024 + (ob ^ (((ob >> 9) & 1) << 5)); }
__host__ __device__ __forceinline__ void stage_rc(int b, int& R, int& C) { const int st = b / 1024, sb = b % 1024, swz = sb ^ (((sb >> 9) & 1) << 5); R = (st >> 1) * 16 + swz / 64; C = (st & 1) * 32 + (swz % 64) / 2; }
__host__ __device__ __forceinline__ int perm32(int rho) { const int n = rho >> 4, i = rho & 15; return 8 * (i >> 2) + 4 * n + (i & 3); }

struct Unit { int pm, pn; };
struct Gemm { const bf16_t* A; const bf16_t* Bt; int M, N, K; const bf16_t* Ae = nullptr; const bf16_t* Bte = nullptr; int lde_a = 0, lde_b = 0; };

struct StaticOrder {
    int nM, nN, nwg, G, c;
    __host__ __device__ void init(int M, int N, int G_, int c_) { nM = M / BM; nN = N / BM; nwg = nM * nN; G = G_; c = c_; }
    __host__ __device__ bool next(int i, Unit& u) const {
        const long L = (long)i * G + c; if (L >= nwg) return false;
        int wgid = (int)L; { const int q = nwg / NXCD, r = nwg % NXCD, xcd = wgid % NXCD, off = wgid / NXCD; wgid = (xcd < r ? xcd * (q + 1) : r * (q + 1) + (xcd - r) * q) + off; }
        const int nig = WGM * nN, gid = wgid / nig, fm = gid * WGM, gsz = (nM - fm) < WGM ? (nM - fm) : WGM;
        u.pm = fm + ((wgid % nig) % gsz); u.pn = (wgid % nig) / gsz; return true;
    }
    __device__ __forceinline__ void a_ready(const Unit&) const {}
    __device__ __forceinline__ void done(const Unit&) const {}
};

typedef float f32x2_cv __attribute__((ext_vector_type(2))); typedef __bf16 bf16x2_cv __attribute__((ext_vector_type(2)));
__device__ __forceinline__ unsigned cvt_pk_bf16(float lo, float hi) { f32x2_cv v = {lo, hi}; bf16x2_cv b = __builtin_convertvector(v, bf16x2_cv); return __builtin_bit_cast(unsigned, b); }
typedef float f32x2 __attribute__((ext_vector_type(2)));
__device__ __forceinline__ f32x2 gelu_pk(f32x2 v) {
    const f32x2 av = __builtin_elementwise_abs(v), d = av * 0.2316418882f + 1.0f;
    f32x2 t; t.x = __builtin_amdgcn_rcpf(d.x); t.y = __builtin_amdgcn_rcpf(d.y);
    f32x2 q = t * 0.5307027145f + (-0.7265760135f); q = q * t + 0.7107068705f; q = q * t + (-0.142248368f); q = q * t + 0.127414796f; q = q * t;
    const f32x2 s = (v * v) * (-0.72134752044f);
    f32x2 e; e.x = __builtin_amdgcn_exp2f(s.x); e.y = __builtin_amdgcn_exp2f(s.y);
    const f32x2 m = v * (q * e), r = v - m;
    f32x2 o; o.x = v.x < 0.f ? m.x : r.x; o.y = v.y < 0.f ? m.y : r.y; return o;
}

template <int ACT  > struct EpiBf16 {
    static constexpr bool PERM = true, AFTER_DRAIN = false, HAS_PRE = false, HAS_MID = false, HAS_EXT = false; static_assert(ACT == 0 || ACT == 1, "EpiBf16: ACT is 0 (none) or 1 (gelu_pk)");
    static constexpr int NVM = 0;
    bf16_t* O; int ldc; const float* bias; int split_cols; size_t split_stride; float scale0;
    __device__ __forceinline__ void operator()(const f32x4 (&acc)[2][2][4][2], const Unit& u, int wr, int wc, int fr, int fq) const {
        const int row0 = u.pm * BM + wr * 64 + fr; int colt = u.pn * BM; bf16_t* base = O;
        float sc = 1.f; if (split_cols) { const int t = colt / split_cols; base += (size_t)t * split_stride; colt -= t * split_cols; if (t == 0) sc = scale0; }
        const int col0 = colt + wc * 32 + 8 * fq, bcol0 = u.pn * BM + wc * 32 + 8 * fq;
        f32x4 bv[2][2];
#pragma unroll
        for (int bj = 0; bj < 2; ++bj)
#pragma unroll
            for (int n = 0; n < 2; ++n) bv[bj][n] = bias ? *(const f32x4*)(bias + bcol0 + bj * HALF + 4 * n) : (f32x4){0.f, 0.f, 0.f, 0.f};
#pragma unroll
        for (int ai = 0; ai < 2; ++ai)
#pragma unroll
            for (int m = 0; m < 4; ++m) { bf16_t* rowp = base + (size_t)(row0 + ai * HALF + m * 16) * ldc + col0;
#pragma unroll
                for (int bj = 0; bj < 2; ++bj) { f32x4 v0 = acc[ai][bj][m][0] + bv[bj][0], v1 = acc[ai][bj][m][1] + bv[bj][1];
                    if (ACT == 1) { f32x2 a = gelu_pk((f32x2){v0[0], v0[1]}), b = gelu_pk((f32x2){v0[2], v0[3]}), c = gelu_pk((f32x2){v1[0], v1[1]}), d = gelu_pk((f32x2){v1[2], v1[3]});
                        v0 = (f32x4){a.x, a.y, b.x, b.y}; v1 = (f32x4){c.x, c.y, d.x, d.y}; }
                    v0 = v0 * sc; v1 = v1 * sc; u32x4 w; w.x = cvt_pk_bf16(v0[0], v0[1]); w.y = cvt_pk_bf16(v0[2], v0[3]); w.z = cvt_pk_bf16(v1[0], v1[1]); w.w = cvt_pk_bf16(v1[2], v1[3]);
                    *(u32x4*)(rowp + bj * HALF) = w; } }
    }
};

template <class Epi, class Sched, bool ALIGN_EPI = false, bool SP2 = false>
__device__ __forceinline__ void gemm_phase(PG8_LAS unsigned char* lds, const Gemm g, const Sched& S, const Epi& E) {
    const int tid = threadIdx.x, wid = __builtin_amdgcn_readfirstlane(tid >> 6), lane = tid & 63, wr = wid >> 2, wc = wid & 3, fr = lane & 15, fq = lane >> 4;
    const int K = g.K, ntm = K / BK, nt = ntm + (Epi::HAS_EXT ? BM / BK : 0);
    unsigned voffA[2], voffB[2];
#pragma unroll
    for (int i = 0; i < 2; ++i) { int R, C; stage_rc(tid * 16 + i * 8192, R, C); const int Rb = Epi::PERM ? ((R & ~31) + perm32(R & 31)) : R;
        voffA[i] = (unsigned)(R * K + C) * 2u; voffB[i] = (unsigned)(Rb * K + C) * 2u; }
    unsigned voffAe[2] = {0u, 0u}, voffBe[2] = {0u, 0u};
    if constexpr (Epi::HAS_EXT) {
#pragma unroll
        for (int i = 0; i < 2; ++i) { int R, C; stage_rc(tid * 16 + i * 8192, R, C); const int Rb = Epi::PERM ? ((R & ~31) + perm32(R & 31)) : R;
            voffAe[i] = (unsigned)(R * g.lde_a + C) * 2u; voffBe[i] = (unsigned)(Rb * g.lde_b + C) * 2u; } }
    const size_t hstepAe = (size_t)HALF * g.lde_a * 2, hstepBe = (size_t)HALF * g.lde_b * 2;
    const size_t kstep = (size_t)(BK * 2);
    const size_t hstep = (size_t)HALF * K * 2;
    const size_t tstep = 2 * hstep;
    const unsigned ldsw = (unsigned)wid * 1024u;
    const int aoff = lds_byte(wr * 64 + fr, fq * 8), boff = lds_byte(wc * 32 + fr, fq * 8);
#define PG8_SA(b, h) (((b) * 2 + (h)) * HTB)
#define PG8_SB(b, h) ((4 + (b) * 2 + (h)) * HTB)
#define PG8_STAGE(bufoff, gbase, voff) do { _Pragma("unroll") for (int _i = 0; _i < 2; ++_i) \
        __builtin_amdgcn_global_load_lds((const unsigned*)((const char*)(gbase) + (voff)[_i]), (PG8_LAS unsigned*)(lds + (bufoff) + ldsw + _i * 8192), 16, 0, 0); } while (0)
#define PG8_LDA(dst, b, h) do { _Pragma("unroll") for (int m = 0; m < 4; ++m) _Pragma("unroll") for (int k = 0; k < 2; ++k) dst[m][k] = *(const PG8_LAS bf16x8*)(lds + PG8_SA(b, h) + aoff + m * 2048 + k * 1024); } while (0)
#define PG8_LDB(dst, b, h) do { _Pragma("unroll") for (int n = 0; n < 2; ++n) _Pragma("unroll") for (int k = 0; k < 2; ++k) dst[n][k] = *(const PG8_LAS bf16x8*)(lds + PG8_SB(b, h) + boff + n * 2048 + k * 1024); } while (0)
#define PG8_MMA(ai, bj, At, Bt) do { __builtin_amdgcn_s_setprio(1); _Pragma("unroll") for (int m = 0; m < 4; ++m) _Pragma("unroll") for (int n = 0; n < 2; ++n) _Pragma("unroll") for (int k = 0; k < 2; ++k) \
        acc[ai][bj][m][n] = __builtin_amdgcn_mfma_f32_16x16x32_bf16(Bt[n][k], At[m][k], acc[ai][bj][m][n], 0, 0, 0); __builtin_amdgcn_s_setprio(0); } while (0)
#define PG8_WAIT_V(n) asm volatile("s_waitcnt vmcnt(" #n ")" ::: "memory")
#define PG8_WAIT_VR do { if constexpr (Epi::NVM >= 32) asm volatile("s_waitcnt vmcnt(40)" ::: "memory"); else if constexpr (Epi::NVM >= 16) asm volatile("s_waitcnt vmcnt(24)" ::: "memory"); \
        else if constexpr (Epi::NVM >= 8) asm volatile("s_waitcnt vmcnt(16)" ::: "memory"); else asm volatile("s_waitcnt vmcnt(8)" ::: "memory"); } while (0)
#define PG8_WAIT_L(n) asm volatile("s_waitcnt lgkmcnt(" #n ")" ::: "memory")
#define PG8_BAR __builtin_amdgcn_s_barrier()
#define PG8_SCHED __builtin_amdgcn_sched_barrier(0)
    static_assert(SP2 || !Epi::HAS_EXT, "the K extension is wired into the SP2 loop only");
    Unit cur, nxt; int ui = 0;
    if (!S.next(0, cur)) return;
    f32x4 acc[2][2][4][2];
#pragma unroll
    for (int a = 0; a < 2; ++a)
#pragma unroll
        for (int b = 0; b < 2; ++b)
#pragma unroll
            for (int m = 0; m < 4; ++m)
#pragma unroll
                for (int n = 0; n < 2; ++n) acc[a][b][m][n] = (f32x4){0.f, 0.f, 0.f, 0.f};
    bf16x8 At[4][2], B0[2][2], B1[2][2];
    const char* cA = (const char*)g.A + (size_t)cur.pm * tstep; const char* cB = (const char*)g.Bt + (size_t)cur.pn * tstep;
    const char* eA = Epi::HAS_EXT ? (const char*)g.Ae + ((size_t)cur.pm * BM * g.lde_a + (size_t)cur.pn * BM) * 2 : nullptr; const char* eB = (const char*)g.Bte;
    S.a_ready(cur);
    float carry[8] = {0.f, 0.f, 0.f, 0.f, 0.f, 0.f, 0.f, 0.f};
    if constexpr (Epi::HAS_PRE) E.pre(cur, wr, fr, carry);
    if constexpr (SP2) {
        PG8_STAGE(PG8_SB(0, 0), cB, voffB); PG8_STAGE(PG8_SB(0, 1), cB + hstep, voffB); PG8_STAGE(PG8_SA(0, 0), cA, voffA); PG8_STAGE(PG8_SA(0, 1), cA + hstep, voffA);
        if (wr == 1) PG8_BAR;
        PG8_WAIT_V(2); PG8_BAR;
        PG8_STAGE(PG8_SB(1, 0), cB + kstep, voffB); PG8_STAGE(PG8_SA(1, 0), cA + kstep, voffA); PG8_STAGE(PG8_SB(1, 1), cB + hstep + kstep, voffB);
        PG8_WAIT_V(6); PG8_BAR;
    } else {
        PG8_STAGE(PG8_SB(0, 0), cB, voffB); PG8_STAGE(PG8_SA(0, 0), cA, voffA); PG8_STAGE(PG8_SB(0, 1), cB + hstep, voffB); PG8_STAGE(PG8_SA(0, 1), cA + hstep, voffA);
        if (wr == 1) PG8_BAR;
        PG8_WAIT_V(4); PG8_BAR;
        PG8_STAGE(PG8_SB(1, 0), cB + kstep, voffB); PG8_STAGE(PG8_SA(1, 0), cA + kstep, voffA); PG8_STAGE(PG8_SB(1, 1), cB + hstep + kstep, voffB);
        PG8_WAIT_V(6); PG8_BAR;
    }
    for (;;) {
        const bool has_next = S.next(ui + 1, nxt);
        const char* nA = has_next ? (const char*)g.A + (size_t)nxt.pm * tstep : cA; const char* nB = has_next ? (const char*)g.Bt + (size_t)nxt.pn * tstep : cB;
        int t0 = 0;
        if constexpr (SP2 && ALIGN_EPI && Epi::NVM > 0) { if (ui > 0) {
            const char* pa2 = cA + 2 * kstep; const char* pb2 = cB + 2 * kstep; const char* pa3 = pa2 + kstep; const char* pb3 = pb2 + kstep;


            PG8_LDB(B0, 0, 0); PG8_LDB(B1, 0, 1); PG8_SCHED; PG8_LDA(At, 0, 0);
            PG8_WAIT_VR; PG8_WAIT_L(0); PG8_BAR; PG8_MMA(0, 0, At, B0); PG8_MMA(0, 1, At, B1); PG8_BAR; PG8_SCHED;

            PG8_LDA(At, 0, 1); PG8_STAGE(PG8_SB(0, 0), pb2, voffB); PG8_STAGE(PG8_SB(0, 1), pb2 + hstep, voffB); PG8_STAGE(PG8_SA(0, 0), pa2, voffA);
            PG8_WAIT_VR; PG8_WAIT_L(0); PG8_BAR; PG8_MMA(1, 0, At, B0); PG8_MMA(1, 1, At, B1); PG8_BAR; PG8_SCHED;

            PG8_LDB(B0, 1, 0); PG8_LDB(B1, 1, 1); PG8_SCHED; PG8_LDA(At, 1, 0); PG8_STAGE(PG8_SA(0, 1), pa2 + hstep, voffA);
            PG8_WAIT_VR; PG8_WAIT_L(0); PG8_BAR; PG8_MMA(0, 0, At, B0); PG8_MMA(0, 1, At, B1); PG8_BAR; PG8_SCHED;

            PG8_LDA(At, 1, 1); PG8_STAGE(PG8_SB(1, 0), pb3, voffB); PG8_STAGE(PG8_SB(1, 1), pb3 + hstep, voffB); PG8_STAGE(PG8_SA(1, 0), pa3, voffA);
            PG8_WAIT_V(8); PG8_WAIT_L(0); PG8_BAR; PG8_MMA(1, 0, At, B0); PG8_MMA(1, 1, At, B1); PG8_BAR; PG8_SCHED;
            t0 = 2; } }
        for (int t = t0; t < nt; t += 2) {
            if constexpr (Epi::HAS_MID) { if (t == Epi::MID_T) { __builtin_amdgcn_sched_barrier(0); E.mid(acc, cur, wr, wc, fr, fq); __builtin_amdgcn_sched_barrier(0); } }
            const bool last = (t == nt - 2);
            const bool x1 = Epi::HAS_EXT && t >= ntm, x2 = Epi::HAS_EXT && !last && t + 2 >= ntm;
            const char* a1 = x1 ? eA + (size_t)(t + 1 - ntm) * kstep : cA + (size_t)(t + 1) * kstep;
            const char* a2 = last ? nA : (x2 ? eA + (size_t)(t + 2 - ntm) * kstep : cA + (size_t)(t + 2) * kstep);
            const char* b2 = last ? nB : (x2 ? eB + (size_t)(t + 2 - ntm) * kstep : cB + (size_t)(t + 2) * kstep);
            const char* a3 = a2 + kstep; const char* b3 = b2 + kstep;
            const size_t hA1 = x1 ? hstepAe : hstep, hA2 = x2 ? hstepAe : hstep, hB2 = x2 ? hstepBe : hstep;
            unsigned vA1[2], vA2[2], vB2[2];
#pragma unroll
            for (int i = 0; i < 2; ++i) { vA1[i] = x1 ? voffAe[i] : voffA[i]; vA2[i] = x2 ? voffAe[i] : voffA[i]; vB2[i] = x2 ? voffBe[i] : voffB[i]; }
            if (last && has_next) S.a_ready(nxt);
            if constexpr (SP2) {
            PG8_LDB(B0, 0, 0); PG8_LDB(B1, 0, 1); PG8_SCHED; PG8_LDA(At, 0, 0); PG8_STAGE(PG8_SA(1, 1), a1 + hA1, vA1);
            PG8_WAIT_V(8); PG8_WAIT_L(0); PG8_BAR; PG8_MMA(0, 0, At, B0); PG8_MMA(0, 1, At, B1); PG8_BAR; PG8_SCHED;
            PG8_LDA(At, 0, 1); PG8_STAGE(PG8_SB(0, 0), b2, vB2); PG8_STAGE(PG8_SB(0, 1), b2 + hB2, vB2); PG8_STAGE(PG8_SA(0, 0), a2, vA2);
            PG8_WAIT_V(8); PG8_WAIT_L(0); PG8_BAR; PG8_MMA(1, 0, At, B0); PG8_MMA(1, 1, At, B1); PG8_BAR; PG8_SCHED;
            PG8_LDB(B0, 1, 0); PG8_LDB(B1, 1, 1); PG8_SCHED; PG8_LDA(At, 1, 0); PG8_STAGE(PG8_SA(0, 1), a2 + hA2, vA2);
            PG8_WAIT_V(8); PG8_WAIT_L(0); PG8_BAR; PG8_MMA(0, 0, At, B0); PG8_MMA(0, 1, At, B1); PG8_BAR; PG8_SCHED;
            PG8_LDA(At, 1, 1); PG8_STAGE(PG8_SB(1, 0), b3, vB2); PG8_STAGE(PG8_SB(1, 1), b3 + hB2, vB2); PG8_STAGE(PG8_SA(1, 0), a3, vA2);
            PG8_WAIT_V(8); PG8_WAIT_L(0); PG8_BAR; PG8_MMA(1, 0, At, B0); PG8_MMA(1, 1, At, B1); PG8_BAR; PG8_SCHED;
            } else {
            PG8_LDB(B0, 0, 0); PG8_SCHED; PG8_LDA(At, 0, 0); PG8_STAGE(PG8_SA(1, 1), a1 + hstep, voffA);
            PG8_WAIT_L(8); PG8_BAR; PG8_WAIT_L(0); PG8_MMA(0, 0, At, B0); PG8_BAR; PG8_SCHED;
            PG8_LDB(B1, 0, 1); PG8_STAGE(PG8_SB(0, 0), b2, voffB);
            PG8_BAR; PG8_WAIT_L(0); PG8_MMA(0, 1, At, B1); PG8_BAR;
            PG8_LDA(At, 0, 1); PG8_STAGE(PG8_SA(0, 0), a2, voffA);
            PG8_BAR; PG8_WAIT_L(0); PG8_MMA(1, 0, At, B0); PG8_BAR; PG8_SCHED;
            PG8_STAGE(PG8_SB(0, 1), b2 + hstep, voffB);
            PG8_WAIT_V(6); PG8_BAR; PG8_MMA(1, 1, At, B1); PG8_BAR;
            PG8_LDB(B0, 1, 0); PG8_SCHED; PG8_LDA(At, 1, 0); PG8_STAGE(PG8_SA(0, 1), a2 + hstep, voffA);
            PG8_WAIT_L(8); PG8_BAR; PG8_WAIT_L(0); PG8_MMA(0, 0, At, B0); PG8_BAR; PG8_SCHED;
            PG8_LDB(B1, 1, 1); PG8_STAGE(PG8_SB(1, 0), b3, voffB);
            PG8_BAR; PG8_WAIT_L(0); PG8_MMA(0, 1, At, B1); PG8_BAR;
            PG8_LDA(At, 1, 1); PG8_STAGE(PG8_SA(1, 0), a3, voffA);
            PG8_BAR; PG8_WAIT_L(0); PG8_MMA(1, 0, At, B0); PG8_BAR; PG8_SCHED;
            PG8_STAGE(PG8_SB(1, 1), b3 + hstep, voffB);
            PG8_WAIT_V(6); PG8_BAR; PG8_MMA(1, 1, At, B1); PG8_BAR;
            }
        }
        if constexpr (ALIGN_EPI) { if (wr == 0) PG8_BAR; }
        if constexpr (SP2 && ALIGN_EPI && Epi::NVM > 0) { if (has_next) PG8_STAGE(PG8_SA(1, 1), nA + kstep + hstep, voffA); asm volatile("" ::: "memory"); PG8_SCHED; }
        if constexpr (!Epi::AFTER_DRAIN) { if constexpr (Epi::HAS_PRE) { E.run(acc, cur, wr, wc, fr, fq, carry); if (has_next) E.pre(nxt, wr, fr, carry); } else E(acc, cur, wr, wc, fr, fq); S.done(cur); }
        if (!has_next) break;
#pragma unroll
        for (int a = 0; a < 2; ++a)
#pragma unroll
            for (int b = 0; b < 2; ++b)
#pragma unroll
                for (int m = 0; m < 4; ++m)
#pragma unroll
                    for (int n = 0; n < 2; ++n) { acc[a][b][m][n] = (f32x4){0.f, 0.f, 0.f, 0.f}; asm volatile("" : "+v"(acc[a][b][m][n])); }
        cur = nxt; cA = nA; cB = nB; ++ui;
        if constexpr (Epi::HAS_EXT) eA = (const char*)g.Ae + ((size_t)cur.pm * BM * g.lde_a + (size_t)cur.pn * BM) * 2;
        if constexpr (ALIGN_EPI) { if (wr == 1) PG8_BAR; }
    }
    PG8_WAIT_V(0);
    if constexpr (!ALIGN_EPI) { if (wr == 0) PG8_BAR; }
    PG8_BAR;
    if constexpr (Epi::AFTER_DRAIN) { E.fused(acc, cur, wr, wc, fr, fq, lds, wid, lane); S.done(cur); }
#undef PG8_SA
#undef PG8_SB
#undef PG8_STAGE
#undef PG8_LDA
#undef PG8_LDB
#undef PG8_MMA
#undef PG8_WAIT_V
#undef PG8_WAIT_L
#undef PG8_BAR
#undef PG8_SCHED
}
}

#ifndef PG8_SP2
#define PG8_SP2 true
#endif
#ifndef PG8_ALIGN
#define PG8_ALIGN true
#endif
#define GAS __attribute__((address_space(1)))
#define LAS __attribute__((address_space(3)))
typedef unsigned short bf16;
typedef unsigned v4u __attribute__((ext_vector_type(4)));
typedef float f32x4 __attribute__((ext_vector_type(4)));
typedef short bf16x8 __attribute__((ext_vector_type(8)));
typedef GAS unsigned gu32;
typedef GAS unsigned long long gu64;
#define RLX_AGENT __ATOMIC_RELAXED, __HIP_MEMORY_SCOPE_AGENT
#define LDS_WAIT() asm volatile("s_waitcnt lgkmcnt(0)" ::: "memory")
#define VM_WAIT() asm volatile("s_waitcnt vmcnt(0)" ::: "memory")
__device__ __forceinline__ unsigned long long rt() { return __builtin_amdgcn_s_memrealtime(); }
__device__ __forceinline__ unsigned f2bf(float f) { unsigned u = __builtin_bit_cast(unsigned, f); return (u + 0x7fffu + ((u >> 16) & 1u)) >> 16; }
__device__ __forceinline__ unsigned pk2(float lo, float hi) { return f2bf(lo) | (f2bf(hi) << 16); }

#define XB_TMO      128
#define XB_XCNT(j)  (256  + 64 * (j))
#define XB_XSUB(j)  (1280 + 64 * (j))
#define XB_XGEN(j)  (2304 + 64 * (j))
#define XB_TOP      3328
#define XB_TOPGEN   3392
#define XCD_BAR_WORDS 3456
#define XB_SPIN_CAP (1u << 18)

__device__ __forceinline__ unsigned xb_ld(unsigned* p)              { return __hip_atomic_load(p, __ATOMIC_RELAXED, __HIP_MEMORY_SCOPE_AGENT); }
__device__ __forceinline__ unsigned xb_add(unsigned* p, unsigned v) { return __hip_atomic_fetch_add(p, v, __ATOMIC_RELAXED, __HIP_MEMORY_SCOPE_AGENT); }
__device__ __forceinline__ unsigned xb_xcc_id() { return (unsigned)__builtin_amdgcn_s_getreg((3 << 11) | 20) & 0xFu; }
#define XB_SPIN(cond, bar) do { unsigned _sp = 0; while (cond) { __builtin_amdgcn_s_sleep(1); \
    if ((++_sp & 255u) == 0u) { if (xb_ld(&(bar)[XB_TMO])) break; if (_sp > XB_SPIN_CAP) { atomicAdd(&(bar)[XB_TMO], 1u); break; } } } } while (0)

struct XcdBarrier {
    unsigned* bar; unsigned x;
    volatile LAS unsigned* st;
};

__device__ __forceinline__ XcdBarrier xcd_barrier_post(unsigned* bar, volatile LAS unsigned* st) {
    XcdBarrier b; b.bar = bar; b.x = xb_xcc_id(); b.st = st;
    if (threadIdx.x == 0) (void)xb_add(&bar[XB_XCNT(b.x)], 1u);
    return b;
}
__device__ __forceinline__ void xcd_barrier_complete(unsigned* bar, unsigned x, unsigned& nloc, unsigned& nx) {
    const unsigned G = gridDim.x * gridDim.y * gridDim.z;
    unsigned sum, cnt, mine, sp = 0u;
    for (;;) {
        sum = 0u; cnt = 0u; mine = 0u;
#pragma unroll
        for (unsigned j = 0; j < 16; ++j) { const unsigned c = xb_ld(&bar[XB_XCNT(j)]); sum += c; cnt += (c > 0u) ? 1u : 0u; mine = (j == x) ? c : mine; }
        if (sum == G) break;
        __builtin_amdgcn_s_sleep(1);
        if ((++sp & 255u) == 0u) { if (xb_ld(&bar[XB_TMO])) break; if (sp > XB_SPIN_CAP) { atomicAdd(&bar[XB_TMO], 1u); break; } }
    }
    nloc = mine > 0u ? mine : 1u; nx = cnt > 0u ? cnt : 1u;
}

__device__ __forceinline__ void xcd_barrier(const XcdBarrier& b) {
    asm volatile("s_waitcnt vmcnt(0)" ::: "memory");
    __syncthreads();
    if (threadIdx.x == 0) {
        unsigned* bar = b.bar;
        __builtin_amdgcn_s_waitcnt(0);
        unsigned nloc = b.st[0], nx = b.st[1];
        if (nloc == 0u) { xcd_barrier_complete(bar, b.x, nloc, nx); b.st[0] = nloc; b.st[1] = nx; }
        const unsigned old = xb_add(&bar[XB_XSUB(b.x)], 1u);
        const unsigned gen = old / nloc;
        if (old + 1u == (gen + 1u) * nloc) {
            __builtin_amdgcn_fence(__ATOMIC_RELEASE, "agent");
            asm volatile("s_waitcnt vmcnt(0)" ::: "memory");
            const unsigned og = xb_add(&bar[XB_TOP], 1u);
            const unsigned tg = og / nx;
            if (og + 1u == (tg + 1u) * nx) xb_add(&bar[XB_TOPGEN], 1u);
            else XB_SPIN(xb_ld(&bar[XB_TOPGEN]) == tg, bar);
            __builtin_amdgcn_fence(__ATOMIC_ACQUIRE, "agent");
            xb_add(&bar[XB_XGEN(b.x)], 1u);
            asm volatile("s_waitcnt vmcnt(0)" ::: "memory");
        } else {
            XB_SPIN(xb_ld(&bar[XB_XGEN(b.x)]) == gen, bar);
            __builtin_amdgcn_fence(__ATOMIC_ACQUIRE, "agent");
            asm volatile("s_waitcnt vmcnt(0)" ::: "memory");
        }
    }
    __syncthreads();
}

constexpr int NWAVES = 8;
#ifndef MK_N_LAUNCHES
#define MK_N_LAUNCHES 1
#endif
constexpr int PER_PHASE = 9;
constexpr int N_LAUNCHES = MK_N_LAUNCHES;
static_assert(N_LAUNCHES == 1 || N_LAUNCHES == PER_PHASE, "MK_N_LAUNCHES is 1 or 9");

constexpr int BATCH = 8, SEQ = 4096, D = 1024, M = BATCH * SEQ;
constexpr int DCONV = 512, DATT = 512, NH = 8, HD = 64, FF = 2816, NGU = 2 * FF;
constexpr int NPROJ_SRC = 4808, NPROJ = 4864;
constexpr int PC_CB = 0, PC_CC = 512, PC_CX = 1024, PC_Q = 1536, PC_IQ = 2048, PC_KVI = 2560, PC_GA = 2816, PC_GB = 3840;
constexpr int KVP = 128, KV_K = 0, KV_V = 64;
constexpr float EPS = 1e-6f;
constexpr int TOPK = 256;

constexpr size_t MiB = 1u << 20;
constexpr size_t WS_CTL = 0, CTL_ZERO_BYTES = 1 * MiB;
constexpr size_t WS_SSQ1 = 256 * 1024, WS_SSQ2 = 512 * 1024;
constexpr size_t WS_RC = 896 * 1024;
constexpr size_t WS_IDENT = 768 * 1024;
constexpr int BM256 = 256;
constexpr size_t WS_WIN = 6 * MiB, WS_WA = 16 * MiB, WS_WB = 17 * MiB, WS_WOUT = 18 * MiB, WS_WGU = 20 * MiB, WS_WD = 31 * MiB;
constexpr size_t WS_XN = 40 * MiB;
constexpr size_t WS_CONV = 104 * MiB, WS_ATTN = 136 * MiB;
constexpr size_t WS_PROJ = 168 * MiB;
constexpr size_t WS_KVI = 472 * MiB;
constexpr size_t WS_IKF = 480 * MiB, WS_IW = 484 * MiB;
constexpr size_t WS_SSQ0 = WS_IW + 3 * MiB;
constexpr size_t WS_END = 488 * MiB;
static_assert(WS_WIN + (size_t)NPROJ * D * 2 <= WS_WA && WS_WGU + (size_t)NGU * D * 2 <= WS_WD && WS_WD + (size_t)D * FF * 2 <= WS_XN, "weights map");
static_assert(WS_PROJ + (size_t)M * NPROJ * 2 <= WS_KVI && WS_KVI + (size_t)M * KVP * 2 <= WS_IKF && WS_IKF + (size_t)M * 64 * 2 <= WS_IW && WS_IW + (size_t)M * 16 <= WS_END && WS_XN + (size_t)M * D * 2 <= WS_CONV && WS_ATTN + (size_t)M * 512 * 2 <= WS_PROJ, "activation map");
constexpr int CW_BAR = 4096;

constexpr int RING_OFF = 0, RING_BYTES = 131072;
constexpr int LDSCTL_OFF = RING_BYTES, MISC_OFF = LDSCTL_OFF + 320;
constexpr int TAB_OFF = RING_BYTES + 1024;
constexpr int LDS_BYTES = 147456;
static_assert(MISC_OFF + 128 <= TAB_OFF && TAB_OFF + 4096 <= LDS_BYTES, "LDS map");

struct Frame {
    LAS unsigned char* lds;
    volatile LAS unsigned* MISC;
    gu32* ctl;
    int tid, lane, wave;
    int vcu, G;
};

__device__ __forceinline__ float wave_sum(float v) {
#pragma unroll
    for (int o = 1; o < 64; o <<= 1) v += __shfl_xor(v, o);
    return v;
}
__device__ __forceinline__ float bf_lo(unsigned w) { return __builtin_bit_cast(float, w << 16); }
__device__ __forceinline__ float bf_hi(unsigned w) { return __builtin_bit_cast(float, w & 0xffff0000u); }
__device__ __forceinline__ float fast_sigmoid(float z) { return __builtin_amdgcn_rcpf(1.0f + __builtin_amdgcn_exp2f(-1.4426950408889634f * z)); }

__device__ __forceinline__ void p0_transpose_item(const float* W, int K, int N, int k0, int scol0, int nvalid, bf16* WT, int drow0, const float* kscale, LAS float* scr, int lane, int ldk = 0, int kd0 = -1) {
    if (ldk == 0) ldk = K; if (kd0 < 0) kd0 = k0;
    const int kr = lane >> 3, j4 = lane & 7;
    f32x4 v[8];
#pragma unroll
    for (int i = 0; i < 8; ++i) { v[i] = (f32x4){0.f, 0.f, 0.f, 0.f};
        if (4 * j4 < nvalid) v[i] = *(const GAS f32x4*)(W + (size_t)(k0 + 8 * i + kr) * N + scol0 + 4 * j4); }
    if (kscale) {
#pragma unroll
        for (int i = 0; i < 8; ++i) v[i] = v[i] * kscale[k0 + 8 * i + kr]; }
#pragma unroll
    for (int i = 0; i < 8; ++i) { LAS float* d = scr + (8 * i + kr) * 33 + 4 * j4; d[0] = v[i].x; d[1] = v[i].y; d[2] = v[i].z; d[3] = v[i].w; }
    LDS_WAIT(); asm volatile("" ::: "memory");
    const int c = lane & 7;
#pragma unroll
    for (int jj = 0; jj < 4; ++jj) { const int n = (lane >> 3) + 8 * jj; const LAS float* s = scr + (8 * c) * 33 + n;
        v4u o; o.x = pk2(s[0 * 33], s[1 * 33]); o.y = pk2(s[2 * 33], s[3 * 33]); o.z = pk2(s[4 * 33], s[5 * 33]); o.w = pk2(s[6 * 33], s[7 * 33]);
        *(GAS v4u*)(WT + (size_t)(drow0 + n) * ldk + kd0 + 8 * c) = o; }
    LDS_WAIT(); asm volatile("" ::: "memory");
}
__device__ __forceinline__ void rms_rows2_to_bf16(int lane, const float* xrow0, const float* xrow1, const float* g, bf16* orow0, bf16* orow1) {
    const GAS f32x4* xa = (const GAS f32x4*)xrow0 + lane; const GAS f32x4* xb = (const GAS f32x4*)xrow1 + lane; const GAS f32x4* gr = (const GAS f32x4*)g + lane;
    f32x4 va[4], vb[4]; float sa = 0.f, sb = 0.f;
#pragma unroll
    for (int j = 0; j < 4; ++j) { va[j] = xa[64 * j]; vb[j] = xb[64 * j]; }
#pragma unroll
    for (int j = 0; j < 4; ++j) { sa += (va[j].x * va[j].x + va[j].y * va[j].y) + (va[j].z * va[j].z + va[j].w * va[j].w); sb += (vb[j].x * vb[j].x + vb[j].y * vb[j].y) + (vb[j].z * vb[j].z + vb[j].w * vb[j].w); }
#pragma unroll
    for (int o = 1; o < 64; o <<= 1) { sa += __shfl_xor(sa, o); sb += __shfl_xor(sb, o); }
    const float ra = 1.f / sqrtf(sa * (1.f / D) + EPS), rb = 1.f / sqrtf(sb * (1.f / D) + EPS);
    GAS unsigned long long* oa = (GAS unsigned long long*)orow0 + lane; GAS unsigned long long* ob = (GAS unsigned long long*)orow1 + lane;
#pragma unroll
    for (int j = 0; j < 4; ++j) { const f32x4 gg = gr[64 * j];
        oa[64 * j] = (unsigned long long)pk2(va[j].x * ra * gg.x, va[j].y * ra * gg.y) | ((unsigned long long)pk2(va[j].z * ra * gg.z, va[j].w * ra * gg.w) << 32);
        ob[64 * j] = (unsigned long long)pk2(vb[j].x * rb * gg.x, vb[j].y * rb * gg.y) | ((unsigned long long)pk2(vb[j].z * rb * gg.z, vb[j].w * rb * gg.w) << 32); }
}

__device__ __forceinline__ void x_rows2_to_bf16(int lane, const float* xrow0, const float* xrow1, bf16* orow0, bf16* orow1, float* ss0, float* ss1) {
    const GAS f32x4* xa = (const GAS f32x4*)xrow0 + lane; const GAS f32x4* xb = (const GAS f32x4*)xrow1 + lane;
    f32x4 va[4], vb[4]; float sa = 0.f, sb = 0.f;
#pragma unroll
    for (int j = 0; j < 4; ++j) { va[j] = xa[64 * j]; vb[j] = xb[64 * j]; }
    GAS unsigned long long* oa = (GAS unsigned long long*)orow0 + lane; GAS unsigned long long* ob = (GAS unsigned long long*)orow1 + lane;
#pragma unroll
    for (int j = 0; j < 4; ++j) { sa += (va[j].x * va[j].x + va[j].y * va[j].y) + (va[j].z * va[j].z + va[j].w * va[j].w); sb += (vb[j].x * vb[j].x + vb[j].y * vb[j].y) + (vb[j].z * vb[j].z + vb[j].w * vb[j].w);
        oa[64 * j] = (unsigned long long)pk2(va[j].x, va[j].y) | ((unsigned long long)pk2(va[j].z, va[j].w) << 32);
        ob[64 * j] = (unsigned long long)pk2(vb[j].x, vb[j].y) | ((unsigned long long)pk2(vb[j].z, vb[j].w) << 32); }
#pragma unroll
    for (int o = 1; o < 64; o <<= 1) { sa += __shfl_xor(sa, o); sb += __shfl_xor(sb, o); }
    if (lane == 0) { *ss0 = sa; *ss1 = sb; }
}

struct Ptrs {
    const float *x, *g_mix, *w_in, *b_gate, *conv_w, *w_a, *w_b, *w_out, *rel_bias, *g_ffn, *w_g, *w_u, *w_d, *g_final;
    float* out; unsigned char* ws;
};

constexpr int PI_IN = (NPROJ / 32) * (D / 64), PI_A = (D / 32) * (DCONV / 64), PI_B = (D / 32) * (DATT / 64), PI_O = (D / 32) * (D / 64), PI_GU = (NGU / 32) * (D / 64), PI_D = (D / 32) * (FF / 64);
constexpr int PI_ALL = PI_IN + PI_A + PI_B + PI_O + PI_GU + PI_D;
__device__ __forceinline__ void p0_weight_items(Frame& F, const Ptrs& P, int lo, int hi, int gw, int NGW) {
    LAS float* scr = (LAS float*)(F.lds + RING_OFF + F.wave * 16384);
    bf16* WinT = (bf16*)(P.ws + WS_WIN); bf16* WaT = (bf16*)(P.ws + WS_WA); bf16* WbT = (bf16*)(P.ws + WS_WB); bf16* WoutT = (bf16*)(P.ws + WS_WOUT);
    bf16* WguT = (bf16*)(P.ws + WS_WGU); bf16* WdT = (bf16*)(P.ws + WS_WD);
    for (int it = lo + gw; it < hi; it += NGW) {
        int r = it;
        if (r < PI_IN) { const int db = r / (D / 64), kb = r % (D / 64), drow0 = 32 * db; int scol0, nvalid;
            if (drow0 < 2048) { scol0 = drow0; nvalid = 32; }
            else if (drow0 < 2560) { scol0 = drow0 + 128; nvalid = 32; }
            else if (drow0 < 2688) { scol0 = drow0 - 512; nvalid = 32; }
            else if (drow0 < 2752) { scol0 = drow0; nvalid = 32; }
            else if (drow0 == 2752) { scol0 = 2752; nvalid = 8; }
            else if (drow0 < PC_GA) { scol0 = 0; nvalid = 0; }
            else { scol0 = drow0 - 56; nvalid = 32; }
            p0_transpose_item(P.w_in, D, NPROJ_SRC, 64 * kb, scol0, nvalid, WinT, drow0, P.g_mix, scr, F.lane); continue; } r -= PI_IN;
        if (r < PI_A) { const int db = r / (DCONV / 64), kb = r % (DCONV / 64); p0_transpose_item(P.w_a, DCONV, D, 64 * kb, 32 * db, 32, WaT, 32 * db, nullptr, scr, F.lane, D, 64 * kb); continue; } r -= PI_A;
        if (r < PI_B) { const int db = r / (DATT / 64), kb = r % (DATT / 64); p0_transpose_item(P.w_b, DATT, D, 64 * kb, 32 * db, 32, WaT, 32 * db, nullptr, scr, F.lane, D, DCONV + 64 * kb); continue; } r -= PI_B;
        if (r < PI_O) { const int db = r / (D / 64), kb = r % (D / 64); p0_transpose_item(P.w_out, D, D, 64 * kb, 32 * db, 32, WoutT, 32 * db, nullptr, scr, F.lane); continue; } r -= PI_O;
        if (r < PI_GU) { const int db = r / (D / 64), kb = r % (D / 64), drow0 = 32 * db, p = drow0 >> 8, bj = (drow0 >> 7) & 1, q = (drow0 >> 5) & 3;
            p0_transpose_item(bj ? P.w_u : P.w_g, D, FF, 64 * kb, 128 * p + 32 * q, 32, WguT, drow0, P.g_ffn, scr, F.lane); continue; } r -= PI_GU;
        { const int db = r / (FF / 64), kb = r % (FF / 64); p0_transpose_item(P.w_d, FF, D, 64 * kb, 32 * db, 32, WdT, 32 * db, nullptr, scr, F.lane); }
    }
}
__device__ __forceinline__ void p0_prologue(Frame& F, const Ptrs& P, bool all_weights) {
    const int gw = F.vcu * NWAVES + F.wave, NGW = F.G * NWAVES;
    p0_weight_items(F, P, 0, all_weights ? PI_ALL : PI_IN, gw, NGW);
    bf16* XB = (bf16*)P.out; float* SSQ0 = (float*)(P.ws + WS_SSQ0);
    for (int m = gw; m < M; m += 2 * NGW) { const int m1 = (m + NGW < M) ? m + NGW : m;
        x_rows2_to_bf16(F.lane, P.x + (size_t)m * D, P.x + (size_t)m1 * D, XB + (size_t)m * D, XB + (size_t)m1 * D, SSQ0 + m, SSQ0 + m1); }
}

namespace pg8 {
struct EpiProj {
    static constexpr bool PERM = true, AFTER_DRAIN = false, HAS_PRE = true, HAS_MID = false, HAS_EXT = false;
    static constexpr int NVM = 16;
    bf16_t* O; int ldc; bf16_t* KV; bf16_t* IKF; bf16_t* IW; int kv_tile; PG8_LAS const float* bgate; int gate_col0; bf16_t* JUNK; const float* SSQ; PG8_LAS float* RS;
    __device__ __forceinline__ void pre(const Unit& u, int wr, int fr, float (&carry)[8]) const {
        const int have = __builtin_amdgcn_readfirstlane(__builtin_bit_cast(int, carry[0])) - 1;
        if (u.pm != have) { const int par = __builtin_amdgcn_readfirstlane(__builtin_bit_cast(int, carry[1])) ^ 1; const int t = threadIdx.x;
            if (t < BM) RS[par * BM + t] = 1.0f / sqrtf(SSQ[u.pm * BM + t] * (1.0f / D) + 1e-6f);
            carry[0] = __builtin_bit_cast(float, u.pm + 1); carry[1] = __builtin_bit_cast(float, par); }
    }
    template <bool GATE> __device__ __forceinline__ void body(const f32x4 (&acc)[2][2][4][2], const Unit& u, int wr, int wc, int fr, int fq, const float (&carry)[8]) const {
        int row0 = u.pm * BM + wr * 64 + fr; const bool kv = !GATE && (u.pn == kv_tile); int cid = 4 * wc + fq;
        asm volatile("" : "+v"(row0), "+v"(cid));
        const PG8_LAS float* rs = RS + __builtin_amdgcn_readfirstlane(__builtin_bit_cast(int, carry[1])) * BM + wr * 64 + fr;
        float rst[8];
#pragma unroll
        for (int ai = 0; ai < 2; ++ai)
#pragma unroll
            for (int m = 0; m < 4; ++m) rst[4 * ai + m] = rs[ai * HALF + m * 16];
        f32x4 gb0[2], gb1[2];
#pragma unroll
        for (int bj = 0; bj < 2; ++bj) { gb0[bj] = (f32x4){0.f, 0.f, 0.f, 0.f}; gb1[bj] = gb0[bj];
            if (GATE) { PG8_LAS const float* bp = bgate + (u.pn * BM - gate_col0) + bj * HALF + 8 * cid; gb0[bj] = *(PG8_LAS const f32x4*)bp; gb1[bj] = *(PG8_LAS const f32x4*)(bp + 4); } }
#pragma unroll
        for (int ai = 0; ai < 2; ++ai)
#pragma unroll
            for (int m = 0; m < 4; ++m) { const int row = row0 + ai * HALF + m * 16;
#pragma unroll
                for (int bj = 0; bj < 2; ++bj) { f32x4 v0 = acc[ai][bj][m][0] * rst[4 * ai + m], v1 = acc[ai][bj][m][1] * rst[4 * ai + m];
                    if (GATE) {
                        v0 = v0 + gb0[bj]; v1 = v1 + gb1[bj]; unsigned q[8];
#pragma unroll
                        for (int k = 0; k < 4; ++k) { q[k] = (unsigned)__builtin_amdgcn_fmed3f(fast_sigmoid(v0[k]) * 256.0f + 0.5f, 1.0f, 255.0f); q[4 + k] = (unsigned)__builtin_amdgcn_fmed3f(fast_sigmoid(v1[k]) * 256.0f + 0.5f, 1.0f, 255.0f); }
                        typedef unsigned u32x2g __attribute__((ext_vector_type(2)));
                        u32x2g w8; w8.x = q[0] | (q[1] << 8) | (q[2] << 16) | (q[3] << 24); w8.y = q[4] | (q[5] << 8) | (q[6] << 16) | (q[7] << 24);
                        *(u32x2g*)((unsigned char*)(O + (size_t)row * ldc + gate_col0) + (u.pn * BM - gate_col0) + bj * HALF + 8 * cid) = w8;
                        continue; }
                    u32x4 w; w.x = cvt_pk_bf16(v0[0], v0[1]); w.y = cvt_pk_bf16(v0[2], v0[3]); w.z = cvt_pk_bf16(v1[0], v1[1]); w.w = cvt_pk_bf16(v1[2], v1[3]);
                    if (!kv) *(u32x4*)(O + (size_t)row * ldc + u.pn * BM + bj * HALF + 8 * cid) = w;
                    else if (bj == 0) *(u32x4*)(KV + (size_t)row * 128 + 8 * cid) = w;
                    else if (cid < 8) { const int s = row & 4095; *(u32x4*)(IKF + (size_t)(row >> 12) * (4096 * 64) + (s >> 5) * 2048 + cid * 256 + (s & 31) * 8) = w; }
                    else if (cid == 8) *(u32x4*)(IW + (size_t)row * 8) = w;
                    else *(u32x4*)(JUNK + (size_t)(row & 1023) * 8) = w; } }
    }
    __device__ __forceinline__ void run(const f32x4 (&acc)[2][2][4][2], const Unit& u, int wr, int wc, int fr, int fq, const float (&carry)[8]) const {
        if (u.pn * BM >= gate_col0) body<true>(acc, u, wr, wc, fr, fq, carry); else body<false>(acc, u, wr, wc, fr, fq, carry);
    }
};
template <bool ACCUM> struct EpiGate {
    static constexpr bool PERM = true, AFTER_DRAIN = false, HAS_PRE = false, HAS_MID = false, HAS_EXT = false;
    static constexpr int NVM = 0;
    bf16_t* O; const bf16_t* G; int ldg; const float* bg;
    __device__ __forceinline__ void operator()(const f32x4 (&acc)[2][2][4][2], const Unit& u, int wr, int wc, int fr, int fq) const {
        const int row0 = u.pm * BM + wr * 64 + fr, col0 = u.pn * BM + wc * 32 + 8 * fq;
        f32x4 bv[2][2];
#pragma unroll
        for (int bj = 0; bj < 2; ++bj)
#pragma unroll
            for (int n = 0; n < 2; ++n) bv[bj][n] = *(const f32x4*)(bg + col0 + bj * HALF + 4 * n);
#pragma unroll
        for (int ai = 0; ai < 2; ++ai) {
            u32x4 gv[4][2], ov[4][2];
#pragma unroll
            for (int m = 0; m < 4; ++m) { const size_t row = (size_t)(row0 + ai * HALF + m * 16);
#pragma unroll
                for (int bj = 0; bj < 2; ++bj) { gv[m][bj] = *(const u32x4*)(G + row * ldg + col0 + bj * HALF); if (ACCUM) ov[m][bj] = *(const u32x4*)(O + row * D + col0 + bj * HALF); } }
#pragma unroll
            for (int m = 0; m < 4; ++m) { const size_t row = (size_t)(row0 + ai * HALF + m * 16);
#pragma unroll
                for (int bj = 0; bj < 2; ++bj) { const u32x4 g4 = gv[m][bj];
                    float g[8] = {bf_lo(g4.x), bf_hi(g4.x), bf_lo(g4.y), bf_hi(g4.y), bf_lo(g4.z), bf_hi(g4.z), bf_lo(g4.w), bf_hi(g4.w)};
                    float o[8];
#pragma unroll
                    for (int k = 0; k < 4; ++k) { o[k] = fast_sigmoid(g[k] + bv[bj][0][k]) * acc[ai][bj][m][0][k]; o[4 + k] = fast_sigmoid(g[4 + k] + bv[bj][1][k]) * acc[ai][bj][m][1][k]; }
                    if (ACCUM) { const u32x4 o4 = ov[m][bj];
                        o[0] += bf_lo(o4.x); o[1] += bf_hi(o4.x); o[2] += bf_lo(o4.y); o[3] += bf_hi(o4.y); o[4] += bf_lo(o4.z); o[5] += bf_hi(o4.z); o[6] += bf_lo(o4.w); o[7] += bf_hi(o4.w); }
                    u32x4 w; w.x = cvt_pk_bf16(o[0], o[1]); w.y = cvt_pk_bf16(o[2], o[3]); w.z = cvt_pk_bf16(o[4], o[5]); w.w = cvt_pk_bf16(o[6], o[7]);
                    *(u32x4*)(O + row * D + col0 + bj * HALF) = w; } }
            asm volatile("" ::: "memory"); }
    }
};
struct EpiGateMerged {
    static constexpr bool PERM = true, AFTER_DRAIN = false, HAS_PRE = false, HAS_MID = true, HAS_EXT = false; static constexpr int MID_T = 8;
    static constexpr int NVM = 16;
    bf16_t* O; const unsigned char* G8; int ldgb;
    typedef unsigned u32x2g __attribute__((ext_vector_type(2)));
    static __device__ __forceinline__ void unpack8(u32x2g g, float (&f)[8]) {
        f[0] = (float)(g.x & 255u); f[1] = (float)((g.x >> 8) & 255u); f[2] = (float)((g.x >> 16) & 255u); f[3] = (float)(g.x >> 24);
        f[4] = (float)(g.y & 255u); f[5] = (float)((g.y >> 8) & 255u); f[6] = (float)((g.y >> 16) & 255u); f[7] = (float)(g.y >> 24); }
    __device__ __forceinline__ void mid(f32x4 (&acc)[2][2][4][2], const Unit& u, int wr, int wc, int fr, int fq) const {
        int row0 = u.pm * BM + wr * 64 + fr, col0 = u.pn * BM + wc * 32 + 8 * fq;
        asm volatile("" : "+v"(row0), "+v"(col0));
#pragma unroll
        for (int bj = 0; bj < 2; ++bj) {
            u32x2g ga[2][4], gb[2][4];
#pragma unroll
            for (int ai = 0; ai < 2; ++ai)
#pragma unroll
                for (int m = 0; m < 4; ++m) { const unsigned char* gp = G8 + (size_t)(row0 + ai * HALF + m * 16) * ldgb + col0 + bj * HALF;
                    ga[ai][m] = *(const u32x2g*)gp; gb[ai][m] = *(const u32x2g*)(gp + D); }
#pragma unroll
            for (int ai = 0; ai < 2; ++ai)
#pragma unroll
                for (int m = 0; m < 4; ++m) { float xa[8], xb[8]; unpack8(ga[ai][m], xa); unpack8(gb[ai][m], xb);
#pragma unroll
                    for (int k = 0; k < 4; ++k) { acc[ai][bj][m][0][k] *= xa[k] * __builtin_amdgcn_rcpf(xb[k]); acc[ai][bj][m][1][k] *= xa[4 + k] * __builtin_amdgcn_rcpf(xb[4 + k]); } }
            asm volatile("" ::: "memory"); }
    }
    __device__ __forceinline__ void operator()(const f32x4 (&acc)[2][2][4][2], const Unit& u, int wr, int wc, int fr, int fq) const {
        int row0 = u.pm * BM + wr * 64 + fr, col0 = u.pn * BM + wc * 32 + 8 * fq;
        asm volatile("" : "+v"(row0), "+v"(col0));
        u32x2g gb[2][4][2];
#pragma unroll
        for (int ai = 0; ai < 2; ++ai)
#pragma unroll
            for (int m = 0; m < 4; ++m) { const unsigned char* gp = G8 + (size_t)(row0 + ai * HALF + m * 16) * ldgb + D + col0;
#pragma unroll
                for (int bj = 0; bj < 2; ++bj) gb[ai][m][bj] = *(const u32x2g*)(gp + bj * HALF); }
#pragma unroll
        for (int ai = 0; ai < 2; ++ai) {
#pragma unroll
            for (int m = 0; m < 4; ++m) { const size_t row = (size_t)(row0 + ai * HALF + m * 16);
#pragma unroll
                for (int bj = 0; bj < 2; ++bj) { float xb[8]; unpack8(gb[ai][m][bj], xb);
                    float o[8];
#pragma unroll
                    for (int k = 0; k < 4; ++k) { o[k] = (xb[k] * 0.00390625f) * acc[ai][bj][m][0][k]; o[4 + k] = (xb[4 + k] * 0.00390625f) * acc[ai][bj][m][1][k]; }
                    u32x4 w; w.x = cvt_pk_bf16(o[0], o[1]); w.y = cvt_pk_bf16(o[2], o[3]); w.z = cvt_pk_bf16(o[4], o[5]); w.w = cvt_pk_bf16(o[6], o[7]);
                    *(u32x4*)(O + row * D + col0 + bj * HALF) = w; } }
            asm volatile("" ::: "memory"); }
    }
};
template <int MODE> struct EpiResid {
    static constexpr bool PERM = false, AFTER_DRAIN = false, HAS_PRE = false, HAS_MID = false, HAS_EXT = (MODE == 2);
    static constexpr int NVM = 32;
    const float* base; const bf16_t* XBin; bf16_t* XB; float* SSQ;
    __device__ __forceinline__ void operator()(const f32x4 (&acc)[2][2][4][2], const Unit& u, int wr, int wc, int fr, int fq) const {
        typedef unsigned u32x2v __attribute__((ext_vector_type(2)));
        const int row0 = u.pm * BM + wr * 64 + fr, col0 = u.pn * BM + wc * 32 + 4 * fq;
#pragma unroll
        for (int ai = 0; ai < 2; ++ai) {
            f32x4 xf[4][2][2]; u32x2v xh[4][2][2];
#pragma unroll
            for (int m = 0; m < 4; ++m) { const size_t row = (size_t)(row0 + ai * HALF + m * 16);
#pragma unroll
                for (int bj = 0; bj < 2; ++bj)
#pragma unroll
                    for (int n = 0; n < 2; ++n) { const size_t off = row * D + col0 + bj * HALF + n * 16;
                        if (MODE == 0) xf[m][bj][n] = *(const f32x4*)(base + off); else if (MODE == 1) xh[m][bj][n] = *(const u32x2v*)(XBin + off); } }
#pragma unroll
            for (int m = 0; m < 4; ++m) { const size_t row = (size_t)(row0 + ai * HALF + m * 16); float ss = 0.f;
#pragma unroll
                for (int bj = 0; bj < 2; ++bj)
#pragma unroll
                    for (int n = 0; n < 2; ++n) { const size_t off = row * D + col0 + bj * HALF + n * 16;
                        f32x4 o;
                        if (MODE == 0) o = xf[m][bj][n] + acc[ai][bj][m][n];
                        else if (MODE == 2) o = acc[ai][bj][m][n];
                        else { const u32x2v xb = xh[m][bj][n]; o = (f32x4){bf_lo(xb.x), bf_hi(xb.x), bf_lo(xb.y), bf_hi(xb.y)} + acc[ai][bj][m][n]; }
                        u32x2v w; w.x = cvt_pk_bf16(o[0], o[1]); w.y = cvt_pk_bf16(o[2], o[3]); *(u32x2v*)(XB + off) = w;
                        ss += (o[0] * o[0] + o[1] * o[1]) + (o[2] * o[2] + o[3] * o[3]); }
                ss += __shfl_xor(ss, 16); ss += __shfl_xor(ss, 32);
                if (fq == 0) __hip_atomic_fetch_add(SSQ + row, ss, __ATOMIC_RELAXED, __HIP_MEMORY_SCOPE_AGENT); }
            asm volatile("" ::: "memory"); }
    }
};
struct EpiFinal {
    static constexpr bool PERM = false, AFTER_DRAIN = false, HAS_PRE = false, HAS_MID = false, HAS_EXT = true;
    static constexpr int NVM = 32;
    float* OUT; float* SSQ; const float* gfin; unsigned* RC; unsigned* tmo;
    __device__ __forceinline__ void operator()(const f32x4 (&acc)[2][2][4][2], const Unit& u, int wr, int wc, int fr, int fq) const {
        const int row0 = u.pm * BM + wr * 64 + fr, col0 = u.pn * BM + wc * 32 + 4 * fq;
#pragma unroll
        for (int ai = 0; ai < 2; ++ai)
#pragma unroll
            for (int m = 0; m < 4; ++m) { float ss = 0.f;
#pragma unroll
                for (int bj = 0; bj < 2; ++bj)
#pragma unroll
                    for (int n = 0; n < 2; ++n) { const f32x4 o = acc[ai][bj][m][n]; ss += (o[0] * o[0] + o[1] * o[1]) + (o[2] * o[2] + o[3] * o[3]); }
                ss += __shfl_xor(ss, 16); ss += __shfl_xor(ss, 32);
                if (fq == 0) __hip_atomic_fetch_add(SSQ + (size_t)(row0 + ai * HALF + m * 16), ss, __ATOMIC_RELAXED, __HIP_MEMORY_SCOPE_AGENT); }
        f32x4 gg[2][2];
#pragma unroll
        for (int bj = 0; bj < 2; ++bj)
#pragma unroll
            for (int n = 0; n < 2; ++n) gg[bj][n] = *(const f32x4*)(gfin + col0 + bj * HALF + n * 16);
        asm volatile("s_waitcnt vmcnt(0)" ::: "memory");
        __builtin_amdgcn_s_barrier();
        if (threadIdx.x == 0) { unsigned* rc = RC + u.pm; (void)__hip_atomic_fetch_add(rc, 1u, __ATOMIC_RELAXED, __HIP_MEMORY_SCOPE_AGENT);
            unsigned sp = 0;
            while (__hip_atomic_load(rc, __ATOMIC_RELAXED, __HIP_MEMORY_SCOPE_AGENT) < 4u) { __builtin_amdgcn_s_sleep(1);
                if ((++sp & 255u) == 0u) { if (__hip_atomic_load(tmo, __ATOMIC_RELAXED, __HIP_MEMORY_SCOPE_AGENT)) break; if (sp > (1u << 18)) { atomicAdd(tmo, 1u); break; } } } }
        __builtin_amdgcn_s_barrier();
        float rs[2][4];
#pragma unroll
        for (int ai = 0; ai < 2; ++ai)
#pragma unroll
            for (int m = 0; m < 4; ++m) { const unsigned b = __hip_atomic_load((const unsigned*)(SSQ + (size_t)(row0 + ai * HALF + m * 16)), __ATOMIC_RELAXED, __HIP_MEMORY_SCOPE_AGENT);
                rs[ai][m] = 1.f / sqrtf(__builtin_bit_cast(float, b) * (1.f / D) + EPS); }
#pragma unroll
        for (int ai = 0; ai < 2; ++ai) {
#pragma unroll
            for (int m = 0; m < 4; ++m) { const size_t row = (size_t)(row0 + ai * HALF + m * 16);
#pragma unroll
                for (int bj = 0; bj < 2; ++bj)
#pragma unroll
                    for (int n = 0; n < 2; ++n) *(f32x4*)(OUT + row * D + col0 + bj * HALF + n * 16) = acc[ai][bj][m][n] * rs[ai][m] * gg[bj][n]; }
            asm volatile("" ::: "memory"); }
    }
};
struct EpiSwiGLU {
    static constexpr bool PERM = true, AFTER_DRAIN = false, HAS_PRE = true, HAS_MID = false, HAS_EXT = false;
    static constexpr int NVM = 8;
    bf16_t* O; int ldc; const float* SSQ; PG8_LAS float* RS;
    __device__ __forceinline__ void pre(const Unit& u, int wr, int fr, float (&carry)[8]) const {
        const int have = __builtin_amdgcn_readfirstlane(__builtin_bit_cast(int, carry[0])) - 1;
        if (u.pm != have) { const int par = __builtin_amdgcn_readfirstlane(__builtin_bit_cast(int, carry[1])) ^ 1; const int t = threadIdx.x;
            if (t < BM) RS[par * BM + t] = 1.0f / sqrtf(SSQ[u.pm * BM + t] * (1.0f / D) + 1e-6f);
            carry[0] = __builtin_bit_cast(float, u.pm + 1); carry[1] = __builtin_bit_cast(float, par); }
    }
    __device__ __forceinline__ void run(const f32x4 (&acc)[2][2][4][2], const Unit& u, int wr, int wc, int fr, int fq, const float (&carry)[8]) const {
        int row0 = u.pm * BM + wr * 64 + fr, col0 = u.pn * HALF + wc * 32 + 8 * fq;
        asm volatile("" : "+v"(row0), "+v"(col0));
        const PG8_LAS float* rs = RS + __builtin_amdgcn_readfirstlane(__builtin_bit_cast(int, carry[1])) * BM + wr * 64 + fr;
        float rst[8];
#pragma unroll
        for (int ai = 0; ai < 2; ++ai)
#pragma unroll
            for (int m = 0; m < 4; ++m) rst[4 * ai + m] = rs[ai * HALF + m * 16];
#pragma unroll
        for (int ai = 0; ai < 2; ++ai)
#pragma unroll
            for (int m = 0; m < 4; ++m) { const size_t row = (size_t)(row0 + ai * HALF + m * 16);
                const float rstd = rst[4 * ai + m];
                float o[8];
#pragma unroll
                for (int n = 0; n < 2; ++n)
#pragma unroll
                    for (int k = 0; k < 4; ++k) { const float g = acc[ai][0][m][n][k] * rstd, up = acc[ai][1][m][n][k] * rstd; o[4 * n + k] = g * fast_sigmoid(g) * up; }
                u32x4 w; w.x = cvt_pk_bf16(o[0], o[1]); w.y = cvt_pk_bf16(o[2], o[3]); w.z = cvt_pk_bf16(o[4], o[5]); w.w = cvt_pk_bf16(o[6], o[7]);
                *(u32x4*)(O + row * ldc + col0) = w; }
    }
};
}

__device__ __forceinline__ void p2_conv(Frame& F, const Ptrs& P) {
    const bf16* PROJ = (const bf16*)(P.ws + WS_PROJ); bf16* CONV = (bf16*)(P.ws + WS_CONV);
    const int gt = F.vcu * (NWAVES * 64) + F.tid, NT = F.G * NWAVES * 64;
    for (int item = gt; item < (M / 16) * (DCONV / 8); item += NT) {
        const int cg = item & 63, rb = item >> 6, c0 = 8 * cg, m0 = 16 * rb, t0 = m0 & (SEQ - 1);
        float w[3][8];
#pragma unroll
        for (int j = 0; j < 3; ++j) { const f32x4 a = *(const GAS f32x4*)(P.conv_w + j * DCONV + c0), b = *(const GAS f32x4*)(P.conv_w + j * DCONV + c0 + 4);
            w[j][0] = a.x; w[j][1] = a.y; w[j][2] = a.z; w[j][3] = a.w; w[j][4] = b.x; w[j][5] = b.y; w[j][6] = b.z; w[j][7] = b.w; }
        float u2[8], u1[8];
#pragma unroll
        for (int k = 0; k < 8; ++k) { u2[k] = 0.f; u1[k] = 0.f; }
        if (t0 >= 2) {
#pragma unroll
            for (int d = 0; d < 2; ++d) { const bf16* rp = PROJ + (size_t)(m0 - 2 + d) * NPROJ;
                const v4u cc = *(const GAS v4u*)(rp + PC_CC + c0), cx = *(const GAS v4u*)(rp + PC_CX + c0);
                float* dst = d ? u1 : u2;
                dst[0] = bf_lo(cc.x) * bf_lo(cx.x); dst[1] = bf_hi(cc.x) * bf_hi(cx.x); dst[2] = bf_lo(cc.y) * bf_lo(cx.y); dst[3] = bf_hi(cc.y) * bf_hi(cx.y);
                dst[4] = bf_lo(cc.z) * bf_lo(cx.z); dst[5] = bf_hi(cc.z) * bf_hi(cx.z); dst[6] = bf_lo(cc.w) * bf_lo(cx.w); dst[7] = bf_hi(cc.w) * bf_hi(cx.w); }
        }
#pragma unroll 4
        for (int i = 0; i < 16; ++i) { const bf16* rp = PROJ + (size_t)(m0 + i) * NPROJ;
            const v4u cb = *(const GAS v4u*)(rp + PC_CB + c0), cc = *(const GAS v4u*)(rp + PC_CC + c0), cx = *(const GAS v4u*)(rp + PC_CX + c0);
            float u0[8], b[8];
            u0[0] = bf_lo(cc.x) * bf_lo(cx.x); u0[1] = bf_hi(cc.x) * bf_hi(cx.x); u0[2] = bf_lo(cc.y) * bf_lo(cx.y); u0[3] = bf_hi(cc.y) * bf_hi(cx.y);
            u0[4] = bf_lo(cc.z) * bf_lo(cx.z); u0[5] = bf_hi(cc.z) * bf_hi(cx.z); u0[6] = bf_lo(cc.w) * bf_lo(cx.w); u0[7] = bf_hi(cc.w) * bf_hi(cx.w);
            b[0] = bf_lo(cb.x); b[1] = bf_hi(cb.x); b[2] = bf_lo(cb.y); b[3] = bf_hi(cb.y); b[4] = bf_lo(cb.z); b[5] = bf_hi(cb.z); b[6] = bf_lo(cb.w); b[7] = bf_hi(cb.w);
            float o[8];
#pragma unroll
            for (int k = 0; k < 8; ++k) { o[k] = b[k] * (w[0][k] * u2[k] + w[1][k] * u1[k] + w[2][k] * u0[k]); u2[k] = u1[k]; u1[k] = u0[k]; }
            v4u ov; ov.x = pk2(o[0], o[1]); ov.y = pk2(o[2], o[3]); ov.z = pk2(o[4], o[5]); ov.w = pk2(o[6], o[7]);
            *(GAS v4u*)(CONV + (size_t)(m0 + i) * D + c0) = ov; }
    }
}

typedef float f32x16 __attribute__((ext_vector_type(16)));
typedef short v4i16_t __attribute__((ext_vector_type(4)));
__device__ __forceinline__ int mbcnt64(unsigned long long m) { return (int)__builtin_amdgcn_mbcnt_hi((unsigned)(m >> 32), __builtin_amdgcn_mbcnt_lo((unsigned)m, 0u)); }
__device__ __forceinline__ int wave_sum_i32(int c) {
    c += __builtin_amdgcn_update_dpp(0, c, 0xB1, 0xf, 0xf, true);
    c += __builtin_amdgcn_update_dpp(0, c, 0x4E, 0xf, 0xf, true);
    c += __builtin_amdgcn_update_dpp(0, c, 0x141, 0xf, 0xf, true);
    c += __builtin_amdgcn_update_dpp(0, c, 0x140, 0xf, 0xf, true);
    return __builtin_amdgcn_readlane(c, 0) + __builtin_amdgcn_readlane(c, 16) + __builtin_amdgcn_readlane(c, 32) + __builtin_amdgcn_readlane(c, 48);
}
__device__ __forceinline__ float z_upper(float p) {
    const bool fl = p > 0.5f; const float pp = fl ? 1.0f - p : p;
    const float t = sqrtf(-2.0f * __logf(pp)); const float z = t - (2.30753f + 0.27061f * t) / (1.0f + t * (0.99229f + 0.04481f * t));
    return fl ? -z : z;
}
constexpr int KPB_UNUSED = 144;
constexpr int VP_UNUSED = 160;
constexpr int SCR_VST = 0;
constexpr int IDX_OFF = TAB_OFF + 4096;
constexpr int CW_Q = 2048;
static_assert(IDX_OFF + 8 * 1280 <= LDS_BYTES, "LDS map (P2)");

__device__ __forceinline__ float fadd_np(float a, float b) { float r; asm("v_add_f32_e32 %0, %1, %2" : "=v"(r) : "v"(a), "v"(b)); return r; }
#define P2_DPPF(c, ctrl) ((c) + __builtin_bit_cast(float, __builtin_amdgcn_update_dpp(0, __builtin_bit_cast(int, (c)), (ctrl), 0xf, 0xf, true)))
__device__ __forceinline__ float wave_total_f32(float c) {
    c = P2_DPPF(c, 0xB1); c = P2_DPPF(c, 0x4E); c = P2_DPPF(c, 0x141); c = P2_DPPF(c, 0x140);
    return __builtin_bit_cast(float, __builtin_amdgcn_readlane(__builtin_bit_cast(int, c), 0)) + __builtin_bit_cast(float, __builtin_amdgcn_readlane(__builtin_bit_cast(int, c), 16)) +
           __builtin_bit_cast(float, __builtin_amdgcn_readlane(__builtin_bit_cast(int, c), 32)) + __builtin_bit_cast(float, __builtin_amdgcn_readlane(__builtin_bit_cast(int, c), 48));
}
template <int NR> __device__ __forceinline__ float lane_count_gt(const float (&v)[64], float tau) {
    const float BIG = 0x1p100f, nb = -tau * BIG; float c0 = 0.f, c1 = 0.f, c2 = 0.f, c3 = 0.f;
#pragma unroll
    for (int i = 0; i < NR; i += 4) {
        c0 = fadd_np(c0, __builtin_amdgcn_fmed3f(__builtin_fmaf(v[i], BIG, nb), 0.f, 1.f)); c1 = fadd_np(c1, __builtin_amdgcn_fmed3f(__builtin_fmaf(v[i + 1], BIG, nb), 0.f, 1.f));
        c2 = fadd_np(c2, __builtin_amdgcn_fmed3f(__builtin_fmaf(v[i + 2], BIG, nb), 0.f, 1.f)); c3 = fadd_np(c3, __builtin_amdgcn_fmed3f(__builtin_fmaf(v[i + 3], BIG, nb), 0.f, 1.f)); }
    return (c0 + c1) + (c2 + c3);
}
template <int NR> __device__ __forceinline__ float lane_count_valid(const float (&v)[64]) {
    float c = 0.f;
#pragma unroll
    for (int i = 0; i < NR; ++i) c += (v[i] > -INFINITY) ? 1.f : 0.f;
    return c;
}
constexpr int P2_MAXPROBE = 8;
template <int NR> __device__ __forceinline__ void topk_search(const float (&v)[64], int nv, float mu, float sg, float& lo_o, float& hi_o, int& need_o, float& nhi_o, float& nlo_o) {
    float tau = mu + z_upper((float)TOPK / (float)nv) * sg;
    float step = fmaxf(0.25f * sg, 1e-6f * (fabsf(mu) + 1e-6f));
    const float wmin = 1e-6f * sg;
    float lo = -INFINITY, hi = INFINITY; int clo = nv, chi = 0; int k = 0; bool found = false; float cl = 0.f, nhi = 0.f, nlo = -1.f;
    const float lt = __builtin_amdgcn_logf((float)TOPK + 0.5f);
    for (int it = 0; it < P2_MAXPROBE; ++it) {
        cl = lane_count_gt<NR>(v, tau);
        const int c = (int)(wave_total_f32(cl) + 0.5f);
        if (c == TOPK) { found = true; break; }
        if (c > TOPK) { lo = tau; clo = c; nlo = cl; } else { hi = tau; chi = c; nhi = cl; }
        if (lo == -INFINITY) { tau = hi - step; step *= 2.f; }
        else if (hi == INFINITY) { tau = lo + step; step *= 2.f; }
        else {
            if (hi - lo < wmin) break;
            ++k; float nt;
            if (k % 3 == 0) nt = 0.5f * (lo + hi);
            else { const float a = __builtin_amdgcn_logf((float)clo + 0.5f), bb = __builtin_amdgcn_logf((float)chi + 0.5f); float f = (a - lt) * __builtin_amdgcn_rcpf(a - bb); f = fminf(fmaxf(f, 0.1f), 0.9f); nt = lo + (hi - lo) * f; }
            if (!(nt > lo && nt < hi)) nt = 0.5f * (lo + hi);
            if (!(nt > lo && nt < hi)) break;
            tau = nt;
        }
    }
    if (found) { lo_o = tau; hi_o = tau; need_o = 0; nhi_o = cl; nlo_o = cl; }
    else { if (hi == INFINITY) { hi = 3.0e38f; chi = 0; nhi = 0.f; }
        if (nlo < 0.f) nlo = lane_count_valid<NR>(v);
        lo_o = lo; hi_o = hi; need_o = TOPK - chi; nhi_o = nhi; nlo_o = nlo; }
}
constexpr int IDXW = 320;
__device__ __forceinline__ int lane_scan_incl(int x, int lane) {
    x += __builtin_amdgcn_update_dpp(0, x, 0x111, 0xf, 0xf, true); x += __builtin_amdgcn_update_dpp(0, x, 0x112, 0xf, 0xf, true);
    x += __builtin_amdgcn_update_dpp(0, x, 0x114, 0xf, 0xf, true); x += __builtin_amdgcn_update_dpp(0, x, 0x118, 0xf, 0xf, true);
    const int r0 = __builtin_amdgcn_readlane(x, 15), r1 = __builtin_amdgcn_readlane(x, 31), r2 = __builtin_amdgcn_readlane(x, 47);
    return x + (lane >= 16 ? r0 : 0) + (lane >= 32 ? r1 : 0) + (lane >= 48 ? r2 : 0);
}
template <int NR> __device__ __forceinline__ void topk_compact_lane(const float (&v)[64], float thr, int cnt, LAS unsigned* IDX, int lane) {
    int k = lane_scan_incl(cnt, lane) - cnt; const int dump = 256 + lane;
#pragma unroll
    for (int i = 0; i < NR; ++i) { const bool a = v[i] > thr; IDX[a ? k : dump] = (unsigned)(512 * (i >> 3) + 8 * lane + (i & 7)); k += a ? 1 : 0; }
}
template <int NR> __device__ __forceinline__ void topk_compact_bracket(const float (&v)[64], float lo, float hi, int need, float nhi_f, float nlo_f, LAS unsigned* IDX, int lane) {
    const int nhi = (int)(nhi_f + 0.5f), nb = (int)(nlo_f + 0.5f) - nhi;
    const int pb = lane_scan_incl(nb, lane) - nb;
    int lim = need - pb; lim = lim < 0 ? 0 : lim; lim = lim > nb ? nb : lim;
    const bool full = (lim == nb), part = (lim > 0) && !full;
    topk_compact_lane<NR>(v, full ? lo : hi, nhi + (full ? nb : 0), IDX, lane);
    const unsigned long long pm = __ballot(part);
    if (pm != 0ull) {
        int k = TOPK - lim, kb = 0; const int dump = 256 + lane;
        asm volatile("" ::: "memory");
#pragma unroll
        for (int i = 0; i < NR; ++i) { const bool c = (v[i] > lo) && !(v[i] > hi); const bool take = part && c && (kb < lim);
            IDX[take ? k : dump] = (unsigned)(512 * (i >> 3) + 8 * lane + (i & 7)); k += take ? 1 : 0; kb += c ? 1 : 0; }
    }
}
typedef _Float16 f16x8 __attribute__((ext_vector_type(8)));
template <int NR> __device__ __forceinline__ int topk_select(const LAS unsigned char* row, int t, LAS unsigned* IDX, int lane) {
    float v[64]; float s1 = 0.f, s2 = 0.f; const int nv = t + 1;
    const int tb = t >> 9;
#pragma unroll
    for (int i = 0; i < NR / 8; ++i) { const f16x8 x = *(const LAS f16x8*)(row + 1024 * i + 16 * lane);
        if (i < tb) {
#pragma unroll
            for (int c = 0; c < 8; ++c) { const float xv = (float)x[c]; s1 += xv; s2 += xv * xv; v[8 * i + c] = xv; } }
        else {
#pragma unroll
            for (int c = 0; c < 8; ++c) { const bool ok = (512 * i + 8 * lane + c) <= t; const float xv = (float)x[c]; const float val = ok ? xv : 0.f; s1 += val; s2 += val * val; v[8 * i + c] = ok ? xv : -INFINITY; } } }
#pragma unroll
    for (int i = NR; i < 64; ++i) v[i] = -INFINITY;
    asm volatile("" ::: "memory");
    if (nv <= TOPK) { topk_compact_lane<NR>(v, -INFINITY, (int)(lane_count_valid<NR>(v) + 0.5f), IDX, lane); return nv; }
    s1 = wave_total_f32(s1); s2 = wave_total_f32(s2);
    const float mu = s1 / (float)nv, var = fmaxf(s2 / (float)nv - mu * mu, 0.f);
    float lo, hi, nhi, nlo; int need;
    topk_search<NR>(v, nv, mu, sqrtf(var), lo, hi, need, nhi, nlo);
    if (need == 0) topk_compact_lane<NR>(v, hi, (int)(nhi + 0.5f), IDX, lane);
    else topk_compact_bracket<NR>(v, lo, hi, need, nhi, nlo, IDX, lane);
    return TOPK;
}

__device__ __forceinline__ void half_barrier(volatile LAS unsigned* hb, int lane) {
    LDS_WAIT(); asm volatile("" ::: "memory");
    if (lane == 0) {
        const unsigned g = hb[1];
        const unsigned old = __hip_atomic_fetch_add((LAS unsigned*)hb, 1u, __ATOMIC_RELAXED, __HIP_MEMORY_SCOPE_WORKGROUP);
        if (old == 3u) { hb[0] = 0u; hb[1] = g + 1u; }
        else { unsigned sp = 0u; while (hb[1] == g) { __builtin_amdgcn_s_sleep(1); if (++sp > (1u << 22)) break; } }
    }
    asm volatile("" ::: "memory");
}

__device__ __forceinline__ void p2_attn(Frame& F, const Ptrs& P) {
    const bf16* PROJ = (const bf16*)(P.ws + WS_PROJ); const bf16* KVI = (const bf16*)(P.ws + WS_KVI); const bf16* IKFp = (const bf16*)(P.ws + WS_IKF); const bf16* IWp = (const bf16*)(P.ws + WS_IW); bf16* ATTN = (bf16*)(P.ws + WS_CONV);
    const int wave = F.wave, half = wave >> 2, w4 = wave & 3;
    LAS unsigned char* hrows = F.lds + RING_OFF + half * 65536;
    LAS _Float16* SC = (LAS _Float16*)hrows;
    LAS float* TAB = (LAS float*)(F.lds + TAB_OFF);
    for (int e = F.tid; e < 128 * 8; e += NWAVES * 64) { const int d = e >> 3, h = e & 7; int bk;
        if (d < 16) bk = d; else { bk = 16 + (int)(logf((float)d / 16.0f) / 2.0794415416798357f * 16.0f); bk = bk < 31 ? bk : 31; }
        TAB[e] = P.rel_bias[bk * 8 + h] * 1.4426950408889634f; }
    LAS unsigned* IDX = (LAS unsigned*)(F.lds + IDX_OFF + wave * (IDXW * 4));
    constexpr int NU = SEQ / 8;
    volatile LAS unsigned* TK = F.MISC + 16 + 4 * half;
    volatile LAS unsigned* HB = F.MISC + 24 + 2 * half;
    const bool tk_lane = (w4 == 0) && (F.lane == 0);
    int bcur = (int)(xb_xcc_id() & 7u), nexh = 0, parity = 0;
    if (tk_lane) TK[0] = xb_add((unsigned*)(F.ctl + CW_Q + 64 * bcur), 1u);
    __syncthreads();
    bool have = false;
    bf16x8 afr[2][4]; v4u wraw[2][2]; bf16x8 bfr[4][4];
#define P2_ZERO_Q() do { _Pragma("unroll") for (int mt = 0; mt < 2; ++mt) { _Pragma("unroll") for (int ks = 0; ks < 4; ++ks) afr[mt][ks] = (bf16x8){0, 0, 0, 0, 0, 0, 0, 0}; wraw[mt][0] = (v4u){0u, 0u, 0u, 0u}; wraw[mt][1] = (v4u){0u, 0u, 0u, 0u}; } \
        _Pragma("unroll") for (int u = 0; u < 4; ++u) { _Pragma("unroll") for (int ks = 0; ks < 4; ++ks) bfr[u][ks] = (bf16x8){0, 0, 0, 0, 0, 0, 0, 0}; } } while (0)
    P2_ZERO_Q();
#define P2_LOAD_Q(T0) do { _Pragma("unroll") for (int mt = 0; mt < 2; ++mt) { const bf16* qp = PB + (size_t)((T0) + 4 * mt + qrho) * NPROJ + PC_IQ + hrho * 64 + 8 * hh; \
        _Pragma("unroll") for (int ks = 0; ks < 4; ++ks) afr[mt][ks] = *(const GAS bf16x8*)(qp + 16 * ks); \
        _Pragma("unroll") for (int qq = 0; qq < 2; ++qq) wraw[mt][qq] = *(const GAS v4u*)(IWB + (size_t)((T0) + 4 * mt + 2 * hh + qq) * 8); } \
        _Pragma("unroll") for (int u = 0; u < 4; ++u) { const bf16* kp = IKB + (size_t)(w4 + 4 * u) * 2048 + hh * 256 + r32 * 8;     \
            _Pragma("unroll") for (int ks = 0; ks < 4; ++ks) bfr[u][ks] = *(const GAS bf16x8*)(kp + 512 * ks); } } while (0)
    for (;;) {
        const int tk = (int)__builtin_amdgcn_readfirstlane(TK[parity]);
        if (tk >= NU) {
            if (++nexh == BATCH) break;
            bcur = (bcur + 1) & 7;
            half_barrier(HB, F.lane);
            if (tk_lane) TK[parity] = xb_add((unsigned*)(F.ctl + CW_Q + 64 * bcur), 1u);
            half_barrier(HB, F.lane);
            have = false; P2_ZERO_Q();
            continue;
        }
        unsigned nxt = 0u;
        if (tk_lane) nxt = xb_add((unsigned*)(F.ctl + CW_Q + 64 * bcur), 1u);
        int lane = F.lane; asm volatile("" : "+v"(lane));
        const int r32 = lane & 31, hh = lane >> 5, fr = lane & 15, fq = lane >> 4;
        const int qrho = ((r32 >> 4) & 1) + 2 * ((r32 >> 2) & 1), hrho = (r32 & 3) + 4 * ((r32 >> 3) & 1);
        const int b = bcur, t0 = 8 * (NU - 1 - tk);
        const bf16* PB = PROJ + (size_t)b * SEQ * NPROJ; const bf16* KB = KVI + (size_t)b * SEQ * KVP; const bf16* IKB = IKFp + (size_t)b * SEQ * 64; const bf16* IWB = IWp + (size_t)b * SEQ * 8;
        if (!have) P2_LOAD_Q(t0);
        {
            float w[2][16];
#pragma unroll
            for (int mt = 0; mt < 2; ++mt)
#pragma unroll
                for (int qq = 0; qq < 2; ++qq) { const v4u wv = wraw[mt][qq];
                    const float sc = 0.04419417382415922f;
                    w[mt][8 * qq + 0] = bf_lo(wv.x) * sc; w[mt][8 * qq + 1] = bf_hi(wv.x) * sc; w[mt][8 * qq + 2] = bf_lo(wv.y) * sc; w[mt][8 * qq + 3] = bf_hi(wv.y) * sc;
                    w[mt][8 * qq + 4] = bf_lo(wv.z) * sc; w[mt][8 * qq + 5] = bf_hi(wv.z) * sc; w[mt][8 * qq + 6] = bf_lo(wv.w) * sc; w[mt][8 * qq + 7] = bf_hi(wv.w) * sc; }
            const int nkt = (t0 + 8 + 31) >> 5;
            for (int kt0 = w4; kt0 < nkt; kt0 += 16) {
#pragma unroll
                for (int u = 0; u < 4; ++u) { const int kt = kt0 + 4 * u;
                    if (kt < nkt) { const int s = 32 * kt + r32;
                        f32x16 acc0 = {}, acc1 = {};
#pragma unroll
                        for (int ks = 0; ks < 4; ++ks) { acc0 = __builtin_amdgcn_mfma_f32_32x32x16_bf16(afr[0][ks], bfr[u][ks], acc0, 0, 0, 0); acc1 = __builtin_amdgcn_mfma_f32_32x32x16_bf16(afr[1][ks], bfr[u][ks], acc1, 0, 0, 0); }
                        if (kt + 16 < nkt) { const bf16* kp = IKB + (size_t)(kt + 16) * 2048 + hh * 256 + r32 * 8;
#pragma unroll
                            for (int ks = 0; ks < 4; ++ks) bfr[u][ks] = *(const GAS bf16x8*)(kp + 512 * ks); }
                        float s0 = 0.f, s1 = 0.f, s2 = 0.f, s3 = 0.f;
#pragma unroll
                        for (int e = 0; e < 8; ++e) { s0 = __builtin_fmaf(w[0][e], __builtin_amdgcn_fmed3f(acc0[e], 0.f, 3.0e38f), s0); s1 = __builtin_fmaf(w[0][8 + e], __builtin_amdgcn_fmed3f(acc0[8 + e], 0.f, 3.0e38f), s1);
                            s2 = __builtin_fmaf(w[1][e], __builtin_amdgcn_fmed3f(acc1[e], 0.f, 3.0e38f), s2); s3 = __builtin_fmaf(w[1][8 + e], __builtin_amdgcn_fmed3f(acc1[8 + e], 0.f, 3.0e38f), s3); }
                        SC[(2 * hh) * 4096 + s] = (_Float16)s0; SC[(2 * hh + 1) * 4096 + s] = (_Float16)s1; SC[(4 + 2 * hh) * 4096 + s] = (_Float16)s2; SC[(4 + 2 * hh + 1) * 4096 + s] = (_Float16)s3; } }
            }
        }
        if (tk_lane) TK[parity ^ 1] = nxt;
        half_barrier(HB, F.lane);
#pragma nounroll
        for (int qi = 0; qi < 2; ++qi) {
        int lane = F.lane; asm volatile("" : "+v"(lane));
        const int fr = lane & 15, fq = lane >> 4;
        const int qrow = w4 + 4 * qi;
        LAS unsigned char* myrow = hrows + qrow * 8192;
        const int t = t0 + qrow;
        int nsel;
        if (t < 1024) nsel = topk_select<16>(myrow, t, IDX, lane);
        else if (t < 2048) nsel = topk_select<32>(myrow, t, IDX, lane);
        else if (t < 3072) nsel = topk_select<48>(myrow, t, IDX, lane);
        else nsel = topk_select<64>(myrow, t, IDX, lane);
#pragma unroll
        for (int k = 0; k < 4; ++k) { const int jx = lane + 64 * k; if (jx >= nsel) IDX[jx] = 0u; }
        asm volatile("" ::: "memory");
        {
            const float c2 = 0.125f * 1.4426950408889634f;
            bf16x8 qf[2];
            { const bf16* qp = PB + (size_t)t * NPROJ + PC_Q + (fr & 7) * 64 + 8 * fq; qf[0] = *(const GAS bf16x8*)qp; qf[1] = *(const GAS bf16x8*)(qp + 32); }
            unsigned koff[8][4];
            f32x4 S[16]; unsigned BI[8][2]; const int cls = fr >> 3;
            {
                v4u kreg[8][4];
#pragma unroll
                for (int kb = 0; kb < 8; ++kb)
#pragma unroll
                    for (int i = 0; i < 4; ++i) { const unsigned kidx = IDX[32 * kb + 8 * i + (lane >> 3)]; koff[kb][i] = (kidx << 8) + (unsigned)(16 * (lane & 7)); kreg[kb][i] = *(const GAS v4u*)((const GAS unsigned char*)KB + koff[kb][i]); }
#pragma unroll
                for (int jo = 0; jo < 8; ++jo) { const int jt = 2 * jo + cls; const v4u kk = *(const LAS v4u*)(IDX + 16 * jt + 4 * fq); float bz[4];
#pragma unroll
                    for (int r = 0; r < 4; ++r) { const int slot = 16 * jt + 4 * fq + r; int dist = t - (int)kk[r]; dist = dist < 127 ? dist : 127; dist = dist > 0 ? dist : 0;
                        const float bias = TAB[dist * 8 + (fr & 7)]; bz[r] = (slot < nsel) ? bias : -INFINITY; }
                    BI[jo][0] = pg8::cvt_pk_bf16(bz[0], bz[1]); BI[jo][1] = pg8::cvt_pk_bf16(bz[2], bz[3]); }
                const int wsl = (lane >> 3) * 128 + 16 * ((lane & 7) ^ ((lane >> 4) & 3));
                const int rsw = (fr >> 1) & 7;
                bf16x8 kf[2][2][2];
#define P2_KW(KB) do { LAS unsigned char* kbuf_ = myrow + ((KB) & 1) * 4096; _Pragma("unroll") for (int i = 0; i < 4; ++i) *(LAS v4u*)(kbuf_ + 1024 * i + (wsl ^ (64 * (i & 1)))) = kreg[KB][i]; asm volatile("" ::: "memory"); } while (0)
#define P2_KR(KB) do { const LAS unsigned char* kbuf_ = myrow + ((KB) & 1) * 4096; _Pragma("unroll") for (int tt = 0; tt < 2; ++tt) { const LAS unsigned char* rp = kbuf_ + (16 * tt + fr) * 128; \
                    kf[(KB) & 1][tt][0] = *(const LAS bf16x8*)(rp + 16 * (fq ^ rsw)); kf[(KB) & 1][tt][1] = *(const LAS bf16x8*)(rp + 16 * ((fq + 4) ^ rsw)); } asm volatile("" ::: "memory"); } while (0)
                P2_KW(0); P2_KR(0);
#pragma unroll
                for (int kb = 0; kb < 8; ++kb) {
                    if (kb < 7) { P2_KW(kb + 1); P2_KR(kb + 1); }
#pragma unroll
                    for (int tt = 0; tt < 2; ++tt) { f32x4 a = {0.f, 0.f, 0.f, 0.f};
                        a = __builtin_amdgcn_mfma_f32_16x16x32_bf16(kf[kb & 1][tt][0], qf[0], a, 0, 0, 0);
                        a = __builtin_amdgcn_mfma_f32_16x16x32_bf16(kf[kb & 1][tt][1], qf[1], a, 0, 0, 0);
                        S[2 * kb + tt] = a; } }
#undef P2_KW
#undef P2_KR
            }
            __builtin_amdgcn_sched_barrier(0);
            v4u vreg[8][4];
#pragma unroll
            for (int kb = 0; kb < 8; ++kb)
#pragma unroll
                for (int i = 0; i < 4; ++i) vreg[kb][i] = *(const GAS v4u*)((const GAS unsigned char*)KB + koff[kb][i] + 128);
            f32x4 W[8];
            float mx = -INFINITY;
#pragma unroll
            for (int jo = 0; jo < 8; ++jo)
#pragma unroll
                for (int r = 0; r < 4; ++r) { const unsigned bw = BI[jo][r >> 1]; const float sv = cls ? S[2 * jo + 1][r] : S[2 * jo][r];
                    const float l2 = sv * c2 + ((r & 1) ? bf_hi(bw) : bf_lo(bw)); W[jo][r] = l2; mx = fmaxf(mx, l2); }
            mx = fmaxf(mx, __shfl_xor(mx, 8)); mx = fmaxf(mx, __shfl_xor(mx, 16)); mx = fmaxf(mx, __shfl_xor(mx, 32));
            float sum = 0.f;
#pragma unroll
            for (int jo = 0; jo < 8; ++jo)
#pragma unroll
                for (int r = 0; r < 4; ++r) { const float p = __builtin_amdgcn_exp2f(W[jo][r] - mx); W[jo][r] = p; sum += p; }
            sum += __shfl_xor(sum, 8); sum += __shfl_xor(sum, 16); sum += __shfl_xor(sum, 32);
            const float rinv = 1.0f / sum;
            unsigned PQ[8][2], PP[8][2];
#pragma unroll
            for (int jo = 0; jo < 8; ++jo) { PQ[jo][0] = pg8::cvt_pk_bf16(W[jo][0], W[jo][1]); PQ[jo][1] = pg8::cvt_pk_bf16(W[jo][2], W[jo][3]);
                PP[jo][0] = (unsigned)__builtin_amdgcn_update_dpp(0, (int)PQ[jo][0], 0x128, 0xf, 0xf, true); PP[jo][1] = (unsigned)__builtin_amdgcn_update_dpp(0, (int)PQ[jo][1], 0x128, 0xf, 0xf, true); }
            f32x4 O[4];
#pragma unroll
            for (int mt = 0; mt < 4; ++mt) O[mt] = (f32x4){0.f, 0.f, 0.f, 0.f};
            const int qq = fr >> 2, pp = fr & 3;
            const int Rr = 4 * fq + qq, vsw = (Rr >> 1) & 3;
            const int rbase = Rr * 128 + 8 * pp;
            const int vwsl = (lane >> 3) * 128 + 16 * ((lane & 7) ^ (2 * ((lane >> 4) & 3)));
            v4i16_t vlo[2][4], vhi[2][4];
#define P2_VW(KB) do { LAS unsigned char* vb_ = myrow + ((KB) & 1) * 4096; _Pragma("unroll") for (int i = 0; i < 4; ++i) *(LAS v4u*)(vb_ + 1024 * i + vwsl) = vreg[KB][i]; asm volatile("" ::: "memory"); } while (0)
#define P2_VR(KB) do { LAS unsigned char* vb_ = myrow + ((KB) & 1) * 4096; _Pragma("unroll") for (int mt = 0; mt < 4; ++mt) { const int co = 32 * (mt ^ vsw); \
                vlo[(KB) & 1][mt] = __builtin_amdgcn_ds_read_tr16_b64_v4i16((LAS v4i16_t*)(vb_ + rbase + co)); vhi[(KB) & 1][mt] = __builtin_amdgcn_ds_read_tr16_b64_v4i16((LAS v4i16_t*)(vb_ + rbase + 16 * 128 + co)); } \
                asm volatile("" ::: "memory"); } while (0)
            P2_VW(0); P2_VR(0);
#pragma unroll
            for (int kb = 0; kb < 8; ++kb) {
                if (kb < 7) { P2_VW(kb + 1); P2_VR(kb + 1); }
                bf16x8 pf;
                { const unsigned p0 = cls ? PP[kb][0] : PQ[kb][0], p1 = cls ? PP[kb][1] : PQ[kb][1], p2 = cls ? PQ[kb][0] : PP[kb][0], p3 = cls ? PQ[kb][1] : PP[kb][1];
                  pf = __builtin_bit_cast(bf16x8, (v4u){p0, p1, p2, p3}); }
#pragma unroll
                for (int mt = 0; mt < 4; ++mt) { const v4i16_t lo4 = vlo[kb & 1][mt], hi4 = vhi[kb & 1][mt];
                    const bf16x8 vf = (bf16x8){lo4[0], lo4[1], lo4[2], lo4[3], hi4[0], hi4[1], hi4[2], hi4[3]};
                    O[mt] = __builtin_amdgcn_mfma_f32_16x16x32_bf16(vf, pf, O[mt], 0, 0, 0); }
            }
#undef P2_VW
#undef P2_VR
            if (fr < 8) { bf16* op = ATTN + (size_t)(b * SEQ + t) * D + DCONV + fr * 64 + 4 * fq;
#pragma unroll
                for (int mt = 0; mt < 4; ++mt) { typedef unsigned u32x2v __attribute__((ext_vector_type(2)));
                    u32x2v wv; wv.x = pg8::cvt_pk_bf16(O[mt][0] * rinv, O[mt][1] * rinv); wv.y = pg8::cvt_pk_bf16(O[mt][2] * rinv, O[mt][3] * rinv);
                    *(GAS u32x2v*)(op + 16 * mt) = wv; } }
        }
        asm volatile("" ::: "memory");
        }
        __builtin_amdgcn_sched_barrier(0);
        {
            const int tkn = (int)__builtin_amdgcn_readfirstlane(TK[parity ^ 1]);
            have = tkn < NU;
            if (have) { const int t0n = 8 * (NU - 1 - tkn); P2_LOAD_Q(t0n); }
            else P2_ZERO_Q();
        }
        half_barrier(HB, F.lane);
        parity ^= 1;
    }
#undef P2_LOAD_Q
#undef P2_ZERO_Q
    __syncthreads();
}

__device__ __forceinline__ void p8_final_norm(Frame& F, const Ptrs& P) {
    const int gw = F.vcu * NWAVES + F.wave, NGW = F.G * NWAVES; const float* SSQ = (const float*)(P.ws + WS_SSQ2); const bf16* X2B = (const bf16*)(P.ws + WS_XN);
    const GAS f32x4* gr = (const GAS f32x4*)P.g_final + F.lane;
    f32x4 gg[4];
#pragma unroll
    for (int j = 0; j < 4; ++j) gg[j] = gr[64 * j];
    typedef unsigned u32x2v __attribute__((ext_vector_type(2)));
    for (int m = gw; m < M; m += 2 * NGW) { const int m1 = (m + NGW < M) ? m + NGW : m;
        const GAS u32x2v* xa = (const GAS u32x2v*)(X2B + (size_t)m * D) + F.lane; const GAS u32x2v* xb = (const GAS u32x2v*)(X2B + (size_t)m1 * D) + F.lane;
        const float* spa = SSQ + m; const float* spb = SSQ + m1; asm volatile("" : "+v"(spa), "+v"(spb));
        const float pa = *spa, pb = *spb;
        u32x2v va[4], vb[4];
#pragma unroll
        for (int j = 0; j < 4; ++j) { va[j] = xa[64 * j]; vb[j] = xb[64 * j]; }
        const float ra = 1.f / sqrtf(pa * (1.f / D) + EPS), rb = 1.f / sqrtf(pb * (1.f / D) + EPS);
        GAS f32x4* oa = (GAS f32x4*)(P.out + (size_t)m * D) + F.lane; GAS f32x4* ob = (GAS f32x4*)(P.out + (size_t)m1 * D) + F.lane;
#pragma unroll
        for (int j = 0; j < 4; ++j) { oa[64 * j] = (f32x4){bf_lo(va[j].x), bf_hi(va[j].x), bf_lo(va[j].y), bf_hi(va[j].y)} * ra * gg[j];
            if (m1 != m) ob[64 * j] = (f32x4){bf_lo(vb[j].x), bf_hi(vb[j].x), bf_lo(vb[j].y), bf_hi(vb[j].y)} * rb * gg[j]; }
    }
}

struct Args { const float* in[14]; float* out; unsigned char* ws; int ph_lo, ph_hi, li, pad; };
__global__ void __launch_bounds__(NWAVES * 64, 2) skel_fwd(Args args) {
    extern __shared__ __attribute__((aligned(16))) unsigned char lds[];
    Frame F;
    F.lds = (LAS unsigned char*)lds;
    F.MISC = (volatile LAS unsigned*)(F.lds + MISC_OFF);
    F.tid = threadIdx.x; F.lane = F.tid & 63; F.wave = __builtin_amdgcn_readfirstlane(F.tid >> 6);
    F.G = gridDim.x; { const int bx = blockIdx.x; F.vcu = (F.G % 8 == 0) ? (bx % 8) * (F.G / 8) + bx / 8 : bx; }
    Ptrs P;
    P.x = args.in[0]; P.g_mix = args.in[1]; P.w_in = args.in[2]; P.b_gate = args.in[3]; P.conv_w = args.in[4]; P.w_a = args.in[5]; P.w_b = args.in[6]; P.w_out = args.in[7];
    P.rel_bias = args.in[8]; P.g_ffn = args.in[9]; P.w_g = args.in[10]; P.w_u = args.in[11]; P.w_d = args.in[12]; P.g_final = args.in[13];
    P.out = args.out; P.ws = args.ws;
    unsigned char* ws = args.ws;
    F.ctl = (gu32*)(ws + WS_CTL);
    for (int u = F.tid; u < (TAB_OFF - LDSCTL_OFF) / 4; u += NWAVES * 64) ((LAS unsigned*)(F.lds + LDSCTL_OFF))[u] = 0u;
    __syncthreads();
    XcdBarrier bar; bar.bar = (unsigned*)(F.ctl + CW_BAR); bar.x = 0; bar.st = nullptr;
    if (N_LAUNCHES == 1) bar = xcd_barrier_post((unsigned*)(F.ctl + CW_BAR), F.MISC + 8);
#define GRID_BAR() do { if (N_LAUNCHES == 1) { xcd_barrier(bar); } } while (0)
    const int lo = args.ph_lo, hi = args.ph_hi;
#define IN(k) (lo <= (k) && (k) < hi)
#define BOTH(k) (IN(k) && IN((k) + 1))
    bf16* XN = (bf16*)(ws + WS_XN); bf16* PROJ = (bf16*)(ws + WS_PROJ); bf16* CONV = (bf16*)(ws + WS_CONV); bf16* ATTN = (bf16*)(ws + WS_ATTN);
    bf16* MERGED = XN; bf16* X1B = CONV; bf16* ACT = PROJ; bf16* X2B = XN;
    float* SSQ1 = (float*)(ws + WS_SSQ1); float* SSQ2 = (float*)(ws + WS_SSQ2);

    const bool split_w = (N_LAUNCHES == 1) && (F.G == 256);
    const bool fuse_final = (N_LAUNCHES == 1) && (F.G == 256) && IN(7) && IN(8);
    if (IN(0)) { if (blockIdx.x == 0 && F.tid < 256) ((bf16*)(ws + WS_IDENT))[F.tid * 257] = (bf16)0x3F80;
        p0_prologue(F, P, !split_w); if (BOTH(0)) GRID_BAR(); }
    if (IN(1)) {
        pg8::Gemm g{(const bf16*)P.out  , (const bf16*)(ws + WS_WIN), M, NPROJ, D}; pg8::StaticOrder S; S.init(M, NPROJ, F.G, (int)blockIdx.x);
        LAS float* BGL = (LAS float*)(F.lds + TAB_OFF);
        for (int i = F.tid; i < 2 * D; i += NWAVES * 64) BGL[i] = P.b_gate[i];
        __syncthreads();
        pg8::EpiProj E{PROJ, NPROJ, (bf16*)(ws + WS_KVI), (bf16*)(ws + WS_IKF), (bf16*)(ws + WS_IW), PC_KVI / 256, BGL, PC_GA, (bf16*)(ws + WS_IW + MiB), (const float*)(ws + WS_SSQ0), (LAS float*)(F.lds + TAB_OFF + 8192)};
        pg8::gemm_phase<pg8::EpiProj, pg8::StaticOrder, PG8_ALIGN, PG8_SP2>(F.lds + RING_OFF, g, S, E);
        if (split_w && blockIdx.x >= 128) p0_weight_items(F, P, PI_IN, PI_ALL, ((int)blockIdx.x - 128) * NWAVES + F.wave, 128 * NWAVES);
        if (BOTH(1)) GRID_BAR();
    }
    if (IN(2)) { p2_conv(F, P); p2_attn(F, P); if (BOTH(2)) GRID_BAR(); }
    if (IN(3)) {
        pg8::Gemm g{CONV, (const bf16*)(ws + WS_WA), M, D, D}; pg8::StaticOrder S; S.init(M, D, F.G, (int)blockIdx.x);
        pg8::EpiGateMerged E{MERGED, (const unsigned char*)(PROJ + PC_GA), NPROJ * 2};
        pg8::gemm_phase<pg8::EpiGateMerged, pg8::StaticOrder, PG8_ALIGN, PG8_SP2>(F.lds + RING_OFF, g, S, E);
        if (BOTH(4)) GRID_BAR();
    }
    if (IN(5)) {
        pg8::Gemm g{MERGED, (const bf16*)(ws + WS_WOUT), M, D, D, (const bf16*)P.out, (const bf16*)(ws + WS_IDENT), D, BM256}; pg8::StaticOrder S; S.init(M, D, F.G, (int)blockIdx.x);
        pg8::EpiResid<2> E{nullptr, nullptr, X1B, SSQ1};
        pg8::gemm_phase<pg8::EpiResid<2>, pg8::StaticOrder, PG8_ALIGN, PG8_SP2>(F.lds + RING_OFF, g, S, E);
        if (BOTH(5)) GRID_BAR();
    }
    if (IN(6)) {
        pg8::Gemm g{X1B, (const bf16*)(ws + WS_WGU), M, NGU, D}; pg8::StaticOrder S; S.init(M, NGU, F.G, (int)blockIdx.x);
        pg8::EpiSwiGLU E{ACT, FF, SSQ1, (LAS float*)(F.lds + TAB_OFF)};
        pg8::gemm_phase<pg8::EpiSwiGLU, pg8::StaticOrder, PG8_ALIGN, PG8_SP2>(F.lds + RING_OFF, g, S, E);
        if (BOTH(6)) GRID_BAR();
    }
    if (IN(7)) {
        pg8::Gemm g{ACT, (const bf16*)(ws + WS_WD), M, D, FF, X1B, (const bf16*)(ws + WS_IDENT), D, BM256}; pg8::StaticOrder S; S.init(M, D, F.G, (int)blockIdx.x);
        if (fuse_final) {
            pg8::EpiFinal E{P.out, SSQ2, P.g_final, (unsigned*)(ws + WS_RC), (unsigned*)(F.ctl + CW_BAR) + XB_TMO};
            pg8::gemm_phase<pg8::EpiFinal, pg8::StaticOrder, PG8_ALIGN, PG8_SP2>(F.lds + RING_OFF, g, S, E);
        } else {
            pg8::EpiResid<2> E{nullptr, nullptr, X2B, SSQ2};
            pg8::gemm_phase<pg8::EpiResid<2>, pg8::StaticOrder, PG8_ALIGN, PG8_SP2>(F.lds + RING_OFF, g, S, E);
            if (BOTH(7)) GRID_BAR();
        }
    }
    if (IN(8) && !fuse_final) { p8_final_norm(F, P); }
#undef IN
#undef BOTH
#undef GRID_BAR
}

extern "C" void kernel_launch(void* const* d_in, const int* in_sizes, int n_in, void* d_out, int out_size, void* d_ws, size_t ws_size, hipStream_t stream) {
    static int grid = 0;
    if (grid == 0) {
        if (n_in != 14 || in_sizes[0] != M * D || out_size != M * D || ws_size < WS_END) { fprintf(stderr, "kernel_launch: shape/workspace mismatch: n_in %d in0 %d out %d ws %zu (need %zu); nothing launched\n", n_in, n_in > 0 ? in_sizes[0] : -1, out_size, ws_size, (size_t)WS_END); grid = -1; return; }
        int dev = 0, cus = 0, per_cu = 0;
        if (hipGetDevice(&dev) != hipSuccess || hipDeviceGetAttribute(&cus, hipDeviceAttributeMultiprocessorCount, dev) != hipSuccess) { grid = -1; return; }
        if (hipFuncSetAttribute((const void*)skel_fwd, hipFuncAttributeMaxDynamicSharedMemorySize, LDS_BYTES) != hipSuccess) { fprintf(stderr, "kernel_launch: hipFuncSetAttribute failed\n"); grid = -1; return; }
        if (hipOccupancyMaxActiveBlocksPerMultiprocessor(&per_cu, (const void*)skel_fwd, NWAVES * 64, LDS_BYTES) != hipSuccess || per_cu < 1)
            fprintf(stderr, "kernel_launch: note: occupancy query reports %d workgroups per CU\n", per_cu);
        (void)hipGetLastError();
        grid = cus;
    }
    if (grid < 0) return;
    if (hipMemsetAsync((char*)d_ws + WS_CTL, 0, CTL_ZERO_BYTES, stream) != hipSuccess) { fprintf(stderr, "kernel_launch: hipMemsetAsync failed\n"); return; }
    Args a{};
    for (int i = 0; i < 14; ++i) a.in[i] = (const float*)d_in[i];
    a.out = (float*)d_out; a.ws = (unsigned char*)d_ws;
    for (int li = 0; li < N_LAUNCHES; ++li) {
        a.ph_lo = (N_LAUNCHES == PER_PHASE) ? li : 0; a.ph_hi = (N_LAUNCHES == PER_PHASE) ? li + 1 : PER_PHASE; a.li = li;
        hipLaunchKernelGGL(skel_fwd, dim3(grid), dim3(NWAVES * 64), LDS_BYTES, stream, a);
        const hipError_t le = hipPeekAtLastError();
        if (le != hipSuccess) { fprintf(stderr, "kernel_launch: launch %d failed: %s\n", li, hipGetErrorName(le)); break; }
    }
}
```

```cpp
#include <hip/hip_runtime.h>
#include <cstdio>
#include <cstdint>
namespace pg8 {
#define PG8_LAS __attribute__((address_space(3)))
typedef unsigned short bf16_t;
typedef short bf16x8 __attribute__((ext_vector_type(8)));
typedef float f32x4 __attribute__((ext_vector_type(4)));
typedef unsigned u32x4 __attribute__((ext_vector_type(4)));
constexpr int BM = 256, BK = 64, HALF = 128, HTB = HALF * BK * 2  , STAGE_BYTES = 8 * HTB, NXCD = 8, WGM = 8;

__host__ __device__ __forceinline__ int lds_byte(int r, int c) { const int st = (r >> 4) * 2 + (c >> 5), rr = r & 15, cc = c & 31, ob = rr * 64 + cc * 2; return st * 1024 + (ob ^ (((ob >> 9) & 1) << 5)); }
__host__ __device__ __forceinline__ void stage_rc(int b, int& R, int& C) { const int st = b / 1024, sb = b % 1024, swz = sb ^ (((sb >> 9) & 1) << 5); R = (st >> 1) * 16 + swz / 64; C = (st & 1) * 32 + (swz % 64) / 2; }
__host__ __device__ __forceinline__ int perm32(int rho) { const int n = rho >> 4, i = rho & 15; return 8 * (i >> 2) + 4 * n + (i & 3); }

struct Unit { int pm, pn; };
struct Gemm { const bf16_t* A; const bf16_t* Bt; int M, N, K; const bf16_t* Ae = nullptr; const bf16_t* Bte = nullptr; int lde_a = 0, lde_b = 0; };

struct StaticOrder {
    int nM, nN, nwg, G, c;
    __host__ __device__ void init(int M, int N, int G_, int c_) { nM = M / BM; nN = N / BM; nwg = nM * nN; G = G_; c = c_; }
    __host__ __device__ bool next(int i, Unit& u) const {
        const long L = (long)i * G + c; if (L >= nwg) return false;
        int wgid = (int)L; { const int q = nwg / NXCD, r = nwg % NXCD, xcd = wgid % NXCD, off = wgid / NXCD; wgid = (xcd < r ? xcd * (q + 1) : r * (q + 1) + (xcd - r) * q) + off; }
        const int nig = WGM * nN, gid = wgid / nig, fm = gid * WGM, gsz = (nM - fm) < WGM ? (nM - fm) : WGM;
        u.pm = fm + ((wgid % nig) % gsz); u.pn = (wgid % nig) / gsz; return true;
    }
    __device__ __forceinline__ void a_ready(const Unit&) const {}
    __device__ __forceinline__ void done(const Unit&) const {}
};

typedef float f32x2_cv __attribute__((ext_vector_type(2))); typedef __bf16 bf16x2_cv __attribute__((ext_vector_type(2)));
__device__ __forceinline__ unsigned cvt_pk_bf16(float lo, float hi) { f32x2_cv v = {lo, hi}; bf16x2_cv b = __builtin_convertvector(v, bf16x2_cv); return __builtin_bit_cast(unsigned, b); }
typedef float f32x2 __attribute__((ext_vector_type(2)));
__device__ __forceinline__ f32x2 gelu_pk(f32x2 v) {
    const f32x2 av = __builtin_elementwise_abs(v), d = av * 0.2316418882f + 1.0f;
    f32x2 t; t.x = __builtin_amdgcn_rcpf(d.x); t.y = __builtin_amdgcn_rcpf(d.y);
    f32x2 q = t * 0.5307027145f + (-0.7265760135f); q = q * t + 0.7107068705f; q = q * t + (-0.142248368f); q = q * t + 0.127414796f; q = q * t;
    const f32x2 s = (v * v) * (-0.72134752044f);
    f32x2 e; e.x = __builtin_amdgcn_exp2f(s.x); e.y = __builtin_amdgcn_exp2f(s.y);
    const f32x2 m = v * (q * e), r = v - m;
    f32x2 o; o.x = v.x < 0.f ? m.x : r.x; o.y = v.y < 0.f ? m.y : r.y; return o;
}

template <int ACT  > struct EpiBf16 {
    static constexpr bool PERM = true, AFTER_DRAIN = false, HAS_PRE = false, HAS_MID = false, HAS_EXT = false; static_assert(ACT == 0 || ACT == 1, "EpiBf16: ACT is 0 (none) or 1 (gelu_pk)");
    static constexpr int NVM = 0;
    bf16_t* O; int ldc; const float* bias; int split_cols; size_t split_stride; float scale0;
    __device__ __forceinline__ void operator()(const f32x4 (&acc)[2][2][4][2], const Unit& u, int wr, int wc, int fr, int fq) const {
        const int row0 = u.pm * BM + wr * 64 + fr; int colt = u.pn * BM; bf16_t* base = O;
        float sc = 1.f; if (split_cols) { const int t = colt / split_cols; base += (size_t)t * split_stride; colt -= t * split_cols; if (t == 0) sc = scale0; }
        const int col0 = colt + wc * 32 + 8 * fq, bcol0 = u.pn * BM + wc * 32 + 8 * fq;
        f32x4 bv[2][2];
#pragma unroll
        for (int bj = 0; bj < 2; ++bj)
#pragma unroll
            for (int n = 0; n < 2; ++n) bv[bj][n] = bias ? *(const f32x4*)(bias + bcol0 + bj * HALF + 4 * n) : (f32x4){0.f, 0.f, 0.f, 0.f};
#pragma unroll
        for (int ai = 0; ai < 2; ++ai)
#pragma unroll
            for (int m = 0; m < 4; ++m) { bf16_t* rowp = base + (size_t)(row0 + ai * HALF + m * 16) * ldc + col0;
#pragma unroll
                for (int bj = 0; bj < 2; ++bj) { f32x4 v0 = acc[ai][bj][m][0] + bv[bj][0], v1 = acc[ai][bj][m][1] + bv[bj][1];
                    if (ACT == 1) { f32x2 a = gelu_pk((f32x2){v0[0], v0[1]}), b = gelu_pk((f32x2){v0[2], v0[3]}), c = gelu_pk((f32x2){v1[0], v1[1]}), d = gelu_pk((f32x2){v1[2], v1[3]});
                        v0 = (f32x4){a.x, a.y, b.x, b.y}; v1 = (f32x4){c.x, c.y, d.x, d.y}; }
                    v0 = v0 * sc; v1 = v1 * sc; u32x4 w; w.x = cvt_pk_bf16(v0[0], v0[1]); w.y = cvt_pk_bf16(v0[2], v0[3]); w.z = cvt_pk_bf16(v1[0], v1[1]); w.w = cvt_pk_bf16(v1[2], v1[3]);
                    *(u32x4*)(rowp + bj * HALF) = w; } }
    }
};

template <class Epi, class Sched, bool ALIGN_EPI = false, bool SP2 = false>
__device__ __forceinline__ void gemm_phase(PG8_LAS unsigned char* lds, const Gemm g, const Sched& S, const Epi& E) {
    const int tid = threadIdx.x, wid = __builtin_amdgcn_readfirstlane(tid >> 6), lane = tid & 63, wr = wid >> 2, wc = wid & 3, fr = lane & 15, fq = lane >> 4;
    const int K = g.K, ntm = K / BK, nt = ntm + (Epi::HAS_EXT ? BM / BK : 0);
    unsigned voffA[2], voffB[2];
#pragma unroll
    for (int i = 0; i < 2; ++i) { int R, C; stage_rc(tid * 16 + i * 8192, R, C); const int Rb = Epi::PERM ? ((R & ~31) + perm32(R & 31)) : R;
        voffA[i] = (unsigned)(R * K + C) * 2u; voffB[i] = (unsigned)(Rb * K + C) * 2u; }
    unsigned voffAe[2] = {0u, 0u}, voffBe[2] = {0u, 0u};
    if constexpr (Epi::HAS_EXT) {
#pragma unroll
        for (int i = 0; i < 2; ++i) { int R, C; stage_rc(tid * 16 + i * 8192, R, C); const int Rb = Epi::PERM ? ((R & ~31) + perm32(R & 31)) : R;
            voffAe[i] = (unsigned)(R * g.lde_a + C) * 2u; voffBe[i] = (unsigned)(Rb * g.lde_b + C) * 2u; } }
    const size_t hstepAe = (size_t)HALF * g.lde_a * 2, hstepBe = (size_t)HALF * g.lde_b * 2;
    const size_t kstep = (size_t)(BK * 2);
    const size_t hstep = (size_t)HALF * K * 2;
    const size_t tstep = 2 * hstep;
    const unsigned ldsw = (unsigned)wid * 1024u;
    const int aoff = lds_byte(wr * 64 + fr, fq * 8), boff = lds_byte(wc * 32 + fr, fq * 8);
#define PG8_SA(b, h) (((b) * 2 + (h)) * HTB)
#define PG8_SB(b, h) ((4 + (b) * 2 + (h)) * HTB)
#define PG8_STAGE(bufoff, gbase, voff) do { _Pragma("unroll") for (int _i = 0; _i < 2; ++_i) \
        __builtin_amdgcn_global_load_lds((const unsigned*)((const char*)(gbase) + (voff)[_i]), (PG8_LAS unsigned*)(lds + (bufoff) + ldsw + _i * 8192), 16, 0, 0); } while (0)
#define PG8_LDA(dst, b, h) do { _Pragma("unroll") for (int m = 0; m < 4; ++m) _Pragma("unroll") for (int k = 0; k < 2; ++k) dst[m][k] = *(const PG8_LAS bf16x8*)(lds + PG8_SA(b, h) + aoff + m * 2048 + k * 1024); } while (0)
#define PG8_LDB(dst, b, h) do { _Pragma("unroll") for (int n = 0; n < 2; ++n) _Pragma("unroll") for (int k = 0; k < 2; ++k) dst[n][k] = *(const PG8_LAS bf16x8*)(lds + PG8_SB(b, h) + boff + n * 2048 + k * 1024); } while (0)
#define PG8_MMA(ai, bj, At, Bt) do { __builtin_amdgcn_s_setprio(1); _Pragma("unroll") for (int m = 0; m < 4; ++m) _Pragma("unroll") for (int n = 0; n < 2; ++n) _Pragma("unroll") for (int k = 0; k < 2; ++k) \
        acc[ai][bj][m][n] = __builtin_amdgcn_mfma_f32_16x16x32_bf16(Bt[n][k], At[m][k], acc[ai][bj][m][n], 0, 0, 0); __builtin_amdgcn_s_setprio(0); } while (0)
#define PG8_WAIT_V(n) asm volatile("s_waitcnt vmcnt(" #n ")" ::: "memory")
#define PG8_WAIT_VR do { if constexpr (Epi::NVM >= 32) asm volatile("s_waitcnt vmcnt(40)" ::: "memory"); else if constexpr (Epi::NVM >= 16) asm volatile("s_waitcnt vmcnt(24)" ::: "memory"); \
        else if constexpr (Epi::NVM >= 8) asm volatile("s_waitcnt vmcnt(16)" ::: "memory"); else asm volatile("s_waitcnt vmcnt(8)" ::: "memory"); } while (0)
#define PG8_WAIT_L(n) asm volatile("s_waitcnt lgkmcnt(" #n ")" ::: "memory")
#define PG8_BAR __builtin_amdgcn_s_barrier()
#define PG8_SCHED __builtin_amdgcn_sched_barrier(0)
    static_assert(SP2 || !Epi::HAS_EXT, "the K extension is wired into the SP2 loop only");
    Unit cur, nxt; int ui = 0;
    if (!S.next(0, cur)) return;
    f32x4 acc[2][2][4][2];
#pragma unroll
    for (int a = 0; a < 2; ++a)
#pragma unroll
        for (int b = 0; b < 2; ++b)
#pragma unroll
            for (int m = 0; m < 4; ++m)
#pragma unroll
                for (int n = 0; n < 2; ++n) acc[a][b][m][n] = (f32x4){0.f, 0.f, 0.f, 0.f};
    bf16x8 At[4][2], B0[2][2], B1[2][2];
    const char* cA = (const char*)g.A + (size_t)cur.pm * tstep; const char* cB = (const char*)g.Bt + (size_t)cur.pn * tstep;
    const char* eA = Epi::HAS_EXT ? (const char*)g.Ae + ((size_t)cur.pm * BM * g.lde_a + (size_t)cur.pn * BM) * 2 : nullptr; const char* eB = (const char*)g.Bte;
    S.a_ready(cur);
    float carry[8] = {0.f, 0.f, 0.f, 0.f, 0.f, 0.f, 0.f, 0.f};
    if constexpr (Epi::HAS_PRE) E.pre(cur, wr, fr, carry);
    if constexpr (SP2) {
        PG8_STAGE(PG8_SB(0, 0), cB, voffB); PG8_STAGE(PG8_SB(0, 1), cB + hstep, voffB); PG8_STAGE(PG8_SA(0, 0), cA, voffA); PG8_STAGE(PG8_SA(0, 1), cA + hstep, voffA);
        if (wr == 1) PG8_BAR;
        PG8_WAIT_V(2); PG8_BAR;
        PG8_STAGE(PG8_SB(1, 0), cB + kstep, voffB); PG8_STAGE(PG8_SA(1, 0), cA + kstep, voffA); PG8_STAGE(PG8_SB(1, 1), cB + hstep + kstep, voffB);
        PG8_WAIT_V(6); PG8_BAR;
    } else {
        PG8_STAGE(PG8_SB(0, 0), cB, voffB); PG8_STAGE(PG8_SA(0, 0), cA, voffA); PG8_STAGE(PG8_SB(0, 1), cB + hstep, voffB); PG8_STAGE(PG8_SA(0, 1), cA + hstep, voffA);
        if (wr == 1) PG8_BAR;
        PG8_WAIT_V(4); PG8_BAR;
        PG8_STAGE(PG8_SB(1, 0), cB + kstep, voffB); PG8_STAGE(PG8_SA(1, 0), cA + kstep, voffA); PG8_STAGE(PG8_SB(1, 1), cB + hstep + kstep, voffB);
        PG8_WAIT_V(6); PG8_BAR;
    }
    for (;;) {
        const bool has_next = S.next(ui + 1, nxt);
        const char* nA = has_next ? (const char*)g.A + (size_t)nxt.pm * tstep : cA; const char* nB = has_next ? (const char*)g.Bt + (size_t)nxt.pn * tstep : cB;
        int t0 = 0;
        if constexpr (SP2 && ALIGN_EPI && Epi::NVM > 0) { if (ui > 0) {
            const char* pa2 = cA + 2 * kstep; const char* pb2 = cB + 2 * kstep; const char* pa3 = pa2 + kstep; const char* pb3 = pb2 + kstep;


            PG8_LDB(B0, 0, 0); PG8_LDB(B1, 0, 1); PG8_SCHED; PG8_LDA(At, 0, 0);
            PG8_WAIT_VR; PG8_WAIT_L(0); PG8_BAR; PG8_MMA(0, 0, At, B0); PG8_MMA(0, 1, At, B1); PG8_BAR; PG8_SCHED;

            PG8_LDA(At, 0, 1); PG8_STAGE(PG8_SB(0, 0), pb2, voffB); PG8_STAGE(PG8_SB(0, 1), pb2 + hstep, voffB); PG8_STAGE(PG8_SA(0, 0), pa2, voffA);
            PG8_WAIT_VR; PG8_WAIT_L(0); PG8_BAR; PG8_MMA(1, 0, At, B0); PG8_MMA(1, 1, At, B1); PG8_BAR; PG8_SCHED;

            PG8_LDB(B0, 1, 0); PG8_LDB(B1, 1, 1); PG8_SCHED; PG8_LDA(At, 1, 0); PG8_STAGE(PG8_SA(0, 1), pa2 + hstep, voffA);
            PG8_WAIT_VR; PG8_WAIT_L(0); PG8_BAR; PG8_MMA(0, 0, At, B0); PG8_MMA(0, 1, At, B1); PG8_BAR; PG8_SCHED;

            PG8_LDA(At, 1, 1); PG8_STAGE(PG8_SB(1, 0), pb3, voffB); PG8_STAGE(PG8_SB(1, 1), pb3 + hstep, voffB); PG8_STAGE(PG8_SA(1, 0), pa3, voffA);
            PG8_WAIT_V(8); PG8_WAIT_L(0); PG8_BAR; PG8_MMA(1, 0, At, B0); PG8_MMA(1, 1, At, B1); PG8_BAR; PG8_SCHED;
            t0 = 2; } }
        for (int t = t0; t < nt; t += 2) {
            if constexpr (Epi::HAS_MID) { if (t == Epi::MID_T) { __builtin_amdgcn_sched_barrier(0); E.mid(acc, cur, wr, wc, fr, fq); __builtin_amdgcn_sched_barrier(0); } }
            const bool last = (t == nt - 2);
            const bool x1 = Epi::HAS_EXT && t >= ntm, x2 = Epi::HAS_EXT && !last && t + 2 >= ntm;
            const char* a1 = x1 ? eA + (size_t)(t + 1 - ntm) * kstep : cA + (size_t)(t + 1) * kstep;
            const char* a2 = last ? nA : (x2 ? eA + (size_t)(t + 2 - ntm) * kstep : cA + (size_t)(t + 2) * kstep);
            const char* b2 = last ? nB : (x2 ? eB + (size_t)(t + 2 - ntm) * kstep : cB + (size_t)(t + 2) * kstep);
            const char* a3 = a2 + kstep; const char* b3 = b2 + kstep;
            const size_t hA1 = x1 ? hstepAe : hstep, hA2 = x2 ? hstepAe : hstep, hB2 = x2 ? hstepBe : hstep;
            unsigned vA1[2], vA2[2], vB2[2];
#pragma unroll
            for (int i = 0; i < 2; ++i) { vA1[i] = x1 ? voffAe[i] : voffA[i]; vA2[i] = x2 ? voffAe[i] : voffA[i]; vB2[i] = x2 ? voffBe[i] : voffB[i]; }
            if (last && has_next) S.a_ready(nxt);
            if constexpr (SP2) {
            PG8_LDB(B0, 0, 0); PG8_LDB(B1, 0, 1); PG8_SCHED; PG8_LDA(At, 0, 0); PG8_STAGE(PG8_SA(1, 1), a1 + hA1, vA1);
            PG8_WAIT_V(8); PG8_WAIT_L(0); PG8_BAR; PG8_MMA(0, 0, At, B0); PG8_MMA(0, 1, At, B1); PG8_BAR; PG8_SCHED;
            PG8_LDA(At, 0, 1); PG8_STAGE(PG8_SB(0, 0), b2, vB2); PG8_STAGE(PG8_SB(0, 1), b2 + hB2, vB2); PG8_STAGE(PG8_SA(0, 0), a2, vA2);
            PG8_WAIT_V(8); PG8_WAIT_L(0); PG8_BAR; PG8_MMA(1, 0, At, B0); PG8_MMA(1, 1, At, B1); PG8_BAR; PG8_SCHED;
            PG8_LDB(B0, 1, 0); PG8_LDB(B1, 1, 1); PG8_SCHED; PG8_LDA(At, 1, 0); PG8_STAGE(PG8_SA(0, 1), a2 + hA2, vA2);
            PG8_WAIT_V(8); PG8_WAIT_L(0); PG8_BAR; PG8_MMA(0, 0, At, B0); PG8_MMA(0, 1, At, B1); PG8_BAR; PG8_SCHED;
            PG8_LDA(At, 1, 1); PG8_STAGE(PG8_SB(1, 0), b3, vB2); PG8_STAGE(PG8_SB(1, 1), b3 + hB2, vB2); PG8_STAGE(PG8_SA(1, 0), a3, vA2);
            PG8_WAIT_V(8); PG8_WAIT_L(0); PG8_BAR; PG8_MMA(1, 0, At, B0); PG8_MMA(1, 1, At, B1); PG8_BAR; PG8_SCHED;
            } else {
            PG8_LDB(B0, 0, 0); PG8_SCHED; PG8_LDA(At, 0, 0); PG8_STAGE(PG8_SA(1, 1), a1 + hstep, voffA);
            PG8_WAIT_L(8); PG8_BAR; PG8_WAIT_L(0); PG8_MMA(0, 0, At, B0); PG8_BAR; PG8_SCHED;
            PG8_LDB(B1, 0, 1); PG8_STAGE(PG8_SB(0, 0), b2, voffB);
            PG8_BAR; PG8_WAIT_L(0); PG8_MMA(0, 1, At, B1); PG8_BAR;
            PG8_LDA(At, 0, 1); PG8_STAGE(PG8_SA(0, 0), a2, voffA);
            PG8_BAR; PG8_WAIT_L(0); PG8_MMA(1, 0, At, B0); PG8_BAR; PG8_SCHED;
            PG8_STAGE(PG8_SB(0, 1), b2 + hstep, voffB);
            PG8_WAIT_V(6); PG8_BAR; PG8_MMA(1, 1, At, B1); PG8_BAR;
            PG8_LDB(B0, 1, 0); PG8_SCHED; PG8_LDA(At, 1, 0); PG8_STAGE(PG8_SA(0, 1), a2 + hstep, voffA);
            PG8_WAIT_L(8); PG8_BAR; PG8_WAIT_L(0); PG8_MMA(0, 0, At, B0); PG8_BAR; PG8_SCHED;
            PG8_LDB(B1, 1, 1); PG8_STAGE(PG8_SB(1, 0), b3, voffB);
            PG8_BAR; PG8_WAIT_L(0); PG8_MMA(0, 1, At, B1); PG8_BAR;
            PG8_LDA(At, 1, 1); PG8_STAGE(PG8_SA(1, 0), a3, voffA);
            PG8_BAR; PG8_WAIT_L(0); PG8_MMA(1, 0, At, B0); PG8_BAR; PG8_SCHED;
            PG8_STAGE(PG8_SB(1, 1), b3 + hstep, voffB);
            PG8_WAIT_V(6); PG8_BAR; PG8_MMA(1, 1, At, B1); PG8_BAR;
            }
        }
        if constexpr (ALIGN_EPI) { if (wr == 0) PG8_BAR; }
        if constexpr (SP2 && ALIGN_EPI && Epi::NVM > 0) { if (has_next) PG8_STAGE(PG8_SA(1, 1), nA + kstep + hstep, voffA); asm volatile("" ::: "memory"); PG8_SCHED; }
        if constexpr (!Epi::AFTER_DRAIN) { if constexpr (Epi::HAS_PRE) { E.run(acc, cur, wr, wc, fr, fq, carry); if (has_next) E.pre(nxt, wr, fr, carry); } else E(acc, cur, wr, wc, fr, fq); S.done(cur); }
        if (!has_next) break;
#pragma unroll
        for (int a = 0; a < 2; ++a)
#pragma unroll
            for (int b = 0; b < 2; ++b)
#pragma unroll
                for (int m = 0; m < 4; ++m)
#pragma unroll
                    for (int n = 0; n < 2; ++n) { acc[a][b][m][n] = (f32x4){0.f, 0.f, 0.f, 0.f}; asm volatile("" : "+v"(acc[a][b][m][n])); }
        cur = nxt; cA = nA; cB = nB; ++ui;
        if constexpr (Epi::HAS_EXT) eA = (const char*)g.Ae + ((size_t)cur.pm * BM * g.lde_a + (size_t)cur.pn * BM) * 2;
        if constexpr (ALIGN_EPI) { if (wr == 1) PG8_BAR; }
    }
    PG8_WAIT_V(0);
    if constexpr (!ALIGN_EPI) { if (wr == 0) PG8_BAR; }
    PG8_BAR;
    if constexpr (Epi::AFTER_DRAIN) { E.fused(acc, cur, wr, wc, fr, fq, lds, wid, lane); S.done(cur); }
#undef PG8_SA
#undef PG8_SB
#undef PG8_STAGE
#undef PG8_LDA
#undef PG8_LDB
#undef PG8_MMA
#undef PG8_WAIT_V
#undef PG8_WAIT_L
#undef PG8_BAR
#undef PG8_SCHED
}
}

#ifndef PG8_SP2
#define PG8_SP2 true
#endif
#ifndef PG8_ALIGN
#define PG8_ALIGN true
#endif
#define GAS __attribute__((address_space(1)))
#define LAS __attribute__((address_space(3)))
typedef unsigned short bf16;
typedef unsigned v4u __attribute__((ext_vector_type(4)));
typedef float f32x4 __attribute__((ext_vector_type(4)));
typedef short bf16x8 __attribute__((ext_vector_type(8)));
typedef GAS unsigned gu32;
typedef GAS unsigned long long gu64;
#define RLX_AGENT __ATOMIC_RELAXED, __HIP_MEMORY_SCOPE_AGENT
#define LDS_WAIT() asm volatile("s_waitcnt lgkmcnt(0)" ::: "memory")
#define VM_WAIT() asm volatile("s_waitcnt vmcnt(0)" ::: "memory")
__device__ __forceinline__ unsigned long long rt() { return __builtin_amdgcn_s_memrealtime(); }
__device__ __forceinline__ unsigned f2bf(float f) { unsigned u = __builtin_bit_cast(unsigned, f); return (u + 0x7fffu + ((u >> 16) & 1u)) >> 16; }
__device__ __forceinline__ unsigned pk2(float lo, float hi) { return f2bf(lo) | (f2bf(hi) << 16); }

#define XB_TMO      128
#define XB_XCNT(j)  (256  + 64 * (j))
#define XB_XSUB(j)  (1280 + 64 * (j))
#define XB_XGEN(j)  (2304 + 64 * (j))
#define XB_TOP      3328
#define XB_TOPGEN   3392
#define XCD_BAR_WORDS 3456
#define XB_SPIN_CAP (1u << 18)

__device__ __forceinline__ unsigned xb_ld(unsigned* p)              { return __hip_atomic_load(p, __ATOMIC_RELAXED, __HIP_MEMORY_SCOPE_AGENT); }
__device__ __forceinline__ unsigned xb_add(unsigned* p, unsigned v) { return __hip_atomic_fetch_add(p, v, __ATOMIC_RELAXED, __HIP_MEMORY_SCOPE_AGENT); }
__device__ __forceinline__ unsigned xb_xcc_id() { return (unsigned)__builtin_amdgcn_s_getreg((3 << 11) | 20) & 0xFu; }
#define XB_SPIN(cond, bar) do { unsigned _sp = 0; while (cond) { __builtin_amdgcn_s_sleep(1); \
    if ((++_sp & 255u) == 0u) { if (xb_ld(&(bar)[XB_TMO])) break; if (_sp > XB_SPIN_CAP) { atomicAdd(&(bar)[XB_TMO], 1u); break; } } } } while (0)

struct XcdBarrier {
    unsigned* bar; unsigned x;
    volatile LAS unsigned* st;
};

__device__ __forceinline__ XcdBarrier xcd_barrier_post(unsigned* bar, volatile LAS unsigned* st) {
    XcdBarrier b; b.bar = bar; b.x = xb_xcc_id(); b.st = st;
    if (threadIdx.x == 0) (void)xb_add(&bar[XB_XCNT(b.x)], 1u);
    return b;
}
__device__ __forceinline__ void xcd_barrier_complete(unsigned* bar, unsigned x, unsigned& nloc, unsigned& nx) {
    const unsigned G = gridDim.x * gridDim.y * gridDim.z;
    unsigned sum, cnt, mine, sp = 0u;
    for (;;) {
        sum = 0u; cnt = 0u; mine = 0u;
#pragma unroll
        for (unsigned j = 0; j < 16; ++j) { const unsigned c = xb_ld(&bar[XB_XCNT(j)]); sum += c; cnt += (c > 0u) ? 1u : 0u; mine = (j == x) ? c : mine; }
        if (sum == G) break;
        __builtin_amdgcn_s_sleep(1);
        if ((++sp & 255u) == 0u) { if (xb_ld(&bar[XB_TMO])) break; if (sp > XB_SPIN_CAP) { atomicAdd(&bar[XB_TMO], 1u); break; } }
    }
    nloc = mine > 0u ? mine : 1u; nx = cnt > 0u ? cnt : 1u;
}

__device__ __forceinline__ void xcd_barrier(const XcdBarrier& b) {
    asm volatile("s_waitcnt vmcnt(0)" ::: "memory");
    __syncthreads();
    if (threadIdx.x == 0) {
        unsigned* bar = b.bar;
        __builtin_amdgcn_s_waitcnt(0);
        unsigned nloc = b.st[0], nx = b.st[1];
        if (nloc == 0u) { xcd_barrier_complete(bar, b.x, nloc, nx); b.st[0] = nloc; b.st[1] = nx; }
        const unsigned old = xb_add(&bar[XB_XSUB(b.x)], 1u);
        const unsigned gen = old / nloc;
        if (old + 1u == (gen + 1u) * nloc) {
            __builtin_amdgcn_fence(__ATOMIC_RELEASE, "agent");
            asm volatile("s_waitcnt vmcnt(0)" ::: "memory");
            const unsigned og = xb_add(&bar[XB_TOP], 1u);
            const unsigned tg = og / nx;
            if (og + 1u == (tg + 1u) * nx) xb_add(&bar[XB_TOPGEN], 1u);
            else XB_SPIN(xb_ld(&bar[XB_TOPGEN]) == tg, bar);
            __builtin_amdgcn_fence(__ATOMIC_ACQUIRE, "agent");
            xb_add(&bar[XB_XGEN(b.x)], 1u);
            asm volatile("s_waitcnt vmcnt(0)" ::: "memory");
        } else {
            XB_SPIN(xb_ld(&bar[XB_XGEN(b.x)]) == gen, bar);
            __builtin_amdgcn_fence(__ATOMIC_ACQUIRE, "agent");
            asm volatile("s_waitcnt vmcnt(0)" ::: "memory");
        }
    }
    __syncthreads();
}

constexpr int NWAVES = 8;
#ifndef MK_N_LAUNCHES
#define MK_N_LAUNCHES 1
#endif
constexpr int PER_PHASE = 9;
constexpr int N_LAUNCHES = MK_N_LAUNCHES;
static_assert(N_LAUNCHES == 1 || N_LAUNCHES == PER_PHASE, "MK_N_LAUNCHES is 1 or 9");

constexpr int BATCH = 8, SEQ = 4096, D = 1024, M = BATCH * SEQ;
constexpr int DCONV = 512, DATT = 512, NH = 8, HD = 64, FF = 2816, NGU = 2 * FF;
constexpr int NPROJ_SRC = 4808, NPROJ = 4864;
constexpr int PC_CB = 0, PC_CC = 512, PC_CX = 1024, PC_Q = 1536, PC_IQ = 2048, PC_KVI = 2560, PC_GA = 2816, PC_GB = 3840;
constexpr int KVP = 128, KV_K = 0, KV_V = 64;
constexpr float EPS = 1e-6f;
constexpr int TOPK = 256;

constexpr size_t MiB = 1u << 20;
constexpr size_t WS_CTL = 0, CTL_ZERO_BYTES = 1 * MiB;
constexpr size_t WS_SSQ1 = 256 * 1024, WS_SSQ2 = 512 * 1024;
constexpr size_t WS_RC = 896 * 1024;
constexpr size_t WS_IDENT = 768 * 1024;
constexpr int BM256 = 256;
constexpr size_t WS_WIN = 6 * MiB, WS_WA = 16 * MiB, WS_WB = 17 * MiB, WS_WOUT = 18 * MiB, WS_WGU = 20 * MiB, WS_WD = 31 * MiB;
constexpr size_t WS_XN = 40 * MiB;
constexpr size_t WS_CONV = 104 * MiB, WS_ATTN = 136 * MiB;
constexpr size_t WS_PROJ = 168 * MiB;
constexpr size_t WS_KVI = 472 * MiB;
constexpr size_t WS_IKF = 480 * MiB, WS_IW = 484 * MiB;
constexpr size_t WS_SSQ0 = WS_IW + 3 * MiB;
constexpr size_t WS_END = 488 * MiB;
static_assert(WS_WIN + (size_t)NPROJ * D * 2 <= WS_WA && WS_WGU + (size_t)NGU * D * 2 <= WS_WD && WS_WD + (size_t)D * FF * 2 <= WS_XN, "weights map");
static_assert(WS_PROJ + (size_t)M * NPROJ * 2 <= WS_KVI && WS_KVI + (size_t)M * KVP * 2 <= WS_IKF && WS_IKF + (size_t)M * 64 * 2 <= WS_IW && WS_IW + (size_t)M * 16 <= WS_END && WS_XN + (size_t)M * D * 2 <= WS_CONV && WS_ATTN + (size_t)M * 512 * 2 <= WS_PROJ, "activation map");
constexpr int CW_BAR = 4096;

constexpr int RING_OFF = 0, RING_BYTES = 131072;
constexpr int LDSCTL_OFF = RING_BYTES, MISC_OFF = LDSCTL_OFF + 320;
constexpr int TAB_OFF = RING_BYTES + 1024;
constexpr int LDS_BYTES = 147456;
static_assert(MISC_OFF + 128 <= TAB_OFF && TAB_OFF + 4096 <= LDS_BYTES, "LDS map");

struct Frame {
    LAS unsigned char* lds;
    volatile LAS unsigned* MISC;
    gu32* ctl;
    int tid, lane, wave;
    int vcu, G;
};

__device__ __forceinline__ float wave_sum(float v) {
#pragma unroll
    for (int o = 1; o < 64; o <<= 1) v += __shfl_xor(v, o);
    return v;
}
__device__ __forceinline__ float bf_lo(unsigned w) { return __builtin_bit_cast(float, w << 16); }
__device__ __forceinline__ float bf_hi(unsigned w) { return __builtin_bit_cast(float, w & 0xffff0000u); }
__device__ __forceinline__ float fast_sigmoid(float z) { return __builtin_amdgcn_rcpf(1.0f + __builtin_amdgcn_exp2f(-1.4426950408889634f * z)); }

__device__ __forceinline__ void p0_transpose_item(const float* W, int K, int N, int k0, int scol0, int nvalid, bf16* WT, int drow0, const float* kscale, LAS float* scr, int lane, int ldk = 0, int kd0 = -1) {
    if (ldk == 0) ldk = K; if (kd0 < 0) kd0 = k0;
    const int kr = lane >> 3, j4 = lane & 7;
    f32x4 v[8];
#pragma unroll
    for (int i = 0; i < 8; ++i) { v[i] = (f32x4){0.f, 0.f, 0.f, 0.f};
        if (4 * j4 < nvalid) v[i] = *(const GAS f32x4*)(W + (size_t)(k0 + 8 * i + kr) * N + scol0 + 4 * j4); }
    if (kscale) {
#pragma unroll
        for (int i = 0; i < 8; ++i) v[i] = v[i] * kscale[k0 + 8 * i + kr]; }
#pragma unroll
    for (int i = 0; i < 8; ++i) { LAS float* d = scr + (8 * i + kr) * 33 + 4 * j4; d[0] = v[i].x; d[1] = v[i].y; d[2] = v[i].z; d[3] = v[i].w; }
    LDS_WAIT(); asm volatile("" ::: "memory");
    const int c = lane & 7;
#pragma unroll
    for (int jj = 0; jj < 4; ++jj) { const int n = (lane >> 3) + 8 * jj; const LAS float* s = scr + (8 * c) * 33 + n;
        v4u o; o.x = pk2(s[0 * 33], s[1 * 33]); o.y = pk2(s[2 * 33], s[3 * 33]); o.z = pk2(s[4 * 33], s[5 * 33]); o.w = pk2(s[6 * 33], s[7 * 33]);
        *(GAS v4u*)(WT + (size_t)(drow0 + n) * ldk + kd0 + 8 * c) = o; }
    LDS_WAIT(); asm volatile("" ::: "memory");
}
__device__ __forceinline__ void rms_rows2_to_bf16(int lane, const float* xrow0, const float* xrow1, const float* g, bf16* orow0, bf16* orow1) {
    const GAS f32x4* xa = (const GAS f32x4*)xrow0 + lane; const GAS f32x4* xb = (const GAS f32x4*)xrow1 + lane; const GAS f32x4* gr = (const GAS f32x4*)g + lane;
    f32x4 va[4], vb[4]; float sa = 0.f, sb = 0.f;
#pragma unroll
    for (int j = 0; j < 4; ++j) { va[j] = xa[64 * j]; vb[j] = xb[64 * j]; }
#pragma unroll
    for (int j = 0; j < 4; ++j) { sa += (va[j].x * va[j].x + va[j].y * va[j].y) + (va[j].z * va[j].z + va[j].w * va[j].w); sb += (vb[j].x * vb[j].x + vb[j].y * vb[j].y) + (vb[j].z * vb[j].z + vb[j].w * vb[j].w); }
#pragma unroll
    for (int o = 1; o < 64; o <<= 1) { sa += __shfl_xor(sa, o); sb += __shfl_xor(sb, o); }
    const float ra = 1.f / sqrtf(sa * (1.f / D) + EPS), rb = 1.f / sqrtf(sb * (1.f / D) + EPS);
    GAS unsigned long long* oa = (GAS unsigned long long*)orow0 + lane; GAS unsigned long long* ob = (GAS unsigned long long*)orow1 + lane;
#pragma unroll
    for (int j = 0; j < 4; ++j) { const f32x4 gg = gr[64 * j];
        oa[64 * j] = (unsigned long long)pk2(va[j].x * ra * gg.x, va[j].y * ra * gg.y) | ((unsigned long long)pk2(va[j].z * ra * gg.z, va[j].w * ra * gg.w) << 32);
        ob[64 * j] = (unsigned long long)pk2(vb[j].x * rb * gg.x, vb[j].y * rb * gg.y) | ((unsigned long long)pk2(vb[j].z * rb * gg.z, vb[j].w * rb * gg.w) << 32); }
}

__device__ __forceinline__ void x_rows2_to_bf16(int lane, const float* xrow0, const float* xrow1, bf16* orow0, bf16* orow1, float* ss0, float* ss1) {
    const GAS f32x4* xa = (const GAS f32x4*)xrow0 + lane; const GAS f32x4* xb = (const GAS f32x4*)xrow1 + lane;
    f32x4 va[4], vb[4]; float sa = 0.f, sb = 0.f;
#pragma unroll
    for (int j = 0; j < 4; ++j) { va[j] = xa[64 * j]; vb[j] = xb[64 * j]; }
    GAS unsigned long long* oa = (GAS unsigned long long*)orow0 + lane; GAS unsigned long long* ob = (GAS unsigned long long*)orow1 + lane;
#pragma unroll
    for (int j = 0; j < 4; ++j) { sa += (va[j].x * va[j].x + va[j].y * va[j].y) + (va[j].z * va[j].z + va[j].w * va[j].w); sb += (vb[j].x * vb[j].x + vb[j].y * vb[j].y) + (vb[j].z * vb[j].z + vb[j].w * vb[j].w);
        oa[64 * j] = (unsigned long long)pk2(va[j].x, va[j].y) | ((unsigned long long)pk2(va[j].z, va[j].w) << 32);
        ob[64 * j] = (unsigned long long)pk2(vb[j].x, vb[j].y) | ((unsigned long long)pk2(vb[j].z, vb[j].w) << 32); }
#pragma unroll
    for (int o = 1; o < 64; o <<= 1) { sa += __shfl_xor(sa, o); sb += __shfl_xor(sb, o); }
    if (lane == 0) { *ss0 = sa; *ss1 = sb; }
}

struct Ptrs {
    const float *x, *g_mix, *w_in, *b_gate, *conv_w, *w_a, *w_b, *w_out, *rel_bias, *g_ffn, *w_g, *w_u, *w_d, *g_final;
    float* out; unsigned char* ws;
};

constexpr int PI_IN = (NPROJ / 32) * (D / 64), PI_A = (D / 32) * (DCONV / 64), PI_B = (D / 32) * (DATT / 64), PI_O = (D / 32) * (D / 64), PI_GU = (NGU / 32) * (D / 64), PI_D = (D / 32) * (FF / 64);
constexpr int PI_ALL = PI_IN + PI_A + PI_B + PI_O + PI_GU + PI_D;
__device__ __forceinline__ void p0_weight_items(Frame& F, const Ptrs& P, int lo, int hi, int gw, int NGW) {
    LAS float* scr = (LAS float*)(F.lds + RING_OFF + F.wave * 16384);
    bf16* WinT = (bf16*)(P.ws + WS_WIN); bf16* WaT = (bf16*)(P.ws + WS_WA); bf16* WbT = (bf16*)(P.ws + WS_WB); bf16* WoutT = (bf16*)(P.ws + WS_WOUT);
    bf16* WguT = (bf16*)(P.ws + WS_WGU); bf16* WdT = (bf16*)(P.ws + WS_WD);
    for (int it = lo + gw; it < hi; it += NGW) {
        int r = it;
        if (r < PI_IN) { const int db = r / (D / 64), kb = r % (D / 64), drow0 = 32 * db; int scol0, nvalid;
            if (drow0 < 2048) { scol0 = drow0; nvalid = 32; }
            else if (drow0 < 2560) { scol0 = drow0 + 128; nvalid = 32; }
            else if (drow0 < 2688) { scol0 = drow0 - 512; nvalid = 32; }
            else if (drow0 < 2752) { scol0 = drow0; nvalid = 32; }
            else if (drow0 == 2752) { scol0 = 2752; nvalid = 8; }
            else if (drow0 < PC_GA) { scol0 = 0; nvalid = 0; }
            else { scol0 = drow0 - 56; nvalid = 32; }
            p0_transpose_item(P.w_in, D, NPROJ_SRC, 64 * kb, scol0, nvalid, WinT, drow0, P.g_mix, scr, F.lane); continue; } r -= PI_IN;
        if (r < PI_A) { const int db = r / (DCONV / 64), kb = r % (DCONV / 64); p0_transpose_item(P.w_a, DCONV, D, 64 * kb, 32 * db, 32, WaT, 32 * db, nullptr, scr, F.lane, D, 64 * kb); continue; } r -= PI_A;
        if (r < PI_B) { const int db = r / (DATT / 64), kb = r % (DATT / 64); p0_transpose_item(P.w_b, DATT, D, 64 * kb, 32 * db, 32, WaT, 32 * db, nullptr, scr, F.lane, D, DCONV + 64 * kb); continue; } r -= PI_B;
        if (r < PI_O) { const int db = r / (D / 64), kb = r % (D / 64); p0_transpose_item(P.w_out, D, D, 64 * kb, 32 * db, 32, WoutT, 32 * db, nullptr, scr, F.lane); continue; } r -= PI_O;
        if (r < PI_GU) { const int db = r / (D / 64), kb = r % (D / 64), drow0 = 32 * db, p = drow0 >> 8, bj = (drow0 >> 7) & 1, q = (drow0 >> 5) & 3;
            p0_transpose_item(bj ? P.w_u : P.w_g, D, FF, 64 * kb, 128 * p + 32 * q, 32, WguT, drow0, P.g_ffn, scr, F.lane); continue; } r -= PI_GU;
        { const int db = r / (FF / 64), kb = r % (FF / 64); p0_transpose_item(P.w_d, FF, D, 64 * kb, 32 * db, 32, WdT, 32 * db, nullptr, scr, F.lane); }
    }
}
__device__ __forceinline__ void p0_prologue(Frame& F, const Ptrs& P, bool all_weights) {
    const int gw = F.vcu * NWAVES + F.wave, NGW = F.G * NWAVES;
    p0_weight_items(F, P, 0, all_weights ? PI_ALL : PI_IN, gw, NGW);
    bf16* XB = (bf16*)P.out; float* SSQ0 = (float*)(P.ws + WS_SSQ0);
    for (int m = gw; m < M; m += 2 * NGW) { const int m1 = (m + NGW < M) ? m + NGW : m;
        x_rows2_to_bf16(F.lane, P.x + (size_t)m * D, P.x + (size_t)m1 * D, XB + (size_t)m * D, XB + (size_t)m1 * D, SSQ0 + m, SSQ0 + m1); }
}

namespace pg8 {
struct EpiProj {
    static constexpr bool PERM = true, AFTER_DRAIN = false, HAS_PRE = true, HAS_MID = false, HAS_EXT = false;
    static constexpr int NVM = 16;
    bf16_t* O; int ldc; bf16_t* KV; bf16_t* IKF; bf16_t* IW; int kv_tile; PG8_LAS const float* bgate; int gate_col0; bf16_t* JUNK; const float* SSQ; PG8_LAS float* RS;
    __device__ __forceinline__ void pre(const Unit& u, int wr, int fr, float (&carry)[8]) const {
        const int have = __builtin_amdgcn_readfirstlane(__builtin_bit_cast(int, carry[0])) - 1;
        if (u.pm != have) { const int par = __builtin_amdgcn_readfirstlane(__builtin_bit_cast(int, carry[1])) ^ 1; const int t = threadIdx.x;
            if (t < BM) RS[par * BM + t] = 1.0f / sqrtf(SSQ[u.pm * BM + t] * (1.0f / D) + 1e-6f);
            carry[0] = __builtin_bit_cast(float, u.pm + 1); carry[1] = __builtin_bit_cast(float, par); }
    }
    template <bool GATE> __device__ __forceinline__ void body(const f32x4 (&acc)[2][2][4][2], const Unit& u, int wr, int wc, int fr, int fq, const float (&carry)[8]) const {
        int row0 = u.pm * BM + wr * 64 + fr; const bool kv = !GATE && (u.pn == kv_tile); int cid = 4 * wc + fq;
        asm volatile("" : "+v"(row0), "+v"(cid));
        const PG8_LAS float* rs = RS + __builtin_amdgcn_readfirstlane(__builtin_bit_cast(int, carry[1])) * BM + wr * 64 + fr;
        float rst[8];
#pragma unroll
        for (int ai = 0; ai < 2; ++ai)
#pragma unroll
            for (int m = 0; m < 4; ++m) rst[4 * ai + m] = rs[ai * HALF + m * 16];
        f32x4 gb0[2], gb1[2];
#pragma unroll
        for (int bj = 0; bj < 2; ++bj) { gb0[bj] = (f32x4){0.f, 0.f, 0.f, 0.f}; gb1[bj] = gb0[bj];
            if (GATE) { PG8_LAS const float* bp = bgate + (u.pn * BM - gate_col0) + bj * HALF + 8 * cid; gb0[bj] = *(PG8_LAS const f32x4*)bp; gb1[bj] = *(PG8_LAS const f32x4*)(bp + 4); } }
#pragma unroll
        for (int ai = 0; ai < 2; ++ai)
#pragma unroll
            for (int m = 0; m < 4; ++m) { const int row = row0 + ai * HALF + m * 16;
#pragma unroll
                for (int bj = 0; bj < 2; ++bj) { f32x4 v0 = acc[ai][bj][m][0] * rst[4 * ai + m], v1 = acc[ai][bj][m][1] * rst[4 * ai + m];
                    if (GATE) {
                        v0 = v0 + gb0[bj]; v1 = v1 + gb1[bj]; unsigned q[8];
#pragma unroll
                        for (int k = 0; k < 4; ++k) { q[k] = (unsigned)__builtin_amdgcn_fmed3f(fast_sigmoid(v0[k]) * 256.0f + 0.5f, 1.0f, 255.0f); q[4 + k] = (unsigned)__builtin_amdgcn_fmed3f(fast_sigmoid(v1[k]) * 256.0f + 0.5f, 1.0f, 255.0f); }
                        typedef unsigned u32x2g __attribute__((ext_vector_type(2)));
                        u32x2g w8; w8.x = q[0] | (q[1] << 8) | (q[2] << 16) | (q[3] << 24); w8.y = q[4] | (q[5] << 8) | (q[6] << 16) | (q[7] << 24);
                        *(u32x2g*)((unsigned char*)(O + (size_t)row * ldc + gate_col0) + (u.pn * BM - gate_col0) + bj * HALF + 8 * cid) = w8;
                        continue; }
                    u32x4 w; w.x = cvt_pk_bf16(v0[0], v0[1]); w.y = cvt_pk_bf16(v0[2], v0[3]); w.z = cvt_pk_bf16(v1[0], v1[1]); w.w = cvt_pk_bf16(v1[2], v1[3]);
                    if (!kv) *(u32x4*)(O + (size_t)row * ldc + u.pn * BM + bj * HALF + 8 * cid) = w;
                    else if (bj == 0) { typedef unsigned u32x2k __attribute__((ext_vector_type(2)));
                        int k0 = __builtin_amdgcn_cvt_pk_fp8_f32(v0[0], v0[1], 0, false); k0 = __builtin_amdgcn_cvt_pk_fp8_f32(v0[2], v0[3], k0, true);
                        int k1 = __builtin_amdgcn_cvt_pk_fp8_f32(v1[0], v1[1], 0, false); k1 = __builtin_amdgcn_cvt_pk_fp8_f32(v1[2], v1[3], k1, true);
                        u32x2k w8; w8.x = (unsigned)k0; w8.y = (unsigned)k1; *(u32x2k*)((unsigned char*)KV + (size_t)row * 128 + 8 * cid) = w8; }
                    else if (cid < 8) { const int s = row & 4095; *(u32x4*)(IKF + (size_t)(row >> 12) * (4096 * 64) + (s >> 5) * 2048 + cid * 256 + (s & 31) * 8) = w; }
                    else if (cid == 8) *(u32x4*)(IW + (size_t)row * 8) = w;
                    else *(u32x4*)(JUNK + (size_t)(row & 1023) * 8) = w; } }
    }
    __device__ __forceinline__ void run(const f32x4 (&acc)[2][2][4][2], const Unit& u, int wr, int wc, int fr, int fq, const float (&carry)[8]) const {
        if (u.pn * BM >= gate_col0) body<true>(acc, u, wr, wc, fr, fq, carry); else body<false>(acc, u, wr, wc, fr, fq, carry);
    }
};
template <bool ACCUM> struct EpiGate {
    static constexpr bool PERM = true, AFTER_DRAIN = false, HAS_PRE = false, HAS_MID = false, HAS_EXT = false;
    static constexpr int NVM = 0;
    bf16_t* O; const bf16_t* G; int ldg; const float* bg;
    __device__ __forceinline__ void operator()(const f32x4 (&acc)[2][2][4][2], const Unit& u, int wr, int wc, int fr, int fq) const {
        const int row0 = u.pm * BM + wr * 64 + fr, col0 = u.pn * BM + wc * 32 + 8 * fq;
        f32x4 bv[2][2];
#pragma unroll
        for (int bj = 0; bj < 2; ++bj)
#pragma unroll
            for (int n = 0; n < 2; ++n) bv[bj][n] = *(const f32x4*)(bg + col0 + bj * HALF + 4 * n);
#pragma unroll
        for (int ai = 0; ai < 2; ++ai) {
            u32x4 gv[4][2], ov[4][2];
#pragma unroll
            for (int m = 0; m < 4; ++m) { const size_t row = (size_t)(row0 + ai * HALF + m * 16);
#pragma unroll
                for (int bj = 0; bj < 2; ++bj) { gv[m][bj] = *(const u32x4*)(G + row * ldg + col0 + bj * HALF); if (ACCUM) ov[m][bj] = *(const u32x4*)(O + row * D + col0 + bj * HALF); } }
#pragma unroll
            for (int m = 0; m < 4; ++m) { const size_t row = (size_t)(row0 + ai * HALF + m * 16);
#pragma unroll
                for (int bj = 0; bj < 2; ++bj) { const u32x4 g4 = gv[m][bj];
                    float g[8] = {bf_lo(g4.x), bf_hi(g4.x), bf_lo(g4.y), bf_hi(g4.y), bf_lo(g4.z), bf_hi(g4.z), bf_lo(g4.w), bf_hi(g4.w)};
                    float o[8];
#pragma unroll
                    for (int k = 0; k < 4; ++k) { o[k] = fast_sigmoid(g[k] + bv[bj][0][k]) * acc[ai][bj][m][0][k]; o[4 + k] = fast_sigmoid(g[4 + k] + bv[bj][1][k]) * acc[ai][bj][m][1][k]; }
                    if (ACCUM) { const u32x4 o4 = ov[m][bj];
                        o[0] += bf_lo(o4.x); o[1] += bf_hi(o4.x); o[2] += bf_lo(o4.y); o[3] += bf_hi(o4.y); o[4] += bf_lo(o4.z); o[5] += bf_hi(o4.z); o[6] += bf_lo(o4.w); o[7] += bf_hi(o4.w); }
                    u32x4 w; w.x = cvt_pk_bf16(o[0], o[1]); w.y = cvt_pk_bf16(o[2], o[3]); w.z = cvt_pk_bf16(o[4], o[5]); w.w = cvt_pk_bf16(o[6], o[7]);
                    *(u32x4*)(O + row * D + col0 + bj * HALF) = w; } }
            asm volatile("" ::: "memory"); }
    }
};
struct EpiGateMerged {
    static constexpr bool PERM = true, AFTER_DRAIN = false, HAS_PRE = false, HAS_MID = true, HAS_EXT = false; static constexpr int MID_T = 8;
    static constexpr int NVM = 16;
    bf16_t* O; const unsigned char* G8; int ldgb;
    typedef unsigned u32x2g __attribute__((ext_vector_type(2)));
    static __device__ __forceinline__ void unpack8(u32x2g g, float (&f)[8]) {
        f[0] = (float)(g.x & 255u); f[1] = (float)((g.x >> 8) & 255u); f[2] = (float)((g.x >> 16) & 255u); f[3] = (float)(g.x >> 24);
        f[4] = (float)(g.y & 255u); f[5] = (float)((g.y >> 8) & 255u); f[6] = (float)((g.y >> 16) & 255u); f[7] = (float)(g.y >> 24); }
    __device__ __forceinline__ void mid(f32x4 (&acc)[2][2][4][2], const Unit& u, int wr, int wc, int fr, int fq) const {
        int row0 = u.pm * BM + wr * 64 + fr, col0 = u.pn * BM + wc * 32 + 8 * fq;
        asm volatile("" : "+v"(row0), "+v"(col0));
#pragma unroll
        for (int bj = 0; bj < 2; ++bj) {
            u32x2g ga[2][4], gb[2][4];
#pragma unroll
            for (int ai = 0; ai < 2; ++ai)
#pragma unroll
                for (int m = 0; m < 4; ++m) { const unsigned char* gp = G8 + (size_t)(row0 + ai * HALF + m * 16) * ldgb + col0 + bj * HALF;
                    ga[ai][m] = *(const u32x2g*)gp; gb[ai][m] = *(const u32x2g*)(gp + D); }
#pragma unroll
            for (int ai = 0; ai < 2; ++ai)
#pragma unroll
                for (int m = 0; m < 4; ++m) { float xa[8], xb[8]; unpack8(ga[ai][m], xa); unpack8(gb[ai][m], xb);
#pragma unroll
                    for (int k = 0; k < 4; ++k) { acc[ai][bj][m][0][k] *= xa[k] * __builtin_amdgcn_rcpf(xb[k]); acc[ai][bj][m][1][k] *= xa[4 + k] * __builtin_amdgcn_rcpf(xb[4 + k]); } }
            asm volatile("" ::: "memory"); }
    }
    __device__ __forceinline__ void operator()(const f32x4 (&acc)[2][2][4][2], const Unit& u, int wr, int wc, int fr, int fq) const {
        int row0 = u.pm * BM + wr * 64 + fr, col0 = u.pn * BM + wc * 32 + 8 * fq;
        asm volatile("" : "+v"(row0), "+v"(col0));
        u32x2g gb[2][4][2];
#pragma unroll
        for (int ai = 0; ai < 2; ++ai)
#pragma unroll
            for (int m = 0; m < 4; ++m) { const unsigned char* gp = G8 + (size_t)(row0 + ai * HALF + m * 16) * ldgb + D + col0;
#pragma unroll
                for (int bj = 0; bj < 2; ++bj) gb[ai][m][bj] = *(const u32x2g*)(gp + bj * HALF); }
#pragma unroll
        for (int ai = 0; ai < 2; ++ai) {
#pragma unroll
            for (int m = 0; m < 4; ++m) { const size_t row = (size_t)(row0 + ai * HALF + m * 16);
#pragma unroll
                for (int bj = 0; bj < 2; ++bj) { float xb[8]; unpack8(gb[ai][m][bj], xb);
                    float o[8];
#pragma unroll
                    for (int k = 0; k < 4; ++k) { o[k] = (xb[k] * 0.00390625f) * acc[ai][bj][m][0][k]; o[4 + k] = (xb[4 + k] * 0.00390625f) * acc[ai][bj][m][1][k]; }
                    u32x4 w; w.x = cvt_pk_bf16(o[0], o[1]); w.y = cvt_pk_bf16(o[2], o[3]); w.z = cvt_pk_bf16(o[4], o[5]); w.w = cvt_pk_bf16(o[6], o[7]);
                    *(u32x4*)(O + row * D + col0 + bj * HALF) = w; } }
            asm volatile("" ::: "memory"); }
    }
};
template <int MODE> struct EpiResid {
    static constexpr bool PERM = false, AFTER_DRAIN = false, HAS_PRE = false, HAS_MID = false, HAS_EXT = (MODE == 2);
    static constexpr int NVM = 32;
    const float* base; const bf16_t* XBin; bf16_t* XB; float* SSQ;
    __device__ __forceinline__ void operator()(const f32x4 (&acc)[2][2][4][2], const Unit& u, int wr, int wc, int fr, int fq) const {
        typedef unsigned u32x2v __attribute__((ext_vector_type(2)));
        const int row0 = u.pm * BM + wr * 64 + fr, col0 = u.pn * BM + wc * 32 + 4 * fq;
#pragma unroll
        for (int ai = 0; ai < 2; ++ai) {
            f32x4 xf[4][2][2]; u32x2v xh[4][2][2];
#pragma unroll
            for (int m = 0; m < 4; ++m) { const size_t row = (size_t)(row0 + ai * HALF + m * 16);
#pragma unroll
                for (int bj = 0; bj < 2; ++bj)
#pragma unroll
                    for (int n = 0; n < 2; ++n) { const size_t off = row * D + col0 + bj * HALF + n * 16;
                        if (MODE == 0) xf[m][bj][n] = *(const f32x4*)(base + off); else if (MODE == 1) xh[m][bj][n] = *(const u32x2v*)(XBin + off); } }
#pragma unroll
            for (int m = 0; m < 4; ++m) { const size_t row = (size_t)(row0 + ai * HALF + m * 16); float ss = 0.f;
#pragma unroll
                for (int bj = 0; bj < 2; ++bj)
#pragma unroll
                    for (int n = 0; n < 2; ++n) { const size_t off = row * D + col0 + bj * HALF + n * 16;
                        f32x4 o;
                        if (MODE == 0) o = xf[m][bj][n] + acc[ai][bj][m][n];
                        else if (MODE == 2) o = acc[ai][bj][m][n];
                        else { const u32x2v xb = xh[m][bj][n]; o = (f32x4){bf_lo(xb.x), bf_hi(xb.x), bf_lo(xb.y), bf_hi(xb.y)} + acc[ai][bj][m][n]; }
                        u32x2v w; w.x = cvt_pk_bf16(o[0], o[1]); w.y = cvt_pk_bf16(o[2], o[3]); *(u32x2v*)(XB + off) = w;
                        ss += (o[0] * o[0] + o[1] * o[1]) + (o[2] * o[2] + o[3] * o[3]); }
                ss += __shfl_xor(ss, 16); ss += __shfl_xor(ss, 32);
                if (fq == 0) __hip_atomic_fetch_add(SSQ + row, ss, __ATOMIC_RELAXED, __HIP_MEMORY_SCOPE_AGENT); }
            asm volatile("" ::: "memory"); }
    }
};
struct EpiFinal {
    static constexpr bool PERM = false, AFTER_DRAIN = false, HAS_PRE = false, HAS_MID = false, HAS_EXT = true;
    static constexpr int NVM = 32;
    float* OUT; float* SSQ; const float* gfin; unsigned* RC; unsigned* tmo;
    __device__ __forceinline__ void operator()(const f32x4 (&acc)[2][2][4][2], const Unit& u, int wr, int wc, int fr, int fq) const {
        const int row0 = u.pm * BM + wr * 64 + fr, col0 = u.pn * BM + wc * 32 + 4 * fq;
#pragma unroll
        for (int ai = 0; ai < 2; ++ai)
#pragma unroll
            for (int m = 0; m < 4; ++m) { float ss = 0.f;
#pragma unroll
                for (int bj = 0; bj < 2; ++bj)
#pragma unroll
                    for (int n = 0; n < 2; ++n) { const f32x4 o = acc[ai][bj][m][n]; ss += (o[0] * o[0] + o[1] * o[1]) + (o[2] * o[2] + o[3] * o[3]); }
                ss += __shfl_xor(ss, 16); ss += __shfl_xor(ss, 32);
                if (fq == 0) __hip_atomic_fetch_add(SSQ + (size_t)(row0 + ai * HALF + m * 16), ss, __ATOMIC_RELAXED, __HIP_MEMORY_SCOPE_AGENT); }
        f32x4 gg[2][2];
#pragma unroll
        for (int bj = 0; bj < 2; ++bj)
#pragma unroll
            for (int n = 0; n < 2; ++n) gg[bj][n] = *(const f32x4*)(gfin + col0 + bj * HALF + n * 16);
        asm volatile("s_waitcnt vmcnt(0)" ::: "memory");
        __builtin_amdgcn_s_barrier();
        if (threadIdx.x == 0) { unsigned* rc = RC + u.pm; (void)__hip_atomic_fetch_add(rc, 1u, __ATOMIC_RELAXED, __HIP_MEMORY_SCOPE_AGENT);
            unsigned sp = 0;
            while (__hip_atomic_load(rc, __ATOMIC_RELAXED, __HIP_MEMORY_SCOPE_AGENT) < 4u) { __builtin_amdgcn_s_sleep(1);
                if ((++sp & 255u) == 0u) { if (__hip_atomic_load(tmo, __ATOMIC_RELAXED, __HIP_MEMORY_SCOPE_AGENT)) break; if (sp > (1u << 18)) { atomicAdd(tmo, 1u); break; } } } }
        __builtin_amdgcn_s_barrier();
        float rs[2][4];
#pragma unroll
        for (int ai = 0; ai < 2; ++ai)
#pragma unroll
            for (int m = 0; m < 4; ++m) { const unsigned b = __hip_atomic_load((const unsigned*)(SSQ + (size_t)(row0 + ai * HALF + m * 16)), __ATOMIC_RELAXED, __HIP_MEMORY_SCOPE_AGENT);
                rs[ai][m] = 1.f / sqrtf(__builtin_bit_cast(float, b) * (1.f / D) + EPS); }
#pragma unroll
        for (int ai = 0; ai < 2; ++ai) {
#pragma unroll
            for (int m = 0; m < 4; ++m) { const size_t row = (size_t)(row0 + ai * HALF + m * 16);
#pragma unroll
                for (int bj = 0; bj < 2; ++bj)
#pragma unroll
                    for (int n = 0; n < 2; ++n) *(f32x4*)(OUT + row * D + col0 + bj * HALF + n * 16) = acc[ai][bj][m][n] * rs[ai][m] * gg[bj][n]; }
            asm volatile("" ::: "memory"); }
    }
};
struct EpiSwiGLU {
    static constexpr bool PERM = true, AFTER_DRAIN = false, HAS_PRE = true, HAS_MID = false, HAS_EXT = false;
    static constexpr int NVM = 8;
    bf16_t* O; int ldc; const float* SSQ; PG8_LAS float* RS;
    __device__ __forceinline__ void pre(const Unit& u, int wr, int fr, float (&carry)[8]) const {
        const int have = __builtin_amdgcn_readfirstlane(__builtin_bit_cast(int, carry[0])) - 1;
        if (u.pm != have) { const int par = __builtin_amdgcn_readfirstlane(__builtin_bit_cast(int, carry[1])) ^ 1; const int t = threadIdx.x;
            if (t < BM) RS[par * BM + t] = 1.0f / sqrtf(SSQ[u.pm * BM + t] * (1.0f / D) + 1e-6f);
            carry[0] = __builtin_bit_cast(float, u.pm + 1); carry[1] = __builtin_bit_cast(float, par); }
    }
    __device__ __forceinline__ void run(const f32x4 (&acc)[2][2][4][2], const Unit& u, int wr, int wc, int fr, int fq, const float (&carry)[8]) const {
        int row0 = u.pm * BM + wr * 64 + fr, col0 = u.pn * HALF + wc * 32 + 8 * fq;
        asm volatile("" : "+v"(row0), "+v"(col0));
        const PG8_LAS float* rs = RS + __builtin_amdgcn_readfirstlane(__builtin_bit_cast(int, carry[1])) * BM + wr * 64 + fr;
        float rst[8];
#pragma unroll
        for (int ai = 0; ai < 2; ++ai)
#pragma unroll
            for (int m = 0; m < 4; ++m) rst[4 * ai + m] = rs[ai * HALF + m * 16];
#pragma unroll
        for (int ai = 0; ai < 2; ++ai)
#pragma unroll
            for (int m = 0; m < 4; ++m) { const size_t row = (size_t)(row0 + ai * HALF + m * 16);
                const float rstd = rst[4 * ai + m];
                float o[8];
#pragma unroll
                for (int n = 0; n < 2; ++n)
#pragma unroll
                    for (int k = 0; k < 4; ++k) { const float g = acc[ai][0][m][n][k] * rstd, up = acc[ai][1][m][n][k] * rstd; o[4 * n + k] = g * fast_sigmoid(g) * up; }
                u32x4 w; w.x = cvt_pk_bf16(o[0], o[1]); w.y = cvt_pk_bf16(o[2], o[3]); w.z = cvt_pk_bf16(o[4], o[5]); w.w = cvt_pk_bf16(o[6], o[7]);
                *(u32x4*)(O + row * ldc + col0) = w; }
    }
};
}

__device__ __forceinline__ void p2_conv(Frame& F, const Ptrs& P) {
    const bf16* PROJ = (const bf16*)(P.ws + WS_PROJ); bf16* CONV = (bf16*)(P.ws + WS_CONV);
    const int gt = F.vcu * (NWAVES * 64) + F.tid, NT = F.G * NWAVES * 64;
    for (int item = gt; item < (M / 16) * (DCONV / 8); item += NT) {
        const int cg = item & 63, rb = item >> 6, c0 = 8 * cg, m0 = 16 * rb, t0 = m0 & (SEQ - 1);
        float w[3][8];
#pragma unroll
        for (int j = 0; j < 3; ++j) { const f32x4 a = *(const GAS f32x4*)(P.conv_w + j * DCONV + c0), b = *(const GAS f32x4*)(P.conv_w + j * DCONV + c0 + 4);
            w[j][0] = a.x; w[j][1] = a.y; w[j][2] = a.z; w[j][3] = a.w; w[j][4] = b.x; w[j][5] = b.y; w[j][6] = b.z; w[j][7] = b.w; }
        float u2[8], u1[8];
#pragma unroll
        for (int k = 0; k < 8; ++k) { u2[k] = 0.f; u1[k] = 0.f; }
        if (t0 >= 2) {
#pragma unroll
            for (int d = 0; d < 2; ++d) { const bf16* rp = PROJ + (size_t)(m0 - 2 + d) * NPROJ;
                const v4u cc = *(const GAS v4u*)(rp + PC_CC + c0), cx = *(const GAS v4u*)(rp + PC_CX + c0);
                float* dst = d ? u1 : u2;
                dst[0] = bf_lo(cc.x) * bf_lo(cx.x); dst[1] = bf_hi(cc.x) * bf_hi(cx.x); dst[2] = bf_lo(cc.y) * bf_lo(cx.y); dst[3] = bf_hi(cc.y) * bf_hi(cx.y);
                dst[4] = bf_lo(cc.z) * bf_lo(cx.z); dst[5] = bf_hi(cc.z) * bf_hi(cx.z); dst[6] = bf_lo(cc.w) * bf_lo(cx.w); dst[7] = bf_hi(cc.w) * bf_hi(cx.w); }
        }
#pragma unroll 4
        for (int i = 0; i < 16; ++i) { const bf16* rp = PROJ + (size_t)(m0 + i) * NPROJ;
            const v4u cb = *(const GAS v4u*)(rp + PC_CB + c0), cc = *(const GAS v4u*)(rp + PC_CC + c0), cx = *(const GAS v4u*)(rp + PC_CX + c0);
            float u0[8], b[8];
            u0[0] = bf_lo(cc.x) * bf_lo(cx.x); u0[1] = bf_hi(cc.x) * bf_hi(cx.x); u0[2] = bf_lo(cc.y) * bf_lo(cx.y); u0[3] = bf_hi(cc.y) * bf_hi(cx.y);
            u0[4] = bf_lo(cc.z) * bf_lo(cx.z); u0[5] = bf_hi(cc.z) * bf_hi(cx.z); u0[6] = bf_lo(cc.w) * bf_lo(cx.w); u0[7] = bf_hi(cc.w) * bf_hi(cx.w);
            b[0] = bf_lo(cb.x); b[1] = bf_hi(cb.x); b[2] = bf_lo(cb.y); b[3] = bf_hi(cb.y); b[4] = bf_lo(cb.z); b[5] = bf_hi(cb.z); b[6] = bf_lo(cb.w); b[7] = bf_hi(cb.w);
            float o[8];
#pragma unroll
            for (int k = 0; k < 8; ++k) { o[k] = b[k] * (w[0][k] * u2[k] + w[1][k] * u1[k] + w[2][k] * u0[k]); u2[k] = u1[k]; u1[k] = u0[k]; }
            v4u ov; ov.x = pk2(o[0], o[1]); ov.y = pk2(o[2], o[3]); ov.z = pk2(o[4], o[5]); ov.w = pk2(o[6], o[7]);
            *(GAS v4u*)(CONV + (size_t)(m0 + i) * D + c0) = ov; }
    }
}

typedef float f32x16 __attribute__((ext_vector_type(16)));
typedef short v4i16_t __attribute__((ext_vector_type(4)));
__device__ __forceinline__ int mbcnt64(unsigned long long m) { return (int)__builtin_amdgcn_mbcnt_hi((unsigned)(m >> 32), __builtin_amdgcn_mbcnt_lo((unsigned)m, 0u)); }
__device__ __forceinline__ int wave_sum_i32(int c) {
    c += __builtin_amdgcn_update_dpp(0, c, 0xB1, 0xf, 0xf, true);
    c += __builtin_amdgcn_update_dpp(0, c, 0x4E, 0xf, 0xf, true);
    c += __builtin_amdgcn_update_dpp(0, c, 0x141, 0xf, 0xf, true);
    c += __builtin_amdgcn_update_dpp(0, c, 0x140, 0xf, 0xf, true);
    return __builtin_amdgcn_readlane(c, 0) + __builtin_amdgcn_readlane(c, 16) + __builtin_amdgcn_readlane(c, 32) + __builtin_amdgcn_readlane(c, 48);
}
__device__ __forceinline__ float z_upper(float p) {
    const bool fl = p > 0.5f; const float pp = fl ? 1.0f - p : p;
    const float t = sqrtf(-2.0f * __logf(pp)); const float z = t - (2.30753f + 0.27061f * t) / (1.0f + t * (0.99229f + 0.04481f * t));
    return fl ? -z : z;
}
constexpr int KPB_UNUSED = 144;
constexpr int VP_UNUSED = 160;
constexpr int SCR_VST = 0;
constexpr int IDX_OFF = TAB_OFF + 4096;
constexpr int CW_Q = 2048;
static_assert(IDX_OFF + 8 * 1280 <= LDS_BYTES, "LDS map (P2)");

__device__ __forceinline__ float fadd_np(float a, float b) { float r; asm("v_add_f32_e32 %0, %1, %2" : "=v"(r) : "v"(a), "v"(b)); return r; }
#define P2_DPPF(c, ctrl) ((c) + __builtin_bit_cast(float, __builtin_amdgcn_update_dpp(0, __builtin_bit_cast(int, (c)), (ctrl), 0xf, 0xf, true)))
__device__ __forceinline__ float wave_total_f32(float c) {
    c = P2_DPPF(c, 0xB1); c = P2_DPPF(c, 0x4E); c = P2_DPPF(c, 0x141); c = P2_DPPF(c, 0x140);
    return __builtin_bit_cast(float, __builtin_amdgcn_readlane(__builtin_bit_cast(int, c), 0)) + __builtin_bit_cast(float, __builtin_amdgcn_readlane(__builtin_bit_cast(int, c), 16)) +
           __builtin_bit_cast(float, __builtin_amdgcn_readlane(__builtin_bit_cast(int, c), 32)) + __builtin_bit_cast(float, __builtin_amdgcn_readlane(__builtin_bit_cast(int, c), 48));
}
template <int NR> __device__ __forceinline__ float lane_count_gt(const float (&v)[64], float tau) {
    const float BIG = 0x1p100f, nb = -tau * BIG; float c0 = 0.f, c1 = 0.f, c2 = 0.f, c3 = 0.f;
#pragma unroll
    for (int i = 0; i < NR; i += 4) {
        c0 = fadd_np(c0, __builtin_amdgcn_fmed3f(__builtin_fmaf(v[i], BIG, nb), 0.f, 1.f)); c1 = fadd_np(c1, __builtin_amdgcn_fmed3f(__builtin_fmaf(v[i + 1], BIG, nb), 0.f, 1.f));
        c2 = fadd_np(c2, __builtin_amdgcn_fmed3f(__builtin_fmaf(v[i + 2], BIG, nb), 0.f, 1.f)); c3 = fadd_np(c3, __builtin_amdgcn_fmed3f(__builtin_fmaf(v[i + 3], BIG, nb), 0.f, 1.f)); }
    return (c0 + c1) + (c2 + c3);
}
template <int NR> __device__ __forceinline__ float lane_count_valid(const float (&v)[64]) {
    float c = 0.f;
#pragma unroll
    for (int i = 0; i < NR; ++i) c += (v[i] > -INFINITY) ? 1.f : 0.f;
    return c;
}
constexpr int P2_MAXPROBE = 8;
template <int NR> __device__ __forceinline__ void topk_search(const float (&v)[64], int nv, float mu, float sg, float& lo_o, float& hi_o, int& need_o, float& nhi_o, float& nlo_o) {
    float tau = mu + z_upper((float)TOPK / (float)nv) * sg;
    float step = fmaxf(0.25f * sg, 1e-6f * (fabsf(mu) + 1e-6f));
    const float wmin = 1e-6f * sg;
    float lo = -INFINITY, hi = INFINITY; int clo = nv, chi = 0; int k = 0; bool found = false; float cl = 0.f, nhi = 0.f, nlo = -1.f;
    const float lt = __builtin_amdgcn_logf((float)TOPK + 0.5f);
    for (int it = 0; it < P2_MAXPROBE; ++it) {
        cl = lane_count_gt<NR>(v, tau);
        const int c = (int)(wave_total_f32(cl) + 0.5f);
        if (c == TOPK) { found = true; break; }
        if (c > TOPK) { lo = tau; clo = c; nlo = cl; } else { hi = tau; chi = c; nhi = cl; }
        if (lo == -INFINITY) { tau = hi - step; step *= 2.f; }
        else if (hi == INFINITY) { tau = lo + step; step *= 2.f; }
        else {
            if (hi - lo < wmin) break;
            ++k; float nt;
            if (k % 3 == 0) nt = 0.5f * (lo + hi);
            else { const float a = __builtin_amdgcn_logf((float)clo + 0.5f), bb = __builtin_amdgcn_logf((float)chi + 0.5f); float f = (a - lt) * __builtin_amdgcn_rcpf(a - bb); f = fminf(fmaxf(f, 0.1f), 0.9f); nt = lo + (hi - lo) * f; }
            if (!(nt > lo && nt < hi)) nt = 0.5f * (lo + hi);
            if (!(nt > lo && nt < hi)) break;
            tau = nt;
        }
    }
    if (found) { lo_o = tau; hi_o = tau; need_o = 0; nhi_o = cl; nlo_o = cl; }
    else { if (hi == INFINITY) { hi = 3.0e38f; chi = 0; nhi = 0.f; }
        if (nlo < 0.f) nlo = lane_count_valid<NR>(v);
        lo_o = lo; hi_o = hi; need_o = TOPK - chi; nhi_o = nhi; nlo_o = nlo; }
}
constexpr int IDXW = 320;
__device__ __forceinline__ int lane_scan_incl(int x, int lane) {
    x += __builtin_amdgcn_update_dpp(0, x, 0x111, 0xf, 0xf, true); x += __builtin_amdgcn_update_dpp(0, x, 0x112, 0xf, 0xf, true);
    x += __builtin_amdgcn_update_dpp(0, x, 0x114, 0xf, 0xf, true); x += __builtin_amdgcn_update_dpp(0, x, 0x118, 0xf, 0xf, true);
    const int r0 = __builtin_amdgcn_readlane(x, 15), r1 = __builtin_amdgcn_readlane(x, 31), r2 = __builtin_amdgcn_readlane(x, 47);
    return x + (lane >= 16 ? r0 : 0) + (lane >= 32 ? r1 : 0) + (lane >= 48 ? r2 : 0);
}
template <int NR> __device__ __forceinline__ void topk_compact_lane(const float (&v)[64], float thr, int cnt, LAS unsigned* IDX, int lane) {
    int k = lane_scan_incl(cnt, lane) - cnt; const int dump = 256 + lane;
#pragma unroll
    for (int i = 0; i < NR; ++i) { const bool a = v[i] > thr; IDX[a ? k : dump] = (unsigned)(512 * (i >> 3) + 8 * lane + (i & 7)); k += a ? 1 : 0; }
}
template <int NR> __device__ __forceinline__ void topk_compact_bracket(const float (&v)[64], float lo, float hi, int need, float nhi_f, float nlo_f, LAS unsigned* IDX, int lane) {
    const int nhi = (int)(nhi_f + 0.5f), nb = (int)(nlo_f + 0.5f) - nhi;
    const int pb = lane_scan_incl(nb, lane) - nb;
    int lim = need - pb; lim = lim < 0 ? 0 : lim; lim = lim > nb ? nb : lim;
    const bool full = (lim == nb), part = (lim > 0) && !full;
    topk_compact_lane<NR>(v, full ? lo : hi, nhi + (full ? nb : 0), IDX, lane);
    const unsigned long long pm = __ballot(part);
    if (pm != 0ull) {
        int k = TOPK - lim, kb = 0; const int dump = 256 + lane;
        asm volatile("" ::: "memory");
#pragma unroll
        for (int i = 0; i < NR; ++i) { const bool c = (v[i] > lo) && !(v[i] > hi); const bool take = part && c && (kb < lim);
            IDX[take ? k : dump] = (unsigned)(512 * (i >> 3) + 8 * lane + (i & 7)); k += take ? 1 : 0; kb += c ? 1 : 0; }
    }
}
typedef _Float16 f16x8 __attribute__((ext_vector_type(8)));
template <int NR> __device__ __forceinline__ int topk_select(const LAS unsigned char* row, int t, LAS unsigned* IDX, int lane) {
    float v[64]; float s1 = 0.f, s2 = 0.f; const int nv = t + 1;
    const int tb = t >> 9;
#pragma unroll
    for (int i = 0; i < NR / 8; ++i) { const f16x8 x = *(const LAS f16x8*)(row + 1024 * i + 16 * lane);
        if (i < tb) {
#pragma unroll
            for (int c = 0; c < 8; ++c) { const float xv = (float)x[c]; s1 += xv; s2 += xv * xv; v[8 * i + c] = xv; } }
        else {
#pragma unroll
            for (int c = 0; c < 8; ++c) { const bool ok = (512 * i + 8 * lane + c) <= t; const float xv = (float)x[c]; const float val = ok ? xv : 0.f; s1 += val; s2 += val * val; v[8 * i + c] = ok ? xv : -INFINITY; } } }
#pragma unroll
    for (int i = NR; i < 64; ++i) v[i] = -INFINITY;
    asm volatile("" ::: "memory");
    if (nv <= TOPK) { topk_compact_lane<NR>(v, -INFINITY, (int)(lane_count_valid<NR>(v) + 0.5f), IDX, lane); return nv; }
    s1 = wave_total_f32(s1); s2 = wave_total_f32(s2);
    const float mu = s1 / (float)nv, var = fmaxf(s2 / (float)nv - mu * mu, 0.f);
    float lo, hi, nhi, nlo; int need;
    topk_search<NR>(v, nv, mu, sqrtf(var), lo, hi, need, nhi, nlo);
    if (need == 0) topk_compact_lane<NR>(v, hi, (int)(nhi + 0.5f), IDX, lane);
    else topk_compact_bracket<NR>(v, lo, hi, need, nhi, nlo, IDX, lane);
    return TOPK;
}

__device__ __forceinline__ unsigned pk4_fp8(float a, float b, float c, float d) { int w = __builtin_amdgcn_cvt_pk_fp8_f32(a, b, 0, false); w = __builtin_amdgcn_cvt_pk_fp8_f32(c, d, w, true); return (unsigned)w; }
typedef int v2i_t __attribute__((ext_vector_type(2)));
#ifndef P2_TR8
#define P2_TR8 1
#endif
__device__ __forceinline__ long p2_vfrag(const LAS unsigned char* buf, int vra, int coff, int fr, int fq) {
#if P2_TR8
    const v2i_t t = __builtin_amdgcn_ds_read_tr8_b64_v2i32((LAS v2i_t*)(buf + vra + coff));
    return (long)((unsigned long long)(unsigned)t.x | ((unsigned long long)(unsigned)t.y << 32));
#else
    unsigned long long r = 0ull;
#pragma unroll
    for (int j = 0; j < 8; ++j) { const int rho = 4 * fq + (j & 3) + 16 * (j >> 2); const int swz = ((rho >> 1) & 7) ^ (4 * (rho >> 4));
        const int chunk = (coff >> 4) ^ ((2 * fq + (((fr >> 1) >> 1) & 1)) ^ (4 * ((fr >> 1) >> 2)));
        r |= (unsigned long long)buf[rho * 128 + 16 * (chunk ^ swz) + fr] << (8 * j); }
    return (long)r;
#endif
}
__device__ __forceinline__ void half_barrier(volatile LAS unsigned* hb, int lane) {
    LDS_WAIT(); asm volatile("" ::: "memory");
    if (lane == 0) {
        const unsigned g = hb[1];
        const unsigned old = __hip_atomic_fetch_add((LAS unsigned*)hb, 1u, __ATOMIC_RELAXED, __HIP_MEMORY_SCOPE_WORKGROUP);
        if (old == 3u) { hb[0] = 0u; hb[1] = g + 1u; }
        else { unsigned sp = 0u; while (hb[1] == g) { __builtin_amdgcn_s_sleep(1); if (++sp > (1u << 22)) break; } }
    }
    asm volatile("" ::: "memory");
}

__device__ __forceinline__ void p2_attn(Frame& F, const Ptrs& P) {
    const bf16* PROJ = (const bf16*)(P.ws + WS_PROJ); const bf16* KVI = (const bf16*)(P.ws + WS_KVI); const bf16* IKFp = (const bf16*)(P.ws + WS_IKF); const bf16* IWp = (const bf16*)(P.ws + WS_IW); bf16* ATTN = (bf16*)(P.ws + WS_CONV);
    const int wave = F.wave, half = wave >> 2, w4 = wave & 3;
    LAS unsigned char* hrows = F.lds + RING_OFF + half * 65536;
    LAS _Float16* SC = (LAS _Float16*)hrows;
    LAS float* TAB = (LAS float*)(F.lds + TAB_OFF);
    for (int e = F.tid; e < 128 * 8; e += NWAVES * 64) { const int d = e >> 3, h = e & 7; int bk;
        if (d < 16) bk = d; else { bk = 16 + (int)(logf((float)d / 16.0f) / 2.0794415416798357f * 16.0f); bk = bk < 31 ? bk : 31; }
        TAB[e] = P.rel_bias[bk * 8 + h] * 1.4426950408889634f; }
    LAS unsigned* IDX = (LAS unsigned*)(F.lds + IDX_OFF + wave * (IDXW * 4));
    constexpr int NU = SEQ / 8;
    volatile LAS unsigned* TK = F.MISC + 16 + 4 * half;
    volatile LAS unsigned* HB = F.MISC + 24 + 2 * half;
    const bool tk_lane = (w4 == 0) && (F.lane == 0);
    int bcur = (int)(xb_xcc_id() & 7u), nexh = 0, parity = 0;
    if (tk_lane) TK[0] = xb_add((unsigned*)(F.ctl + CW_Q + 64 * bcur), 1u);
    __syncthreads();
    bool have = false;
    bf16x8 afr[2][4]; v4u wraw[2][2]; bf16x8 bfr[4][4];
#define P2_ZERO_Q() do { _Pragma("unroll") for (int mt = 0; mt < 2; ++mt) { _Pragma("unroll") for (int ks = 0; ks < 4; ++ks) afr[mt][ks] = (bf16x8){0, 0, 0, 0, 0, 0, 0, 0}; wraw[mt][0] = (v4u){0u, 0u, 0u, 0u}; wraw[mt][1] = (v4u){0u, 0u, 0u, 0u}; } \
        _Pragma("unroll") for (int u = 0; u < 4; ++u) { _Pragma("unroll") for (int ks = 0; ks < 4; ++ks) bfr[u][ks] = (bf16x8){0, 0, 0, 0, 0, 0, 0, 0}; } } while (0)
    P2_ZERO_Q();
#define P2_LOAD_Q(T0) do { _Pragma("unroll") for (int mt = 0; mt < 2; ++mt) { const bf16* qp = PB + (size_t)((T0) + 4 * mt + qrho) * NPROJ + PC_IQ + hrho * 64 + 8 * hh; \
        _Pragma("unroll") for (int ks = 0; ks < 4; ++ks) afr[mt][ks] = *(const GAS bf16x8*)(qp + 16 * ks); \
        _Pragma("unroll") for (int qq = 0; qq < 2; ++qq) wraw[mt][qq] = *(const GAS v4u*)(IWB + (size_t)((T0) + 4 * mt + 2 * hh + qq) * 8); } \
        _Pragma("unroll") for (int u = 0; u < 4; ++u) { const bf16* kp = IKB + (size_t)(w4 + 4 * u) * 2048 + hh * 256 + r32 * 8;     \
            _Pragma("unroll") for (int ks = 0; ks < 4; ++ks) bfr[u][ks] = *(const GAS bf16x8*)(kp + 512 * ks); } } while (0)
    for (;;) {
        const int tk = (int)__builtin_amdgcn_readfirstlane(TK[parity]);
        if (tk >= NU) {
            if (++nexh == BATCH) break;
            bcur = (bcur + 1) & 7;
            half_barrier(HB, F.lane);
            if (tk_lane) TK[parity] = xb_add((unsigned*)(F.ctl + CW_Q + 64 * bcur), 1u);
            half_barrier(HB, F.lane);
            have = false; P2_ZERO_Q();
            continue;
        }
        unsigned nxt = 0u;
        if (tk_lane) nxt = xb_add((unsigned*)(F.ctl + CW_Q + 64 * bcur), 1u);
        int lane = F.lane; asm volatile("" : "+v"(lane));
        const int r32 = lane & 31, hh = lane >> 5, fr = lane & 15, fq = lane >> 4;
        const int qrho = ((r32 >> 4) & 1) + 2 * ((r32 >> 2) & 1), hrho = (r32 & 3) + 4 * ((r32 >> 3) & 1);
        const int b = bcur, t0 = 8 * (NU - 1 - tk);
        const bf16* PB = PROJ + (size_t)b * SEQ * NPROJ; const GAS unsigned char* KB8 = (const GAS unsigned char*)KVI + (size_t)b * SEQ * 128; const bf16* IKB = IKFp + (size_t)b * SEQ * 64; const bf16* IWB = IWp + (size_t)b * SEQ * 8;
        if (!have) P2_LOAD_Q(t0);
        {
            float w[2][16];
#pragma unroll
            for (int mt = 0; mt < 2; ++mt)
#pragma unroll
                for (int qq = 0; qq < 2; ++qq) { const v4u wv = wraw[mt][qq];
                    const float sc = 0.04419417382415922f;
                    w[mt][8 * qq + 0] = bf_lo(wv.x) * sc; w[mt][8 * qq + 1] = bf_hi(wv.x) * sc; w[mt][8 * qq + 2] = bf_lo(wv.y) * sc; w[mt][8 * qq + 3] = bf_hi(wv.y) * sc;
                    w[mt][8 * qq + 4] = bf_lo(wv.z) * sc; w[mt][8 * qq + 5] = bf_hi(wv.z) * sc; w[mt][8 * qq + 6] = bf_lo(wv.w) * sc; w[mt][8 * qq + 7] = bf_hi(wv.w) * sc; }
            const int nkt = (t0 + 8 + 31) >> 5;
            for (int kt0 = w4; kt0 < nkt; kt0 += 16) {
#pragma unroll
                for (int u = 0; u < 4; ++u) { const int kt = kt0 + 4 * u;
                    if (kt < nkt) { const int s = 32 * kt + r32;
                        f32x16 acc0 = {}, acc1 = {};
#pragma unroll
                        for (int ks = 0; ks < 4; ++ks) { acc0 = __builtin_amdgcn_mfma_f32_32x32x16_bf16(afr[0][ks], bfr[u][ks], acc0, 0, 0, 0); acc1 = __builtin_amdgcn_mfma_f32_32x32x16_bf16(afr[1][ks], bfr[u][ks], acc1, 0, 0, 0); }
                        if (kt + 16 < nkt) { const bf16* kp = IKB + (size_t)(kt + 16) * 2048 + hh * 256 + r32 * 8;
#pragma unroll
                            for (int ks = 0; ks < 4; ++ks) bfr[u][ks] = *(const GAS bf16x8*)(kp + 512 * ks); }
                        float s0 = 0.f, s1 = 0.f, s2 = 0.f, s3 = 0.f;
#pragma unroll
                        for (int e = 0; e < 8; ++e) { s0 = __builtin_fmaf(w[0][e], __builtin_amdgcn_fmed3f(acc0[e], 0.f, 3.0e38f), s0); s1 = __builtin_fmaf(w[0][8 + e], __builtin_amdgcn_fmed3f(acc0[8 + e], 0.f, 3.0e38f), s1);
                            s2 = __builtin_fmaf(w[1][e], __builtin_amdgcn_fmed3f(acc1[e], 0.f, 3.0e38f), s2); s3 = __builtin_fmaf(w[1][8 + e], __builtin_amdgcn_fmed3f(acc1[8 + e], 0.f, 3.0e38f), s3); }
                        SC[(2 * hh) * 4096 + s] = (_Float16)s0; SC[(2 * hh + 1) * 4096 + s] = (_Float16)s1; SC[(4 + 2 * hh) * 4096 + s] = (_Float16)s2; SC[(4 + 2 * hh + 1) * 4096 + s] = (_Float16)s3; } }
            }
        }
        if (tk_lane) TK[parity ^ 1] = nxt;
        half_barrier(HB, F.lane);
#pragma nounroll
        for (int qi = 0; qi < 2; ++qi) {
        int lane = F.lane; asm volatile("" : "+v"(lane));
        const int fr = lane & 15, fq = lane >> 4;
        const int qrow = w4 + 4 * qi;
        LAS unsigned char* myrow = hrows + qrow * 8192;
        const int t = t0 + qrow;
        int nsel;
        if (t < 1024) nsel = topk_select<16>(myrow, t, IDX, lane);
        else if (t < 2048) nsel = topk_select<32>(myrow, t, IDX, lane);
        else if (t < 3072) nsel = topk_select<48>(myrow, t, IDX, lane);
        else nsel = topk_select<64>(myrow, t, IDX, lane);
#pragma unroll
        for (int k = 0; k < 4; ++k) { const int jx = lane + 64 * k; if (jx >= nsel) IDX[jx] = 0u; }
        asm volatile("" ::: "memory");
        {
            const float c2 = 0.125f * 1.4426950408889634f;
            long qf8[2];
            { const bf16* qp = PB + (size_t)t * NPROJ + PC_Q + (fr & 7) * 64 + 8 * fq; const v4u q0 = *(const GAS v4u*)qp, q1 = *(const GAS v4u*)(qp + 32);
              qf8[0] = (long)(unsigned long long)(pk4_fp8(bf_lo(q0.x), bf_hi(q0.x), bf_lo(q0.y), bf_hi(q0.y)) | ((unsigned long long)pk4_fp8(bf_lo(q0.z), bf_hi(q0.z), bf_lo(q0.w), bf_hi(q0.w)) << 32));
              qf8[1] = (long)(unsigned long long)(pk4_fp8(bf_lo(q1.x), bf_hi(q1.x), bf_lo(q1.y), bf_hi(q1.y)) | ((unsigned long long)pk4_fp8(bf_lo(q1.z), bf_hi(q1.z), bf_lo(q1.w), bf_hi(q1.w)) << 32)); }
            f32x4 S[8]; unsigned BI[8][2]; const int cls = fr >> 3;
            long vf[8][4];
            {
                v4u kvreg[8][4];
#pragma unroll
                for (int kb = 0; kb < 8; ++kb)
#pragma unroll
                    for (int i = 0; i < 4; ++i) { const unsigned kidx = IDX[32 * kb + 8 * i + (lane >> 3)]; kvreg[kb][i] = *(const GAS v4u*)(KB8 + ((kidx << 7) + (unsigned)(16 * (lane & 7)))); }
#pragma unroll
                for (int jo = 0; jo < 8; ++jo) { const int jt = 2 * jo + cls; const v4u kk = *(const LAS v4u*)(IDX + 16 * jt + 4 * fq); float bz[4];
#pragma unroll
                    for (int r = 0; r < 4; ++r) { const int slot = 16 * jt + 4 * fq + r; int dist = t - (int)kk[r]; dist = dist < 127 ? dist : 127; dist = dist > 0 ? dist : 0;
                        const float bias = TAB[dist * 8 + (fr & 7)]; bz[r] = (slot < nsel) ? bias : -INFINITY; }
                    BI[jo][0] = pg8::cvt_pk_bf16(bz[0], bz[1]); BI[jo][1] = pg8::cvt_pk_bf16(bz[2], bz[3]); }
                const int wsl = (lane >> 3) * 128 + 16 * ((lane & 7) ^ ((lane >> 4) & 3));
                const int rsw = (fr >> 1) & 7;
                const int kra = fr * 128 + 8 * (fq & 1);
                const int vj = fr >> 1, vrho = 4 * fq + (vj & 3) + 16 * (vj >> 2), vswz = (2 * fq + ((vj >> 1) & 1)) ^ (4 * (vj >> 2));
                const int vra = vrho * 128 + 8 * (fr & 1);
                long kf[2][2][2];
#define P2_KW(KB) do { LAS unsigned char* kbuf_ = myrow + ((KB) & 1) * 4096; _Pragma("unroll") for (int i = 0; i < 4; ++i) *(LAS v4u*)(kbuf_ + 1024 * i + (wsl ^ (64 * ((i & 1) ^ (i >> 1))))) = kvreg[KB][i]; asm volatile("" ::: "memory"); } while (0)
#define P2_KR(KB) do { const LAS unsigned char* kbuf_ = myrow + ((KB) & 1) * 4096; _Pragma("unroll") for (int tt = 0; tt < 2; ++tt) { _Pragma("unroll") for (int ks = 0; ks < 2; ++ks) \
                    kf[(KB) & 1][tt][ks] = *(const LAS long*)(kbuf_ + 2048 * tt + kra + 16 * (((2 * ks + (fq >> 1)) ^ rsw) ^ (4 * tt))); } \
                    _Pragma("unroll") for (int mt = 0; mt < 4; ++mt) vf[KB][mt] = p2_vfrag(kbuf_, vra, 16 * ((4 + mt) ^ vswz), fr, fq); asm volatile("" ::: "memory"); } while (0)
                P2_KW(0); P2_KR(0);
#pragma unroll
                for (int kb = 0; kb < 8; ++kb) {
                    if (kb < 7) { P2_KW(kb + 1); P2_KR(kb + 1); }
                    f32x4 a2[2];
#pragma unroll
                    for (int tt = 0; tt < 2; ++tt) { f32x4 a = {0.f, 0.f, 0.f, 0.f};
                        a = __builtin_amdgcn_mfma_f32_16x16x32_fp8_fp8(kf[kb & 1][tt][0], qf8[0], a, 0, 0, 0);
                        a = __builtin_amdgcn_mfma_f32_16x16x32_fp8_fp8(kf[kb & 1][tt][1], qf8[1], a, 0, 0, 0);
                        a2[tt] = a; }
                    S[kb] = cls ? a2[1] : a2[0]; }
#undef P2_KW
#undef P2_KR
            }
            __builtin_amdgcn_sched_barrier(0);
            f32x4 W[8];
            float mx = -INFINITY;
#pragma unroll
            for (int jo = 0; jo < 8; ++jo)
#pragma unroll
                for (int r = 0; r < 4; ++r) { const unsigned bw = BI[jo][r >> 1]; const float sv = S[jo][r];
                    const float l2 = sv * c2 + ((r & 1) ? bf_hi(bw) : bf_lo(bw)); W[jo][r] = l2; mx = fmaxf(mx, l2); }
            mx = fmaxf(mx, __shfl_xor(mx, 8)); mx = fmaxf(mx, __shfl_xor(mx, 16)); mx = fmaxf(mx, __shfl_xor(mx, 32));
            float sum = 0.f;
#pragma unroll
            for (int jo = 0; jo < 8; ++jo)
#pragma unroll
                for (int r = 0; r < 4; ++r) { const float p = __builtin_amdgcn_exp2f(W[jo][r] - mx); W[jo][r] = p; sum += p; }
            sum += __shfl_xor(sum, 8); sum += __shfl_xor(sum, 16); sum += __shfl_xor(sum, 32);
            const float rinv = 0.00390625f / sum;
            f32x4 O[4];
#pragma unroll
            for (int mt = 0; mt < 4; ++mt) O[mt] = (f32x4){0.f, 0.f, 0.f, 0.f};
#pragma unroll
            for (int kb = 0; kb < 8; ++kb) {
                const unsigned pq = pk4_fp8(W[kb][0] * 256.0f, W[kb][1] * 256.0f, W[kb][2] * 256.0f, W[kb][3] * 256.0f);
                const unsigned pp = (unsigned)__builtin_amdgcn_update_dpp(0, (int)pq, 0x128, 0xf, 0xf, true);
                const unsigned long long pf = cls ? ((unsigned long long)pp | ((unsigned long long)pq << 32)) : ((unsigned long long)pq | ((unsigned long long)pp << 32));
#pragma unroll
                for (int mt = 0; mt < 4; ++mt) O[mt] = __builtin_amdgcn_mfma_f32_16x16x32_fp8_fp8(vf[kb][mt], (long)pf, O[mt], 0, 0, 0);
            }
            if (fr < 8) { bf16* op = ATTN + (size_t)(b * SEQ + t) * D + DCONV + fr * 64 + 4 * fq;
#pragma unroll
                for (int mt = 0; mt < 4; ++mt) { typedef unsigned u32x2v __attribute__((ext_vector_type(2)));
                    u32x2v wv; wv.x = pg8::cvt_pk_bf16(O[mt][0] * rinv, O[mt][1] * rinv); wv.y = pg8::cvt_pk_bf16(O[mt][2] * rinv, O[mt][3] * rinv);
                    *(GAS u32x2v*)(op + 16 * mt) = wv; } }
        }
        asm volatile("" ::: "memory");
        }
        __builtin_amdgcn_sched_barrier(0);
        {
            const int tkn = (int)__builtin_amdgcn_readfirstlane(TK[parity ^ 1]);
            have = tkn < NU;
            if (have) { const int t0n = 8 * (NU - 1 - tkn); P2_LOAD_Q(t0n); }
            else P2_ZERO_Q();
        }
        half_barrier(HB, F.lane);
        parity ^= 1;
    }
#undef P2_LOAD_Q
#undef P2_ZERO_Q
    __syncthreads();
}

__device__ __forceinline__ void p8_final_norm(Frame& F, const Ptrs& P) {
    const int gw = F.vcu * NWAVES + F.wave, NGW = F.G * NWAVES; const float* SSQ = (const float*)(P.ws + WS_SSQ2); const bf16* X2B = (const bf16*)(P.ws + WS_XN);
    const GAS f32x4* gr = (const GAS f32x4*)P.g_final + F.lane;
    f32x4 gg[4];
#pragma unroll
    for (int j = 0; j < 4; ++j) gg[j] = gr[64 * j];
    typedef unsigned u32x2v __attribute__((ext_vector_type(2)));
    for (int m = gw; m < M; m += 2 * NGW) { const int m1 = (m + NGW < M) ? m + NGW : m;
        const GAS u32x2v* xa = (const GAS u32x2v*)(X2B + (size_t)m * D) + F.lane; const GAS u32x2v* xb = (const GAS u32x2v*)(X2B + (size_t)m1 * D) + F.lane;
        const float* spa = SSQ + m; const float* spb = SSQ + m1; asm volatile("" : "+v"(spa), "+v"(spb));
        const float pa = *spa, pb = *spb;
        u32x2v va[4], vb[4];
#pragma unroll
        for (int j = 0; j < 4; ++j) { va[j] = xa[64 * j]; vb[j] = xb[64 * j]; }
        const float ra = 1.f / sqrtf(pa * (1.f / D) + EPS), rb = 1.f / sqrtf(pb * (1.f / D) + EPS);
        GAS f32x4* oa = (GAS f32x4*)(P.out + (size_t)m * D) + F.lane; GAS f32x4* ob = (GAS f32x4*)(P.out + (size_t)m1 * D) + F.lane;
#pragma unroll
        for (int j = 0; j < 4; ++j) { oa[64 * j] = (f32x4){bf_lo(va[j].x), bf_hi(va[j].x), bf_lo(va[j].y), bf_hi(va[j].y)} * ra * gg[j];
            if (m1 != m) ob[64 * j] = (f32x4){bf_lo(vb[j].x), bf_hi(vb[j].x), bf_lo(vb[j].y), bf_hi(vb[j].y)} * rb * gg[j]; }
    }
}

struct Args { const float* in[14]; float* out; unsigned char* ws; int ph_lo, ph_hi, li, pad; };
__global__ void __launch_bounds__(NWAVES * 64, 2) skel_fwd(Args args) {
    extern __shared__ __attribute__((aligned(16))) unsigned char lds[];
    Frame F;
    F.lds = (LAS unsigned char*)lds;
    F.MISC = (volatile LAS unsigned*)(F.lds + MISC_OFF);
    F.tid = threadIdx.x; F.lane = F.tid & 63; F.wave = __builtin_amdgcn_readfirstlane(F.tid >> 6);
    F.G = gridDim.x; { const int bx = blockIdx.x; F.vcu = (F.G % 8 == 0) ? (bx % 8) * (F.G / 8) + bx / 8 : bx; }
    Ptrs P;
    P.x = args.in[0]; P.g_mix = args.in[1]; P.w_in = args.in[2]; P.b_gate = args.in[3]; P.conv_w = args.in[4]; P.w_a = args.in[5]; P.w_b = args.in[6]; P.w_out = args.in[7];
    P.rel_bias = args.in[8]; P.g_ffn = args.in[9]; P.w_g = args.in[10]; P.w_u = args.in[11]; P.w_d = args.in[12]; P.g_final = args.in[13];
    P.out = args.out; P.ws = args.ws;
    unsigned char* ws = args.ws;
    F.ctl = (gu32*)(ws + WS_CTL);
    for (int u = F.tid; u < (TAB_OFF - LDSCTL_OFF) / 4; u += NWAVES * 64) ((LAS unsigned*)(F.lds + LDSCTL_OFF))[u] = 0u;
    __syncthreads();
    XcdBarrier bar; bar.bar = (unsigned*)(F.ctl + CW_BAR); bar.x = 0; bar.st = nullptr;
    if (N_LAUNCHES == 1) bar = xcd_barrier_post((unsigned*)(F.ctl + CW_BAR), F.MISC + 8);
#define GRID_BAR() do { if (N_LAUNCHES == 1) { xcd_barrier(bar); } } while (0)
    const int lo = args.ph_lo, hi = args.ph_hi;
#define IN(k) (lo <= (k) && (k) < hi)
#define BOTH(k) (IN(k) && IN((k) + 1))
    bf16* XN = (bf16*)(ws + WS_XN); bf16* PROJ = (bf16*)(ws + WS_PROJ); bf16* CONV = (bf16*)(ws + WS_CONV); bf16* ATTN = (bf16*)(ws + WS_ATTN);
    bf16* MERGED = XN; bf16* X1B = CONV; bf16* ACT = PROJ; bf16* X2B = XN;
    float* SSQ1 = (float*)(ws + WS_SSQ1); float* SSQ2 = (float*)(ws + WS_SSQ2);

    const bool split_w = (N_LAUNCHES == 1) && (F.G == 256);
    const bool fuse_final = (N_LAUNCHES == 1) && (F.G == 256) && IN(7) && IN(8);
    if (IN(0)) { if (blockIdx.x == 0 && F.tid < 256) ((bf16*)(ws + WS_IDENT))[F.tid * 257] = (bf16)0x3F80;
        p0_prologue(F, P, !split_w); if (BOTH(0)) GRID_BAR(); }
    if (IN(1)) {
        pg8::Gemm g{(const bf16*)P.out  , (const bf16*)(ws + WS_WIN), M, NPROJ, D}; pg8::StaticOrder S; S.init(M, NPROJ, F.G, (int)blockIdx.x);
        LAS float* BGL = (LAS float*)(F.lds + TAB_OFF);
        for (int i = F.tid; i < 2 * D; i += NWAVES * 64) BGL[i] = P.b_gate[i];
        __syncthreads();
        pg8::EpiProj E{PROJ, NPROJ, (bf16*)(ws + WS_KVI), (bf16*)(ws + WS_IKF), (bf16*)(ws + WS_IW), PC_KVI / 256, BGL, PC_GA, (bf16*)(ws + WS_IW + MiB), (const float*)(ws + WS_SSQ0), (LAS float*)(F.lds + TAB_OFF + 8192)};
        pg8::gemm_phase<pg8::EpiProj, pg8::StaticOrder, PG8_ALIGN, PG8_SP2>(F.lds + RING_OFF, g, S, E);
        if (split_w && blockIdx.x >= 128) p0_weight_items(F, P, PI_IN, PI_ALL, ((int)blockIdx.x - 128) * NWAVES + F.wave, 128 * NWAVES);
        if (BOTH(1)) GRID_BAR();
    }
    if (IN(2)) { p2_conv(F, P); p2_attn(F, P); if (BOTH(2)) GRID_BAR(); }
    if (IN(3)) {
        pg8::Gemm g{CONV, (const bf16*)(ws + WS_WA), M, D, D}; pg8::StaticOrder S; S.init(M, D, F.G, (int)blockIdx.x);
        pg8::EpiGateMerged E{MERGED, (const unsigned char*)(PROJ + PC_GA), NPROJ * 2};
        pg8::gemm_phase<pg8::EpiGateMerged, pg8::StaticOrder, PG8_ALIGN, PG8_SP2>(F.lds + RING_OFF, g, S, E);
        if (BOTH(4)) GRID_BAR();
    }
    if (IN(5)) {
        pg8::Gemm g{MERGED, (const bf16*)(ws + WS_WOUT), M, D, D, (const bf16*)P.out, (const bf16*)(ws + WS_IDENT), D, BM256}; pg8::StaticOrder S; S.init(M, D, F.G, (int)blockIdx.x);
        pg8::EpiResid<2> E{nullptr, nullptr, X1B, SSQ1};
        pg8::gemm_phase<pg8::EpiResid<2>, pg8::StaticOrder, PG8_ALIGN, PG8_SP2>(F.lds + RING_OFF, g, S, E);
        if (BOTH(5)) GRID_BAR();
    }
    if (IN(6)) {
        pg8::Gemm g{X1B, (const bf16*)(ws + WS_WGU), M, NGU, D}; pg8::StaticOrder S; S.init(M, NGU, F.G, (int)blockIdx.x);
        pg8::EpiSwiGLU E{ACT, FF, SSQ1, (LAS float*)(F.lds + TAB_OFF)};
        pg8::gemm_phase<pg8::EpiSwiGLU, pg8::StaticOrder, PG8_ALIGN, PG8_SP2>(F.lds + RING_OFF, g, S, E);
        if (BOTH(6)) GRID_BAR();
    }
    if (IN(7)) {
        pg8::Gemm g{ACT, (const bf16*)(ws + WS_WD), M, D, FF, X1B, (const bf16*)(ws + WS_IDENT), D, BM256}; pg8::StaticOrder S; S.init(M, D, F.G, (int)blockIdx.x);
        if (fuse_final) {
            pg8::EpiFinal E{P.out, SSQ2, P.g_final, (unsigned*)(ws + WS_RC), (unsigned*)(F.ctl + CW_BAR) + XB_TMO};
            pg8::gemm_phase<pg8::EpiFinal, pg8::StaticOrder, PG8_ALIGN, PG8_SP2>(F.lds + RING_OFF, g, S, E);
        } else {
            pg8::EpiResid<2> E{nullptr, nullptr, X2B, SSQ2};
            pg8::gemm_phase<pg8::EpiResid<2>, pg8::StaticOrder, PG8_ALIGN, PG8_SP2>(F.lds + RING_OFF, g, S, E);
            if (BOTH(7)) GRID_BAR();
        }
    }
    if (IN(8) && !fuse_final) { p8_final_norm(F, P); }
#undef IN
#undef BOTH
#undef GRID_BAR
}

extern "C" void kernel_launch(void* const* d_in, const int* in_sizes, int n_in, void* d_out, int out_size, void* d_ws, size_t ws_size, hipStream_t stream) {
    static int grid = 0;
    if (grid == 0) {
        if (n_in != 14 || in_sizes[0] != M * D || out_size != M * D || ws_size < WS_END) { fprintf(stderr, "kernel_launch: shape/workspace mismatch: n_in %d in0 %d out %d ws %zu (need %zu); nothing launched\n", n_in, n_in > 0 ? in_sizes[0] : -1, out_size, ws_size, (size_t)WS_END); grid = -1; return; }
        int dev = 0, cus = 0, per_cu = 0;
        if (hipGetDevice(&dev) != hipSuccess || hipDeviceGetAttribute(&cus, hipDeviceAttributeMultiprocessorCount, dev) != hipSuccess) { grid = -1; return; }
        if (hipFuncSetAttribute((const void*)skel_fwd, hipFuncAttributeMaxDynamicSharedMemorySize, LDS_BYTES) != hipSuccess) { fprintf(stderr, "kernel_launch: hipFuncSetAttribute failed\n"); grid = -1; return; }
        if (hipOccupancyMaxActiveBlocksPerMultiprocessor(&per_cu, (const void*)skel_fwd, NWAVES * 64, LDS_BYTES) != hipSuccess || per_cu < 1)
            fprintf(stderr, "kernel_launch: note: occupancy query reports %d workgroups per CU\n", per_cu);
        (void)hipGetLastError();
        grid = cus;
    }
    if (grid < 0) return;
    if (hipMemsetAsync((char*)d_ws + WS_CTL, 0, CTL_ZERO_BYTES, stream) != hipSuccess) { fprintf(stderr, "kernel_launch: hipMemsetAsync failed\n"); return; }
    Args a{};
    for (int i = 0; i < 14; ++i) a.in[i] = (const float*)d_in[i];
    a.out = (float*)d_out; a.ws = (unsigned char*)d_ws;
    for (int li = 0; li < N_LAUNCHES; ++li) {
        a.ph_lo = (N_LAUNCHES == PER_PHASE) ? li : 0; a.ph_hi = (N_LAUNCHES == PER_PHASE) ? li + 1 : PER_PHASE; a.li = li;
        hipLaunchKernelGGL(skel_fwd, dim3(grid), dim3(NWAVES * 64), LDS_BYTES, stream, a);
        const hipError_t le = hipPeekAtLastError();
        if (le != hipSuccess) { fprintf(stderr, "kernel_launch: launch %d failed: %s\n", li, hipGetErrorName(le)); break; }
    }
}
```

```cpp
#include <hip/hip_runtime.h>
#include <cstdio>
#include <cstdint>
namespace pg8 {
#define PG8_LAS __attribute__((address_space(3)))
typedef unsigned short bf16_t;
typedef short bf16x8 __attribute__((ext_vector_type(8)));
typedef float f32x4 __attribute__((ext_vector_type(4)));
typedef unsigned u32x4 __attribute__((ext_vector_type(4)));
constexpr int BM = 256, BK = 64, HALF = 128, HTB = HALF * BK * 2  , STAGE_BYTES = 8 * HTB, NXCD = 8, WGM = 8;

__host__ __device__ __forceinline__ int lds_byte(int r, int c) { const int st = (r >> 4) * 2 + (c >> 5), rr = r & 15, cc = c & 31, ob = rr * 64 + cc * 2; return st * 1024 + (ob ^ (((ob >> 9) & 1) << 5)); }
__host__ __device__ __forceinline__ void stage_rc(int b, int& R, int& C) { const int st = b / 1024, sb = b % 1024, swz = sb ^ (((sb >> 9) & 1) << 5); R = (st >> 1) * 16 + swz / 64; C = (st & 1) * 32 + (swz % 64) / 2; }
__host__ __device__ __forceinline__ int perm32(int rho) { const int n = rho >> 4, i = rho & 15; return 8 * (i >> 2) + 4 * n + (i & 3); }

struct Unit { int pm, pn; };
struct Gemm { const bf16_t* A; const bf16_t* Bt; int M, N, K; const bf16_t* Ae = nullptr; const bf16_t* Bte = nullptr; int lde_a = 0, lde_b = 0; };

struct StaticOrder {
    int nM, nN, nwg, G, c;
    __host__ __device__ void init(int M, int N, int G_, int c_) { nM = M / BM; nN = N / BM; nwg = nM * nN; G = G_; c = c_; }
    __host__ __device__ bool next(int i, Unit& u) const {
        const long L = (long)i * G + c; if (L >= nwg) return false;
        int wgid = (int)L; { const int q = nwg / NXCD, r = nwg % NXCD, xcd = wgid % NXCD, off = wgid / NXCD; wgid = (xcd < r ? xcd * (q + 1) : r * (q + 1) + (xcd - r) * q) + off; }
        const int nig = WGM * nN, gid = wgid / nig, fm = gid * WGM, gsz = (nM - fm) < WGM ? (nM - fm) : WGM;
        u.pm = fm + ((wgid % nig) % gsz); u.pn = (wgid % nig) / gsz; return true;
    }
    __device__ __forceinline__ void a_ready(const Unit&) const {}
    __device__ __forceinline__ void done(const Unit&) const {}
};

typedef float f32x2_cv __attribute__((ext_vector_type(2))); typedef __bf16 bf16x2_cv __attribute__((ext_vector_type(2)));
__device__ __forceinline__ unsigned cvt_pk_bf16(float lo, float hi) { f32x2_cv v = {lo, hi}; bf16x2_cv b = __builtin_convertvector(v, bf16x2_cv); return __builtin_bit_cast(unsigned, b); }
typedef float f32x2 __attribute__((ext_vector_type(2)));
__device__ __forceinline__ f32x2 gelu_pk(f32x2 v) {
    const f32x2 av = __builtin_elementwise_abs(v), d = av * 0.2316418882f + 1.0f;
    f32x2 t; t.x = __builtin_amdgcn_rcpf(d.x); t.y = __builtin_amdgcn_rcpf(d.y);
    f32x2 q = t * 0.5307027145f + (-0.7265760135f); q = q * t + 0.7107068705f; q = q * t + (-0.142248368f); q = q * t + 0.127414796f; q = q * t;
    const f32x2 s = (v * v) * (-0.72134752044f);
    f32x2 e; e.x = __builtin_amdgcn_exp2f(s.x); e.y = __builtin_amdgcn_exp2f(s.y);
    const f32x2 m = v * (q * e), r = v - m;
    f32x2 o; o.x = v.x < 0.f ? m.x : r.x; o.y = v.y < 0.f ? m.y : r.y; return o;
}

template <int ACT  > struct EpiBf16 {
    static constexpr bool PERM = true, AFTER_DRAIN = false, HAS_PRE = false, HAS_MID = false, HAS_EXT = false; static_assert(ACT == 0 || ACT == 1, "EpiBf16: ACT is 0 (none) or 1 (gelu_pk)");
    static constexpr int NVM = 0;
    bf16_t* O; int ldc; const float* bias; int split_cols; size_t split_stride; float scale0;
    __device__ __forceinline__ void operator()(const f32x4 (&acc)[2][2][4][2], const Unit& u, int wr, int wc, int fr, int fq) const {
        const int row0 = u.pm * BM + wr * 64 + fr; int colt = u.pn * BM; bf16_t* base = O;
        float sc = 1.f; if (split_cols) { const int t = colt / split_cols; base += (size_t)t * split_stride; colt -= t * split_cols; if (t == 0) sc = scale0; }
        const int col0 = colt + wc * 32 + 8 * fq, bcol0 = u.pn * BM + wc * 32 + 8 * fq;
        f32x4 bv[2][2];
#pragma unroll
        for (int bj = 0; bj < 2; ++bj)
#pragma unroll
            for (int n = 0; n < 2; ++n) bv[bj][n] = bias ? *(const f32x4*)(bias + bcol0 + bj * HALF + 4 * n) : (f32x4){0.f, 0.f, 0.f, 0.f};
#pragma unroll
        for (int ai = 0; ai < 2; ++ai)
#pragma unroll
            for (int m = 0; m < 4; ++m) { bf16_t* rowp = base + (size_t)(row0 + ai * HALF + m * 16) * ldc + col0;
#pragma unroll
                for (int bj = 0; bj < 2; ++bj) { f32x4 v0 = acc[ai][bj][m][0] + bv[bj][0], v1 = acc[ai][bj][m][1] + bv[bj][1];
                    if (ACT == 1) { f32x2 a = gelu_pk((f32x2){v0[0], v0[1]}), b = gelu_pk((f32x2){v0[2], v0[3]}), c = gelu_pk((f32x2){v1[0], v1[1]}), d = gelu_pk((f32x2){v1[2], v1[3]});
                        v0 = (f32x4){a.x, a.y, b.x, b.y}; v1 = (f32x4){c.x, c.y, d.x, d.y}; }
                    v0 = v0 * sc; v1 = v1 * sc; u32x4 w; w.x = cvt_pk_bf16(v0[0], v0[1]); w.y = cvt_pk_bf16(v0[2], v0[3]); w.z = cvt_pk_bf16(v1[0], v1[1]); w.w = cvt_pk_bf16(v1[2], v1[3]);
                    *(u32x4*)(rowp + bj * HALF) = w; } }
    }
};

template <class Epi, class Sched, bool ALIGN_EPI = false, bool SP2 = false>
__device__ __forceinline__ void gemm_phase(PG8_LAS unsigned char* lds, const Gemm g, const Sched& S, const Epi& E) {
    const int tid = threadIdx.x, wid = __builtin_amdgcn_readfirstlane(tid >> 6), lane = tid & 63, wr = wid >> 2, wc = wid & 3, fr = lane & 15, fq = lane >> 4;
    const int K = g.K, ntm = K / BK, nt = ntm + (Epi::HAS_EXT ? BM / BK : 0);
    unsigned voffA[2], voffB[2];
#pragma unroll
    for (int i = 0; i < 2; ++i) { int R, C; stage_rc(tid * 16 + i * 8192, R, C); const int Rb = Epi::PERM ? ((R & ~31) + perm32(R & 31)) : R;
        voffA[i] = (unsigned)(R * K + C) * 2u; voffB[i] = (unsigned)(Rb * K + C) * 2u; }
    unsigned voffAe[2] = {0u, 0u}, voffBe[2] = {0u, 0u};
    if constexpr (Epi::HAS_EXT) {
#pragma unroll
        for (int i = 0; i < 2; ++i) { int R, C; stage_rc(tid * 16 + i * 8192, R, C); const int Rb = Epi::PERM ? ((R & ~31) + perm32(R & 31)) : R;
            voffAe[i] = (unsigned)(R * g.lde_a + C) * 2u; voffBe[i] = (unsigned)(Rb * g.lde_b + C) * 2u; } }
    const size_t hstepAe = (size_t)HALF * g.lde_a * 2, hstepBe = (size_t)HALF * g.lde_b * 2;
    const size_t kstep = (size_t)(BK * 2);
    const size_t hstep = (size_t)HALF * K * 2;
    const size_t tstep = 2 * hstep;
    const unsigned ldsw = (unsigned)wid * 1024u;
    const int aoff = lds_byte(wr * 64 + fr, fq * 8), boff = lds_byte(wc * 32 + fr, fq * 8);
#define PG8_SA(b, h) (((b) * 2 + (h)) * HTB)
#define PG8_SB(b, h) ((4 + (b) * 2 + (h)) * HTB)
#define PG8_STAGE(bufoff, gbase, voff) do { _Pragma("unroll") for (int _i = 0; _i < 2; ++_i) \
        __builtin_amdgcn_global_load_lds((const unsigned*)((const char*)(gbase) + (voff)[_i]), (PG8_LAS unsigned*)(lds + (bufoff) + ldsw + _i * 8192), 16, 0, 0); } while (0)
#define PG8_LDA(dst, b, h) do { _Pragma("unroll") for (int m = 0; m < 4; ++m) _Pragma("unroll") for (int k = 0; k < 2; ++k) dst[m][k] = *(const PG8_LAS bf16x8*)(lds + PG8_SA(b, h) + aoff + m * 2048 + k * 1024); } while (0)
#define PG8_LDB(dst, b, h) do { _Pragma("unroll") for (int n = 0; n < 2; ++n) _Pragma("unroll") for (int k = 0; k < 2; ++k) dst[n][k] = *(const PG8_LAS bf16x8*)(lds + PG8_SB(b, h) + boff + n * 2048 + k * 1024); } while (0)
#define PG8_MMA(ai, bj, At, Bt) do { __builtin_amdgcn_s_setprio(1); _Pragma("unroll") for (int m = 0; m < 4; ++m) _Pragma("unroll") for (int n = 0; n < 2; ++n) _Pragma("unroll") for (int k = 0; k < 2; ++k) \
        acc[ai][bj][m][n] = __builtin_amdgcn_mfma_f32_16x16x32_bf16(Bt[n][k], At[m][k], acc[ai][bj][m][n], 0, 0, 0); __builtin_amdgcn_s_setprio(0); } while (0)
#define PG8_WAIT_V(n) asm volatile("s_waitcnt vmcnt(" #n ")" ::: "memory")
#define PG8_WAIT_VR do { if constexpr (Epi::NVM >= 32) asm volatile("s_waitcnt vmcnt(40)" ::: "memory"); else if constexpr (Epi::NVM >= 16) asm volatile("s_waitcnt vmcnt(24)" ::: "memory"); \
        else if constexpr (Epi::NVM >= 8) asm volatile("s_waitcnt vmcnt(16)" ::: "memory"); else asm volatile("s_waitcnt vmcnt(8)" ::: "memory"); } while (0)
#define PG8_WAIT_L(n) asm volatile("s_waitcnt lgkmcnt(" #n ")" ::: "memory")
#define PG8_BAR __builtin_amdgcn_s_barrier()
#define PG8_SCHED __builtin_amdgcn_sched_barrier(0)
    static_assert(SP2 || !Epi::HAS_EXT, "the K extension is wired into the SP2 loop only");
    Unit cur, nxt; int ui = 0;
    if (!S.next(0, cur)) return;
    f32x4 acc[2][2][4][2];
#pragma unroll
    for (int a = 0; a < 2; ++a)
#pragma unroll
        for (int b = 0; b < 2; ++b)
#pragma unroll
            for (int m = 0; m < 4; ++m)
#pragma unroll
                for (int n = 0; n < 2; ++n) acc[a][b][m][n] = (f32x4){0.f, 0.f, 0.f, 0.f};
    bf16x8 At[4][2], B0[2][2], B1[2][2];
    const char* cA = (const char*)g.A + (size_t)cur.pm * tstep; const char* cB = (const char*)g.Bt + (size_t)cur.pn * tstep;
    const char* eA = Epi::HAS_EXT ? (const char*)g.Ae + ((size_t)cur.pm * BM * g.lde_a + (size_t)cur.pn * BM) * 2 : nullptr; const char* eB = (const char*)g.Bte;
    S.a_ready(cur);
    float carry[8] = {0.f, 0.f, 0.f, 0.f, 0.f, 0.f, 0.f, 0.f};
    if constexpr (Epi::HAS_PRE) E.pre(cur, wr, fr, carry);
    if constexpr (SP2) {
        PG8_STAGE(PG8_SB(0, 0), cB, voffB); PG8_STAGE(PG8_SB(0, 1), cB + hstep, voffB); PG8_STAGE(PG8_SA(0, 0), cA, voffA); PG8_STAGE(PG8_SA(0, 1), cA + hstep, voffA);
        if (wr == 1) PG8_BAR;
        PG8_WAIT_V(2); PG8_BAR;
        PG8_STAGE(PG8_SB(1, 0), cB + kstep, voffB); PG8_STAGE(PG8_SA(1, 0), cA + kstep, voffA); PG8_STAGE(PG8_SB(1, 1), cB + hstep + kstep, voffB);
        PG8_WAIT_V(6); PG8_BAR;
    } else {
        PG8_STAGE(PG8_SB(0, 0), cB, voffB); PG8_STAGE(PG8_SA(0, 0), cA, voffA); PG8_STAGE(PG8_SB(0, 1), cB + hstep, voffB); PG8_STAGE(PG8_SA(0, 1), cA + hstep, voffA);
        if (wr == 1) PG8_BAR;
        PG8_WAIT_V(4); PG8_BAR;
        PG8_STAGE(PG8_SB(1, 0), cB + kstep, voffB); PG8_STAGE(PG8_SA(1, 0), cA + kstep, voffA); PG8_STAGE(PG8_SB(1, 1), cB + hstep + kstep, voffB);
        PG8_WAIT_V(6); PG8_BAR;
    }
    for (;;) {
        const bool has_next = S.next(ui + 1, nxt);
        const char* nA = has_next ? (const char*)g.A + (size_t)nxt.pm * tstep : cA; const char* nB = has_next ? (const char*)g.Bt + (size_t)nxt.pn * tstep : cB;
        int t0 = 0;
        if constexpr (SP2 && ALIGN_EPI && Epi::NVM > 0) { if (ui > 0) {
            const char* pa2 = cA + 2 * kstep; const char* pb2 = cB + 2 * kstep; const char* pa3 = pa2 + kstep; const char* pb3 = pb2 + kstep;


            PG8_LDB(B0, 0, 0); PG8_LDB(B1, 0, 1); PG8_SCHED; PG8_LDA(At, 0, 0);
            PG8_WAIT_VR; PG8_WAIT_L(0); PG8_BAR; PG8_MMA(0, 0, At, B0); PG8_MMA(0, 1, At, B1); PG8_BAR; PG8_SCHED;

            PG8_LDA(At, 0, 1); PG8_STAGE(PG8_SB(0, 0), pb2, voffB); PG8_STAGE(PG8_SB(0, 1), pb2 + hstep, voffB); PG8_STAGE(PG8_SA(0, 0), pa2, voffA);
            PG8_WAIT_VR; PG8_WAIT_L(0); PG8_BAR; PG8_MMA(1, 0, At, B0); PG8_MMA(1, 1, At, B1); PG8_BAR; PG8_SCHED;

            PG8_LDB(B0, 1, 0); PG8_LDB(B1, 1, 1); PG8_SCHED; PG8_LDA(At, 1, 0); PG8_STAGE(PG8_SA(0, 1), pa2 + hstep, voffA);
            PG8_WAIT_VR; PG8_WAIT_L(0); PG8_BAR; PG8_MMA(0, 0, At, B0); PG8_MMA(0, 1, At, B1); PG8_BAR; PG8_SCHED;

            PG8_LDA(At, 1, 1); PG8_STAGE(PG8_SB(1, 0), pb3, voffB); PG8_STAGE(PG8_SB(1, 1), pb3 + hstep, voffB); PG8_STAGE(PG8_SA(1, 0), pa3, voffA);
            PG8_WAIT_V(8); PG8_WAIT_L(0); PG8_BAR; PG8_MMA(1, 0, At, B0); PG8_MMA(1, 1, At, B1); PG8_BAR; PG8_SCHED;
            t0 = 2; } }
        for (int t = t0; t < nt; t += 2) {
            if constexpr (Epi::HAS_MID) { if (t == Epi::MID_T) { __builtin_amdgcn_sched_barrier(0); E.mid(acc, cur, wr, wc, fr, fq); __builtin_amdgcn_sched_barrier(0); } }
            const bool last = (t == nt - 2);
            const bool x1 = Epi::HAS_EXT && t >= ntm, x2 = Epi::HAS_EXT && !last && t + 2 >= ntm;
            const char* a1 = x1 ? eA + (size_t)(t + 1 - ntm) * kstep : cA + (size_t)(t + 1) * kstep;
            const char* a2 = last ? nA : (x2 ? eA + (size_t)(t + 2 - ntm) * kstep : cA + (size_t)(t + 2) * kstep);
            const char* b2 = last ? nB : (x2 ? eB + (size_t)(t + 2 - ntm) * kstep : cB + (size_t)(t + 2) * kstep);
            const char* a3 = a2 + kstep; const char* b3 = b2 + kstep;
            const size_t hA1 = x1 ? hstepAe : hstep, hA2 = x2 ? hstepAe : hstep, hB2 = x2 ? hstepBe : hstep;
            unsigned vA1[2], vA2[2], vB2[2];
#pragma unroll
            for (int i = 0; i < 2; ++i) { vA1[i] = x1 ? voffAe[i] : voffA[i]; vA2[i] = x2 ? voffAe[i] : voffA[i]; vB2[i] = x2 ? voffBe[i] : voffB[i]; }
            if (last && has_next) S.a_ready(nxt);
            if constexpr (SP2) {
            PG8_LDB(B0, 0, 0); PG8_LDB(B1, 0, 1); PG8_SCHED; PG8_LDA(At, 0, 0); PG8_STAGE(PG8_SA(1, 1), a1 + hA1, vA1);
            PG8_WAIT_V(8); PG8_WAIT_L(0); PG8_BAR; PG8_MMA(0, 0, At, B0); PG8_MMA(0, 1, At, B1); PG8_BAR; PG8_SCHED;
            PG8_LDA(At, 0, 1); PG8_STAGE(PG8_SB(0, 0), b2, vB2); PG8_STAGE(PG8_SB(0, 1), b2 + hB2, vB2); PG8_STAGE(PG8_SA(0, 0), a2, vA2);
            PG8_WAIT_V(8); PG8_WAIT_L(0); PG8_BAR; PG8_MMA(1, 0, At, B0); PG8_MMA(1, 1, At, B1); PG8_BAR; PG8_SCHED;
            PG8_LDB(B0, 1, 0); PG8_LDB(B1, 1, 1); PG8_SCHED; PG8_LDA(At, 1, 0); PG8_STAGE(PG8_SA(0, 1), a2 + hA2, vA2);
            PG8_WAIT_V(8); PG8_WAIT_L(0); PG8_BAR; PG8_MMA(0, 0, At, B0); PG8_MMA(0, 1, At, B1); PG8_BAR; PG8_SCHED;
            PG8_LDA(At, 1, 1); PG8_STAGE(PG8_SB(1, 0), b3, vB2); PG8_STAGE(PG8_SB(1, 1), b3 + hB2, vB2); PG8_STAGE(PG8_SA(1, 0), a3, vA2);
            PG8_WAIT_V(8); PG8_WAIT_L(0); PG8_BAR; PG8_MMA(1, 0, At, B0); PG8_MMA(1, 1, At, B1); PG8_BAR; PG8_SCHED;
            } else {
            PG8_LDB(B0, 0, 0); PG8_SCHED; PG8_LDA(At, 0, 0); PG8_STAGE(PG8_SA(1, 1), a1 + hstep, voffA);
            PG8_WAIT_L(8); PG8_BAR; PG8_WAIT_L(0); PG8_MMA(0, 0, At, B0); PG8_BAR; PG8_SCHED;
            PG8_LDB(B1, 0, 1); PG8_STAGE(PG8_SB(0, 0), b2, voffB);
            PG8_BAR; PG8_WAIT_L(0); PG8_MMA(0, 1, At, B1); PG8_BAR;
            PG8_LDA(At, 0, 1); PG8_STAGE(PG8_SA(0, 0), a2, voffA);
            PG8_BAR; PG8_WAIT_L(0); PG8_MMA(1, 0, At, B0); PG8_BAR; PG8_SCHED;
            PG8_STAGE(PG8_SB(0, 1), b2 + hstep, voffB);
            PG8_WAIT_V(6); PG8_BAR; PG8_MMA(1, 1, At, B1); PG8_BAR;
            PG8_LDB(B0, 1, 0); PG8_SCHED; PG8_LDA(At, 1, 0); PG8_STAGE(PG8_SA(0, 1), a2 + hstep, voffA);
            PG8_WAIT_L(8); PG8_BAR; PG8_WAIT_L(0); PG8_MMA(0, 0, At, B0); PG8_BAR; PG8_SCHED;
            PG8_LDB(B1, 1, 1); PG8_STAGE(PG8_SB(1, 0), b3, voffB);
            PG8_BAR; PG8_WAIT_L(0); PG8_MMA(0, 1, At, B1); PG8_BAR;
            PG8_LDA(At, 1, 1); PG8_STAGE(PG8_SA(1, 0), a3, voffA);
            PG8_BAR; PG8_WAIT_L(0); PG8_MMA(1, 0, At, B0); PG8_BAR; PG8_SCHED;
            PG8_STAGE(PG8_SB(1, 1), b3 + hstep, voffB);
            PG8_WAIT_V(6); PG8_BAR; PG8_MMA(1, 1, At, B1); PG8_BAR;
            }
        }
        if constexpr (ALIGN_EPI) { if (wr == 0) PG8_BAR; }
        if constexpr (SP2 && ALIGN_EPI && Epi::NVM > 0) { if (has_next) PG8_STAGE(PG8_SA(1, 1), nA + kstep + hstep, voffA); asm volatile("" ::: "memory"); PG8_SCHED; }
        if constexpr (!Epi::AFTER_DRAIN) { if constexpr (Epi::HAS_PRE) { E.run(acc, cur, wr, wc, fr, fq, carry); if (has_next) E.pre(nxt, wr, fr, carry); } else E(acc, cur, wr, wc, fr, fq); S.done(cur); }
        if (!has_next) break;
#pragma unroll
        for (int a = 0; a < 2; ++a)
#pragma unroll
            for (int b = 0; b < 2; ++b)
#pragma unroll
                for (int m = 0; m < 4; ++m)
#pragma unroll
                    for (int n = 0; n < 2; ++n) { acc[a][b][m][n] = (f32x4){0.f, 0.f, 0.f, 0.f}; asm volatile("" : "+v"(acc[a][b][m][n])); }
        cur = nxt; cA = nA; cB = nB; ++ui;
        if constexpr (Epi::HAS_EXT) eA = (const char*)g.Ae + ((size_t)cur.pm * BM * g.lde_a + (size_t)cur.pn * BM) * 2;
        if constexpr (ALIGN_EPI) { if (wr == 1) PG8_BAR; }
    }
    PG8_WAIT_V(0);
    if constexpr (!ALIGN_EPI) { if (wr == 0) PG8_BAR; }
    PG8_BAR;
    if constexpr (Epi::AFTER_DRAIN) { E.fused(acc, cur, wr, wc, fr, fq, lds, wid, lane); S.done(cur); }
#undef PG8_SA
#undef PG8_SB
#undef PG8_STAGE
#undef PG8_LDA
#undef PG8_LDB
#undef PG8_MMA
#undef PG8_WAIT_V
#undef PG8_WAIT_L
#undef PG8_BAR
#undef PG8_SCHED
}
}

#ifndef PG8_SP2
#define PG8_SP2 true
#endif
#ifndef PG8_ALIGN
#define PG8_ALIGN true
#endif
#define GAS __attribute__((address_space(1)))
#define LAS __attribute__((address_space(3)))
typedef unsigned short bf16;
typedef unsigned v4u __attribute__((ext_vector_type(4)));
typedef float f32x4 __attribute__((ext_vector_type(4)));
typedef short bf16x8 __attribute__((ext_vector_type(8)));
typedef GAS unsigned gu32;
typedef GAS unsigned long long gu64;
#define RLX_AGENT __ATOMIC_RELAXED, __HIP_MEMORY_SCOPE_AGENT
#define LDS_WAIT() asm volatile("s_waitcnt lgkmcnt(0)" ::: "memory")
#define VM_WAIT() asm volatile("s_waitcnt vmcnt(0)" ::: "memory")
__device__ __forceinline__ unsigned long long rt() { return __builtin_amdgcn_s_memrealtime(); }
__device__ __forceinline__ unsigned f2bf(float f) { unsigned u = __builtin_bit_cast(unsigned, f); return (u + 0x7fffu + ((u >> 16) & 1u)) >> 16; }
__device__ __forceinline__ unsigned pk2(float lo, float hi) { return f2bf(lo) | (f2bf(hi) << 16); }

#define XB_TMO      128
#define XB_XCNT(j)  (256  + 64 * (j))
#define XB_XSUB(j)  (1280 + 64 * (j))
#define XB_XGEN(j)  (2304 + 64 * (j))
#define XB_TOP      3328
#define XB_TOPGEN   3392
#define XCD_BAR_WORDS 3456
#define XB_SPIN_CAP (1u << 18)

__device__ __forceinline__ unsigned xb_ld(unsigned* p)              { return __hip_atomic_load(p, __ATOMIC_RELAXED, __HIP_MEMORY_SCOPE_AGENT); }
__device__ __forceinline__ unsigned xb_add(unsigned* p, unsigned v) { return __hip_atomic_fetch_add(p, v, __ATOMIC_RELAXED, __HIP_MEMORY_SCOPE_AGENT); }
__device__ __forceinline__ unsigned xb_xcc_id() { return (unsigned)__builtin_amdgcn_s_getreg((3 << 11) | 20) & 0xFu; }
#define XB_SPIN(cond, bar) do { unsigned _sp = 0; while (cond) { __builtin_amdgcn_s_sleep(1); \
    if ((++_sp & 255u) == 0u) { if (xb_ld(&(bar)[XB_TMO])) break; if (_sp > XB_SPIN_CAP) { atomicAdd(&(bar)[XB_TMO], 1u); break; } } } } while (0)

struct XcdBarrier {
    unsigned* bar; unsigned x;
    volatile LAS unsigned* st;
};

__device__ __forceinline__ XcdBarrier xcd_barrier_post(unsigned* bar, volatile LAS unsigned* st) {
    XcdBarrier b; b.bar = bar; b.x = xb_xcc_id(); b.st = st;
    if (threadIdx.x == 0) (void)xb_add(&bar[XB_XCNT(b.x)], 1u);
    return b;
}
__device__ __forceinline__ void xcd_barrier_complete(unsigned* bar, unsigned x, unsigned& nloc, unsigned& nx) {
    const unsigned G = gridDim.x * gridDim.y * gridDim.z;
    unsigned sum, cnt, mine, sp = 0u;
    for (;;) {
        sum = 0u; cnt = 0u; mine = 0u;
#pragma unroll
        for (unsigned j = 0; j < 16; ++j) { const unsigned c = xb_ld(&bar[XB_XCNT(j)]); sum += c; cnt += (c > 0u) ? 1u : 0u; mine = (j == x) ? c : mine; }
        if (sum == G) break;
        __builtin_amdgcn_s_sleep(1);
        if ((++sp & 255u) == 0u) { if (xb_ld(&bar[XB_TMO])) break; if (sp > XB_SPIN_CAP) { atomicAdd(&bar[XB_TMO], 1u); break; } }
    }
    nloc = mine > 0u ? mine : 1u; nx = cnt > 0u ? cnt : 1u;
}

__device__ __forceinline__ void xcd_barrier(const XcdBarrier& b) {
    asm volatile("s_waitcnt vmcnt(0)" ::: "memory");
    __syncthreads();
    if (threadIdx.x == 0) {
        unsigned* bar = b.bar;
        __builtin_amdgcn_s_waitcnt(0);
        unsigned nloc = b.st[0], nx = b.st[1];
        if (nloc == 0u) { xcd_barrier_complete(bar, b.x, nloc, nx); b.st[0] = nloc; b.st[1] = nx; }
        const unsigned old = xb_add(&bar[XB_XSUB(b.x)], 1u);
        const unsigned gen = old / nloc;
        if (old + 1u == (gen + 1u) * nloc) {
            __builtin_amdgcn_fence(__ATOMIC_RELEASE, "agent");
            asm volatile("s_waitcnt vmcnt(0)" ::: "memory");
            const unsigned og = xb_add(&bar[XB_TOP], 1u);
            const unsigned tg = og / nx;
            if (og + 1u == (tg + 1u) * nx) xb_add(&bar[XB_TOPGEN], 1u);
            else XB_SPIN(xb_ld(&bar[XB_TOPGEN]) == tg, bar);
            __builtin_amdgcn_fence(__ATOMIC_ACQUIRE, "agent");
            xb_add(&bar[XB_XGEN(b.x)], 1u);
            asm volatile("s_waitcnt vmcnt(0)" ::: "memory");
        } else {
            XB_SPIN(xb_ld(&bar[XB_XGEN(b.x)]) == gen, bar);
            __builtin_amdgcn_fence(__ATOMIC_ACQUIRE, "agent");
            asm volatile("s_waitcnt vmcnt(0)" ::: "memory");
        }
    }
    __syncthreads();
}

constexpr int NWAVES = 8;
#ifndef MK_N_LAUNCHES
#define MK_N_LAUNCHES 1
#endif
constexpr int PER_PHASE = 9;
constexpr int N_LAUNCHES = MK_N_LAUNCHES;
static_assert(N_LAUNCHES == 1 || N_LAUNCHES == PER_PHASE, "MK_N_LAUNCHES is 1 or 9");

constexpr int BATCH = 8, SEQ = 4096, D = 1024, M = BATCH * SEQ;
constexpr int DCONV = 512, DATT = 512, NH = 8, HD = 64, FF = 2816, NGU = 2 * FF;
constexpr int NPROJ_SRC = 4808, NPROJ = 4864;
constexpr int PC_CB = 0, PC_CC = 512, PC_CX = 1024, PC_Q = 1536, PC_IQ = 2048, PC_KVI = 2560, PC_GA = 2816, PC_GB = 3840;
constexpr int KVP = 128, KV_K = 0, KV_V = 64;
constexpr float EPS = 1e-6f;
constexpr int TOPK = 256;

constexpr size_t MiB = 1u << 20;
constexpr size_t WS_CTL = 0, CTL_ZERO_BYTES = 1 * MiB;
constexpr size_t WS_SSQ1 = 256 * 1024, WS_SSQ2 = 512 * 1024;
constexpr size_t WS_RC = 896 * 1024;
constexpr size_t WS_IDENT = 768 * 1024;
constexpr int BM256 = 256;
constexpr size_t WS_WIN = 6 * MiB, WS_WA = 16 * MiB, WS_WB = 17 * MiB, WS_WOUT = 18 * MiB, WS_WGU = 20 * MiB, WS_WD = 31 * MiB;
constexpr size_t WS_XN = 40 * MiB;
constexpr size_t WS_CONV = 104 * MiB, WS_ATTN = 136 * MiB;
constexpr size_t WS_PROJ = 168 * MiB;
constexpr size_t WS_KVI = 472 * MiB;
constexpr size_t WS_IKF = 480 * MiB, WS_IW = 484 * MiB;
constexpr size_t WS_SSQ0 = WS_IW + 3 * MiB;
constexpr size_t WS_END = 488 * MiB;
static_assert(WS_WIN + (size_t)NPROJ * D * 2 <= WS_WA && WS_WGU + (size_t)NGU * D * 2 <= WS_WD && WS_WD + (size_t)D * FF * 2 <= WS_XN, "weights map");
static_assert(WS_PROJ + (size_t)M * NPROJ * 2 <= WS_KVI && WS_KVI + (size_t)M * KVP * 2 <= WS_IKF && WS_IKF + (size_t)M * 64 * 2 <= WS_IW && WS_IW + (size_t)M * 16 <= WS_END && WS_XN + (size_t)M * D * 2 <= WS_CONV && WS_ATTN + (size_t)M * 512 * 2 <= WS_PROJ, "activation map");
constexpr int CW_BAR = 4096;

constexpr int RING_OFF = 0, RING_BYTES = 131072;
constexpr int LDSCTL_OFF = RING_BYTES, MISC_OFF = LDSCTL_OFF + 320;
constexpr int TAB_OFF = RING_BYTES + 1024;
constexpr int LDS_BYTES = 147456;
static_assert(MISC_OFF + 128 <= TAB_OFF && TAB_OFF + 4096 <= LDS_BYTES, "LDS map");

struct Frame {
    LAS unsigned char* lds;
    volatile LAS unsigned* MISC;
    gu32* ctl;
    int tid, lane, wave;
    int vcu, G;
};

__device__ __forceinline__ float wave_sum(float v) {
#pragma unroll
    for (int o = 1; o < 64; o <<= 1) v += __shfl_xor(v, o);
    return v;
}
__device__ __forceinline__ float bf_lo(unsigned w) { return __builtin_bit_cast(float, w << 16); }
__device__ __forceinline__ float bf_hi(unsigned w) { return __builtin_bit_cast(float, w & 0xffff0000u); }
__device__ __forceinline__ float fast_sigmoid(float z) { return __builtin_amdgcn_rcpf(1.0f + __builtin_amdgcn_exp2f(-1.4426950408889634f * z)); }

__device__ __forceinline__ void p0_transpose_item(const float* W, int K, int N, int k0, int scol0, int nvalid, bf16* WT, int drow0, const float* kscale, LAS float* scr, int lane, int ldk = 0, int kd0 = -1) {
    if (ldk == 0) ldk = K; if (kd0 < 0) kd0 = k0;
    const int kr = lane >> 3, j4 = lane & 7;
    f32x4 v[8];
#pragma unroll
    for (int i = 0; i < 8; ++i) { v[i] = (f32x4){0.f, 0.f, 0.f, 0.f};
        if (4 * j4 < nvalid) v[i] = *(const GAS f32x4*)(W + (size_t)(k0 + 8 * i + kr) * N + scol0 + 4 * j4); }
    if (kscale) {
#pragma unroll
        for (int i = 0; i < 8; ++i) v[i] = v[i] * kscale[k0 + 8 * i + kr]; }
#pragma unroll
    for (int i = 0; i < 8; ++i) { LAS float* d = scr + (8 * i + kr) * 33 + 4 * j4; d[0] = v[i].x; d[1] = v[i].y; d[2] = v[i].z; d[3] = v[i].w; }
    LDS_WAIT(); asm volatile("" ::: "memory");
    const int c = lane & 7;
#pragma unroll
    for (int jj = 0; jj < 4; ++jj) { const int n = (lane >> 3) + 8 * jj; const LAS float* s = scr + (8 * c) * 33 + n;
        v4u o; o.x = pk2(s[0 * 33], s[1 * 33]); o.y = pk2(s[2 * 33], s[3 * 33]); o.z = pk2(s[4 * 33], s[5 * 33]); o.w = pk2(s[6 * 33], s[7 * 33]);
        *(GAS v4u*)(WT + (size_t)(drow0 + n) * ldk + kd0 + 8 * c) = o; }
    LDS_WAIT(); asm volatile("" ::: "memory");
}
__device__ __forceinline__ void rms_rows2_to_bf16(int lane, const float* xrow0, const float* xrow1, const float* g, bf16* orow0, bf16* orow1) {
    const GAS f32x4* xa = (const GAS f32x4*)xrow0 + lane; const GAS f32x4* xb = (const GAS f32x4*)xrow1 + lane; const GAS f32x4* gr = (const GAS f32x4*)g + lane;
    f32x4 va[4], vb[4]; float sa = 0.f, sb = 0.f;
#pragma unroll
    for (int j = 0; j < 4; ++j) { va[j] = xa[64 * j]; vb[j] = xb[64 * j]; }
#pragma unroll
    for (int j = 0; j < 4; ++j) { sa += (va[j].x * va[j].x + va[j].y * va[j].y) + (va[j].z * va[j].z + va[j].w * va[j].w); sb += (vb[j].x * vb[j].x + vb[j].y * vb[j].y) + (vb[j].z * vb[j].z + vb[j].w * vb[j].w); }
#pragma unroll
    for (int o = 1; o < 64; o <<= 1) { sa += __shfl_xor(sa, o); sb += __shfl_xor(sb, o); }
    const float ra = 1.f / sqrtf(sa * (1.f / D) + EPS), rb = 1.f / sqrtf(sb * (1.f / D) + EPS);
    GAS unsigned long long* oa = (GAS unsigned long long*)orow0 + lane; GAS unsigned long long* ob = (GAS unsigned long long*)orow1 + lane;
#pragma unroll
    for (int j = 0; j < 4; ++j) { const f32x4 gg = gr[64 * j];
        oa[64 * j] = (unsigned long long)pk2(va[j].x * ra * gg.x, va[j].y * ra * gg.y) | ((unsigned long long)pk2(va[j].z * ra * gg.z, va[j].w * ra * gg.w) << 32);
        ob[64 * j] = (unsigned long long)pk2(vb[j].x * rb * gg.x, vb[j].y * rb * gg.y) | ((unsigned long long)pk2(vb[j].z * rb * gg.z, vb[j].w * rb * gg.w) << 32); }
}

__device__ __forceinline__ void x_rows2_to_bf16(int lane, const float* xrow0, const float* xrow1, bf16* orow0, bf16* orow1, float* ss0, float* ss1) {
    const GAS f32x4* xa = (const GAS f32x4*)xrow0 + lane; const GAS f32x4* xb = (const GAS f32x4*)xrow1 + lane;
    f32x4 va[4], vb[4]; float sa = 0.f, sb = 0.f;
#pragma unroll
    for (int j = 0; j < 4; ++j) { va[j] = xa[64 * j]; vb[j] = xb[64 * j]; }
    GAS unsigned long long* oa = (GAS unsigned long long*)orow0 + lane; GAS unsigned long long* ob = (GAS unsigned long long*)orow1 + lane;
#pragma unroll
    for (int j = 0; j < 4; ++j) { sa += (va[j].x * va[j].x + va[j].y * va[j].y) + (va[j].z * va[j].z + va[j].w * va[j].w); sb += (vb[j].x * vb[j].x + vb[j].y * vb[j].y) + (vb[j].z * vb[j].z + vb[j].w * vb[j].w);
        oa[64 * j] = (unsigned long long)pk2(va[j].x, va[j].y) | ((unsigned long long)pk2(va[j].z, va[j].w) << 32);
        ob[64 * j] = (unsigned long long)pk2(vb[j].x, vb[j].y) | ((unsigned long long)pk2(vb[j].z, vb[j].w) << 32); }
#pragma unroll
    for (int o = 1; o < 64; o <<= 1) { sa += __shfl_xor(sa, o); sb += __shfl_xor(sb, o); }
    if (lane == 0) { *ss0 = sa; *ss1 = sb; }
}

struct Ptrs {
    const float *x, *g_mix, *w_in, *b_gate, *conv_w, *w_a, *w_b, *w_out, *rel_bias, *g_ffn, *w_g, *w_u, *w_d, *g_final;
    float* out; unsigned char* ws;
};

constexpr int PI_IN = (NPROJ / 32) * (D / 64), PI_A = (D / 32) * (DCONV / 64), PI_B = (D / 32) * (DATT / 64), PI_O = (D / 32) * (D / 64), PI_GU = (NGU / 32) * (D / 64), PI_D = (D / 32) * (FF / 64);
constexpr int PI_ALL = PI_IN + PI_A + PI_B + PI_O + PI_GU + PI_D;
__device__ __forceinline__ void p0_weight_items(Frame& F, const Ptrs& P, int lo, int hi, int gw, int NGW) {
    LAS float* scr = (LAS float*)(F.lds + RING_OFF + F.wave * 16384);
    bf16* WinT = (bf16*)(P.ws + WS_WIN); bf16* WaT = (bf16*)(P.ws + WS_WA); bf16* WbT = (bf16*)(P.ws + WS_WB); bf16* WoutT = (bf16*)(P.ws + WS_WOUT);
    bf16* WguT = (bf16*)(P.ws + WS_WGU); bf16* WdT = (bf16*)(P.ws + WS_WD);
    for (int it = lo + gw; it < hi; it += NGW) {
        int r = it;
        if (r < PI_IN) { const int db = r / (D / 64), kb = r % (D / 64), drow0 = 32 * db; int scol0, nvalid;
            if (drow0 < 2048) { scol0 = drow0; nvalid = 32; }
            else if (drow0 < 2560) { scol0 = drow0 + 128; nvalid = 32; }
            else if (drow0 < 2688) { scol0 = drow0 - 512; nvalid = 32; }
            else if (drow0 < 2752) { scol0 = drow0; nvalid = 32; }
            else if (drow0 == 2752) { scol0 = 2752; nvalid = 8; }
            else if (drow0 < PC_GA) { scol0 = 0; nvalid = 0; }
            else { scol0 = drow0 - 56; nvalid = 32; }
            p0_transpose_item(P.w_in, D, NPROJ_SRC, 64 * kb, scol0, nvalid, WinT, drow0, P.g_mix, scr, F.lane); continue; } r -= PI_IN;
        if (r < PI_A) { const int db = r / (DCONV / 64), kb = r % (DCONV / 64); p0_transpose_item(P.w_a, DCONV, D, 64 * kb, 32 * db, 32, WaT, 32 * db, nullptr, scr, F.lane, D, 64 * kb); continue; } r -= PI_A;
        if (r < PI_B) { const int db = r / (DATT / 64), kb = r % (DATT / 64); p0_transpose_item(P.w_b, DATT, D, 64 * kb, 32 * db, 32, WaT, 32 * db, nullptr, scr, F.lane, D, DCONV + 64 * kb); continue; } r -= PI_B;
        if (r < PI_O) { const int db = r / (D / 64), kb = r % (D / 64); p0_transpose_item(P.w_out, D, D, 64 * kb, 32 * db, 32, WoutT, 32 * db, nullptr, scr, F.lane); continue; } r -= PI_O;
        if (r < PI_GU) { const int db = r / (D / 64), kb = r % (D / 64), drow0 = 32 * db, p = drow0 >> 8, bj = (drow0 >> 7) & 1, q = (drow0 >> 5) & 3;
            p0_transpose_item(bj ? P.w_u : P.w_g, D, FF, 64 * kb, 128 * p + 32 * q, 32, WguT, drow0, P.g_ffn, scr, F.lane); continue; } r -= PI_GU;
        { const int db = r / (FF / 64), kb = r % (FF / 64); p0_transpose_item(P.w_d, FF, D, 64 * kb, 32 * db, 32, WdT, 32 * db, nullptr, scr, F.lane); }
    }
}
__device__ __forceinline__ void p0_prologue(Frame& F, const Ptrs& P, bool all_weights) {
    const int gw = F.vcu * NWAVES + F.wave, NGW = F.G * NWAVES;
    p0_weight_items(F, P, 0, all_weights ? PI_ALL : PI_IN, gw, NGW);
    bf16* XB = (bf16*)P.out; float* SSQ0 = (float*)(P.ws + WS_SSQ0);
    for (int m = gw; m < M; m += 2 * NGW) { const int m1 = (m + NGW < M) ? m + NGW : m;
        x_rows2_to_bf16(F.lane, P.x + (size_t)m * D, P.x + (size_t)m1 * D, XB + (size_t)m * D, XB + (size_t)m1 * D, SSQ0 + m, SSQ0 + m1); }
}

namespace pg8 {
struct EpiProj {
    static constexpr bool PERM = true, AFTER_DRAIN = false, HAS_PRE = true, HAS_MID = false, HAS_EXT = false;
    static constexpr int NVM = 16;
    bf16_t* O; int ldc; bf16_t* KV; bf16_t* IKF; bf16_t* IW; int kv_tile; PG8_LAS const float* bgate; int gate_col0; bf16_t* JUNK; const float* SSQ; PG8_LAS float* RS;
    __device__ __forceinline__ void pre(const Unit& u, int wr, int fr, float (&carry)[8]) const {
        const int have = __builtin_amdgcn_readfirstlane(__builtin_bit_cast(int, carry[0])) - 1;
        if (u.pm != have) { const int par = __builtin_amdgcn_readfirstlane(__builtin_bit_cast(int, carry[1])) ^ 1; const int t = threadIdx.x;
            if (t < BM) RS[par * BM + t] = 1.0f / sqrtf(SSQ[u.pm * BM + t] * (1.0f / D) + 1e-6f);
            carry[0] = __builtin_bit_cast(float, u.pm + 1); carry[1] = __builtin_bit_cast(float, par); }
    }
    template <bool GATE> __device__ __forceinline__ void body(const f32x4 (&acc)[2][2][4][2], const Unit& u, int wr, int wc, int fr, int fq, const float (&carry)[8]) const {
        int row0 = u.pm * BM + wr * 64 + fr; const bool kv = !GATE && (u.pn == kv_tile); int cid = 4 * wc + fq;
        asm volatile("" : "+v"(row0), "+v"(cid));
        const PG8_LAS float* rs = RS + __builtin_amdgcn_readfirstlane(__builtin_bit_cast(int, carry[1])) * BM + wr * 64 + fr;
        float rst[8];
#pragma unroll
        for (int ai = 0; ai < 2; ++ai)
#pragma unroll
            for (int m = 0; m < 4; ++m) rst[4 * ai + m] = rs[ai * HALF + m * 16];
        f32x4 gb0[2], gb1[2];
#pragma unroll
        for (int bj = 0; bj < 2; ++bj) { gb0[bj] = (f32x4){0.f, 0.f, 0.f, 0.f}; gb1[bj] = gb0[bj];
            if (GATE) { PG8_LAS const float* bp = bgate + (u.pn * BM - gate_col0) + bj * HALF + 8 * cid; gb0[bj] = *(PG8_LAS const f32x4*)bp; gb1[bj] = *(PG8_LAS const f32x4*)(bp + 4); } }
#pragma unroll
        for (int ai = 0; ai < 2; ++ai)
#pragma unroll
            for (int m = 0; m < 4; ++m) { const int row = row0 + ai * HALF + m * 16;
#pragma unroll
                for (int bj = 0; bj < 2; ++bj) { f32x4 v0 = acc[ai][bj][m][0] * rst[4 * ai + m], v1 = acc[ai][bj][m][1] * rst[4 * ai + m];
                    if (GATE) {
                        v0 = v0 + gb0[bj]; v1 = v1 + gb1[bj]; unsigned q[8];
#pragma unroll
                        for (int k = 0; k < 4; ++k) { q[k] = (unsigned)__builtin_amdgcn_fmed3f(fast_sigmoid(v0[k]) * 256.0f + 0.5f, 1.0f, 255.0f); q[4 + k] = (unsigned)__builtin_amdgcn_fmed3f(fast_sigmoid(v1[k]) * 256.0f + 0.5f, 1.0f, 255.0f); }
                        typedef unsigned u32x2g __attribute__((ext_vector_type(2)));
                        u32x2g w8; w8.x = q[0] | (q[1] << 8) | (q[2] << 16) | (q[3] << 24); w8.y = q[4] | (q[5] << 8) | (q[6] << 16) | (q[7] << 24);
                        *(u32x2g*)((unsigned char*)(O + (size_t)row * ldc + gate_col0) + (u.pn * BM - gate_col0) + bj * HALF + 8 * cid) = w8;
                        continue; }
                    u32x4 w; w.x = cvt_pk_bf16(v0[0], v0[1]); w.y = cvt_pk_bf16(v0[2], v0[3]); w.z = cvt_pk_bf16(v1[0], v1[1]); w.w = cvt_pk_bf16(v1[2], v1[3]);
                    if (!kv) *(u32x4*)(O + (size_t)row * ldc + u.pn * BM + bj * HALF + 8 * cid) = w;
                    else if (bj == 0) { typedef unsigned u32x2k __attribute__((ext_vector_type(2)));
                        int k0 = __builtin_amdgcn_cvt_pk_fp8_f32(v0[0], v0[1], 0, false); k0 = __builtin_amdgcn_cvt_pk_fp8_f32(v0[2], v0[3], k0, true);
                        int k1 = __builtin_amdgcn_cvt_pk_fp8_f32(v1[0], v1[1], 0, false); k1 = __builtin_amdgcn_cvt_pk_fp8_f32(v1[2], v1[3], k1, true);
                        u32x2k w8; w8.x = (unsigned)k0; w8.y = (unsigned)k1; *(u32x2k*)((unsigned char*)KV + (size_t)row * 128 + 8 * cid) = w8; }
                    else if (cid < 8) { const int s = row & 4095; *(u32x4*)(IKF + (size_t)(row >> 12) * (4096 * 64) + (s >> 5) * 2048 + cid * 256 + (s & 31) * 8) = w; }
                    else if (cid == 8) *(u32x4*)(IW + (size_t)row * 8) = w;
                    else *(u32x4*)(JUNK + (size_t)(row & 1023) * 8) = w; } }
    }
    __device__ __forceinline__ void run(const f32x4 (&acc)[2][2][4][2], const Unit& u, int wr, int wc, int fr, int fq, const float (&carry)[8]) const {
        if (u.pn * BM >= gate_col0) body<true>(acc, u, wr, wc, fr, fq, carry); else body<false>(acc, u, wr, wc, fr, fq, carry);
    }
};
template <bool ACCUM> struct EpiGate {
    static constexpr bool PERM = true, AFTER_DRAIN = false, HAS_PRE = false, HAS_MID = false, HAS_EXT = false;
    static constexpr int NVM = 0;
    bf16_t* O; const bf16_t* G; int ldg; const float* bg;
    __device__ __forceinline__ void operator()(const f32x4 (&acc)[2][2][4][2], const Unit& u, int wr, int wc, int fr, int fq) const {
        const int row0 = u.pm * BM + wr * 64 + fr, col0 = u.pn * BM + wc * 32 + 8 * fq;
        f32x4 bv[2][2];
#pragma unroll
        for (int bj = 0; bj < 2; ++bj)
#pragma unroll
            for (int n = 0; n < 2; ++n) bv[bj][n] = *(const f32x4*)(bg + col0 + bj * HALF + 4 * n);
#pragma unroll
        for (int ai = 0; ai < 2; ++ai) {
            u32x4 gv[4][2], ov[4][2];
#pragma unroll
            for (int m = 0; m < 4; ++m) { const size_t row = (size_t)(row0 + ai * HALF + m * 16);
#pragma unroll
                for (int bj = 0; bj < 2; ++bj) { gv[m][bj] = *(const u32x4*)(G + row * ldg + col0 + bj * HALF); if (ACCUM) ov[m][bj] = *(const u32x4*)(O + row * D + col0 + bj * HALF); } }
#pragma unroll
            for (int m = 0; m < 4; ++m) { const size_t row = (size_t)(row0 + ai * HALF + m * 16);
#pragma unroll
                for (int bj = 0; bj < 2; ++bj) { const u32x4 g4 = gv[m][bj];
                    float g[8] = {bf_lo(g4.x), bf_hi(g4.x), bf_lo(g4.y), bf_hi(g4.y), bf_lo(g4.z), bf_hi(g4.z), bf_lo(g4.w), bf_hi(g4.w)};
                    float o[8];
#pragma unroll
                    for (int k = 0; k < 4; ++k) { o[k] = fast_sigmoid(g[k] + bv[bj][0][k]) * acc[ai][bj][m][0][k]; o[4 + k] = fast_sigmoid(g[4 + k] + bv[bj][1][k]) * acc[ai][bj][m][1][k]; }
                    if (ACCUM) { const u32x4 o4 = ov[m][bj];
                        o[0] += bf_lo(o4.x); o[1] += bf_hi(o4.x); o[2] += bf_lo(o4.y); o[3] += bf_hi(o4.y); o[4] += bf_lo(o4.z); o[5] += bf_hi(o4.z); o[6] += bf_lo(o4.w); o[7] += bf_hi(o4.w); }
                    u32x4 w; w.x = cvt_pk_bf16(o[0], o[1]); w.y = cvt_pk_bf16(o[2], o[3]); w.z = cvt_pk_bf16(o[4], o[5]); w.w = cvt_pk_bf16(o[6], o[7]);
                    *(u32x4*)(O + row * D + col0 + bj * HALF) = w; } }
            asm volatile("" ::: "memory"); }
    }
};
struct EpiGateMerged {
    static constexpr bool PERM = true, AFTER_DRAIN = false, HAS_PRE = false, HAS_MID = true, HAS_EXT = false; static constexpr int MID_T = 8;
    static constexpr int NVM = 16;
    bf16_t* O; const unsigned char* G8; int ldgb;
    typedef unsigned u32x2g __attribute__((ext_vector_type(2)));
    static __device__ __forceinline__ void unpack8(u32x2g g, float (&f)[8]) {
        f[0] = (float)(g.x & 255u); f[1] = (float)((g.x >> 8) & 255u); f[2] = (float)((g.x >> 16) & 255u); f[3] = (float)(g.x >> 24);
        f[4] = (float)(g.y & 255u); f[5] = (float)((g.y >> 8) & 255u); f[6] = (float)((g.y >> 16) & 255u); f[7] = (float)(g.y >> 24); }
    __device__ __forceinline__ void mid(f32x4 (&acc)[2][2][4][2], const Unit& u, int wr, int wc, int fr, int fq) const {
        int row0 = u.pm * BM + wr * 64 + fr, col0 = u.pn * BM + wc * 32 + 8 * fq;
        asm volatile("" : "+v"(row0), "+v"(col0));
#pragma unroll
        for (int bj = 0; bj < 2; ++bj) {
            u32x2g ga[2][4], gb[2][4];
#pragma unroll
            for (int ai = 0; ai < 2; ++ai)
#pragma unroll
                for (int m = 0; m < 4; ++m) { const unsigned char* gp = G8 + (size_t)(row0 + ai * HALF + m * 16) * ldgb + col0 + bj * HALF;
                    ga[ai][m] = *(const u32x2g*)gp; gb[ai][m] = *(const u32x2g*)(gp + D); }
#pragma unroll
            for (int ai = 0; ai < 2; ++ai)
#pragma unroll
                for (int m = 0; m < 4; ++m) { float xa[8], xb[8]; unpack8(ga[ai][m], xa); unpack8(gb[ai][m], xb);
#pragma unroll
                    for (int k = 0; k < 4; ++k) { acc[ai][bj][m][0][k] *= xa[k] * __builtin_amdgcn_rcpf(xb[k]); acc[ai][bj][m][1][k] *= xa[4 + k] * __builtin_amdgcn_rcpf(xb[4 + k]); } }
            asm volatile("" ::: "memory"); }
    }
    __device__ __forceinline__ void operator()(const f32x4 (&acc)[2][2][4][2], const Unit& u, int wr, int wc, int fr, int fq) const {
        int row0 = u.pm * BM + wr * 64 + fr, col0 = u.pn * BM + wc * 32 + 8 * fq;
        asm volatile("" : "+v"(row0), "+v"(col0));
        u32x2g gb[2][4][2];
#pragma unroll
        for (int ai = 0; ai < 2; ++ai)
#pragma unroll
            for (int m = 0; m < 4; ++m) { const unsigned char* gp = G8 + (size_t)(row0 + ai * HALF + m * 16) * ldgb + D + col0;
#pragma unroll
                for (int bj = 0; bj < 2; ++bj) gb[ai][m][bj] = *(const u32x2g*)(gp + bj * HALF); }
#pragma unroll
        for (int ai = 0; ai < 2; ++ai) {
#pragma unroll
            for (int m = 0; m < 4; ++m) { const size_t row = (size_t)(row0 + ai * HALF + m * 16);
#pragma unroll
                for (int bj = 0; bj < 2; ++bj) { float xb[8]; unpack8(gb[ai][m][bj], xb);
                    float o[8];
#pragma unroll
                    for (int k = 0; k < 4; ++k) { o[k] = (xb[k] * 0.00390625f) * acc[ai][bj][m][0][k]; o[4 + k] = (xb[4 + k] * 0.00390625f) * acc[ai][bj][m][1][k]; }
                    u32x4 w; w.x = cvt_pk_bf16(o[0], o[1]); w.y = cvt_pk_bf16(o[2], o[3]); w.z = cvt_pk_bf16(o[4], o[5]); w.w = cvt_pk_bf16(o[6], o[7]);
                    *(u32x4*)(O + row * D + col0 + bj * HALF) = w; } }
            asm volatile("" ::: "memory"); }
    }
};
template <int MODE> struct EpiResid {
    static constexpr bool PERM = false, AFTER_DRAIN = false, HAS_PRE = false, HAS_MID = false, HAS_EXT = (MODE == 2);
    static constexpr int NVM = 32;
    const float* base; const bf16_t* XBin; bf16_t* XB; float* SSQ;
    __device__ __forceinline__ void operator()(const f32x4 (&acc)[2][2][4][2], const Unit& u, int wr, int wc, int fr, int fq) const {
        typedef unsigned u32x2v __attribute__((ext_vector_type(2)));
        const int row0 = u.pm * BM + wr * 64 + fr, col0 = u.pn * BM + wc * 32 + 4 * fq;
#pragma unroll
        for (int ai = 0; ai < 2; ++ai) {
            f32x4 xf[4][2][2]; u32x2v xh[4][2][2];
#pragma unroll
            for (int m = 0; m < 4; ++m) { const size_t row = (size_t)(row0 + ai * HALF + m * 16);
#pragma unroll
                for (int bj = 0; bj < 2; ++bj)
#pragma unroll
                    for (int n = 0; n < 2; ++n) { const size_t off = row * D + col0 + bj * HALF + n * 16;
                        if (MODE == 0) xf[m][bj][n] = *(const f32x4*)(base + off); else if (MODE == 1) xh[m][bj][n] = *(const u32x2v*)(XBin + off); } }
#pragma unroll
            for (int m = 0; m < 4; ++m) { const size_t row = (size_t)(row0 + ai * HALF + m * 16); float ss = 0.f;
#pragma unroll
                for (int bj = 0; bj < 2; ++bj)
#pragma unroll
                    for (int n = 0; n < 2; ++n) { const size_t off = row * D + col0 + bj * HALF + n * 16;
                        f32x4 o;
                        if (MODE == 0) o = xf[m][bj][n] + acc[ai][bj][m][n];
                        else if (MODE == 2) o = acc[ai][bj][m][n];
                        else { const u32x2v xb = xh[m][bj][n]; o = (f32x4){bf_lo(xb.x), bf_hi(xb.x), bf_lo(xb.y), bf_hi(xb.y)} + acc[ai][bj][m][n]; }
                        u32x2v w; w.x = cvt_pk_bf16(o[0], o[1]); w.y = cvt_pk_bf16(o[2], o[3]); *(u32x2v*)(XB + off) = w;
                        ss += (o[0] * o[0] + o[1] * o[1]) + (o[2] * o[2] + o[3] * o[3]); }
                ss += __shfl_xor(ss, 16); ss += __shfl_xor(ss, 32);
                if (fq == 0) __hip_atomic_fetch_add(SSQ + row, ss, __ATOMIC_RELAXED, __HIP_MEMORY_SCOPE_AGENT); }
            asm volatile("" ::: "memory"); }
    }
};
struct EpiFinal {
    static constexpr bool PERM = false, AFTER_DRAIN = false, HAS_PRE = false, HAS_MID = false, HAS_EXT = true;
    static constexpr int NVM = 32;
    float* OUT; float* SSQ; const float* gfin; unsigned* RC; unsigned* tmo;
    __device__ __forceinline__ void operator()(const f32x4 (&acc)[2][2][4][2], const Unit& u, int wr, int wc, int fr, int fq) const {
        const int row0 = u.pm * BM + wr * 64 + fr, col0 = u.pn * BM + wc * 32 + 4 * fq;
#pragma unroll
        for (int ai = 0; ai < 2; ++ai)
#pragma unroll
            for (int m = 0; m < 4; ++m) { float ss = 0.f;
#pragma unroll
                for (int bj = 0; bj < 2; ++bj)
#pragma unroll
                    for (int n = 0; n < 2; ++n) { const f32x4 o = acc[ai][bj][m][n]; ss += (o[0] * o[0] + o[1] * o[1]) + (o[2] * o[2] + o[3] * o[3]); }
                ss += __shfl_xor(ss, 16); ss += __shfl_xor(ss, 32);
                if (fq == 0) __hip_atomic_fetch_add(SSQ + (size_t)(row0 + ai * HALF + m * 16), ss, __ATOMIC_RELAXED, __HIP_MEMORY_SCOPE_AGENT); }
        f32x4 gg[2][2];
#pragma unroll
        for (int bj = 0; bj < 2; ++bj)
#pragma unroll
            for (int n = 0; n < 2; ++n) gg[bj][n] = *(const f32x4*)(gfin + col0 + bj * HALF + n * 16);
        asm volatile("s_waitcnt vmcnt(0)" ::: "memory");
        __builtin_amdgcn_s_barrier();
        if (threadIdx.x == 0) { unsigned* rc = RC + u.pm; (void)__hip_atomic_fetch_add(rc, 1u, __ATOMIC_RELAXED, __HIP_MEMORY_SCOPE_AGENT);
            unsigned sp = 0;
            while (__hip_atomic_load(rc, __ATOMIC_RELAXED, __HIP_MEMORY_SCOPE_AGENT) < 4u) { __builtin_amdgcn_s_sleep(1);
                if ((++sp & 255u) == 0u) { if (__hip_atomic_load(tmo, __ATOMIC_RELAXED, __HIP_MEMORY_SCOPE_AGENT)) break; if (sp > (1u << 18)) { atomicAdd(tmo, 1u); break; } } } }
        __builtin_amdgcn_s_barrier();
        float rs[2][4];
#pragma unroll
        for (int ai = 0; ai < 2; ++ai)
#pragma unroll
            for (int m = 0; m < 4; ++m) { const unsigned b = __hip_atomic_load((const unsigned*)(SSQ + (size_t)(row0 + ai * HALF + m * 16)), __ATOMIC_RELAXED, __HIP_MEMORY_SCOPE_AGENT);
                rs[ai][m] = 1.f / sqrtf(__builtin_bit_cast(float, b) * (1.f / D) + EPS); }
#pragma unroll
        for (int ai = 0; ai < 2; ++ai) {
#pragma unroll
            for (int m = 0; m < 4; ++m) { const size_t row = (size_t)(row0 + ai * HALF + m * 16);
#pragma unroll
                for (int bj = 0; bj < 2; ++bj)
#pragma unroll
                    for (int n = 0; n < 2; ++n) *(f32x4*)(OUT + row * D + col0 + bj * HALF + n * 16) = acc[ai][bj][m][n] * rs[ai][m] * gg[bj][n]; }
            asm volatile("" ::: "memory"); }
    }
};
struct EpiSwiGLU {
    static constexpr bool PERM = true, AFTER_DRAIN = false, HAS_PRE = true, HAS_MID = false, HAS_EXT = false;
    static constexpr int NVM = 8;
    bf16_t* O; int ldc; const float* SSQ; PG8_LAS float* RS;
    __device__ __forceinline__ void pre(const Unit& u, int wr, int fr, float (&carry)[8]) const {
        const int have = __builtin_amdgcn_readfirstlane(__builtin_bit_cast(int, carry[0])) - 1;
        if (u.pm != have) { const int par = __builtin_amdgcn_readfirstlane(__builtin_bit_cast(int, carry[1])) ^ 1; const int t = threadIdx.x;
            if (t < BM) RS[par * BM + t] = 1.0f / sqrtf(SSQ[u.pm * BM + t] * (1.0f / D) + 1e-6f);
            carry[0] = __builtin_bit_cast(float, u.pm + 1); carry[1] = __builtin_bit_cast(float, par); }
    }
    __device__ __forceinline__ void run(const f32x4 (&acc)[2][2][4][2], const Unit& u, int wr, int wc, int fr, int fq, const float (&carry)[8]) const {
        int row0 = u.pm * BM + wr * 64 + fr, col0 = u.pn * HALF + wc * 32 + 8 * fq;
        asm volatile("" : "+v"(row0), "+v"(col0));
        const PG8_LAS float* rs = RS + __builtin_amdgcn_readfirstlane(__builtin_bit_cast(int, carry[1])) * BM + wr * 64 + fr;
        float rst[8];
#pragma unroll
        for (int ai = 0; ai < 2; ++ai)
#pragma unroll
            for (int m = 0; m < 4; ++m) rst[4 * ai + m] = rs[ai * HALF + m * 16];
#pragma unroll
        for (int ai = 0; ai < 2; ++ai)
#pragma unroll
            for (int m = 0; m < 4; ++m) { const size_t row = (size_t)(row0 + ai * HALF + m * 16);
                const float rstd = rst[4 * ai + m];
                float o[8];
#pragma unroll
                for (int n = 0; n < 2; ++n)
#pragma unroll
                    for (int k = 0; k < 4; ++k) { const float g = acc[ai][0][m][n][k] * rstd, up = acc[ai][1][m][n][k] * rstd; o[4 * n + k] = g * fast_sigmoid(g) * up; }
                u32x4 w; w.x = cvt_pk_bf16(o[0], o[1]); w.y = cvt_pk_bf16(o[2], o[3]); w.z = cvt_pk_bf16(o[4], o[5]); w.w = cvt_pk_bf16(o[6], o[7]);
                *(u32x4*)(O + row * ldc + col0) = w; }
    }
};
}

__device__ __forceinline__ void p2_conv(Frame& F, const Ptrs& P) {
    const bf16* PROJ = (const bf16*)(P.ws + WS_PROJ); bf16* CONV = (bf16*)(P.ws + WS_CONV);
    const int gt = F.vcu * (NWAVES * 64) + F.tid, NT = F.G * NWAVES * 64;
    for (int item = gt; item < (M / 16) * (DCONV / 8); item += NT) {
        const int cg = item & 63, rb = item >> 6, c0 = 8 * cg, m0 = 16 * rb, t0 = m0 & (SEQ - 1);
        float w[3][8];
#pragma unroll
        for (int j = 0; j < 3; ++j) { const f32x4 a = *(const GAS f32x4*)(P.conv_w + j * DCONV + c0), b = *(const GAS f32x4*)(P.conv_w + j * DCONV + c0 + 4);
            w[j][0] = a.x; w[j][1] = a.y; w[j][2] = a.z; w[j][3] = a.w; w[j][4] = b.x; w[j][5] = b.y; w[j][6] = b.z; w[j][7] = b.w; }
        float u2[8], u1[8];
#pragma unroll
        for (int k = 0; k < 8; ++k) { u2[k] = 0.f; u1[k] = 0.f; }
        if (t0 >= 2) {
#pragma unroll
            for (int d = 0; d < 2; ++d) { const bf16* rp = PROJ + (size_t)(m0 - 2 + d) * NPROJ;
                const v4u cc = *(const GAS v4u*)(rp + PC_CC + c0), cx = *(const GAS v4u*)(rp + PC_CX + c0);
                float* dst = d ? u1 : u2;
                dst[0] = bf_lo(cc.x) * bf_lo(cx.x); dst[1] = bf_hi(cc.x) * bf_hi(cx.x); dst[2] = bf_lo(cc.y) * bf_lo(cx.y); dst[3] = bf_hi(cc.y) * bf_hi(cx.y);
                dst[4] = bf_lo(cc.z) * bf_lo(cx.z); dst[5] = bf_hi(cc.z) * bf_hi(cx.z); dst[6] = bf_lo(cc.w) * bf_lo(cx.w); dst[7] = bf_hi(cc.w) * bf_hi(cx.w); }
        }
#pragma unroll 4
        for (int i = 0; i < 16; ++i) { const bf16* rp = PROJ + (size_t)(m0 + i) * NPROJ;
            const v4u cb = *(const GAS v4u*)(rp + PC_CB + c0), cc = *(const GAS v4u*)(rp + PC_CC + c0), cx = *(const GAS v4u*)(rp + PC_CX + c0);
            float u0[8], b[8];
            u0[0] = bf_lo(cc.x) * bf_lo(cx.x); u0[1] = bf_hi(cc.x) * bf_hi(cx.x); u0[2] = bf_lo(cc.y) * bf_lo(cx.y); u0[3] = bf_hi(cc.y) * bf_hi(cx.y);
            u0[4] = bf_lo(cc.z) * bf_lo(cx.z); u0[5] = bf_hi(cc.z) * bf_hi(cx.z); u0[6] = bf_lo(cc.w) * bf_lo(cx.w); u0[7] = bf_hi(cc.w) * bf_hi(cx.w);
            b[0] = bf_lo(cb.x); b[1] = bf_hi(cb.x); b[2] = bf_lo(cb.y); b[3] = bf_hi(cb.y); b[4] = bf_lo(cb.z); b[5] = bf_hi(cb.z); b[6] = bf_lo(cb.w); b[7] = bf_hi(cb.w);
            float o[8];
#pragma unroll
            for (int k = 0; k < 8; ++k) { o[k] = b[k] * (w[0][k] * u2[k] + w[1][k] * u1[k] + w[2][k] * u0[k]); u2[k] = u1[k]; u1[k] = u0[k]; }
            v4u ov; ov.x = pk2(o[0], o[1]); ov.y = pk2(o[2], o[3]); ov.z = pk2(o[4], o[5]); ov.w = pk2(o[6], o[7]);
            *(GAS v4u*)(CONV + (size_t)(m0 + i) * D + c0) = ov; }
    }
}

typedef float f32x16 __attribute__((ext_vector_type(16)));
typedef short v4i16_t __attribute__((ext_vector_type(4)));
__device__ __forceinline__ int mbcnt64(unsigned long long m) { return (int)__builtin_amdgcn_mbcnt_hi((unsigned)(m >> 32), __builtin_amdgcn_mbcnt_lo((unsigned)m, 0u)); }
__device__ __forceinline__ int wave_sum_i32(int c) {
    c += __builtin_amdgcn_update_dpp(0, c, 0xB1, 0xf, 0xf, true);
    c += __builtin_amdgcn_update_dpp(0, c, 0x4E, 0xf, 0xf, true);
    c += __builtin_amdgcn_update_dpp(0, c, 0x141, 0xf, 0xf, true);
    c += __builtin_amdgcn_update_dpp(0, c, 0x140, 0xf, 0xf, true);
    return __builtin_amdgcn_readlane(c, 0) + __builtin_amdgcn_readlane(c, 16) + __builtin_amdgcn_readlane(c, 32) + __builtin_amdgcn_readlane(c, 48);
}
__device__ __forceinline__ float z_upper(float p) {
    const bool fl = p > 0.5f; const float pp = fl ? 1.0f - p : p;
    const float t = sqrtf(-2.0f * __logf(pp)); const float z = t - (2.30753f + 0.27061f * t) / (1.0f + t * (0.99229f + 0.04481f * t));
    return fl ? -z : z;
}
constexpr int KPB_UNUSED = 144;
constexpr int VP_UNUSED = 160;
constexpr int SCR_VST = 0;
constexpr int IDX_OFF = TAB_OFF + 4096;
constexpr int CW_Q = 2048;
static_assert(IDX_OFF + 8 * 1280 <= LDS_BYTES, "LDS map (P2)");

__device__ __forceinline__ float fadd_np(float a, float b) { float r; asm("v_add_f32_e32 %0, %1, %2" : "=v"(r) : "v"(a), "v"(b)); return r; }
#define P2_DPPF(c, ctrl) ((c) + __builtin_bit_cast(float, __builtin_amdgcn_update_dpp(0, __builtin_bit_cast(int, (c)), (ctrl), 0xf, 0xf, true)))
__device__ __forceinline__ float wave_total_f32(float c) {
    c = P2_DPPF(c, 0xB1); c = P2_DPPF(c, 0x4E); c = P2_DPPF(c, 0x141); c = P2_DPPF(c, 0x140);
    return __builtin_bit_cast(float, __builtin_amdgcn_readlane(__builtin_bit_cast(int, c), 0)) + __builtin_bit_cast(float, __builtin_amdgcn_readlane(__builtin_bit_cast(int, c), 16)) +
           __builtin_bit_cast(float, __builtin_amdgcn_readlane(__builtin_bit_cast(int, c), 32)) + __builtin_bit_cast(float, __builtin_amdgcn_readlane(__builtin_bit_cast(int, c), 48));
}
template <int NR> __device__ __forceinline__ float lane_count_gt(const float (&v)[64], float tau) {
    const float BIG = 0x1p100f, nb = -tau * BIG; float c0 = 0.f, c1 = 0.f, c2 = 0.f, c3 = 0.f;
#pragma unroll
    for (int i = 0; i < NR; i += 4) {
        c0 = fadd_np(c0, __builtin_amdgcn_fmed3f(__builtin_fmaf(v[i], BIG, nb), 0.f, 1.f)); c1 = fadd_np(c1, __builtin_amdgcn_fmed3f(__builtin_fmaf(v[i + 1], BIG, nb), 0.f, 1.f));
        c2 = fadd_np(c2, __builtin_amdgcn_fmed3f(__builtin_fmaf(v[i + 2], BIG, nb), 0.f, 1.f)); c3 = fadd_np(c3, __builtin_amdgcn_fmed3f(__builtin_fmaf(v[i + 3], BIG, nb), 0.f, 1.f)); }
    return (c0 + c1) + (c2 + c3);
}
template <int NR> __device__ __forceinline__ float lane_count_valid(const float (&v)[64]) {
    float c = 0.f;
#pragma unroll
    for (int i = 0; i < NR; ++i) c += (v[i] > -INFINITY) ? 1.f : 0.f;
    return c;
}
constexpr int P2_MAXPROBE = 8;
template <int NR> __device__ __forceinline__ void topk_search(const float (&v)[64], int nv, float mu, float sg, float& lo_o, float& hi_o, int& need_o, float& nhi_o, float& nlo_o) {
    float tau = mu + z_upper((float)TOPK / (float)nv) * sg;
    float step = fmaxf(0.25f * sg, 1e-6f * (fabsf(mu) + 1e-6f));
    const float wmin = 1e-6f * sg;
    float lo = -INFINITY, hi = INFINITY; int clo = nv, chi = 0; int k = 0; bool found = false; float cl = 0.f, nhi = 0.f, nlo = -1.f;
    const float lt = __builtin_amdgcn_logf((float)TOPK + 0.5f);
    for (int it = 0; it < P2_MAXPROBE; ++it) {
        cl = lane_count_gt<NR>(v, tau);
        const int c = (int)(wave_total_f32(cl) + 0.5f);
        if (c == TOPK) { found = true; break; }
        if (c > TOPK) { lo = tau; clo = c; nlo = cl; } else { hi = tau; chi = c; nhi = cl; }
        if (lo == -INFINITY) { tau = hi - step; step *= 2.f; }
        else if (hi == INFINITY) { tau = lo + step; step *= 2.f; }
        else {
            if (hi - lo < wmin) break;
            ++k; float nt;
            if (k % 3 == 0) nt = 0.5f * (lo + hi);
            else { const float a = __builtin_amdgcn_logf((float)clo + 0.5f), bb = __builtin_amdgcn_logf((float)chi + 0.5f); float f = (a - lt) * __builtin_amdgcn_rcpf(a - bb); f = fminf(fmaxf(f, 0.1f), 0.9f); nt = lo + (hi - lo) * f; }
            if (!(nt > lo && nt < hi)) nt = 0.5f * (lo + hi);
            if (!(nt > lo && nt < hi)) break;
            tau = nt;
        }
    }
    if (found) { lo_o = tau; hi_o = tau; need_o = 0; nhi_o = cl; nlo_o = cl; }
    else { if (hi == INFINITY) { hi = 3.0e38f; chi = 0; nhi = 0.f; }
        if (nlo < 0.f) nlo = lane_count_valid<NR>(v);
        lo_o = lo; hi_o = hi; need_o = TOPK - chi; nhi_o = nhi; nlo_o = nlo; }
}
constexpr int IDXW = 320;
__device__ __forceinline__ int lane_scan_incl(int x, int lane) {
    x += __builtin_amdgcn_update_dpp(0, x, 0x111, 0xf, 0xf, true); x += __builtin_amdgcn_update_dpp(0, x, 0x112, 0xf, 0xf, true);
    x += __builtin_amdgcn_update_dpp(0, x, 0x114, 0xf, 0xf, true); x += __builtin_amdgcn_update_dpp(0, x, 0x118, 0xf, 0xf, true);
    const int r0 = __builtin_amdgcn_readlane(x, 15), r1 = __builtin_amdgcn_readlane(x, 31), r2 = __builtin_amdgcn_readlane(x, 47);
    return x + (lane >= 16 ? r0 : 0) + (lane >= 32 ? r1 : 0) + (lane >= 48 ? r2 : 0);
}
template <int NR> __device__ __forceinline__ void topk_compact_lane(const float (&v)[64], float thr, int cnt, LAS unsigned* IDX, int lane) {
    int k = lane_scan_incl(cnt, lane) - cnt; const int dump = 256 + lane;
#pragma unroll
    for (int i = 0; i < NR; ++i) { const bool a = v[i] > thr; IDX[a ? k : dump] = (unsigned)(512 * (i >> 3) + 8 * lane + (i & 7)); k += a ? 1 : 0; }
}
template <int NR> __device__ __forceinline__ void topk_compact_bracket(const float (&v)[64], float lo, float hi, int need, float nhi_f, float nlo_f, LAS unsigned* IDX, int lane) {
    const int nhi = (int)(nhi_f + 0.5f), nb = (int)(nlo_f + 0.5f) - nhi;
    const int pb = lane_scan_incl(nb, lane) - nb;
    int lim = need - pb; lim = lim < 0 ? 0 : lim; lim = lim > nb ? nb : lim;
    const bool full = (lim == nb), part = (lim > 0) && !full;
    topk_compact_lane<NR>(v, full ? lo : hi, nhi + (full ? nb : 0), IDX, lane);
    const unsigned long long pm = __ballot(part);
    if (pm != 0ull) {
        int k = TOPK - lim, kb = 0; const int dump = 256 + lane;
        asm volatile("" ::: "memory");
#pragma unroll
        for (int i = 0; i < NR; ++i) { const bool c = (v[i] > lo) && !(v[i] > hi); const bool take = part && c && (kb < lim);
            IDX[take ? k : dump] = (unsigned)(512 * (i >> 3) + 8 * lane + (i & 7)); k += take ? 1 : 0; kb += c ? 1 : 0; }
    }
}
typedef _Float16 f16x8 __attribute__((ext_vector_type(8)));
template <int NR> __device__ __forceinline__ int topk_select(const LAS unsigned char* row, int t, LAS unsigned* IDX, int lane) {
    float v[64]; float s1 = 0.f, s2 = 0.f; const int nv = t + 1;
    const int tb = t >> 9;
#pragma unroll
    for (int i = 0; i < NR / 8; ++i) { const f16x8 x = *(const LAS f16x8*)(row + 1024 * i + 16 * lane);
        if (i < tb) {
#pragma unroll
            for (int c = 0; c < 8; ++c) { const float xv = (float)x[c]; s1 += xv; s2 += xv * xv; v[8 * i + c] = xv; } }
        else {
#pragma unroll
            for (int c = 0; c < 8; ++c) { const bool ok = (512 * i + 8 * lane + c) <= t; const float xv = (float)x[c]; const float val = ok ? xv : 0.f; s1 += val; s2 += val * val; v[8 * i + c] = ok ? xv : -INFINITY; } } }
#pragma unroll
    for (int i = NR; i < 64; ++i) v[i] = -INFINITY;
    asm volatile("" ::: "memory");
    if (nv <= TOPK) { topk_compact_lane<NR>(v, -INFINITY, (int)(lane_count_valid<NR>(v) + 0.5f), IDX, lane); return nv; }
    s1 = wave_total_f32(s1); s2 = wave_total_f32(s2);
    const float mu = s1 / (float)nv, var = fmaxf(s2 / (float)nv - mu * mu, 0.f);
    float lo, hi, nhi, nlo; int need;
    topk_search<NR>(v, nv, mu, sqrtf(var), lo, hi, need, nhi, nlo);
    if (need == 0) topk_compact_lane<NR>(v, hi, (int)(nhi + 0.5f), IDX, lane);
    else topk_compact_bracket<NR>(v, lo, hi, need, nhi, nlo, IDX, lane);
    return TOPK;
}

__device__ __forceinline__ unsigned pk4_fp8(float a, float b, float c, float d) { int w = __builtin_amdgcn_cvt_pk_fp8_f32(a, b, 0, false); w = __builtin_amdgcn_cvt_pk_fp8_f32(c, d, w, true); return (unsigned)w; }
typedef int v2i_t __attribute__((ext_vector_type(2)));
typedef long v2l_t __attribute__((ext_vector_type(2)));
#ifndef P2_TR8
#define P2_TR8 1
#endif
__device__ __forceinline__ long p2_vfrag(const LAS unsigned char* buf, int vra, int coff, int fr, int fq) {
#if P2_TR8
    const v2i_t t = __builtin_amdgcn_ds_read_tr8_b64_v2i32((LAS v2i_t*)(buf + vra + coff));
    return (long)((unsigned long long)(unsigned)t.x | ((unsigned long long)(unsigned)t.y << 32));
#else
    unsigned long long r = 0ull;
#pragma unroll
    for (int j = 0; j < 8; ++j) { const int rho = 4 * fq + (j & 3) + 16 * (j >> 2); const int swz = ((rho >> 1) & 7) ^ (4 * (rho >> 4));
        const int chunk = (coff >> 4) ^ ((2 * fq + (((fr >> 1) >> 1) & 1)) ^ (4 * ((fr >> 1) >> 2)));
        r |= (unsigned long long)buf[rho * 128 + 16 * (chunk ^ swz) + fr] << (8 * j); }
    return (long)r;
#endif
}
__device__ __forceinline__ void half_barrier(volatile LAS unsigned* hb, int lane) {
    LDS_WAIT(); asm volatile("" ::: "memory");
    if (lane == 0) {
        const unsigned g = hb[1];
        const unsigned old = __hip_atomic_fetch_add((LAS unsigned*)hb, 1u, __ATOMIC_RELAXED, __HIP_MEMORY_SCOPE_WORKGROUP);
        if (old == 3u) { hb[0] = 0u; hb[1] = g + 1u; }
        else { unsigned sp = 0u; while (hb[1] == g) { __builtin_amdgcn_s_sleep(1); if (++sp > (1u << 22)) break; } }
    }
    asm volatile("" ::: "memory");
}

__device__ __forceinline__ void p2_attn(Frame& F, const Ptrs& P) {
    const bf16* PROJ = (const bf16*)(P.ws + WS_PROJ); const bf16* KVI = (const bf16*)(P.ws + WS_KVI); const bf16* IKFp = (const bf16*)(P.ws + WS_IKF); const bf16* IWp = (const bf16*)(P.ws + WS_IW); bf16* ATTN = (bf16*)(P.ws + WS_CONV);
    const int wave = F.wave, half = wave >> 2, w4 = wave & 3;
    LAS unsigned char* hrows = F.lds + RING_OFF + half * 65536;
    LAS _Float16* SC = (LAS _Float16*)hrows;
    LAS float* TAB = (LAS float*)(F.lds + TAB_OFF);
    for (int e = F.tid; e < 128 * 8; e += NWAVES * 64) { const int d = e >> 3, h = e & 7; int bk;
        if (d < 16) bk = d; else { bk = 16 + (int)(logf((float)d / 16.0f) / 2.0794415416798357f * 16.0f); bk = bk < 31 ? bk : 31; }
        TAB[e] = P.rel_bias[bk * 8 + h] * 1.4426950408889634f; }
    LAS unsigned* IDX = (LAS unsigned*)(F.lds + IDX_OFF + wave * (IDXW * 4));
    constexpr int NU = SEQ / 8;
    volatile LAS unsigned* TK = F.MISC + 16 + 4 * half;
    volatile LAS unsigned* HB = F.MISC + 24 + 2 * half;
    const bool tk_lane = (w4 == 0) && (F.lane == 0);
    int bcur = (int)(xb_xcc_id() & 7u), nexh = 0, parity = 0;
    if (tk_lane) TK[0] = xb_add((unsigned*)(F.ctl + CW_Q + 64 * bcur), 1u);
    __syncthreads();
    bool have = false;
    bf16x8 afr[2][4]; v4u wraw[2][2]; bf16x8 bfr[4][4];
#define P2_ZERO_Q() do { _Pragma("unroll") for (int mt = 0; mt < 2; ++mt) { _Pragma("unroll") for (int ks = 0; ks < 4; ++ks) afr[mt][ks] = (bf16x8){0, 0, 0, 0, 0, 0, 0, 0}; wraw[mt][0] = (v4u){0u, 0u, 0u, 0u}; wraw[mt][1] = (v4u){0u, 0u, 0u, 0u}; } \
        _Pragma("unroll") for (int u = 0; u < 4; ++u) { _Pragma("unroll") for (int ks = 0; ks < 4; ++ks) bfr[u][ks] = (bf16x8){0, 0, 0, 0, 0, 0, 0, 0}; } } while (0)
    P2_ZERO_Q();
#define P2_LOAD_Q(T0) do { _Pragma("unroll") for (int mt = 0; mt < 2; ++mt) { const bf16* qp = PB + (size_t)((T0) + 4 * mt + qrho) * NPROJ + PC_IQ + hrho * 64 + 8 * hh; \
        _Pragma("unroll") for (int ks = 0; ks < 4; ++ks) afr[mt][ks] = *(const GAS bf16x8*)(qp + 16 * ks); \
        _Pragma("unroll") for (int qq = 0; qq < 2; ++qq) wraw[mt][qq] = *(const GAS v4u*)(IWB + (size_t)((T0) + 4 * mt + 2 * hh + qq) * 8); } \
        _Pragma("unroll") for (int u = 0; u < 4; ++u) { const bf16* kp = IKB + (size_t)(w4 + 4 * u) * 2048 + hh * 256 + r32 * 8;     \
            _Pragma("unroll") for (int ks = 0; ks < 4; ++ks) bfr[u][ks] = *(const GAS bf16x8*)(kp + 512 * ks); } } while (0)
    for (;;) {
        const int tk = (int)__builtin_amdgcn_readfirstlane(TK[parity]);
        if (tk >= NU) {
            if (++nexh == BATCH) break;
            bcur = (bcur + 1) & 7;
            half_barrier(HB, F.lane);
            if (tk_lane) TK[parity] = xb_add((unsigned*)(F.ctl + CW_Q + 64 * bcur), 1u);
            half_barrier(HB, F.lane);
            have = false; P2_ZERO_Q();
            continue;
        }
        unsigned nxt = 0u;
        if (tk_lane) nxt = xb_add((unsigned*)(F.ctl + CW_Q + 64 * bcur), 1u);
        int lane = F.lane; asm volatile("" : "+v"(lane));
        const int r32 = lane & 31, hh = lane >> 5, fr = lane & 15, fq = lane >> 4;
        const int qrho = ((r32 >> 4) & 1) + 2 * ((r32 >> 2) & 1), hrho = (r32 & 3) + 4 * ((r32 >> 3) & 1);
        const int b = bcur, t0 = 8 * (NU - 1 - tk);
        const bf16* PB = PROJ + (size_t)b * SEQ * NPROJ; const GAS unsigned char* KB8 = (const GAS unsigned char*)KVI + (size_t)b * SEQ * 128; const bf16* IKB = IKFp + (size_t)b * SEQ * 64; const bf16* IWB = IWp + (size_t)b * SEQ * 8;
        if (!have) P2_LOAD_Q(t0);
        {
            float w[2][16];
#pragma unroll
            for (int mt = 0; mt < 2; ++mt)
#pragma unroll
                for (int qq = 0; qq < 2; ++qq) { const v4u wv = wraw[mt][qq];
                    const float sc = 0.04419417382415922f;
                    w[mt][8 * qq + 0] = bf_lo(wv.x) * sc; w[mt][8 * qq + 1] = bf_hi(wv.x) * sc; w[mt][8 * qq + 2] = bf_lo(wv.y) * sc; w[mt][8 * qq + 3] = bf_hi(wv.y) * sc;
                    w[mt][8 * qq + 4] = bf_lo(wv.z) * sc; w[mt][8 * qq + 5] = bf_hi(wv.z) * sc; w[mt][8 * qq + 6] = bf_lo(wv.w) * sc; w[mt][8 * qq + 7] = bf_hi(wv.w) * sc; }
            const int nkt = (t0 + 8 + 31) >> 5;
            for (int kt0 = w4; kt0 < nkt; kt0 += 16) {
#pragma unroll
                for (int u = 0; u < 4; ++u) { const int kt = kt0 + 4 * u;
                    if (kt < nkt) { const int s = 32 * kt + r32;
                        f32x16 acc0 = {}, acc1 = {};
#pragma unroll
                        for (int ks = 0; ks < 4; ++ks) { acc0 = __builtin_amdgcn_mfma_f32_32x32x16_bf16(afr[0][ks], bfr[u][ks], acc0, 0, 0, 0); acc1 = __builtin_amdgcn_mfma_f32_32x32x16_bf16(afr[1][ks], bfr[u][ks], acc1, 0, 0, 0); }
                        if (kt + 16 < nkt) { const bf16* kp = IKB + (size_t)(kt + 16) * 2048 + hh * 256 + r32 * 8;
#pragma unroll
                            for (int ks = 0; ks < 4; ++ks) bfr[u][ks] = *(const GAS bf16x8*)(kp + 512 * ks); }
                        float s0 = 0.f, s1 = 0.f, s2 = 0.f, s3 = 0.f;
#pragma unroll
                        for (int e = 0; e < 8; ++e) { s0 = __builtin_fmaf(w[0][e], __builtin_amdgcn_fmed3f(acc0[e], 0.f, 3.0e38f), s0); s1 = __builtin_fmaf(w[0][8 + e], __builtin_amdgcn_fmed3f(acc0[8 + e], 0.f, 3.0e38f), s1);
                            s2 = __builtin_fmaf(w[1][e], __builtin_amdgcn_fmed3f(acc1[e], 0.f, 3.0e38f), s2); s3 = __builtin_fmaf(w[1][8 + e], __builtin_amdgcn_fmed3f(acc1[8 + e], 0.f, 3.0e38f), s3); }
                        SC[(2 * hh) * 4096 + s] = (_Float16)s0; SC[(2 * hh + 1) * 4096 + s] = (_Float16)s1; SC[(4 + 2 * hh) * 4096 + s] = (_Float16)s2; SC[(4 + 2 * hh + 1) * 4096 + s] = (_Float16)s3; } }
            }
        }
        if (tk_lane) TK[parity ^ 1] = nxt;
        half_barrier(HB, F.lane);
#pragma nounroll
        for (int qi = 0; qi < 2; ++qi) {
        int lane = F.lane; asm volatile("" : "+v"(lane));
        const int fr = lane & 15, fq = lane >> 4;
        const int qrow = w4 + 4 * qi;
        LAS unsigned char* myrow = hrows + qrow * 8192;
        const int t = t0 + qrow;
        int nsel;
        if (t < 1024) nsel = topk_select<16>(myrow, t, IDX, lane);
        else if (t < 2048) nsel = topk_select<32>(myrow, t, IDX, lane);
        else if (t < 3072) nsel = topk_select<48>(myrow, t, IDX, lane);
        else nsel = topk_select<64>(myrow, t, IDX, lane);
#pragma unroll
        for (int k = 0; k < 4; ++k) { const int jx = lane + 64 * k; if (jx >= nsel) IDX[jx] = 0u; }
        asm volatile("" ::: "memory");
        {
            const float c2 = 0.125f * 1.4426950408889634f;
            long qf8[2];
            { const bf16* qp = PB + (size_t)t * NPROJ + PC_Q + (fr & 7) * 64 + 16 * fq; const v4u q0 = *(const GAS v4u*)qp, q1 = *(const GAS v4u*)(qp + 8);
              qf8[0] = (long)(unsigned long long)(pk4_fp8(bf_lo(q0.x), bf_hi(q0.x), bf_lo(q0.y), bf_hi(q0.y)) | ((unsigned long long)pk4_fp8(bf_lo(q0.z), bf_hi(q0.z), bf_lo(q0.w), bf_hi(q0.w)) << 32));
              qf8[1] = (long)(unsigned long long)(pk4_fp8(bf_lo(q1.x), bf_hi(q1.x), bf_lo(q1.y), bf_hi(q1.y)) | ((unsigned long long)pk4_fp8(bf_lo(q1.z), bf_hi(q1.z), bf_lo(q1.w), bf_hi(q1.w)) << 32)); }
            f32x4 S[8]; unsigned BI[8][2]; const int cls = fr >> 3;
            long vf[8][4];
            {
                v4u kvreg[8][4];
#pragma unroll
                for (int kb = 0; kb < 8; ++kb)
#pragma unroll
                    for (int i = 0; i < 4; ++i) { const unsigned kidx = IDX[32 * kb + 8 * i + (lane >> 3)]; kvreg[kb][i] = *(const GAS v4u*)(KB8 + ((kidx << 7) + (unsigned)(16 * (lane & 7)))); }
#pragma unroll
                for (int jo = 0; jo < 8; ++jo) { const int jt = 2 * jo + cls; const v4u kk = *(const LAS v4u*)(IDX + 16 * jt + 4 * fq); float bz[4];
#pragma unroll
                    for (int r = 0; r < 4; ++r) { const int slot = 16 * jt + 4 * fq + r; int dist = t - (int)kk[r]; dist = dist < 127 ? dist : 127; dist = dist > 0 ? dist : 0;
                        const float bias = TAB[dist * 8 + (fr & 7)]; bz[r] = (slot < nsel) ? bias : -INFINITY; }
                    BI[jo][0] = pg8::cvt_pk_bf16(bz[0], bz[1]); BI[jo][1] = pg8::cvt_pk_bf16(bz[2], bz[3]); }
                const int wsl = (lane >> 3) * 128 + 16 * ((lane & 7) ^ ((lane >> 4) & 3));
                const int rsw = (fr >> 1) & 7;
                const int kra = fr * 128;
                const int vj = fr >> 1, vrho = 4 * fq + (vj & 3) + 16 * (vj >> 2), vswz = (2 * fq + ((vj >> 1) & 1)) ^ (4 * (vj >> 2));
                const int vra = vrho * 128 + 8 * (fr & 1);
                v2l_t kf[2][2];
#define P2_KW(KB) do { LAS unsigned char* kbuf_ = myrow + ((KB) & 1) * 4096; _Pragma("unroll") for (int i = 0; i < 4; ++i) *(LAS v4u*)(kbuf_ + 1024 * i + (wsl ^ (64 * ((i & 1) ^ (i >> 1))))) = kvreg[KB][i]; asm volatile("" ::: "memory"); } while (0)
#define P2_KR(KB) do { const LAS unsigned char* kbuf_ = myrow + ((KB) & 1) * 4096; _Pragma("unroll") for (int tt = 0; tt < 2; ++tt) \
                    kf[(KB) & 1][tt] = *(const LAS v2l_t*)(kbuf_ + 2048 * tt + kra + 16 * ((fq ^ rsw) ^ (4 * tt))); \
                    _Pragma("unroll") for (int mt = 0; mt < 4; ++mt) vf[KB][mt] = p2_vfrag(kbuf_, vra, 16 * ((4 + mt) ^ vswz), fr, fq); asm volatile("" ::: "memory"); } while (0)
                P2_KW(0); P2_KR(0);
#pragma unroll
                for (int kb = 0; kb < 8; ++kb) {
                    if (kb < 7) { P2_KW(kb + 1); P2_KR(kb + 1); }
                    f32x4 a2[2];
#pragma unroll
                    for (int tt = 0; tt < 2; ++tt) { f32x4 a = {0.f, 0.f, 0.f, 0.f};
                        a = __builtin_amdgcn_mfma_f32_16x16x32_fp8_fp8(kf[kb & 1][tt][0], qf8[0], a, 0, 0, 0);
                        a = __builtin_amdgcn_mfma_f32_16x16x32_fp8_fp8(kf[kb & 1][tt][1], qf8[1], a, 0, 0, 0);
                        a2[tt] = a; }
                    S[kb] = cls ? a2[1] : a2[0]; }
#undef P2_KW
#undef P2_KR
            }
            __builtin_amdgcn_sched_barrier(0);
            f32x4 W[8];
            float mx = -INFINITY;
#pragma unroll
            for (int jo = 0; jo < 8; ++jo)
#pragma unroll
                for (int r = 0; r < 4; ++r) { const unsigned bw = BI[jo][r >> 1]; const float sv = S[jo][r];
                    const float l2 = sv * c2 + ((r & 1) ? bf_hi(bw) : bf_lo(bw)); W[jo][r] = l2; mx = fmaxf(mx, l2); }
            mx = fmaxf(mx, __shfl_xor(mx, 8)); mx = fmaxf(mx, __shfl_xor(mx, 16)); mx = fmaxf(mx, __shfl_xor(mx, 32));
            float sum = 0.f;
#pragma unroll
            for (int jo = 0; jo < 8; ++jo)
#pragma unroll
                for (int r = 0; r < 4; ++r) { const float p = __builtin_amdgcn_exp2f(W[jo][r] - mx); W[jo][r] = p; sum += p; }
            sum += __shfl_xor(sum, 8); sum += __shfl_xor(sum, 16); sum += __shfl_xor(sum, 32);
            const float rinv = 0.00390625f / sum;
            f32x4 O[4];
#pragma unroll
            for (int mt = 0; mt < 4; ++mt) O[mt] = (f32x4){0.f, 0.f, 0.f, 0.f};
#pragma unroll
            for (int kb = 0; kb < 8; ++kb) {
                const unsigned pq = pk4_fp8(W[kb][0] * 256.0f, W[kb][1] * 256.0f, W[kb][2] * 256.0f, W[kb][3] * 256.0f);
                const unsigned pp = (unsigned)__builtin_amdgcn_update_dpp(0, (int)pq, 0x128, 0xf, 0xf, true);
                const unsigned long long pf = cls ? ((unsigned long long)pp | ((unsigned long long)pq << 32)) : ((unsigned long long)pq | ((unsigned long long)pp << 32));
#pragma unroll
                for (int mt = 0; mt < 4; ++mt) O[mt] = __builtin_amdgcn_mfma_f32_16x16x32_fp8_fp8(vf[kb][mt], (long)pf, O[mt], 0, 0, 0);
            }
            if (fr < 8) { bf16* op = ATTN + (size_t)(b * SEQ + t) * D + DCONV + fr * 64 + 4 * fq;
#pragma unroll
                for (int mt = 0; mt < 4; ++mt) { typedef unsigned u32x2v __attribute__((ext_vector_type(2)));
                    u32x2v wv; wv.x = pg8::cvt_pk_bf16(O[mt][0] * rinv, O[mt][1] * rinv); wv.y = pg8::cvt_pk_bf16(O[mt][2] * rinv, O[mt][3] * rinv);
                    *(GAS u32x2v*)(op + 16 * mt) = wv; } }
        }
        asm volatile("" ::: "memory");
        }
        __builtin_amdgcn_sched_barrier(0);
        {
            const int tkn = (int)__builtin_amdgcn_readfirstlane(TK[parity ^ 1]);
            have = tkn < NU;
            if (have) { const int t0n = 8 * (NU - 1 - tkn); P2_LOAD_Q(t0n); }
            else P2_ZERO_Q();
        }
        half_barrier(HB, F.lane);
        parity ^= 1;
    }
#undef P2_LOAD_Q
#undef P2_ZERO_Q
    __syncthreads();
}

__device__ __forceinline__ void p8_final_norm(Frame& F, const Ptrs& P) {
    const int gw = F.vcu * NWAVES + F.wave, NGW = F.G * NWAVES; const float* SSQ = (const float*)(P.ws + WS_SSQ2); const bf16* X2B = (const bf16*)(P.ws + WS_XN);
    const GAS f32x4* gr = (const GAS f32x4*)P.g_final + F.lane;
    f32x4 gg[4];
#pragma unroll
    for (int j = 0; j < 4; ++j) gg[j] = gr[64 * j];
    typedef unsigned u32x2v __attribute__((ext_vector_type(2)));
    for (int m = gw; m < M; m += 2 * NGW) { const int m1 = (m + NGW < M) ? m + NGW : m;
        const GAS u32x2v* xa = (const GAS u32x2v*)(X2B + (size_t)m * D) + F.lane; const GAS u32x2v* xb = (const GAS u32x2v*)(X2B + (size_t)m1 * D) + F.lane;
        const float* spa = SSQ + m; const float* spb = SSQ + m1; asm volatile("" : "+v"(spa), "+v"(spb));
        const float pa = *spa, pb = *spb;
        u32x2v va[4], vb[4];
#pragma unroll
        for (int j = 0; j < 4; ++j) { va[j] = xa[64 * j]; vb[j] = xb[64 * j]; }
        const float ra = 1.f / sqrtf(pa * (1.f / D) + EPS), rb = 1.f / sqrtf(pb * (1.f / D) + EPS);
        GAS f32x4* oa = (GAS f32x4*)(P.out + (size_t)m * D) + F.lane; GAS f32x4* ob = (GAS f32x4*)(P.out + (size_t)m1 * D) + F.lane;
#pragma unroll
        for (int j = 0; j < 4; ++j) { oa[64 * j] = (f32x4){bf_lo(va[j].x), bf_hi(va[j].x), bf_lo(va[j].y), bf_hi(va[j].y)} * ra * gg[j];
            if (m1 != m) ob[64 * j] = (f32x4){bf_lo(vb[j].x), bf_hi(vb[j].x), bf_lo(vb[j].y), bf_hi(vb[j].y)} * rb * gg[j]; }
    }
}

struct Args { const float* in[14]; float* out; unsigned char* ws; int ph_lo, ph_hi, li, pad; };
__global__ void __launch_bounds__(NWAVES * 64, 2) skel_fwd(Args args) {
    extern __shared__ __attribute__((aligned(16))) unsigned char lds[];
    Frame F;
    F.lds = (LAS unsigned char*)lds;
    F.MISC = (volatile LAS unsigned*)(F.lds + MISC_OFF);
    F.tid = threadIdx.x; F.lane = F.tid & 63; F.wave = __builtin_amdgcn_readfirstlane(F.tid >> 6);
    F.G = gridDim.x; { const int bx = blockIdx.x; F.vcu = (F.G % 8 == 0) ? (bx % 8) * (F.G / 8) + bx / 8 : bx; }
    Ptrs P;
    P.x = args.in[0]; P.g_mix = args.in[1]; P.w_in = args.in[2]; P.b_gate = args.in[3]; P.conv_w = args.in[4]; P.w_a = args.in[5]; P.w_b = args.in[6]; P.w_out = args.in[7];
    P.rel_bias = args.in[8]; P.g_ffn = args.in[9]; P.w_g = args.in[10]; P.w_u = args.in[11]; P.w_d = args.in[12]; P.g_final = args.in[13];
    P.out = args.out; P.ws = args.ws;
    unsigned char* ws = args.ws;
    F.ctl = (gu32*)(ws + WS_CTL);
    for (int u = F.tid; u < (TAB_OFF - LDSCTL_OFF) / 4; u += NWAVES * 64) ((LAS unsigned*)(F.lds + LDSCTL_OFF))[u] = 0u;
    __syncthreads();
    XcdBarrier bar; bar.bar = (unsigned*)(F.ctl + CW_BAR); bar.x = 0; bar.st = nullptr;
    if (N_LAUNCHES == 1) bar = xcd_barrier_post((unsigned*)(F.ctl + CW_BAR), F.MISC + 8);
#define GRID_BAR() do { if (N_LAUNCHES == 1) { xcd_barrier(bar); } } while (0)
    const int lo = args.ph_lo, hi = args.ph_hi;
#define IN(k) (lo <= (k) && (k) < hi)
#define BOTH(k) (IN(k) && IN((k) + 1))
    bf16* XN = (bf16*)(ws + WS_XN); bf16* PROJ = (bf16*)(ws + WS_PROJ); bf16* CONV = (bf16*)(ws + WS_CONV); bf16* ATTN = (bf16*)(ws + WS_ATTN);
    bf16* MERGED = XN; bf16* X1B = CONV; bf16* ACT = PROJ; bf16* X2B = XN;
    float* SSQ1 = (float*)(ws + WS_SSQ1); float* SSQ2 = (float*)(ws + WS_SSQ2);

    const bool split_w = (N_LAUNCHES == 1) && (F.G == 256);
    const bool fuse_final = (N_LAUNCHES == 1) && (F.G == 256) && IN(7) && IN(8);
    if (IN(0)) { if (blockIdx.x == 0 && F.tid < 256) ((bf16*)(ws + WS_IDENT))[F.tid * 257] = (bf16)0x3F80;
        p0_prologue(F, P, !split_w); if (BOTH(0)) GRID_BAR(); }
    if (IN(1)) {
        pg8::Gemm g{(const bf16*)P.out  , (const bf16*)(ws + WS_WIN), M, NPROJ, D}; pg8::StaticOrder S; S.init(M, NPROJ, F.G, (int)blockIdx.x);
        LAS float* BGL = (LAS float*)(F.lds + TAB_OFF);
        for (int i = F.tid; i < 2 * D; i += NWAVES * 64) BGL[i] = P.b_gate[i];
        __syncthreads();
        pg8::EpiProj E{PROJ, NPROJ, (bf16*)(ws + WS_KVI), (bf16*)(ws + WS_IKF), (bf16*)(ws + WS_IW), PC_KVI / 256, BGL, PC_GA, (bf16*)(ws + WS_IW + MiB), (const float*)(ws + WS_SSQ0), (LAS float*)(F.lds + TAB_OFF + 8192)};
        pg8::gemm_phase<pg8::EpiProj, pg8::StaticOrder, PG8_ALIGN, PG8_SP2>(F.lds + RING_OFF, g, S, E);
        if (split_w && blockIdx.x >= 128) p0_weight_items(F, P, PI_IN, PI_ALL, ((int)blockIdx.x - 128) * NWAVES + F.wave, 128 * NWAVES);
        if (BOTH(1)) GRID_BAR();
    }
    if (IN(2)) { p2_conv(F, P); p2_attn(F, P); if (BOTH(2)) GRID_BAR(); }
    if (IN(3)) {
        pg8::Gemm g{CONV, (const bf16*)(ws + WS_WA), M, D, D}; pg8::StaticOrder S; S.init(M, D, F.G, (int)blockIdx.x);
        pg8::EpiGateMerged E{MERGED, (const unsigned char*)(PROJ + PC_GA), NPROJ * 2};
        pg8::gemm_phase<pg8::EpiGateMerged, pg8::StaticOrder, PG8_ALIGN, PG8_SP2>(F.lds + RING_OFF, g, S, E);
        if (BOTH(4)) GRID_BAR();
    }
    if (IN(5)) {
        pg8::Gemm g{MERGED, (const bf16*)(ws + WS_WOUT), M, D, D, (const bf16*)P.out, (const bf16*)(ws + WS_IDENT), D, BM256}; pg8::StaticOrder S; S.init(M, D, F.G, (int)blockIdx.x);
        pg8::EpiResid<2> E{nullptr, nullptr, X1B, SSQ1};
        pg8::gemm_phase<pg8::EpiResid<2>, pg8::StaticOrder, PG8_ALIGN, PG8_SP2>(F.lds + RING_OFF, g, S, E);
        if (BOTH(5)) GRID_BAR();
    }
    if (IN(6)) {
        pg8::Gemm g{X1B, (const bf16*)(ws + WS_WGU), M, NGU, D}; pg8::StaticOrder S; S.init(M, NGU, F.G, (int)blockIdx.x);
        pg8::EpiSwiGLU E{ACT, FF, SSQ1, (LAS float*)(F.lds + TAB_OFF)};
        pg8::gemm_phase<pg8::EpiSwiGLU, pg8::StaticOrder, PG8_ALIGN, PG8_SP2>(F.lds + RING_OFF, g, S, E);
        if (BOTH(6)) GRID_BAR();
    }
    if (IN(7)) {
        pg8::Gemm g{ACT, (const bf16*)(ws + WS_WD), M, D, FF, X1B, (const bf16*)(ws + WS_IDENT), D, BM256}; pg8::StaticOrder S; S.init(M, D, F.G, (int)blockIdx.x);
        if (fuse_final) {
            pg8::EpiFinal E{P.out, SSQ2, P.g_final, (unsigned*)(ws + WS_RC), (unsigned*)(F.ctl + CW_BAR) + XB_TMO};
            pg8::gemm_phase<pg8::EpiFinal, pg8::StaticOrder, PG8_ALIGN, PG8_SP2>(F.lds + RING_OFF, g, S, E);
        } else {
            pg8::EpiResid<2> E{nullptr, nullptr, X2B, SSQ2};
            pg8::gemm_phase<pg8::EpiResid<2>, pg8::StaticOrder, PG8_ALIGN, PG8_SP2>(F.lds + RING_OFF, g, S, E);
            if (BOTH(7)) GRID_BAR();
        }
    }
    if (IN(8) && !fuse_final) { p8_final_norm(F, P); }
#undef IN
#undef BOTH
#undef GRID_BAR
}

extern "C" void kernel_launch(void* const* d_in, const int* in_sizes, int n_in, void* d_out, int out_size, void* d_ws, size_t ws_size, hipStream_t stream) {
    static int grid = 0;
    if (grid == 0) {
        if (n_in != 14 || in_sizes[0] != M * D || out_size != M * D || ws_size < WS_END) { fprintf(stderr, "kernel_launch: shape/workspace mismatch: n_in %d in0 %d out %d ws %zu (need %zu); nothing launched\n", n_in, n_in > 0 ? in_sizes[0] : -1, out_size, ws_size, (size_t)WS_END); grid = -1; return; }
        int dev = 0, cus = 0, per_cu = 0;
        if (hipGetDevice(&dev) != hipSuccess || hipDeviceGetAttribute(&cus, hipDeviceAttributeMultiprocessorCount, dev) != hipSuccess) { grid = -1; return; }
        if (hipFuncSetAttribute((const void*)skel_fwd, hipFuncAttributeMaxDynamicSharedMemorySize, LDS_BYTES) != hipSuccess) { fprintf(stderr, "kernel_launch: hipFuncSetAttribute failed\n"); grid = -1; return; }
        if (hipOccupancyMaxActiveBlocksPerMultiprocessor(&per_cu, (const void*)skel_fwd, NWAVES * 64, LDS_BYTES) != hipSuccess || per_cu < 1)
            fprintf(stderr, "kernel_launch: note: occupancy query reports %d workgroups per CU\n", per_cu);
        (void)hipGetLastError();
        grid = cus;
    }
    if (grid < 0) return;
    if (hipMemsetAsync((char*)d_ws + WS_CTL, 0, CTL_ZERO_BYTES, stream) != hipSuccess) { fprintf(stderr, "kernel_launch: hipMemsetAsync failed\n"); return; }
    Args a{};
    for (int i = 0; i < 14; ++i) a.in[i] = (const float*)d_in[i];
    a.out = (float*)d_out; a.ws = (unsigned char*)d_ws;
    for (int li = 0; li < N_LAUNCHES; ++li) {
        a.ph_lo = (N_LAUNCHES == PER_PHASE) ? li : 0; a.ph_hi = (N_LAUNCHES == PER_PHASE) ? li + 1 : PER_PHASE; a.li = li;
        hipLaunchKernelGGL(skel_fwd, dim3(grid), dim3(NWAVES * 64), LDS_BYTES, stream, a);
        const hipError_t le = hipPeekAtLastError();
        if (le != hipSuccess) { fprintf(stderr, "kernel_launch: launch %d failed: %s\n", li, hipGetErrorName(le)); break; }
    }
}
```

```cpp
#include <hip/hip_runtime.h>
#include <cstdio>
#include <cstdint>
namespace pg8 {
#define PG8_LAS __attribute__((address_space(3)))
typedef unsigned short bf16_t;
typedef short bf16x8 __attribute__((ext_vector_type(8)));
typedef float f32x4 __attribute__((ext_vector_type(4)));
typedef unsigned u32x4 __attribute__((ext_vector_type(4)));
constexpr int BM = 256, BK = 64, HALF = 128, HTB = HALF * BK * 2  , STAGE_BYTES = 8 * HTB, NXCD = 8, WGM = 8;

__host__ __device__ __forceinline__ int lds_byte(int r, int c) { const int st = (r >> 4) * 2 + (c >> 5), rr = r & 15, cc = c & 31, ob = rr * 64 + cc * 2; return st * 1024 + (ob ^ (((ob >> 9) & 1) << 5)); }
__host__ __device__ __forceinline__ void stage_rc(int b, int& R, int& C) { const int st = b / 1024, sb = b % 1024, swz = sb ^ (((sb >> 9) & 1) << 5); R = (st >> 1) * 16 + swz / 64; C = (st & 1) * 32 + (swz % 64) / 2; }
__host__ __device__ __forceinline__ int perm32(int rho) { const int n = rho >> 4, i = rho & 15; return 8 * (i >> 2) + 4 * n + (i & 3); }

typedef int pg8_v8i __attribute__((ext_vector_type(8)));
__device__ __forceinline__ pg8_v8i pg8_cat8(bf16x8 lo, bf16x8 hi) { typedef int v4i_ __attribute__((ext_vector_type(4))); const v4i_ a = __builtin_bit_cast(v4i_, lo), b = __builtin_bit_cast(v4i_, hi); return (pg8_v8i){a.x, a.y, a.z, a.w, b.x, b.y, b.z, b.w}; }
struct Unit { int pm, pn; };
struct Gemm { const bf16_t* A; const bf16_t* Bt; int M, N, K; const bf16_t* Ae = nullptr; const bf16_t* Bte = nullptr; int lde_a = 0, lde_b = 0; };

struct StaticOrder {
    int nM, nN, nwg, G, c;
    __host__ __device__ void init(int M, int N, int G_, int c_) { nM = M / BM; nN = N / BM; nwg = nM * nN; G = G_; c = c_; }
    __host__ __device__ bool next(int i, Unit& u) const {
        const long L = (long)i * G + c; if (L >= nwg) return false;
        int wgid = (int)L; { const int q = nwg / NXCD, r = nwg % NXCD, xcd = wgid % NXCD, off = wgid / NXCD; wgid = (xcd < r ? xcd * (q + 1) : r * (q + 1) + (xcd - r) * q) + off; }
        const int nig = WGM * nN, gid = wgid / nig, fm = gid * WGM, gsz = (nM - fm) < WGM ? (nM - fm) : WGM;
        u.pm = fm + ((wgid % nig) % gsz); u.pn = (wgid % nig) / gsz; return true;
    }
    __device__ __forceinline__ void a_ready(const Unit&) const {}
    __device__ __forceinline__ void done(const Unit&) const {}
};

typedef float f32x2_cv __attribute__((ext_vector_type(2))); typedef __bf16 bf16x2_cv __attribute__((ext_vector_type(2)));
__device__ __forceinline__ unsigned cvt_pk_bf16(float lo, float hi) { f32x2_cv v = {lo, hi}; bf16x2_cv b = __builtin_convertvector(v, bf16x2_cv); return __builtin_bit_cast(unsigned, b); }
typedef float f32x2 __attribute__((ext_vector_type(2)));
__device__ __forceinline__ f32x2 gelu_pk(f32x2 v) {
    const f32x2 av = __builtin_elementwise_abs(v), d = av * 0.2316418882f + 1.0f;
    f32x2 t; t.x = __builtin_amdgcn_rcpf(d.x); t.y = __builtin_amdgcn_rcpf(d.y);
    f32x2 q = t * 0.5307027145f + (-0.7265760135f); q = q * t + 0.7107068705f; q = q * t + (-0.142248368f); q = q * t + 0.127414796f; q = q * t;
    const f32x2 s = (v * v) * (-0.72134752044f);
    f32x2 e; e.x = __builtin_amdgcn_exp2f(s.x); e.y = __builtin_amdgcn_exp2f(s.y);
    const f32x2 m = v * (q * e), r = v - m;
    f32x2 o; o.x = v.x < 0.f ? m.x : r.x; o.y = v.y < 0.f ? m.y : r.y; return o;
}

template <int ACT  > struct EpiBf16 {
    static constexpr bool PERM = true, AFTER_DRAIN = false, HAS_PRE = false, HAS_MID = false, HAS_EXT = false, F8 = false; static_assert(ACT == 0 || ACT == 1, "EpiBf16: ACT is 0 (none) or 1 (gelu_pk)");
    static constexpr int NVM = 0;
    bf16_t* O; int ldc; const float* bias; int split_cols; size_t split_stride; float scale0;
    __device__ __forceinline__ void operator()(const f32x4 (&acc)[2][2][4][2], const Unit& u, int wr, int wc, int fr, int fq) const {
        const int row0 = u.pm * BM + wr * 64 + fr; int colt = u.pn * BM; bf16_t* base = O;
        float sc = 1.f; if (split_cols) { const int t = colt / split_cols; base += (size_t)t * split_stride; colt -= t * split_cols; if (t == 0) sc = scale0; }
        const int col0 = colt + wc * 32 + 8 * fq, bcol0 = u.pn * BM + wc * 32 + 8 * fq;
        f32x4 bv[2][2];
#pragma unroll
        for (int bj = 0; bj < 2; ++bj)
#pragma unroll
            for (int n = 0; n < 2; ++n) bv[bj][n] = bias ? *(const f32x4*)(bias + bcol0 + bj * HALF + 4 * n) : (f32x4){0.f, 0.f, 0.f, 0.f};
#pragma unroll
        for (int ai = 0; ai < 2; ++ai)
#pragma unroll
            for (int m = 0; m < 4; ++m) { bf16_t* rowp = base + (size_t)(row0 + ai * HALF + m * 16) * ldc + col0;
#pragma unroll
                for (int bj = 0; bj < 2; ++bj) { f32x4 v0 = acc[ai][bj][m][0] + bv[bj][0], v1 = acc[ai][bj][m][1] + bv[bj][1];
                    if (ACT == 1) { f32x2 a = gelu_pk((f32x2){v0[0], v0[1]}), b = gelu_pk((f32x2){v0[2], v0[3]}), c = gelu_pk((f32x2){v1[0], v1[1]}), d = gelu_pk((f32x2){v1[2], v1[3]});
                        v0 = (f32x4){a.x, a.y, b.x, b.y}; v1 = (f32x4){c.x, c.y, d.x, d.y}; }
                    v0 = v0 * sc; v1 = v1 * sc; u32x4 w; w.x = cvt_pk_bf16(v0[0], v0[1]); w.y = cvt_pk_bf16(v0[2], v0[3]); w.z = cvt_pk_bf16(v1[0], v1[1]); w.w = cvt_pk_bf16(v1[2], v1[3]);
                    *(u32x4*)(rowp + bj * HALF) = w; } }
    }
};

template <class Epi, class Sched, bool ALIGN_EPI = false, bool SP2 = false>
__device__ __forceinline__ void gemm_phase(PG8_LAS unsigned char* lds, const Gemm g, const Sched& S, const Epi& E) {
    const int tid = threadIdx.x, wid = __builtin_amdgcn_readfirstlane(tid >> 6), lane = tid & 63, wr = wid >> 2, wc = wid & 3, fr = lane & 15, fq = lane >> 4;
    const int K = g.K, ntm = K / BK, nt = ntm + (Epi::HAS_EXT ? BM / BK : 0);
    unsigned voffA[2], voffB[2];
#pragma unroll
    for (int i = 0; i < 2; ++i) { int R, C; stage_rc(tid * 16 + i * 8192, R, C); const int Rb = Epi::PERM ? ((R & ~31) + perm32(R & 31)) : R;
        voffA[i] = (unsigned)(R * K + C) * 2u; voffB[i] = (unsigned)(Rb * K + C) * 2u; }
    unsigned voffAe[2] = {0u, 0u}, voffBe[2] = {0u, 0u};
    if constexpr (Epi::HAS_EXT) {
#pragma unroll
        for (int i = 0; i < 2; ++i) { int R, C; stage_rc(tid * 16 + i * 8192, R, C); const int Rb = Epi::PERM ? ((R & ~31) + perm32(R & 31)) : R;
            voffAe[i] = (unsigned)(R * g.lde_a + C) * 2u; voffBe[i] = (unsigned)(Rb * g.lde_b + C) * 2u; } }
    const size_t hstepAe = (size_t)HALF * g.lde_a * 2, hstepBe = (size_t)HALF * g.lde_b * 2;
    const size_t kstep = (size_t)(BK * 2);
    const size_t hstep = (size_t)HALF * K * 2;
    const size_t tstep = 2 * hstep;
    const unsigned ldsw = (unsigned)wid * 1024u;
    const int aoff = lds_byte(wr * 64 + fr, fq * 8), boff = lds_byte(wc * 32 + fr, fq * 8);
#define PG8_SA(b, h) (((b) * 2 + (h)) * HTB)
#define PG8_SB(b, h) ((4 + (b) * 2 + (h)) * HTB)
#define PG8_STAGE(bufoff, gbase, voff) do { _Pragma("unroll") for (int _i = 0; _i < 2; ++_i) \
        __builtin_amdgcn_global_load_lds((const unsigned*)((const char*)(gbase) + (voff)[_i]), (PG8_LAS unsigned*)(lds + (bufoff) + ldsw + _i * 8192), 16, 0, 0); } while (0)
#define PG8_LDA(dst, b, h) do { if constexpr (Epi::F8) { _Pragma("unroll") for (int m = 0; m < 4; ++m) dst##8[m] = pg8_cat8(*(const PG8_LAS bf16x8*)(lds + PG8_SA(b, h) + aoff + m * 2048), *(const PG8_LAS bf16x8*)(lds + PG8_SA(b, h) + aoff + m * 2048 + 1024)); } \
        else { _Pragma("unroll") for (int m = 0; m < 4; ++m) _Pragma("unroll") for (int k = 0; k < 2; ++k) dst[m][k] = *(const PG8_LAS bf16x8*)(lds + PG8_SA(b, h) + aoff + m * 2048 + k * 1024); } } while (0)
#define PG8_LDB(dst, b, h) do { if constexpr (Epi::F8) { _Pragma("unroll") for (int n = 0; n < 2; ++n) dst##8[n] = pg8_cat8(*(const PG8_LAS bf16x8*)(lds + PG8_SB(b, h) + boff + n * 2048), *(const PG8_LAS bf16x8*)(lds + PG8_SB(b, h) + boff + n * 2048 + 1024)); } \
        else { _Pragma("unroll") for (int n = 0; n < 2; ++n) _Pragma("unroll") for (int k = 0; k < 2; ++k) dst[n][k] = *(const PG8_LAS bf16x8*)(lds + PG8_SB(b, h) + boff + n * 2048 + k * 1024); } } while (0)
#define PG8_MMA(ai, bj, At, Bt) do { __builtin_amdgcn_s_setprio(1); _Pragma("unroll") for (int m = 0; m < 4; ++m) _Pragma("unroll") for (int n = 0; n < 2; ++n) { \
        if constexpr (Epi::F8) asm volatile("v_mfma_scale_f32_16x16x128_f8f6f4 %0, %1, %2, %0, %3, %3 op_sel_hi:[0,0,0]" : "+v"(acc[ai][bj][m][n]) : "v"(Bt##8[n]), "v"(At##8[m]), "v"(f8scale));     \
        else { _Pragma("unroll") for (int k = 0; k < 2; ++k) acc[ai][bj][m][n] = __builtin_amdgcn_mfma_f32_16x16x32_bf16(Bt[n][k], At[m][k], acc[ai][bj][m][n], 0, 0, 0); } } __builtin_amdgcn_s_setprio(0); } while (0)
#define PG8_WAIT_V(n) asm volatile("s_waitcnt vmcnt(" #n ")" ::: "memory")
#define PG8_WAIT_VR do { if constexpr (Epi::NVM >= 32) asm volatile("s_waitcnt vmcnt(40)" ::: "memory"); else if constexpr (Epi::NVM >= 16) asm volatile("s_waitcnt vmcnt(24)" ::: "memory"); \
        else if constexpr (Epi::NVM >= 8) asm volatile("s_waitcnt vmcnt(16)" ::: "memory"); else asm volatile("s_waitcnt vmcnt(8)" ::: "memory"); } while (0)
#define PG8_WAIT_L(n) asm volatile("s_waitcnt lgkmcnt(" #n ")" ::: "memory")
#define PG8_BAR __builtin_amdgcn_s_barrier()
#define PG8_SCHED __builtin_amdgcn_sched_barrier(0)
    static_assert(SP2 || !Epi::HAS_EXT, "the K extension is wired into the SP2 loop only");
    Unit cur, nxt; int ui = 0;
    if (!S.next(0, cur)) return;
    f32x4 acc[2][2][4][2];
#pragma unroll
    for (int a = 0; a < 2; ++a)
#pragma unroll
        for (int b = 0; b < 2; ++b)
#pragma unroll
            for (int m = 0; m < 4; ++m)
#pragma unroll
                for (int n = 0; n < 2; ++n) acc[a][b][m][n] = (f32x4){0.f, 0.f, 0.f, 0.f};
    bf16x8 At[4][2], B0[2][2], B1[2][2];
    int f8scale = 0x7f7f7f7f; asm volatile("" : "+v"(f8scale));
    pg8_v8i At8[4], B08[2], B18[2];
    const char* cA = (const char*)g.A + (size_t)cur.pm * tstep; const char* cB = (const char*)g.Bt + (size_t)cur.pn * tstep;
    const char* eA = Epi::HAS_EXT ? (const char*)g.Ae + ((size_t)cur.pm * BM * g.lde_a + (size_t)cur.pn * BM) * 2 : nullptr; const char* eB = (const char*)g.Bte;
    S.a_ready(cur);
    float carry[8] = {0.f, 0.f, 0.f, 0.f, 0.f, 0.f, 0.f, 0.f};
    if constexpr (Epi::HAS_PRE) E.pre(cur, wr, fr, carry);
    if constexpr (SP2) {
        PG8_STAGE(PG8_SB(0, 0), cB, voffB); PG8_STAGE(PG8_SB(0, 1), cB + hstep, voffB); PG8_STAGE(PG8_SA(0, 0), cA, voffA); PG8_STAGE(PG8_SA(0, 1), cA + hstep, voffA);
        if (wr == 1) PG8_BAR;
        PG8_WAIT_V(2); PG8_BAR;
        PG8_STAGE(PG8_SB(1, 0), cB + kstep, voffB); PG8_STAGE(PG8_SA(1, 0), cA + kstep, voffA); PG8_STAGE(PG8_SB(1, 1), cB + hstep + kstep, voffB);
        PG8_WAIT_V(6); PG8_BAR;
    } else {
        PG8_STAGE(PG8_SB(0, 0), cB, voffB); PG8_STAGE(PG8_SA(0, 0), cA, voffA); PG8_STAGE(PG8_SB(0, 1), cB + hstep, voffB); PG8_STAGE(PG8_SA(0, 1), cA + hstep, voffA);
        if (wr == 1) PG8_BAR;
        PG8_WAIT_V(4); PG8_BAR;
        PG8_STAGE(PG8_SB(1, 0), cB + kstep, voffB); PG8_STAGE(PG8_SA(1, 0), cA + kstep, voffA); PG8_STAGE(PG8_SB(1, 1), cB + hstep + kstep, voffB);
        PG8_WAIT_V(6); PG8_BAR;
    }
    for (;;) {
        const bool has_next = S.next(ui + 1, nxt);
        const char* nA = has_next ? (const char*)g.A + (size_t)nxt.pm * tstep : cA; const char* nB = has_next ? (const char*)g.Bt + (size_t)nxt.pn * tstep : cB;
        int t0 = 0;
        if constexpr (SP2 && ALIGN_EPI && Epi::NVM > 0) { if (ui > 0) {
            const char* pa2 = cA + 2 * kstep; const char* pb2 = cB + 2 * kstep; const char* pa3 = pa2 + kstep; const char* pb3 = pb2 + kstep;


            PG8_LDB(B0, 0, 0); PG8_LDB(B1, 0, 1); PG8_SCHED; PG8_LDA(At, 0, 0);
            PG8_WAIT_VR; PG8_WAIT_L(0); PG8_BAR; PG8_MMA(0, 0, At, B0); PG8_MMA(0, 1, At, B1); PG8_BAR; PG8_SCHED;

            PG8_LDA(At, 0, 1); PG8_STAGE(PG8_SB(0, 0), pb2, voffB); PG8_STAGE(PG8_SB(0, 1), pb2 + hstep, voffB); PG8_STAGE(PG8_SA(0, 0), pa2, voffA);
            PG8_WAIT_VR; PG8_WAIT_L(0); PG8_BAR; PG8_MMA(1, 0, At, B0); PG8_MMA(1, 1, At, B1); PG8_BAR; PG8_SCHED;

            PG8_LDB(B0, 1, 0); PG8_LDB(B1, 1, 1); PG8_SCHED; PG8_LDA(At, 1, 0); PG8_STAGE(PG8_SA(0, 1), pa2 + hstep, voffA);
            PG8_WAIT_VR; PG8_WAIT_L(0); PG8_BAR; PG8_MMA(0, 0, At, B0); PG8_MMA(0, 1, At, B1); PG8_BAR; PG8_SCHED;

            PG8_LDA(At, 1, 1); PG8_STAGE(PG8_SB(1, 0), pb3, voffB); PG8_STAGE(PG8_SB(1, 1), pb3 + hstep, voffB); PG8_STAGE(PG8_SA(1, 0), pa3, voffA);
            PG8_WAIT_V(8); PG8_WAIT_L(0); PG8_BAR; PG8_MMA(1, 0, At, B0); PG8_MMA(1, 1, At, B1); PG8_BAR; PG8_SCHED;
            t0 = 2; } }
        for (int t = t0; t < nt; t += 2) {
            if constexpr (Epi::HAS_MID) { if (t == Epi::MID_T) { __builtin_amdgcn_sched_barrier(0); E.mid(acc, cur, wr, wc, fr, fq); __builtin_amdgcn_sched_barrier(0); } }
            const bool last = (t == nt - 2);
            const bool x1 = Epi::HAS_EXT && t >= ntm, x2 = Epi::HAS_EXT && !last && t + 2 >= ntm;
            const char* a1 = x1 ? eA + (size_t)(t + 1 - ntm) * kstep : cA + (size_t)(t + 1) * kstep;
            const char* a2 = last ? nA : (x2 ? eA + (size_t)(t + 2 - ntm) * kstep : cA + (size_t)(t + 2) * kstep);
            const char* b2 = last ? nB : (x2 ? eB + (size_t)(t + 2 - ntm) * kstep : cB + (size_t)(t + 2) * kstep);
            const char* a3 = a2 + kstep; const char* b3 = b2 + kstep;
            const size_t hA1 = x1 ? hstepAe : hstep, hA2 = x2 ? hstepAe : hstep, hB2 = x2 ? hstepBe : hstep;
            unsigned vA1[2], vA2[2], vB2[2];
#pragma unroll
            for (int i = 0; i < 2; ++i) { vA1[i] = x1 ? voffAe[i] : voffA[i]; vA2[i] = x2 ? voffAe[i] : voffA[i]; vB2[i] = x2 ? voffBe[i] : voffB[i]; }
            if (last && has_next) S.a_ready(nxt);
            if constexpr (SP2) {
            PG8_LDB(B0, 0, 0); PG8_LDB(B1, 0, 1); PG8_SCHED; PG8_LDA(At, 0, 0); PG8_STAGE(PG8_SA(1, 1), a1 + hA1, vA1);
            PG8_WAIT_V(8); PG8_WAIT_L(0); PG8_BAR; PG8_MMA(0, 0, At, B0); PG8_MMA(0, 1, At, B1); PG8_BAR; PG8_SCHED;
            PG8_LDA(At, 0, 1); PG8_STAGE(PG8_SB(0, 0), b2, vB2); PG8_STAGE(PG8_SB(0, 1), b2 + hB2, vB2); PG8_STAGE(PG8_SA(0, 0), a2, vA2);
            PG8_WAIT_V(8); PG8_WAIT_L(0); PG8_BAR; PG8_MMA(1, 0, At, B0); PG8_MMA(1, 1, At, B1); PG8_BAR; PG8_SCHED;
            PG8_LDB(B0, 1, 0); PG8_LDB(B1, 1, 1); PG8_SCHED; PG8_LDA(At, 1, 0); PG8_STAGE(PG8_SA(0, 1), a2 + hA2, vA2);
            PG8_WAIT_V(8); PG8_WAIT_L(0); PG8_BAR; PG8_MMA(0, 0, At, B0); PG8_MMA(0, 1, At, B1); PG8_BAR; PG8_SCHED;
            PG8_LDA(At, 1, 1); PG8_STAGE(PG8_SB(1, 0), b3, vB2); PG8_STAGE(PG8_SB(1, 1), b3 + hB2, vB2); PG8_STAGE(PG8_SA(1, 0), a3, vA2);
            PG8_WAIT_V(8); PG8_WAIT_L(0); PG8_BAR; PG8_MMA(1, 0, At, B0); PG8_MMA(1, 1, At, B1); PG8_BAR; PG8_SCHED;
            } else {
            PG8_LDB(B0, 0, 0); PG8_SCHED; PG8_LDA(At, 0, 0); PG8_STAGE(PG8_SA(1, 1), a1 + hstep, voffA);
            PG8_WAIT_L(8); PG8_BAR; PG8_WAIT_L(0); PG8_MMA(0, 0, At, B0); PG8_BAR; PG8_SCHED;
            PG8_LDB(B1, 0, 1); PG8_STAGE(PG8_SB(0, 0), b2, voffB);
            PG8_BAR; PG8_WAIT_L(0); PG8_MMA(0, 1, At, B1); PG8_BAR;
            PG8_LDA(At, 0, 1); PG8_STAGE(PG8_SA(0, 0), a2, voffA);
            PG8_BAR; PG8_WAIT_L(0); PG8_MMA(1, 0, At, B0); PG8_BAR; PG8_SCHED;
            PG8_STAGE(PG8_SB(0, 1), b2 + hstep, voffB);
            PG8_WAIT_V(6); PG8_BAR; PG8_MMA(1, 1, At, B1); PG8_BAR;
            PG8_LDB(B0, 1, 0); PG8_SCHED; PG8_LDA(At, 1, 0); PG8_STAGE(PG8_SA(0, 1), a2 + hstep, voffA);
            PG8_WAIT_L(8); PG8_BAR; PG8_WAIT_L(0); PG8_MMA(0, 0, At, B0); PG8_BAR; PG8_SCHED;
            PG8_LDB(B1, 1, 1); PG8_STAGE(PG8_SB(1, 0), b3, voffB);
            PG8_BAR; PG8_WAIT_L(0); PG8_MMA(0, 1, At, B1); PG8_BAR;
            PG8_LDA(At, 1, 1); PG8_STAGE(PG8_SA(1, 0), a3, voffA);
            PG8_BAR; PG8_WAIT_L(0); PG8_MMA(1, 0, At, B0); PG8_BAR; PG8_SCHED;
            PG8_STAGE(PG8_SB(1, 1), b3 + hstep, voffB);
            PG8_WAIT_V(6); PG8_BAR; PG8_MMA(1, 1, At, B1); PG8_BAR;
            }
        }
        if constexpr (Epi::F8) asm volatile("s_nop 15\n\ts_nop 15" ::: "memory");
        if constexpr (ALIGN_EPI) { if (wr == 0) PG8_BAR; }
        if constexpr (SP2 && ALIGN_EPI && Epi::NVM > 0) { if (has_next) PG8_STAGE(PG8_SA(1, 1), nA + kstep + hstep, voffA); asm volatile("" ::: "memory"); PG8_SCHED; }
        if constexpr (!Epi::AFTER_DRAIN) { if constexpr (Epi::HAS_PRE) { E.run(acc, cur, wr, wc, fr, fq, carry); if (has_next) E.pre(nxt, wr, fr, carry); } else E(acc, cur, wr, wc, fr, fq); S.done(cur); }
        if (!has_next) break;
#pragma unroll
        for (int a = 0; a < 2; ++a)
#pragma unroll
            for (int b = 0; b < 2; ++b)
#pragma unroll
                for (int m = 0; m < 4; ++m)
#pragma unroll
                    for (int n = 0; n < 2; ++n) { acc[a][b][m][n] = (f32x4){0.f, 0.f, 0.f, 0.f}; asm volatile("" : "+v"(acc[a][b][m][n])); }
        cur = nxt; cA = nA; cB = nB; ++ui;
        if constexpr (Epi::HAS_EXT) eA = (const char*)g.Ae + ((size_t)cur.pm * BM * g.lde_a + (size_t)cur.pn * BM) * 2;
        if constexpr (ALIGN_EPI) { if (wr == 1) PG8_BAR; }
    }
    PG8_WAIT_V(0);
    if constexpr (!ALIGN_EPI) { if (wr == 0) PG8_BAR; }
    PG8_BAR;
    if constexpr (Epi::AFTER_DRAIN) { E.fused(acc, cur, wr, wc, fr, fq, lds, wid, lane); S.done(cur); }
#undef PG8_SA
#undef PG8_SB
#undef PG8_STAGE
#undef PG8_LDA
#undef PG8_LDB
#undef PG8_MMA
#undef PG8_WAIT_V
#undef PG8_WAIT_L
#undef PG8_BAR
#undef PG8_SCHED
}
}

#ifndef PG8_SP2
#define PG8_SP2 true
#endif
#ifndef PG8_ALIGN
#define PG8_ALIGN true
#endif
#define GAS __attribute__((address_space(1)))
#define LAS __attribute__((address_space(3)))
typedef unsigned short bf16;
typedef unsigned v4u __attribute__((ext_vector_type(4)));
typedef float f32x4 __attribute__((ext_vector_type(4)));
typedef short bf16x8 __attribute__((ext_vector_type(8)));
typedef GAS unsigned gu32;
typedef GAS unsigned long long gu64;
#define RLX_AGENT __ATOMIC_RELAXED, __HIP_MEMORY_SCOPE_AGENT
#define LDS_WAIT() asm volatile("s_waitcnt lgkmcnt(0)" ::: "memory")
#define VM_WAIT() asm volatile("s_waitcnt vmcnt(0)" ::: "memory")
__device__ __forceinline__ unsigned long long rt() { return __builtin_amdgcn_s_memrealtime(); }
__device__ __forceinline__ unsigned f2bf(float f) { unsigned u = __builtin_bit_cast(unsigned, f); return (u + 0x7fffu + ((u >> 16) & 1u)) >> 16; }
__device__ __forceinline__ unsigned pk2(float lo, float hi) { return f2bf(lo) | (f2bf(hi) << 16); }

#define XB_TMO      128
#define XB_XCNT(j)  (256  + 64 * (j))
#define XB_XSUB(j)  (1280 + 64 * (j))
#define XB_XGEN(j)  (2304 + 64 * (j))
#define XB_TOP      3328
#define XB_TOPGEN   3392
#define XCD_BAR_WORDS 3456
#define XB_SPIN_CAP (1u << 18)

__device__ __forceinline__ unsigned xb_ld(unsigned* p)              { return __hip_atomic_load(p, __ATOMIC_RELAXED, __HIP_MEMORY_SCOPE_AGENT); }
__device__ __forceinline__ unsigned xb_add(unsigned* p, unsigned v) { return __hip_atomic_fetch_add(p, v, __ATOMIC_RELAXED, __HIP_MEMORY_SCOPE_AGENT); }
__device__ __forceinline__ unsigned xb_xcc_id() { return (unsigned)__builtin_amdgcn_s_getreg((3 << 11) | 20) & 0xFu; }
#define XB_SPIN(cond, bar) do { unsigned _sp = 0; while (cond) { __builtin_amdgcn_s_sleep(1); \
    if ((++_sp & 255u) == 0u) { if (xb_ld(&(bar)[XB_TMO])) break; if (_sp > XB_SPIN_CAP) { atomicAdd(&(bar)[XB_TMO], 1u); break; } } } } while (0)

struct XcdBarrier {
    unsigned* bar; unsigned x;
    volatile LAS unsigned* st;
};

__device__ __forceinline__ XcdBarrier xcd_barrier_post(unsigned* bar, volatile LAS unsigned* st) {
    XcdBarrier b; b.bar = bar; b.x = xb_xcc_id(); b.st = st;
    if (threadIdx.x == 0) (void)xb_add(&bar[XB_XCNT(b.x)], 1u);
    return b;
}
__device__ __forceinline__ void xcd_barrier_complete(unsigned* bar, unsigned x, unsigned& nloc, unsigned& nx) {
    const unsigned G = gridDim.x * gridDim.y * gridDim.z;
    unsigned sum, cnt, mine, sp = 0u;
    for (;;) {
        sum = 0u; cnt = 0u; mine = 0u;
#pragma unroll
        for (unsigned j = 0; j < 16; ++j) { const unsigned c = xb_ld(&bar[XB_XCNT(j)]); sum += c; cnt += (c > 0u) ? 1u : 0u; mine = (j == x) ? c : mine; }
        if (sum == G) break;
        __builtin_amdgcn_s_sleep(1);
        if ((++sp & 255u) == 0u) { if (xb_ld(&bar[XB_TMO])) break; if (sp > XB_SPIN_CAP) { atomicAdd(&bar[XB_TMO], 1u); break; } }
    }
    nloc = mine > 0u ? mine : 1u; nx = cnt > 0u ? cnt : 1u;
}

__device__ __forceinline__ void xcd_barrier(const XcdBarrier& b) {
    asm volatile("s_waitcnt vmcnt(0)" ::: "memory");
    __syncthreads();
    if (threadIdx.x == 0) {
        unsigned* bar = b.bar;
        __builtin_amdgcn_s_waitcnt(0);
        unsigned nloc = b.st[0], nx = b.st[1];
        if (nloc == 0u) { xcd_barrier_complete(bar, b.x, nloc, nx); b.st[0] = nloc; b.st[1] = nx; }
        const unsigned old = xb_add(&bar[XB_XSUB(b.x)], 1u);
        const unsigned gen = old / nloc;
        if (old + 1u == (gen + 1u) * nloc) {
            __builtin_amdgcn_fence(__ATOMIC_RELEASE, "agent");
            asm volatile("s_waitcnt vmcnt(0)" ::: "memory");
            const unsigned og = xb_add(&bar[XB_TOP], 1u);
            const unsigned tg = og / nx;
            if (og + 1u == (tg + 1u) * nx) xb_add(&bar[XB_TOPGEN], 1u);
            else XB_SPIN(xb_ld(&bar[XB_TOPGEN]) == tg, bar);
            __builtin_amdgcn_fence(__ATOMIC_ACQUIRE, "agent");
            xb_add(&bar[XB_XGEN(b.x)], 1u);
            asm volatile("s_waitcnt vmcnt(0)" ::: "memory");
        } else {
            XB_SPIN(xb_ld(&bar[XB_XGEN(b.x)]) == gen, bar);
            __builtin_amdgcn_fence(__ATOMIC_ACQUIRE, "agent");
            asm volatile("s_waitcnt vmcnt(0)" ::: "memory");
        }
    }
    __syncthreads();
}

constexpr int NWAVES = 8;
#ifndef MK_N_LAUNCHES
#define MK_N_LAUNCHES 1
#endif
constexpr int PER_PHASE = 9;
constexpr int N_LAUNCHES = MK_N_LAUNCHES;
static_assert(N_LAUNCHES == 1 || N_LAUNCHES == PER_PHASE, "MK_N_LAUNCHES is 1 or 9");

constexpr int BATCH = 8, SEQ = 4096, D = 1024, M = BATCH * SEQ;
constexpr int DCONV = 512, DATT = 512, NH = 8, HD = 64, FF = 2816, NGU = 2 * FF;
constexpr int NPROJ_SRC = 4808, NPROJ = 4864;
constexpr int PC_CB = 0, PC_CC = 512, PC_CX = 1024, PC_Q = 1536, PC_IQ = 2048, PC_KVI = 2560, PC_GA = 2816, PC_GB = 3840;
constexpr int KVP = 128, KV_K = 0, KV_V = 64;
constexpr float EPS = 1e-6f;
constexpr int TOPK = 256;

constexpr size_t MiB = 1u << 20;
constexpr size_t WS_CTL = 0, CTL_ZERO_BYTES = 1 * MiB;
constexpr size_t WS_SSQ1 = 256 * 1024, WS_SSQ2 = 512 * 1024;
constexpr size_t WS_RC = 896 * 1024;
constexpr size_t WS_IDENT = 768 * 1024;
constexpr int BM256 = 256;
constexpr size_t WS_WIN = 6 * MiB, WS_WA = 16 * MiB, WS_WB = 17 * MiB, WS_WOUT = 18 * MiB, WS_WGU = 20 * MiB, WS_WD = 31 * MiB;
constexpr size_t WS_XN = 40 * MiB;
constexpr size_t WS_CONV = 104 * MiB, WS_ATTN = 136 * MiB;
constexpr size_t WS_PROJ = 168 * MiB;
constexpr size_t WS_KVI = 472 * MiB;
constexpr size_t WS_IKF = 480 * MiB, WS_IW = 484 * MiB;
constexpr size_t WS_WG8 = 37 * MiB;
constexpr size_t WS_XB8 = WS_XN;
constexpr size_t WS_SSQ0 = WS_IW + 3 * MiB;
constexpr size_t WS_END = 488 * MiB;
static_assert(WS_WIN + (size_t)NPROJ * D * 2 <= WS_WA && WS_WGU + (size_t)NGU * D * 2 <= WS_WD && WS_WD + (size_t)D * FF * 2 <= WS_XN, "weights map");
static_assert(WS_PROJ + (size_t)M * NPROJ * 2 <= WS_KVI && WS_KVI + (size_t)M * KVP * 2 <= WS_IKF && WS_IKF + (size_t)M * 64 * 2 <= WS_IW && WS_IW + (size_t)M * 16 <= WS_END && WS_XN + (size_t)M * D * 2 <= WS_CONV && WS_ATTN + (size_t)M * 512 * 2 <= WS_PROJ, "activation map");
constexpr int CW_BAR = 4096;

constexpr int RING_OFF = 0, RING_BYTES = 131072;
constexpr int LDSCTL_OFF = RING_BYTES, MISC_OFF = LDSCTL_OFF + 320;
constexpr int TAB_OFF = RING_BYTES + 1024;
constexpr int LDS_BYTES = 147456;
static_assert(MISC_OFF + 128 <= TAB_OFF && TAB_OFF + 4096 <= LDS_BYTES, "LDS map");

struct Frame {
    LAS unsigned char* lds;
    volatile LAS unsigned* MISC;
    gu32* ctl;
    int tid, lane, wave;
    int vcu, G;
};

__device__ __forceinline__ float wave_sum(float v) {
#pragma unroll
    for (int o = 1; o < 64; o <<= 1) v += __shfl_xor(v, o);
    return v;
}
__device__ __forceinline__ float bf_lo(unsigned w) { return __builtin_bit_cast(float, w << 16); }
__device__ __forceinline__ float bf_hi(unsigned w) { return __builtin_bit_cast(float, w & 0xffff0000u); }
__device__ __forceinline__ float fast_sigmoid(float z) { return __builtin_amdgcn_rcpf(1.0f + __builtin_amdgcn_exp2f(-1.4426950408889634f * z)); }

__device__ __forceinline__ void p0_transpose_item(const float* W, int K, int N, int k0, int scol0, int nvalid, bf16* WT, int drow0, const float* kscale, LAS float* scr, int lane, int ldk = 0, int kd0 = -1, bool f8 = false) {
    if (ldk == 0) ldk = K; if (kd0 < 0) kd0 = k0;
    const int kr = lane >> 3, j4 = lane & 7;
    f32x4 v[8];
#pragma unroll
    for (int i = 0; i < 8; ++i) { v[i] = (f32x4){0.f, 0.f, 0.f, 0.f};
        if (4 * j4 < nvalid) v[i] = *(const GAS f32x4*)(W + (size_t)(k0 + 8 * i + kr) * N + scol0 + 4 * j4); }
    if (kscale) {
#pragma unroll
        for (int i = 0; i < 8; ++i) v[i] = v[i] * kscale[k0 + 8 * i + kr]; }
#pragma unroll
    for (int i = 0; i < 8; ++i) { LAS float* d = scr + (8 * i + kr) * 33 + 4 * j4; d[0] = v[i].x; d[1] = v[i].y; d[2] = v[i].z; d[3] = v[i].w; }
    LDS_WAIT(); asm volatile("" ::: "memory");
    const int c = lane & 7;
#pragma unroll
    for (int jj = 0; jj < 4; ++jj) { const int n = (lane >> 3) + 8 * jj; const LAS float* s = scr + (8 * c) * 33 + n;
        v4u o; o.x = pk2(s[0 * 33], s[1 * 33]); o.y = pk2(s[2 * 33], s[3 * 33]); o.z = pk2(s[4 * 33], s[5 * 33]); o.w = pk2(s[6 * 33], s[7 * 33]);
        if (!f8) *(GAS v4u*)(WT + (size_t)(drow0 + n) * ldk + kd0 + 8 * c) = o;
        else { typedef unsigned u32x2w __attribute__((ext_vector_type(2)));
            int q0 = __builtin_amdgcn_cvt_pk_fp8_f32(s[0 * 33], s[1 * 33], 0, false); q0 = __builtin_amdgcn_cvt_pk_fp8_f32(s[2 * 33], s[3 * 33], q0, true);
            int q1 = __builtin_amdgcn_cvt_pk_fp8_f32(s[4 * 33], s[5 * 33], 0, false); q1 = __builtin_amdgcn_cvt_pk_fp8_f32(s[6 * 33], s[7 * 33], q1, true);
            u32x2w o8; o8.x = (unsigned)q0; o8.y = (unsigned)q1; *(GAS u32x2w*)((unsigned char*)WT + (size_t)(drow0 + n) * ldk + kd0 + 8 * c) = o8; } }
    LDS_WAIT(); asm volatile("" ::: "memory");
}
__device__ __forceinline__ void rms_rows2_to_bf16(int lane, const float* xrow0, const float* xrow1, const float* g, bf16* orow0, bf16* orow1) {
    const GAS f32x4* xa = (const GAS f32x4*)xrow0 + lane; const GAS f32x4* xb = (const GAS f32x4*)xrow1 + lane; const GAS f32x4* gr = (const GAS f32x4*)g + lane;
    f32x4 va[4], vb[4]; float sa = 0.f, sb = 0.f;
#pragma unroll
    for (int j = 0; j < 4; ++j) { va[j] = xa[64 * j]; vb[j] = xb[64 * j]; }
#pragma unroll
    for (int j = 0; j < 4; ++j) { sa += (va[j].x * va[j].x + va[j].y * va[j].y) + (va[j].z * va[j].z + va[j].w * va[j].w); sb += (vb[j].x * vb[j].x + vb[j].y * vb[j].y) + (vb[j].z * vb[j].z + vb[j].w * vb[j].w); }
#pragma unroll
    for (int o = 1; o < 64; o <<= 1) { sa += __shfl_xor(sa, o); sb += __shfl_xor(sb, o); }
    const float ra = 1.f / sqrtf(sa * (1.f / D) + EPS), rb = 1.f / sqrtf(sb * (1.f / D) + EPS);
    GAS unsigned long long* oa = (GAS unsigned long long*)orow0 + lane; GAS unsigned long long* ob = (GAS unsigned long long*)orow1 + lane;
#pragma unroll
    for (int j = 0; j < 4; ++j) { const f32x4 gg = gr[64 * j];
        oa[64 * j] = (unsigned long long)pk2(va[j].x * ra * gg.x, va[j].y * ra * gg.y) | ((unsigned long long)pk2(va[j].z * ra * gg.z, va[j].w * ra * gg.w) << 32);
        ob[64 * j] = (unsigned long long)pk2(vb[j].x * rb * gg.x, vb[j].y * rb * gg.y) | ((unsigned long long)pk2(vb[j].z * rb * gg.z, vb[j].w * rb * gg.w) << 32); }
}

__device__ __forceinline__ void x_rows2_to_bf16(int lane, const float* xrow0, const float* xrow1, bf16* orow0, bf16* orow1, float* ss0, float* ss1, unsigned* o8row0, unsigned* o8row1) {
    const GAS f32x4* xa = (const GAS f32x4*)xrow0 + lane; const GAS f32x4* xb = (const GAS f32x4*)xrow1 + lane;
    f32x4 va[4], vb[4]; float sa = 0.f, sb = 0.f;
#pragma unroll
    for (int j = 0; j < 4; ++j) { va[j] = xa[64 * j]; vb[j] = xb[64 * j]; }
    GAS unsigned long long* oa = (GAS unsigned long long*)orow0 + lane; GAS unsigned long long* ob = (GAS unsigned long long*)orow1 + lane;
#pragma unroll
    for (int j = 0; j < 4; ++j) { sa += (va[j].x * va[j].x + va[j].y * va[j].y) + (va[j].z * va[j].z + va[j].w * va[j].w); sb += (vb[j].x * vb[j].x + vb[j].y * vb[j].y) + (vb[j].z * vb[j].z + vb[j].w * vb[j].w);
        oa[64 * j] = (unsigned long long)pk2(va[j].x, va[j].y) | ((unsigned long long)pk2(va[j].z, va[j].w) << 32);
        ob[64 * j] = (unsigned long long)pk2(vb[j].x, vb[j].y) | ((unsigned long long)pk2(vb[j].z, vb[j].w) << 32);
        { int q = __builtin_amdgcn_cvt_pk_fp8_f32(va[j].x, va[j].y, 0, false); q = __builtin_amdgcn_cvt_pk_fp8_f32(va[j].z, va[j].w, q, true); ((GAS unsigned*)o8row0)[lane + 64 * j] = (unsigned)q; }
        { int q = __builtin_amdgcn_cvt_pk_fp8_f32(vb[j].x, vb[j].y, 0, false); q = __builtin_amdgcn_cvt_pk_fp8_f32(vb[j].z, vb[j].w, q, true); ((GAS unsigned*)o8row1)[lane + 64 * j] = (unsigned)q; } }
#pragma unroll
    for (int o = 1; o < 64; o <<= 1) { sa += __shfl_xor(sa, o); sb += __shfl_xor(sb, o); }
    if (lane == 0) { *ss0 = sa; *ss1 = sb; }
}

struct Ptrs {
    const float *x, *g_mix, *w_in, *b_gate, *conv_w, *w_a, *w_b, *w_out, *rel_bias, *g_ffn, *w_g, *w_u, *w_d, *g_final;
    float* out; unsigned char* ws;
};

constexpr int PI_IN = (NPROJ / 32) * (D / 64), PI_A = (D / 32) * (DCONV / 64), PI_B = (D / 32) * (DATT / 64), PI_O = (D / 32) * (D / 64), PI_GU = (NGU / 32) * (D / 64), PI_D = (D / 32) * (FF / 64);
constexpr int PI_ALL = PI_IN + PI_A + PI_B + PI_O + PI_GU + PI_D;
__device__ __forceinline__ void p0_weight_items(Frame& F, const Ptrs& P, int lo, int hi, int gw, int NGW) {
    LAS float* scr = (LAS float*)(F.lds + RING_OFF + F.wave * 16384);
    bf16* WinT = (bf16*)(P.ws + WS_WIN); bf16* WaT = (bf16*)(P.ws + WS_WA); bf16* WbT = (bf16*)(P.ws + WS_WB); bf16* WoutT = (bf16*)(P.ws + WS_WOUT);
    bf16* WguT = (bf16*)(P.ws + WS_WGU); bf16* WdT = (bf16*)(P.ws + WS_WD);
    for (int it = lo + gw; it < hi; it += NGW) {
        int r = it;
        if (r < PI_IN) { const int db = r / (D / 64), kb = r % (D / 64), drow0 = 32 * db; int scol0, nvalid;
            if (drow0 < 2048) { scol0 = drow0; nvalid = 32; }
            else if (drow0 < 2560) { scol0 = drow0 + 128; nvalid = 32; }
            else if (drow0 < 2688) { scol0 = drow0 - 512; nvalid = 32; }
            else if (drow0 < 2752) { scol0 = drow0; nvalid = 32; }
            else if (drow0 == 2752) { scol0 = 2752; nvalid = 8; }
            else if (drow0 < PC_GA) { scol0 = 0; nvalid = 0; }
            else { scol0 = drow0 - 56; nvalid = 32; }
            if (drow0 >= PC_GA) p0_transpose_item(P.w_in, D, NPROJ_SRC, 64 * kb, scol0, nvalid, (bf16*)(P.ws + WS_WG8), drow0 - PC_GA, P.g_mix, scr, F.lane, D, 64 * kb, true);
            else p0_transpose_item(P.w_in, D, NPROJ_SRC, 64 * kb, scol0, nvalid, WinT, drow0, P.g_mix, scr, F.lane);
            continue; } r -= PI_IN;
        if (r < PI_A) { const int db = r / (DCONV / 64), kb = r % (DCONV / 64); p0_transpose_item(P.w_a, DCONV, D, 64 * kb, 32 * db, 32, WaT, 32 * db, nullptr, scr, F.lane, D, 64 * kb); continue; } r -= PI_A;
        if (r < PI_B) { const int db = r / (DATT / 64), kb = r % (DATT / 64); p0_transpose_item(P.w_b, DATT, D, 64 * kb, 32 * db, 32, WaT, 32 * db, nullptr, scr, F.lane, D, DCONV + 64 * kb); continue; } r -= PI_B;
        if (r < PI_O) { const int db = r / (D / 64), kb = r % (D / 64); p0_transpose_item(P.w_out, D, D, 64 * kb, 32 * db, 32, WoutT, 32 * db, nullptr, scr, F.lane); continue; } r -= PI_O;
        if (r < PI_GU) { const int db = r / (D / 64), kb = r % (D / 64), drow0 = 32 * db, p = drow0 >> 8, bj = (drow0 >> 7) & 1, q = (drow0 >> 5) & 3;
            p0_transpose_item(bj ? P.w_u : P.w_g, D, FF, 64 * kb, 128 * p + 32 * q, 32, WguT, drow0, P.g_ffn, scr, F.lane); continue; } r -= PI_GU;
        { const int db = r / (FF / 64), kb = r % (FF / 64); p0_transpose_item(P.w_d, FF, D, 64 * kb, 32 * db, 32, WdT, 32 * db, nullptr, scr, F.lane); }
    }
}
__device__ __forceinline__ void p0_prologue(Frame& F, const Ptrs& P, bool all_weights) {
    const int gw = F.vcu * NWAVES + F.wave, NGW = F.G * NWAVES;
    p0_weight_items(F, P, 0, all_weights ? PI_ALL : PI_IN, gw, NGW);
    bf16* XB = (bf16*)P.out; float* SSQ0 = (float*)(P.ws + WS_SSQ0);
    for (int m = gw; m < M; m += 2 * NGW) { const int m1 = (m + NGW < M) ? m + NGW : m;
        x_rows2_to_bf16(F.lane, P.x + (size_t)m * D, P.x + (size_t)m1 * D, XB + (size_t)m * D, XB + (size_t)m1 * D, SSQ0 + m, SSQ0 + m1, (unsigned*)(P.ws + WS_XB8) + (size_t)m * (D / 4), (unsigned*)(P.ws + WS_XB8) + (size_t)m1 * (D / 4)); }
}

namespace pg8 {
template <bool F8_> struct EpiProj {
    static constexpr bool PERM = true, AFTER_DRAIN = false, HAS_PRE = true, HAS_MID = false, HAS_EXT = false, F8 = F8_;
    static constexpr int NVM = 16;
    bf16_t* O; int ldc; bf16_t* KV; bf16_t* IKF; bf16_t* IW; int kv_tile; PG8_LAS const float* bgate; int gate_col0; bf16_t* JUNK; const float* SSQ; PG8_LAS float* RS; int pn0;
    __device__ __forceinline__ void pre(const Unit& u, int wr, int fr, float (&carry)[8]) const {
        const int have = __builtin_amdgcn_readfirstlane(__builtin_bit_cast(int, carry[0])) - 1;
        if (u.pm != have) { const int par = __builtin_amdgcn_readfirstlane(__builtin_bit_cast(int, carry[1])) ^ 1; const int t = threadIdx.x;
            if (t < BM) RS[par * BM + t] = 1.0f / sqrtf(SSQ[u.pm * BM + t] * (1.0f / D) + 1e-6f);
            carry[0] = __builtin_bit_cast(float, u.pm + 1); carry[1] = __builtin_bit_cast(float, par); }
    }
    template <bool GATE> __device__ __forceinline__ void body(const f32x4 (&acc)[2][2][4][2], const Unit& u0, int wr, int wc, int fr, int fq, const float (&carry)[8]) const {
        Unit u; u.pm = u0.pm; u.pn = u0.pn + pn0;
        int row0 = u.pm * BM + wr * 64 + fr; const bool kv = !GATE && (u.pn == kv_tile); int cid = 4 * wc + fq;
        asm volatile("" : "+v"(row0), "+v"(cid));
        const PG8_LAS float* rs = RS + __builtin_amdgcn_readfirstlane(__builtin_bit_cast(int, carry[1])) * BM + wr * 64 + fr;
        float rst[8];
#pragma unroll
        for (int ai = 0; ai < 2; ++ai)
#pragma unroll
            for (int m = 0; m < 4; ++m) rst[4 * ai + m] = rs[ai * HALF + m * 16];
        f32x4 gb0[2], gb1[2];
#pragma unroll
        for (int bj = 0; bj < 2; ++bj) { gb0[bj] = (f32x4){0.f, 0.f, 0.f, 0.f}; gb1[bj] = gb0[bj];
            if (GATE) { PG8_LAS const float* bp = bgate + (u.pn * BM - gate_col0) + bj * HALF + 8 * cid; gb0[bj] = *(PG8_LAS const f32x4*)bp; gb1[bj] = *(PG8_LAS const f32x4*)(bp + 4); } }
#pragma unroll
        for (int ai = 0; ai < 2; ++ai)
#pragma unroll
            for (int m = 0; m < 4; ++m) { const int row = row0 + ai * HALF + m * 16;
#pragma unroll
                for (int bj = 0; bj < 2; ++bj) { f32x4 v0 = acc[ai][bj][m][0] * rst[4 * ai + m], v1 = acc[ai][bj][m][1] * rst[4 * ai + m];
                    if (GATE) {
                        v0 = v0 + gb0[bj]; v1 = v1 + gb1[bj]; unsigned q[8];
#pragma unroll
                        for (int k = 0; k < 4; ++k) { q[k] = (unsigned)__builtin_amdgcn_fmed3f(fast_sigmoid(v0[k]) * 256.0f + 0.5f, 1.0f, 255.0f); q[4 + k] = (unsigned)__builtin_amdgcn_fmed3f(fast_sigmoid(v1[k]) * 256.0f + 0.5f, 1.0f, 255.0f); }
                        typedef unsigned u32x2g __attribute__((ext_vector_type(2)));
                        u32x2g w8; w8.x = q[0] | (q[1] << 8) | (q[2] << 16) | (q[3] << 24); w8.y = q[4] | (q[5] << 8) | (q[6] << 16) | (q[7] << 24);
                        *(u32x2g*)((unsigned char*)(O + (size_t)row * ldc + gate_col0) + (u.pn * BM - gate_col0) + bj * HALF + 8 * cid) = w8;
                        continue; }
                    u32x4 w; w.x = cvt_pk_bf16(v0[0], v0[1]); w.y = cvt_pk_bf16(v0[2], v0[3]); w.z = cvt_pk_bf16(v1[0], v1[1]); w.w = cvt_pk_bf16(v1[2], v1[3]);
                    if (!kv) *(u32x4*)(O + (size_t)row * ldc + u.pn * BM + bj * HALF + 8 * cid) = w;
                    else if (bj == 0) { typedef unsigned u32x2k __attribute__((ext_vector_type(2)));
                        int k0 = __builtin_amdgcn_cvt_pk_fp8_f32(v0[0], v0[1], 0, false); k0 = __builtin_amdgcn_cvt_pk_fp8_f32(v0[2], v0[3], k0, true);
                        int k1 = __builtin_amdgcn_cvt_pk_fp8_f32(v1[0], v1[1], 0, false); k1 = __builtin_amdgcn_cvt_pk_fp8_f32(v1[2], v1[3], k1, true);
                        u32x2k w8; w8.x = (unsigned)k0; w8.y = (unsigned)k1; *(u32x2k*)((unsigned char*)KV + (size_t)row * 128 + 8 * cid) = w8; }
                    else if (cid < 8) { const int s = row & 4095; *(u32x4*)(IKF + (size_t)(row >> 12) * (4096 * 64) + (s >> 5) * 2048 + cid * 256 + (s & 31) * 8) = w; }
                    else if (cid == 8) *(u32x4*)(IW + (size_t)row * 8) = w;
                    else *(u32x4*)(JUNK + (size_t)(row & 1023) * 8) = w; } }
    }
    __device__ __forceinline__ void run(const f32x4 (&acc)[2][2][4][2], const Unit& u, int wr, int wc, int fr, int fq, const float (&carry)[8]) const {
        if ((u.pn + pn0) * BM >= gate_col0) body<true>(acc, u, wr, wc, fr, fq, carry); else body<false>(acc, u, wr, wc, fr, fq, carry);
    }
};
template <bool ACCUM> struct EpiGate {
    static constexpr bool PERM = true, AFTER_DRAIN = false, HAS_PRE = false, HAS_MID = false, HAS_EXT = false, F8 = false;
    static constexpr int NVM = 0;
    bf16_t* O; const bf16_t* G; int ldg; const float* bg;
    __device__ __forceinline__ void operator()(const f32x4 (&acc)[2][2][4][2], const Unit& u, int wr, int wc, int fr, int fq) const {
        const int row0 = u.pm * BM + wr * 64 + fr, col0 = u.pn * BM + wc * 32 + 8 * fq;
        f32x4 bv[2][2];
#pragma unroll
        for (int bj = 0; bj < 2; ++bj)
#pragma unroll
            for (int n = 0; n < 2; ++n) bv[bj][n] = *(const f32x4*)(bg + col0 + bj * HALF + 4 * n);
#pragma unroll
        for (int ai = 0; ai < 2; ++ai) {
            u32x4 gv[4][2], ov[4][2];
#pragma unroll
            for (int m = 0; m < 4; ++m) { const size_t row = (size_t)(row0 + ai * HALF + m * 16);
#pragma unroll
                for (int bj = 0; bj < 2; ++bj) { gv[m][bj] = *(const u32x4*)(G + row * ldg + col0 + bj * HALF); if (ACCUM) ov[m][bj] = *(const u32x4*)(O + row * D + col0 + bj * HALF); } }
#pragma unroll
            for (int m = 0; m < 4; ++m) { const size_t row = (size_t)(row0 + ai * HALF + m * 16);
#pragma unroll
                for (int bj = 0; bj < 2; ++bj) { const u32x4 g4 = gv[m][bj];
                    float g[8] = {bf_lo(g4.x), bf_hi(g4.x), bf_lo(g4.y), bf_hi(g4.y), bf_lo(g4.z), bf_hi(g4.z), bf_lo(g4.w), bf_hi(g4.w)};
                    float o[8];
#pragma unroll
                    for (int k = 0; k < 4; ++k) { o[k] = fast_sigmoid(g[k] + bv[bj][0][k]) * acc[ai][bj][m][0][k]; o[4 + k] = fast_sigmoid(g[4 + k] + bv[bj][1][k]) * acc[ai][bj][m][1][k]; }
                    if (ACCUM) { const u32x4 o4 = ov[m][bj];
                        o[0] += bf_lo(o4.x); o[1] += bf_hi(o4.x); o[2] += bf_lo(o4.y); o[3] += bf_hi(o4.y); o[4] += bf_lo(o4.z); o[5] += bf_hi(o4.z); o[6] += bf_lo(o4.w); o[7] += bf_hi(o4.w); }
                    u32x4 w; w.x = cvt_pk_bf16(o[0], o[1]); w.y = cvt_pk_bf16(o[2], o[3]); w.z = cvt_pk_bf16(o[4], o[5]); w.w = cvt_pk_bf16(o[6], o[7]);
                    *(u32x4*)(O + row * D + col0 + bj * HALF) = w; } }
            asm volatile("" ::: "memory"); }
    }
};
struct EpiGateMerged {
    static constexpr bool PERM = true, AFTER_DRAIN = false, HAS_PRE = false, HAS_MID = true, HAS_EXT = false, F8 = false; static constexpr int MID_T = 8;
    static constexpr int NVM = 16;
    bf16_t* O; const unsigned char* G8; int ldgb;
    typedef unsigned u32x2g __attribute__((ext_vector_type(2)));
    static __device__ __forceinline__ void unpack8(u32x2g g, float (&f)[8]) {
        f[0] = (float)(g.x & 255u); f[1] = (float)((g.x >> 8) & 255u); f[2] = (float)((g.x >> 16) & 255u); f[3] = (float)(g.x >> 24);
        f[4] = (float)(g.y & 255u); f[5] = (float)((g.y >> 8) & 255u); f[6] = (float)((g.y >> 16) & 255u); f[7] = (float)(g.y >> 24); }
    __device__ __forceinline__ void mid(f32x4 (&acc)[2][2][4][2], const Unit& u, int wr, int wc, int fr, int fq) const {
        int row0 = u.pm * BM + wr * 64 + fr, col0 = u.pn * BM + wc * 32 + 8 * fq;
        asm volatile("" : "+v"(row0), "+v"(col0));
#pragma unroll
        for (int bj = 0; bj < 2; ++bj) {
            u32x2g ga[2][4], gb[2][4];
#pragma unroll
            for (int ai = 0; ai < 2; ++ai)
#pragma unroll
                for (int m = 0; m < 4; ++m) { const unsigned char* gp = G8 + (size_t)(row0 + ai * HALF + m * 16) * ldgb + col0 + bj * HALF;
                    ga[ai][m] = *(const u32x2g*)gp; gb[ai][m] = *(const u32x2g*)(gp + D); }
#pragma unroll
            for (int ai = 0; ai < 2; ++ai)
#pragma unroll
                for (int m = 0; m < 4; ++m) { float xa[8], xb[8]; unpack8(ga[ai][m], xa); unpack8(gb[ai][m], xb);
#pragma unroll
                    for (int k = 0; k < 4; ++k) { acc[ai][bj][m][0][k] *= xa[k] * __builtin_amdgcn_rcpf(xb[k]); acc[ai][bj][m][1][k] *= xa[4 + k] * __builtin_amdgcn_rcpf(xb[4 + k]); } }
            asm volatile("" ::: "memory"); }
    }
    __device__ __forceinline__ void operator()(const f32x4 (&acc)[2][2][4][2], const Unit& u, int wr, int wc, int fr, int fq) const {
        int row0 = u.pm * BM + wr * 64 + fr, col0 = u.pn * BM + wc * 32 + 8 * fq;
        asm volatile("" : "+v"(row0), "+v"(col0));
        u32x2g gb[2][4][2];
#pragma unroll
        for (int ai = 0; ai < 2; ++ai)
#pragma unroll
            for (int m = 0; m < 4; ++m) { const unsigned char* gp = G8 + (size_t)(row0 + ai * HALF + m * 16) * ldgb + D + col0;
#pragma unroll
                for (int bj = 0; bj < 2; ++bj) gb[ai][m][bj] = *(const u32x2g*)(gp + bj * HALF); }
#pragma unroll
        for (int ai = 0; ai < 2; ++ai) {
#pragma unroll
            for (int m = 0; m < 4; ++m) { const size_t row = (size_t)(row0 + ai * HALF + m * 16);
#pragma unroll
                for (int bj = 0; bj < 2; ++bj) { float xb[8]; unpack8(gb[ai][m][bj], xb);
                    float o[8];
#pragma unroll
                    for (int k = 0; k < 4; ++k) { o[k] = (xb[k] * 0.00390625f) * acc[ai][bj][m][0][k]; o[4 + k] = (xb[4 + k] * 0.00390625f) * acc[ai][bj][m][1][k]; }
                    u32x4 w; w.x = cvt_pk_bf16(o[0], o[1]); w.y = cvt_pk_bf16(o[2], o[3]); w.z = cvt_pk_bf16(o[4], o[5]); w.w = cvt_pk_bf16(o[6], o[7]);
                    *(u32x4*)(O + row * D + col0 + bj * HALF) = w; } }
            asm volatile("" ::: "memory"); }
    }
};
template <int MODE> struct EpiResid {
    static constexpr bool PERM = false, AFTER_DRAIN = false, HAS_PRE = false, HAS_MID = false, HAS_EXT = (MODE == 2), F8 = false;
    static constexpr int NVM = 32;
    const float* base; const bf16_t* XBin; bf16_t* XB; float* SSQ;
    __device__ __forceinline__ void operator()(const f32x4 (&acc)[2][2][4][2], const Unit& u, int wr, int wc, int fr, int fq) const {
        typedef unsigned u32x2v __attribute__((ext_vector_type(2)));
        const int row0 = u.pm * BM + wr * 64 + fr, col0 = u.pn * BM + wc * 32 + 4 * fq;
#pragma unroll
        for (int ai = 0; ai < 2; ++ai) {
            f32x4 xf[4][2][2]; u32x2v xh[4][2][2];
#pragma unroll
            for (int m = 0; m < 4; ++m) { const size_t row = (size_t)(row0 + ai * HALF + m * 16);
#pragma unroll
                for (int bj = 0; bj < 2; ++bj)
#pragma unroll
                    for (int n = 0; n < 2; ++n) { const size_t off = row * D + col0 + bj * HALF + n * 16;
                        if (MODE == 0) xf[m][bj][n] = *(const f32x4*)(base + off); else if (MODE == 1) xh[m][bj][n] = *(const u32x2v*)(XBin + off); } }
#pragma unroll
            for (int m = 0; m < 4; ++m) { const size_t row = (size_t)(row0 + ai * HALF + m * 16); float ss = 0.f;
#pragma unroll
                for (int bj = 0; bj < 2; ++bj)
#pragma unroll
                    for (int n = 0; n < 2; ++n) { const size_t off = row * D + col0 + bj * HALF + n * 16;
                        f32x4 o;
                        if (MODE == 0) o = xf[m][bj][n] + acc[ai][bj][m][n];
                        else if (MODE == 2) o = acc[ai][bj][m][n];
                        else { const u32x2v xb = xh[m][bj][n]; o = (f32x4){bf_lo(xb.x), bf_hi(xb.x), bf_lo(xb.y), bf_hi(xb.y)} + acc[ai][bj][m][n]; }
                        u32x2v w; w.x = cvt_pk_bf16(o[0], o[1]); w.y = cvt_pk_bf16(o[2], o[3]); *(u32x2v*)(XB + off) = w;
                        ss += (o[0] * o[0] + o[1] * o[1]) + (o[2] * o[2] + o[3] * o[3]); }
                ss += __shfl_xor(ss, 16); ss += __shfl_xor(ss, 32);
                if (fq == 0) __hip_atomic_fetch_add(SSQ + row, ss, __ATOMIC_RELAXED, __HIP_MEMORY_SCOPE_AGENT); }
            asm volatile("" ::: "memory"); }
    }
};
struct EpiFinal {
    static constexpr bool PERM = false, AFTER_DRAIN = false, HAS_PRE = false, HAS_MID = false, HAS_EXT = true, F8 = false;
    static constexpr int NVM = 32;
    float* OUT; float* SSQ; const float* gfin; unsigned* RC; unsigned* tmo;
    __device__ __forceinline__ void operator()(const f32x4 (&acc)[2][2][4][2], const Unit& u, int wr, int wc, int fr, int fq) const {
        const int row0 = u.pm * BM + wr * 64 + fr, col0 = u.pn * BM + wc * 32 + 4 * fq;
#pragma unroll
        for (int ai = 0; ai < 2; ++ai)
#pragma unroll
            for (int m = 0; m < 4; ++m) { float ss = 0.f;
#pragma unroll
                for (int bj = 0; bj < 2; ++bj)
#pragma unroll
                    for (int n = 0; n < 2; ++n) { const f32x4 o = acc[ai][bj][m][n]; ss += (o[0] * o[0] + o[1] * o[1]) + (o[2] * o[2] + o[3] * o[3]); }
                ss += __shfl_xor(ss, 16); ss += __shfl_xor(ss, 32);
                if (fq == 0) __hip_atomic_fetch_add(SSQ + (size_t)(row0 + ai * HALF + m * 16), ss, __ATOMIC_RELAXED, __HIP_MEMORY_SCOPE_AGENT); }
        f32x4 gg[2][2];
#pragma unroll
        for (int bj = 0; bj < 2; ++bj)
#pragma unroll
            for (int n = 0; n < 2; ++n) gg[bj][n] = *(const f32x4*)(gfin + col0 + bj * HALF + n * 16);
        asm volatile("s_waitcnt vmcnt(0)" ::: "memory");
        __builtin_amdgcn_s_barrier();
        if (threadIdx.x == 0) { unsigned* rc = RC + u.pm; (void)__hip_atomic_fetch_add(rc, 1u, __ATOMIC_RELAXED, __HIP_MEMORY_SCOPE_AGENT);
            unsigned sp = 0;
            while (__hip_atomic_load(rc, __ATOMIC_RELAXED, __HIP_MEMORY_SCOPE_AGENT) < 4u) { __builtin_amdgcn_s_sleep(1);
                if ((++sp & 255u) == 0u) { if (__hip_atomic_load(tmo, __ATOMIC_RELAXED, __HIP_MEMORY_SCOPE_AGENT)) break; if (sp > (1u << 18)) { atomicAdd(tmo, 1u); break; } } } }
        __builtin_amdgcn_s_barrier();
        float rs[2][4];
#pragma unroll
        for (int ai = 0; ai < 2; ++ai)
#pragma unroll
            for (int m = 0; m < 4; ++m) { const unsigned b = __hip_atomic_load((const unsigned*)(SSQ + (size_t)(row0 + ai * HALF + m * 16)), __ATOMIC_RELAXED, __HIP_MEMORY_SCOPE_AGENT);
                rs[ai][m] = 1.f / sqrtf(__builtin_bit_cast(float, b) * (1.f / D) + EPS); }
#pragma unroll
        for (int ai = 0; ai < 2; ++ai) {
#pragma unroll
            for (int m = 0; m < 4; ++m) { const size_t row = (size_t)(row0 + ai * HALF + m * 16);
#pragma unroll
                for (int bj = 0; bj < 2; ++bj)
#pragma unroll
                    for (int n = 0; n < 2; ++n) *(f32x4*)(OUT + row * D + col0 + bj * HALF + n * 16) = acc[ai][bj][m][n] * rs[ai][m] * gg[bj][n]; }
            asm volatile("" ::: "memory"); }
    }
};
struct EpiSwiGLU {
    static constexpr bool PERM = true, AFTER_DRAIN = false, HAS_PRE = true, HAS_MID = false, HAS_EXT = false, F8 = false;
    static constexpr int NVM = 8;
    bf16_t* O; int ldc; const float* SSQ; PG8_LAS float* RS;
    __device__ __forceinline__ void pre(const Unit& u, int wr, int fr, float (&carry)[8]) const {
        const int have = __builtin_amdgcn_readfirstlane(__builtin_bit_cast(int, carry[0])) - 1;
        if (u.pm != have) { const int par = __builtin_amdgcn_readfirstlane(__builtin_bit_cast(int, carry[1])) ^ 1; const int t = threadIdx.x;
            if (t < BM) RS[par * BM + t] = 1.0f / sqrtf(SSQ[u.pm * BM + t] * (1.0f / D) + 1e-6f);
            carry[0] = __builtin_bit_cast(float, u.pm + 1); carry[1] = __builtin_bit_cast(float, par); }
    }
    __device__ __forceinline__ void run(const f32x4 (&acc)[2][2][4][2], const Unit& u, int wr, int wc, int fr, int fq, const float (&carry)[8]) const {
        int row0 = u.pm * BM + wr * 64 + fr, col0 = u.pn * HALF + wc * 32 + 8 * fq;
        asm volatile("" : "+v"(row0), "+v"(col0));
        const PG8_LAS float* rs = RS + __builtin_amdgcn_readfirstlane(__builtin_bit_cast(int, carry[1])) * BM + wr * 64 + fr;
        float rst[8];
#pragma unroll
        for (int ai = 0; ai < 2; ++ai)
#pragma unroll
            for (int m = 0; m < 4; ++m) rst[4 * ai + m] = rs[ai * HALF + m * 16];
#pragma unroll
        for (int ai = 0; ai < 2; ++ai)
#pragma unroll
            for (int m = 0; m < 4; ++m) { const size_t row = (size_t)(row0 + ai * HALF + m * 16);
                const float rstd = rst[4 * ai + m];
                float o[8];
#pragma unroll
                for (int n = 0; n < 2; ++n)
#pragma unroll
                    for (int k = 0; k < 4; ++k) { const float g = acc[ai][0][m][n][k] * rstd, up = acc[ai][1][m][n][k] * rstd; o[4 * n + k] = g * fast_sigmoid(g) * up; }
                u32x4 w; w.x = cvt_pk_bf16(o[0], o[1]); w.y = cvt_pk_bf16(o[2], o[3]); w.z = cvt_pk_bf16(o[4], o[5]); w.w = cvt_pk_bf16(o[6], o[7]);
                *(u32x4*)(O + row * ldc + col0) = w; }
    }
};
}

__device__ __forceinline__ void p2_conv(Frame& F, const Ptrs& P) {
    const bf16* PROJ = (const bf16*)(P.ws + WS_PROJ); bf16* CONV = (bf16*)(P.ws + WS_CONV);
    const int gt = F.vcu * (NWAVES * 64) + F.tid, NT = F.G * NWAVES * 64;
    for (int item = gt; item < (M / 16) * (DCONV / 8); item += NT) {
        const int cg = item & 63, rb = item >> 6, c0 = 8 * cg, m0 = 16 * rb, t0 = m0 & (SEQ - 1);
        float w[3][8];
#pragma unroll
        for (int j = 0; j < 3; ++j) { const f32x4 a = *(const GAS f32x4*)(P.conv_w + j * DCONV + c0), b = *(const GAS f32x4*)(P.conv_w + j * DCONV + c0 + 4);
            w[j][0] = a.x; w[j][1] = a.y; w[j][2] = a.z; w[j][3] = a.w; w[j][4] = b.x; w[j][5] = b.y; w[j][6] = b.z; w[j][7] = b.w; }
        float u2[8], u1[8];
#pragma unroll
        for (int k = 0; k < 8; ++k) { u2[k] = 0.f; u1[k] = 0.f; }
        if (t0 >= 2) {
#pragma unroll
            for (int d = 0; d < 2; ++d) { const bf16* rp = PROJ + (size_t)(m0 - 2 + d) * NPROJ;
                const v4u cc = *(const GAS v4u*)(rp + PC_CC + c0), cx = *(const GAS v4u*)(rp + PC_CX + c0);
                float* dst = d ? u1 : u2;
                dst[0] = bf_lo(cc.x) * bf_lo(cx.x); dst[1] = bf_hi(cc.x) * bf_hi(cx.x); dst[2] = bf_lo(cc.y) * bf_lo(cx.y); dst[3] = bf_hi(cc.y) * bf_hi(cx.y);
                dst[4] = bf_lo(cc.z) * bf_lo(cx.z); dst[5] = bf_hi(cc.z) * bf_hi(cx.z); dst[6] = bf_lo(cc.w) * bf_lo(cx.w); dst[7] = bf_hi(cc.w) * bf_hi(cx.w); }
        }
#pragma unroll 4
        for (int i = 0; i < 16; ++i) { const bf16* rp = PROJ + (size_t)(m0 + i) * NPROJ;
            const v4u cb = *(const GAS v4u*)(rp + PC_CB + c0), cc = *(const GAS v4u*)(rp + PC_CC + c0), cx = *(const GAS v4u*)(rp + PC_CX + c0);
            float u0[8], b[8];
            u0[0] = bf_lo(cc.x) * bf_lo(cx.x); u0[1] = bf_hi(cc.x) * bf_hi(cx.x); u0[2] = bf_lo(cc.y) * bf_lo(cx.y); u0[3] = bf_hi(cc.y) * bf_hi(cx.y);
            u0[4] = bf_lo(cc.z) * bf_lo(cx.z); u0[5] = bf_hi(cc.z) * bf_hi(cx.z); u0[6] = bf_lo(cc.w) * bf_lo(cx.w); u0[7] = bf_hi(cc.w) * bf_hi(cx.w);
            b[0] = bf_lo(cb.x); b[1] = bf_hi(cb.x); b[2] = bf_lo(cb.y); b[3] = bf_hi(cb.y); b[4] = bf_lo(cb.z); b[5] = bf_hi(cb.z); b[6] = bf_lo(cb.w); b[7] = bf_hi(cb.w);
            float o[8];
#pragma unroll
            for (int k = 0; k < 8; ++k) { o[k] = b[k] * (w[0][k] * u2[k] + w[1][k] * u1[k] + w[2][k] * u0[k]); u2[k] = u1[k]; u1[k] = u0[k]; }
            v4u ov; ov.x = pk2(o[0], o[1]); ov.y = pk2(o[2], o[3]); ov.z = pk2(o[4], o[5]); ov.w = pk2(o[6], o[7]);
            *(GAS v4u*)(CONV + (size_t)(m0 + i) * D + c0) = ov; }
    }
}

typedef float f32x16 __attribute__((ext_vector_type(16)));
typedef short v4i16_t __attribute__((ext_vector_type(4)));
__device__ __forceinline__ int mbcnt64(unsigned long long m) { return (int)__builtin_amdgcn_mbcnt_hi((unsigned)(m >> 32), __builtin_amdgcn_mbcnt_lo((unsigned)m, 0u)); }
__device__ __forceinline__ int wave_sum_i32(int c) {
    c += __builtin_amdgcn_update_dpp(0, c, 0xB1, 0xf, 0xf, true);
    c += __builtin_amdgcn_update_dpp(0, c, 0x4E, 0xf, 0xf, true);
    c += __builtin_amdgcn_update_dpp(0, c, 0x141, 0xf, 0xf, true);
    c += __builtin_amdgcn_update_dpp(0, c, 0x140, 0xf, 0xf, true);
    return __builtin_amdgcn_readlane(c, 0) + __builtin_amdgcn_readlane(c, 16) + __builtin_amdgcn_readlane(c, 32) + __builtin_amdgcn_readlane(c, 48);
}
__device__ __forceinline__ float z_upper(float p) {
    const bool fl = p > 0.5f; const float pp = fl ? 1.0f - p : p;
    const float t = sqrtf(-2.0f * __logf(pp)); const float z = t - (2.30753f + 0.27061f * t) / (1.0f + t * (0.99229f + 0.04481f * t));
    return fl ? -z : z;
}
constexpr int KPB_UNUSED = 144;
constexpr int VP_UNUSED = 160;
constexpr int SCR_VST = 0;
constexpr int IDX_OFF = TAB_OFF + 4096;
constexpr int CW_Q = 2048;
static_assert(IDX_OFF + 8 * 1280 <= LDS_BYTES, "LDS map (P2)");

__device__ __forceinline__ float fadd_np(float a, float b) { float r; asm("v_add_f32_e32 %0, %1, %2" : "=v"(r) : "v"(a), "v"(b)); return r; }
#define P2_DPPF(c, ctrl) ((c) + __builtin_bit_cast(float, __builtin_amdgcn_update_dpp(0, __builtin_bit_cast(int, (c)), (ctrl), 0xf, 0xf, true)))
__device__ __forceinline__ float wave_total_f32(float c) {
    c = P2_DPPF(c, 0xB1); c = P2_DPPF(c, 0x4E); c = P2_DPPF(c, 0x141); c = P2_DPPF(c, 0x140);
    return __builtin_bit_cast(float, __builtin_amdgcn_readlane(__builtin_bit_cast(int, c), 0)) + __builtin_bit_cast(float, __builtin_amdgcn_readlane(__builtin_bit_cast(int, c), 16)) +
           __builtin_bit_cast(float, __builtin_amdgcn_readlane(__builtin_bit_cast(int, c), 32)) + __builtin_bit_cast(float, __builtin_amdgcn_readlane(__builtin_bit_cast(int, c), 48));
}
template <int NR> __device__ __forceinline__ float lane_count_gt(const float (&v)[64], float tau) {
    const float BIG = 0x1p100f, nb = -tau * BIG; float c0 = 0.f, c1 = 0.f, c2 = 0.f, c3 = 0.f;
#pragma unroll
    for (int i = 0; i < NR; i += 4) {
        c0 = fadd_np(c0, __builtin_amdgcn_fmed3f(__builtin_fmaf(v[i], BIG, nb), 0.f, 1.f)); c1 = fadd_np(c1, __builtin_amdgcn_fmed3f(__builtin_fmaf(v[i + 1], BIG, nb), 0.f, 1.f));
        c2 = fadd_np(c2, __builtin_amdgcn_fmed3f(__builtin_fmaf(v[i + 2], BIG, nb), 0.f, 1.f)); c3 = fadd_np(c3, __builtin_amdgcn_fmed3f(__builtin_fmaf(v[i + 3], BIG, nb), 0.f, 1.f)); }
    return (c0 + c1) + (c2 + c3);
}
template <int NR> __device__ __forceinline__ float lane_count_valid(const float (&v)[64]) {
    float c = 0.f;
#pragma unroll
    for (int i = 0; i < NR; ++i) c += (v[i] > -INFINITY) ? 1.f : 0.f;
    return c;
}
constexpr int P2_MAXPROBE = 8;
template <int NR> __device__ __forceinline__ void topk_search(const float (&v)[64], int nv, float mu, float sg, float& lo_o, float& hi_o, int& need_o, float& nhi_o, float& nlo_o) {
    float tau = mu + z_upper((float)TOPK / (float)nv) * sg;
    float step = fmaxf(0.25f * sg, 1e-6f * (fabsf(mu) + 1e-6f));
    const float wmin = 1e-6f * sg;
    float lo = -INFINITY, hi = INFINITY; int clo = nv, chi = 0; int k = 0; bool found = false; float cl = 0.f, nhi = 0.f, nlo = -1.f;
    const float lt = __builtin_amdgcn_logf((float)TOPK + 0.5f);
    for (int it = 0; it < P2_MAXPROBE; ++it) {
        cl = lane_count_gt<NR>(v, tau);
        const int c = (int)(wave_total_f32(cl) + 0.5f);
        if (c == TOPK) { found = true; break; }
        if (c > TOPK) { lo = tau; clo = c; nlo = cl; } else { hi = tau; chi = c; nhi = cl; }
        if (lo == -INFINITY) { tau = hi - step; step *= 2.f; }
        else if (hi == INFINITY) { tau = lo + step; step *= 2.f; }
        else {
            if (hi - lo < wmin) break;
            ++k; float nt;
            if (k % 3 == 0) nt = 0.5f * (lo + hi);
            else { const float a = __builtin_amdgcn_logf((float)clo + 0.5f), bb = __builtin_amdgcn_logf((float)chi + 0.5f); float f = (a - lt) * __builtin_amdgcn_rcpf(a - bb); f = fminf(fmaxf(f, 0.1f), 0.9f); nt = lo + (hi - lo) * f; }
            if (!(nt > lo && nt < hi)) nt = 0.5f * (lo + hi);
            if (!(nt > lo && nt < hi)) break;
            tau = nt;
        }
    }
    if (found) { lo_o = tau; hi_o = tau; need_o = 0; nhi_o = cl; nlo_o = cl; }
    else { if (hi == INFINITY) { hi = 3.0e38f; chi = 0; nhi = 0.f; }
        if (nlo < 0.f) nlo = lane_count_valid<NR>(v);
        lo_o = lo; hi_o = hi; need_o = TOPK - chi; nhi_o = nhi; nlo_o = nlo; }
}
constexpr int IDXW = 320;
__device__ __forceinline__ int lane_scan_incl(int x, int lane) {
    x += __builtin_amdgcn_update_dpp(0, x, 0x111, 0xf, 0xf, true); x += __builtin_amdgcn_update_dpp(0, x, 0x112, 0xf, 0xf, true);
    x += __builtin_amdgcn_update_dpp(0, x, 0x114, 0xf, 0xf, true); x += __builtin_amdgcn_update_dpp(0, x, 0x118, 0xf, 0xf, true);
    const int r0 = __builtin_amdgcn_readlane(x, 15), r1 = __builtin_amdgcn_readlane(x, 31), r2 = __builtin_amdgcn_readlane(x, 47);
    return x + (lane >= 16 ? r0 : 0) + (lane >= 32 ? r1 : 0) + (lane >= 48 ? r2 : 0);
}
template <int NR> __device__ __forceinline__ void topk_compact_lane(const float (&v)[64], float thr, int cnt, LAS unsigned* IDX, int lane) {
    int k = lane_scan_incl(cnt, lane) - cnt; const int dump = 256 + lane;
#pragma unroll
    for (int i = 0; i < NR; ++i) { const bool a = v[i] > thr; IDX[a ? k : dump] = (unsigned)(512 * (i >> 3) + 8 * lane + (i & 7)); k += a ? 1 : 0; }
}
template <int NR> __device__ __forceinline__ void topk_compact_bracket(const float (&v)[64], float lo, float hi, int need, float nhi_f, float nlo_f, LAS unsigned* IDX, int lane) {
    const int nhi = (int)(nhi_f + 0.5f), nb = (int)(nlo_f + 0.5f) - nhi;
    const int pb = lane_scan_incl(nb, lane) - nb;
    int lim = need - pb; lim = lim < 0 ? 0 : lim; lim = lim > nb ? nb : lim;
    const bool full = (lim == nb), part = (lim > 0) && !full;
    topk_compact_lane<NR>(v, full ? lo : hi, nhi + (full ? nb : 0), IDX, lane);
    const unsigned long long pm = __ballot(part);
    if (pm != 0ull) {
        int k = TOPK - lim, kb = 0; const int dump = 256 + lane;
        asm volatile("" ::: "memory");
#pragma unroll
        for (int i = 0; i < NR; ++i) { const bool c = (v[i] > lo) && !(v[i] > hi); const bool take = part && c && (kb < lim);
            IDX[take ? k : dump] = (unsigned)(512 * (i >> 3) + 8 * lane + (i & 7)); k += take ? 1 : 0; kb += c ? 1 : 0; }
    }
}
typedef _Float16 f16x8 __attribute__((ext_vector_type(8)));
template <int NR> __device__ __forceinline__ int topk_select(const LAS unsigned char* row, int t, LAS unsigned* IDX, int lane) {
    float v[64]; float s1 = 0.f, s2 = 0.f; const int nv = t + 1;
    const int tb = t >> 9;
#pragma unroll
    for (int i = 0; i < NR / 8; ++i) { const f16x8 x = *(const LAS f16x8*)(row + 1024 * i + 16 * lane);
        if (i < tb) {
#pragma unroll
            for (int c = 0; c < 8; ++c) { const float xv = (float)x[c]; s1 += xv; s2 += xv * xv; v[8 * i + c] = xv; } }
        else {
#pragma unroll
            for (int c = 0; c < 8; ++c) { const bool ok = (512 * i + 8 * lane + c) <= t; const float xv = (float)x[c]; const float val = ok ? xv : 0.f; s1 += val; s2 += val * val; v[8 * i + c] = ok ? xv : -INFINITY; } } }
#pragma unroll
    for (int i = NR; i < 64; ++i) v[i] = -INFINITY;
    asm volatile("" ::: "memory");
    if (nv <= TOPK) { topk_compact_lane<NR>(v, -INFINITY, (int)(lane_count_valid<NR>(v) + 0.5f), IDX, lane); return nv; }
    s1 = wave_total_f32(s1); s2 = wave_total_f32(s2);
    const float mu = s1 / (float)nv, var = fmaxf(s2 / (float)nv - mu * mu, 0.f);
    float lo, hi, nhi, nlo; int need;
    topk_search<NR>(v, nv, mu, sqrtf(var), lo, hi, need, nhi, nlo);
    if (need == 0) topk_compact_lane<NR>(v, hi, (int)(nhi + 0.5f), IDX, lane);
    else topk_compact_bracket<NR>(v, lo, hi, need, nhi, nlo, IDX, lane);
    return TOPK;
}

__device__ __forceinline__ unsigned pk4_fp8(float a, float b, float c, float d) { int w = __builtin_amdgcn_cvt_pk_fp8_f32(a, b, 0, false); w = __builtin_amdgcn_cvt_pk_fp8_f32(c, d, w, true); return (unsigned)w; }
typedef int v2i_t __attribute__((ext_vector_type(2)));
typedef long v2l_t __attribute__((ext_vector_type(2)));
#ifndef P2_TR8
#define P2_TR8 1
#endif
__device__ __forceinline__ long p2_vfrag(const LAS unsigned char* buf, int vra, int coff, int fr, int fq) {
#if P2_TR8
    const v2i_t t = __builtin_amdgcn_ds_read_tr8_b64_v2i32((LAS v2i_t*)(buf + vra + coff));
    return (long)((unsigned long long)(unsigned)t.x | ((unsigned long long)(unsigned)t.y << 32));
#else
    unsigned long long r = 0ull;
#pragma unroll
    for (int j = 0; j < 8; ++j) { const int rho = 4 * fq + (j & 3) + 16 * (j >> 2); const int swz = ((rho >> 1) & 7) ^ (4 * (rho >> 4));
        const int chunk = (coff >> 4) ^ ((2 * fq + (((fr >> 1) >> 1) & 1)) ^ (4 * ((fr >> 1) >> 2)));
        r |= (unsigned long long)buf[rho * 128 + 16 * (chunk ^ swz) + fr] << (8 * j); }
    return (long)r;
#endif
}
__device__ __forceinline__ void half_barrier(volatile LAS unsigned* hb, int lane) {
    LDS_WAIT(); asm volatile("" ::: "memory");
    if (lane == 0) {
        const unsigned g = hb[1];
        const unsigned old = __hip_atomic_fetch_add((LAS unsigned*)hb, 1u, __ATOMIC_RELAXED, __HIP_MEMORY_SCOPE_WORKGROUP);
        if (old == 3u) { hb[0] = 0u; hb[1] = g + 1u; }
        else { unsigned sp = 0u; while (hb[1] == g) { __builtin_amdgcn_s_sleep(1); if (++sp > (1u << 22)) break; } }
    }
    asm volatile("" ::: "memory");
}

__device__ __forceinline__ void p2_attn(Frame& F, const Ptrs& P) {
    const bf16* PROJ = (const bf16*)(P.ws + WS_PROJ); const bf16* KVI = (const bf16*)(P.ws + WS_KVI); const bf16* IKFp = (const bf16*)(P.ws + WS_IKF); const bf16* IWp = (const bf16*)(P.ws + WS_IW); bf16* ATTN = (bf16*)(P.ws + WS_CONV);
    const int wave = F.wave, half = wave >> 2, w4 = wave & 3;
    LAS unsigned char* hrows = F.lds + RING_OFF + half * 65536;
    LAS _Float16* SC = (LAS _Float16*)hrows;
    LAS float* TAB = (LAS float*)(F.lds + TAB_OFF);
    for (int e = F.tid; e < 128 * 8; e += NWAVES * 64) { const int d = e >> 3, h = e & 7; int bk;
        if (d < 16) bk = d; else { bk = 16 + (int)(logf((float)d / 16.0f) / 2.0794415416798357f * 16.0f); bk = bk < 31 ? bk : 31; }
        TAB[e] = P.rel_bias[bk * 8 + h] * 1.4426950408889634f; }
    LAS unsigned* IDX = (LAS unsigned*)(F.lds + IDX_OFF + wave * (IDXW * 4));
    constexpr int NU = SEQ / 8;
    volatile LAS unsigned* TK = F.MISC + 16 + 4 * half;
    volatile LAS unsigned* HB = F.MISC + 24 + 2 * half;
    const bool tk_lane = (w4 == 0) && (F.lane == 0);
    int bcur = (int)(xb_xcc_id() & 7u), nexh = 0, parity = 0;
    if (tk_lane) TK[0] = xb_add((unsigned*)(F.ctl + CW_Q + 64 * bcur), 1u);
    __syncthreads();
    bool have = false;
    bf16x8 afr[2][4]; v4u wraw[2][2]; bf16x8 bfr[4][4];
#define P2_ZERO_Q() do { _Pragma("unroll") for (int mt = 0; mt < 2; ++mt) { _Pragma("unroll") for (int ks = 0; ks < 4; ++ks) afr[mt][ks] = (bf16x8){0, 0, 0, 0, 0, 0, 0, 0}; wraw[mt][0] = (v4u){0u, 0u, 0u, 0u}; wraw[mt][1] = (v4u){0u, 0u, 0u, 0u}; } \
        _Pragma("unroll") for (int u = 0; u < 4; ++u) { _Pragma("unroll") for (int ks = 0; ks < 4; ++ks) bfr[u][ks] = (bf16x8){0, 0, 0, 0, 0, 0, 0, 0}; } } while (0)
    P2_ZERO_Q();
#define P2_LOAD_Q(T0) do { _Pragma("unroll") for (int mt = 0; mt < 2; ++mt) { const bf16* qp = PB + (size_t)((T0) + 4 * mt + qrho) * NPROJ + PC_IQ + hrho * 64 + 8 * hh; \
        _Pragma("unroll") for (int ks = 0; ks < 4; ++ks) afr[mt][ks] = *(const GAS bf16x8*)(qp + 16 * ks); \
        _Pragma("unroll") for (int qq = 0; qq < 2; ++qq) wraw[mt][qq] = *(const GAS v4u*)(IWB + (size_t)((T0) + 4 * mt + 2 * hh + qq) * 8); } \
        _Pragma("unroll") for (int u = 0; u < 4; ++u) { const bf16* kp = IKB + (size_t)(w4 + 4 * u) * 2048 + hh * 256 + r32 * 8;     \
            _Pragma("unroll") for (int ks = 0; ks < 4; ++ks) bfr[u][ks] = *(const GAS bf16x8*)(kp + 512 * ks); } } while (0)
    for (;;) {
        const int tk = (int)__builtin_amdgcn_readfirstlane(TK[parity]);
        if (tk >= NU) {
            if (++nexh == BATCH) break;
            bcur = (bcur + 1) & 7;
            half_barrier(HB, F.lane);
            if (tk_lane) TK[parity] = xb_add((unsigned*)(F.ctl + CW_Q + 64 * bcur), 1u);
            half_barrier(HB, F.lane);
            have = false; P2_ZERO_Q();
            continue;
        }
        unsigned nxt = 0u;
        if (tk_lane) nxt = xb_add((unsigned*)(F.ctl + CW_Q + 64 * bcur), 1u);
        int lane = F.lane; asm volatile("" : "+v"(lane));
        const int r32 = lane & 31, hh = lane >> 5, fr = lane & 15, fq = lane >> 4;
        const int qrho = ((r32 >> 4) & 1) + 2 * ((r32 >> 2) & 1), hrho = (r32 & 3) + 4 * ((r32 >> 3) & 1);
        const int b = bcur, t0 = 8 * (NU - 1 - tk);
        const bf16* PB = PROJ + (size_t)b * SEQ * NPROJ; const GAS unsigned char* KB8 = (const GAS unsigned char*)KVI + (size_t)b * SEQ * 128; const bf16* IKB = IKFp + (size_t)b * SEQ * 64; const bf16* IWB = IWp + (size_t)b * SEQ * 8;
        if (!have) P2_LOAD_Q(t0);
        {
            float w[2][16];
#pragma unroll
            for (int mt = 0; mt < 2; ++mt)
#pragma unroll
                for (int qq = 0; qq < 2; ++qq) { const v4u wv = wraw[mt][qq];
                    const float sc = 0.04419417382415922f;
                    w[mt][8 * qq + 0] = bf_lo(wv.x) * sc; w[mt][8 * qq + 1] = bf_hi(wv.x) * sc; w[mt][8 * qq + 2] = bf_lo(wv.y) * sc; w[mt][8 * qq + 3] = bf_hi(wv.y) * sc;
                    w[mt][8 * qq + 4] = bf_lo(wv.z) * sc; w[mt][8 * qq + 5] = bf_hi(wv.z) * sc; w[mt][8 * qq + 6] = bf_lo(wv.w) * sc; w[mt][8 * qq + 7] = bf_hi(wv.w) * sc; }
            const int nkt = (t0 + 8 + 31) >> 5;
            for (int kt0 = w4; kt0 < nkt; kt0 += 16) {
#pragma unroll
                for (int u = 0; u < 4; ++u) { const int kt = kt0 + 4 * u;
                    if (kt < nkt) { const int s = 32 * kt + r32;
                        f32x16 acc0 = {}, acc1 = {};
#pragma unroll
                        for (int ks = 0; ks < 4; ++ks) { acc0 = __builtin_amdgcn_mfma_f32_32x32x16_bf16(afr[0][ks], bfr[u][ks], acc0, 0, 0, 0); acc1 = __builtin_amdgcn_mfma_f32_32x32x16_bf16(afr[1][ks], bfr[u][ks], acc1, 0, 0, 0); }
                        if (kt + 16 < nkt) { const bf16* kp = IKB + (size_t)(kt + 16) * 2048 + hh * 256 + r32 * 8;
#pragma unroll
                            for (int ks = 0; ks < 4; ++ks) bfr[u][ks] = *(const GAS bf16x8*)(kp + 512 * ks); }
                        float s0 = 0.f, s1 = 0.f, s2 = 0.f, s3 = 0.f;
#pragma unroll
                        for (int e = 0; e < 8; ++e) { s0 = __builtin_fmaf(w[0][e], __builtin_amdgcn_fmed3f(acc0[e], 0.f, 3.0e38f), s0); s1 = __builtin_fmaf(w[0][8 + e], __builtin_amdgcn_fmed3f(acc0[8 + e], 0.f, 3.0e38f), s1);
                            s2 = __builtin_fmaf(w[1][e], __builtin_amdgcn_fmed3f(acc1[e], 0.f, 3.0e38f), s2); s3 = __builtin_fmaf(w[1][8 + e], __builtin_amdgcn_fmed3f(acc1[8 + e], 0.f, 3.0e38f), s3); }
                        SC[(2 * hh) * 4096 + s] = (_Float16)s0; SC[(2 * hh + 1) * 4096 + s] = (_Float16)s1; SC[(4 + 2 * hh) * 4096 + s] = (_Float16)s2; SC[(4 + 2 * hh + 1) * 4096 + s] = (_Float16)s3; } }
            }
        }
        if (tk_lane) TK[parity ^ 1] = nxt;
        half_barrier(HB, F.lane);
#pragma nounroll
        for (int qi = 0; qi < 2; ++qi) {
        int lane = F.lane; asm volatile("" : "+v"(lane));
        const int fr = lane & 15, fq = lane >> 4;
        const int qrow = w4 + 4 * qi;
        LAS unsigned char* myrow = hrows + qrow * 8192;
        const int t = t0 + qrow;
        int nsel;
        if (t < 1024) nsel = topk_select<16>(myrow, t, IDX, lane);
        else if (t < 2048) nsel = topk_select<32>(myrow, t, IDX, lane);
        else if (t < 3072) nsel = topk_select<48>(myrow, t, IDX, lane);
        else nsel = topk_select<64>(myrow, t, IDX, lane);
#pragma unroll
        for (int k = 0; k < 4; ++k) { const int jx = lane + 64 * k; if (jx >= nsel) IDX[jx] = 0u; }
        asm volatile("" ::: "memory");
        {
            const float c2 = 0.125f * 1.4426950408889634f;
            long qf8[2];
            { const bf16* qp = PB + (size_t)t * NPROJ + PC_Q + (fr & 7) * 64 + 16 * fq; const v4u q0 = *(const GAS v4u*)qp, q1 = *(const GAS v4u*)(qp + 8);
              qf8[0] = (long)(unsigned long long)(pk4_fp8(bf_lo(q0.x), bf_hi(q0.x), bf_lo(q0.y), bf_hi(q0.y)) | ((unsigned long long)pk4_fp8(bf_lo(q0.z), bf_hi(q0.z), bf_lo(q0.w), bf_hi(q0.w)) << 32));
              qf8[1] = (long)(unsigned long long)(pk4_fp8(bf_lo(q1.x), bf_hi(q1.x), bf_lo(q1.y), bf_hi(q1.y)) | ((unsigned long long)pk4_fp8(bf_lo(q1.z), bf_hi(q1.z), bf_lo(q1.w), bf_hi(q1.w)) << 32)); }
            f32x4 S[8]; unsigned BI[8][2]; const int cls = fr >> 3;
            long vf[8][4];
            {
                v4u kvreg[8][4];
#pragma unroll
                for (int kb = 0; kb < 8; ++kb)
#pragma unroll
                    for (int i = 0; i < 4; ++i) { const unsigned kidx = IDX[32 * kb + 8 * i + (lane >> 3)]; kvreg[kb][i] = *(const GAS v4u*)(KB8 + ((kidx << 7) + (unsigned)(16 * (lane & 7)))); }
#pragma unroll
                for (int jo = 0; jo < 8; ++jo) { const int jt = 2 * jo + cls; const v4u kk = *(const LAS v4u*)(IDX + 16 * jt + 4 * fq); float bz[4];
#pragma unroll
                    for (int r = 0; r < 4; ++r) { const int slot = 16 * jt + 4 * fq + r; int dist = t - (int)kk[r]; dist = dist < 127 ? dist : 127; dist = dist > 0 ? dist : 0;
                        const float bias = TAB[dist * 8 + (fr & 7)]; bz[r] = (slot < nsel) ? bias : -INFINITY; }
                    BI[jo][0] = pg8::cvt_pk_bf16(bz[0], bz[1]); BI[jo][1] = pg8::cvt_pk_bf16(bz[2], bz[3]); }
                const int wsl = (lane >> 3) * 128 + 16 * ((lane & 7) ^ ((lane >> 4) & 3));
                const int rsw = (fr >> 1) & 7;
                const int kra = fr * 128;
                const int vj = fr >> 1, vrho = 4 * fq + (vj & 3) + 16 * (vj >> 2), vswz = (2 * fq + ((vj >> 1) & 1)) ^ (4 * (vj >> 2));
                const int vra = vrho * 128 + 8 * (fr & 1);
                v2l_t kf[2][2];
#define P2_KW(KB) do { LAS unsigned char* kbuf_ = myrow + ((KB) & 1) * 4096; _Pragma("unroll") for (int i = 0; i < 4; ++i) *(LAS v4u*)(kbuf_ + 1024 * i + (wsl ^ (64 * ((i & 1) ^ (i >> 1))))) = kvreg[KB][i]; asm volatile("" ::: "memory"); } while (0)
#define P2_KR(KB) do { const LAS unsigned char* kbuf_ = myrow + ((KB) & 1) * 4096; _Pragma("unroll") for (int tt = 0; tt < 2; ++tt) \
                    kf[(KB) & 1][tt] = *(const LAS v2l_t*)(kbuf_ + 2048 * tt + kra + 16 * ((fq ^ rsw) ^ (4 * tt))); \
                    _Pragma("unroll") for (int mt = 0; mt < 4; ++mt) vf[KB][mt] = p2_vfrag(kbuf_, vra, 16 * ((4 + mt) ^ vswz), fr, fq); asm volatile("" ::: "memory"); } while (0)
                P2_KW(0); P2_KR(0);
#pragma unroll
                for (int kb = 0; kb < 8; ++kb) {
                    if (kb < 7) { P2_KW(kb + 1); P2_KR(kb + 1); }
                    f32x4 a2[2];
#pragma unroll
                    for (int tt = 0; tt < 2; ++tt) { f32x4 a = {0.f, 0.f, 0.f, 0.f};
                        a = __builtin_amdgcn_mfma_f32_16x16x32_fp8_fp8(kf[kb & 1][tt][0], qf8[0], a, 0, 0, 0);
                        a = __builtin_amdgcn_mfma_f32_16x16x32_fp8_fp8(kf[kb & 1][tt][1], qf8[1], a, 0, 0, 0);
                        a2[tt] = a; }
                    S[kb] = cls ? a2[1] : a2[0]; }
#undef P2_KW
#undef P2_KR
            }
            __builtin_amdgcn_sched_barrier(0);
            f32x4 W[8];
            float mx = -INFINITY;
#pragma unroll
            for (int jo = 0; jo < 8; ++jo)
#pragma unroll
                for (int r = 0; r < 4; ++r) { const unsigned bw = BI[jo][r >> 1]; const float sv = S[jo][r];
                    const float l2 = sv * c2 + ((r & 1) ? bf_hi(bw) : bf_lo(bw)); W[jo][r] = l2; mx = fmaxf(mx, l2); }
            mx = fmaxf(mx, __shfl_xor(mx, 8)); mx = fmaxf(mx, __shfl_xor(mx, 16)); mx = fmaxf(mx, __shfl_xor(mx, 32));
            float sum = 0.f;
#pragma unroll
            for (int jo = 0; jo < 8; ++jo)
#pragma unroll
                for (int r = 0; r < 4; ++r) { const float p = __builtin_amdgcn_exp2f(W[jo][r] - mx); W[jo][r] = p; sum += p; }
            sum += __shfl_xor(sum, 8); sum += __shfl_xor(sum, 16); sum += __shfl_xor(sum, 32);
            const float rinv = 0.00390625f / sum;
            f32x4 O[4];
#pragma unroll
            for (int mt = 0; mt < 4; ++mt) O[mt] = (f32x4){0.f, 0.f, 0.f, 0.f};
#pragma unroll
            for (int kb = 0; kb < 8; ++kb) {
                const unsigned pq = pk4_fp8(W[kb][0] * 256.0f, W[kb][1] * 256.0f, W[kb][2] * 256.0f, W[kb][3] * 256.0f);
                const unsigned pp = (unsigned)__builtin_amdgcn_update_dpp(0, (int)pq, 0x128, 0xf, 0xf, true);
                const unsigned long long pf = cls ? ((unsigned long long)pp | ((unsigned long long)pq << 32)) : ((unsigned long long)pq | ((unsigned long long)pp << 32));
#pragma unroll
                for (int mt = 0; mt < 4; ++mt) O[mt] = __builtin_amdgcn_mfma_f32_16x16x32_fp8_fp8(vf[kb][mt], (long)pf, O[mt], 0, 0, 0);
            }
            if (fr < 8) { bf16* op = ATTN + (size_t)(b * SEQ + t) * D + DCONV + fr * 64 + 4 * fq;
#pragma unroll
                for (int mt = 0; mt < 4; ++mt) { typedef unsigned u32x2v __attribute__((ext_vector_type(2)));
                    u32x2v wv; wv.x = pg8::cvt_pk_bf16(O[mt][0] * rinv, O[mt][1] * rinv); wv.y = pg8::cvt_pk_bf16(O[mt][2] * rinv, O[mt][3] * rinv);
                    *(GAS u32x2v*)(op + 16 * mt) = wv; } }
        }
        asm volatile("" ::: "memory");
        }
        __builtin_amdgcn_sched_barrier(0);
        {
            const int tkn = (int)__builtin_amdgcn_readfirstlane(TK[parity ^ 1]);
            have = tkn < NU;
            if (have) { const int t0n = 8 * (NU - 1 - tkn); P2_LOAD_Q(t0n); }
            else P2_ZERO_Q();
        }
        half_barrier(HB, F.lane);
        parity ^= 1;
    }
#undef P2_LOAD_Q
#undef P2_ZERO_Q
    __syncthreads();
}

__device__ __forceinline__ void p8_final_norm(Frame& F, const Ptrs& P) {
    const int gw = F.vcu * NWAVES + F.wave, NGW = F.G * NWAVES; const float* SSQ = (const float*)(P.ws + WS_SSQ2); const bf16* X2B = (const bf16*)(P.ws + WS_XN);
    const GAS f32x4* gr = (const GAS f32x4*)P.g_final + F.lane;
    f32x4 gg[4];
#pragma unroll
    for (int j = 0; j < 4; ++j) gg[j] = gr[64 * j];
    typedef unsigned u32x2v __attribute__((ext_vector_type(2)));
    for (int m = gw; m < M; m += 2 * NGW) { const int m1 = (m + NGW < M) ? m + NGW : m;
        const GAS u32x2v* xa = (const GAS u32x2v*)(X2B + (size_t)m * D) + F.lane; const GAS u32x2v* xb = (const GAS u32x2v*)(X2B + (size_t)m1 * D) + F.lane;
        const float* spa = SSQ + m; const float* spb = SSQ + m1; asm volatile("" : "+v"(spa), "+v"(spb));
        const float pa = *spa, pb = *spb;
        u32x2v va[4], vb[4];
#pragma unroll
        for (int j = 0; j < 4; ++j) { va[j] = xa[64 * j]; vb[j] = xb[64 * j]; }
        const float ra = 1.f / sqrtf(pa * (1.f / D) + EPS), rb = 1.f / sqrtf(pb * (1.f / D) + EPS);
        GAS f32x4* oa = (GAS f32x4*)(P.out + (size_t)m * D) + F.lane; GAS f32x4* ob = (GAS f32x4*)(P.out + (size_t)m1 * D) + F.lane;
#pragma unroll
        for (int j = 0; j < 4; ++j) { oa[64 * j] = (f32x4){bf_lo(va[j].x), bf_hi(va[j].x), bf_lo(va[j].y), bf_hi(va[j].y)} * ra * gg[j];
            if (m1 != m) ob[64 * j] = (f32x4){bf_lo(vb[j].x), bf_hi(vb[j].x), bf_lo(vb[j].y), bf_hi(vb[j].y)} * rb * gg[j]; }
    }
}

struct Args { const float* in[14]; float* out; unsigned char* ws; int ph_lo, ph_hi, li, pad; };
__global__ void __launch_bounds__(NWAVES * 64, 2) skel_fwd(Args args) {
    extern __shared__ __attribute__((aligned(16))) unsigned char lds[];
    Frame F;
    F.lds = (LAS unsigned char*)lds;
    F.MISC = (volatile LAS unsigned*)(F.lds + MISC_OFF);
    F.tid = threadIdx.x; F.lane = F.tid & 63; F.wave = __builtin_amdgcn_readfirstlane(F.tid >> 6);
    F.G = gridDim.x; { const int bx = blockIdx.x; F.vcu = (F.G % 8 == 0) ? (bx % 8) * (F.G / 8) + bx / 8 : bx; }
    Ptrs P;
    P.x = args.in[0]; P.g_mix = args.in[1]; P.w_in = args.in[2]; P.b_gate = args.in[3]; P.conv_w = args.in[4]; P.w_a = args.in[5]; P.w_b = args.in[6]; P.w_out = args.in[7];
    P.rel_bias = args.in[8]; P.g_ffn = args.in[9]; P.w_g = args.in[10]; P.w_u = args.in[11]; P.w_d = args.in[12]; P.g_final = args.in[13];
    P.out = args.out; P.ws = args.ws;
    unsigned char* ws = args.ws;
    F.ctl = (gu32*)(ws + WS_CTL);
    for (int u = F.tid; u < (TAB_OFF - LDSCTL_OFF) / 4; u += NWAVES * 64) ((LAS unsigned*)(F.lds + LDSCTL_OFF))[u] = 0u;
    __syncthreads();
    XcdBarrier bar; bar.bar = (unsigned*)(F.ctl + CW_BAR); bar.x = 0; bar.st = nullptr;
    if (N_LAUNCHES == 1) bar = xcd_barrier_post((unsigned*)(F.ctl + CW_BAR), F.MISC + 8);
#define GRID_BAR() do { if (N_LAUNCHES == 1) { xcd_barrier(bar); } } while (0)
    const int lo = args.ph_lo, hi = args.ph_hi;
#define IN(k) (lo <= (k) && (k) < hi)
#define BOTH(k) (IN(k) && IN((k) + 1))
    bf16* XN = (bf16*)(ws + WS_XN); bf16* PROJ = (bf16*)(ws + WS_PROJ); bf16* CONV = (bf16*)(ws + WS_CONV); bf16* ATTN = (bf16*)(ws + WS_ATTN);
    bf16* MERGED = XN; bf16* X1B = CONV; bf16* ACT = PROJ; bf16* X2B = XN;
    float* SSQ1 = (float*)(ws + WS_SSQ1); float* SSQ2 = (float*)(ws + WS_SSQ2);

    const bool split_w = (N_LAUNCHES == 1) && (F.G == 256);
    const bool fuse_final = (N_LAUNCHES == 1) && (F.G == 256) && IN(7) && IN(8);
    if (IN(0)) { if (blockIdx.x == 0 && F.tid < 256) ((bf16*)(ws + WS_IDENT))[F.tid * 257] = (bf16)0x3F80;
        p0_prologue(F, P, !split_w); if (BOTH(0)) GRID_BAR(); }
    if (IN(1)) {
        LAS float* BGL = (LAS float*)(F.lds + TAB_OFF);
        for (int i = F.tid; i < 2 * D; i += NWAVES * 64) BGL[i] = P.b_gate[i];
        __syncthreads();
        {
            pg8::Gemm g{(const bf16*)P.out  , (const bf16*)(ws + WS_WIN), M, PC_GA, D}; pg8::StaticOrder S; S.init(M, PC_GA, F.G, (int)blockIdx.x);
            pg8::EpiProj<false> E{PROJ, NPROJ, (bf16*)(ws + WS_KVI), (bf16*)(ws + WS_IKF), (bf16*)(ws + WS_IW), PC_KVI / 256, BGL, PC_GA, (bf16*)(ws + WS_IW + MiB), (const float*)(ws + WS_SSQ0), (LAS float*)(F.lds + TAB_OFF + 8192), 0};
            pg8::gemm_phase<pg8::EpiProj<false>, pg8::StaticOrder, PG8_ALIGN, PG8_SP2>(F.lds + RING_OFF, g, S, E); }
        if (split_w && blockIdx.x >= 128) p0_weight_items(F, P, PI_IN, PI_ALL, ((int)blockIdx.x - 128) * NWAVES + F.wave, 128 * NWAVES);
        __syncthreads();
        {
            pg8::Gemm g{(const bf16*)(ws + WS_XB8), (const bf16*)(ws + WS_WG8), M, 2 * D, D / 2}; pg8::StaticOrder S; S.init(M, 2 * D, F.G, (int)blockIdx.x);
            pg8::EpiProj<true> E{PROJ, NPROJ, (bf16*)(ws + WS_KVI), (bf16*)(ws + WS_IKF), (bf16*)(ws + WS_IW), PC_KVI / 256, BGL, PC_GA, (bf16*)(ws + WS_IW + MiB), (const float*)(ws + WS_SSQ0), (LAS float*)(F.lds + TAB_OFF + 8192), PC_GA / 256};
            pg8::gemm_phase<pg8::EpiProj<true>, pg8::StaticOrder, PG8_ALIGN, PG8_SP2>(F.lds + RING_OFF, g, S, E); }
        if (BOTH(1)) GRID_BAR();
    }
    if (IN(2)) { p2_conv(F, P); p2_attn(F, P); if (BOTH(2)) GRID_BAR(); }
    if (IN(3)) {
        pg8::Gemm g{CONV, (const bf16*)(ws + WS_WA), M, D, D}; pg8::StaticOrder S; S.init(M, D, F.G, (int)blockIdx.x);
        pg8::EpiGateMerged E{MERGED, (const unsigned char*)(PROJ + PC_GA), NPROJ * 2};
        pg8::gemm_phase<pg8::EpiGateMerged, pg8::StaticOrder, PG8_ALIGN, PG8_SP2>(F.lds + RING_OFF, g, S, E);
        if (BOTH(4)) GRID_BAR();
    }
    if (IN(5)) {
        pg8::Gemm g{MERGED, (const bf16*)(ws + WS_WOUT), M, D, D, (const bf16*)P.out, (const bf16*)(ws + WS_IDENT), D, BM256}; pg8::StaticOrder S; S.init(M, D, F.G, (int)blockIdx.x);
        pg8::EpiResid<2> E{nullptr, nullptr, X1B, SSQ1};
        pg8::gemm_phase<pg8::EpiResid<2>, pg8::StaticOrder, PG8_ALIGN, PG8_SP2>(F.lds + RING_OFF, g, S, E);
        if (BOTH(5)) GRID_BAR();
    }
    if (IN(6)) {
        pg8::Gemm g{X1B, (const bf16*)(ws + WS_WGU), M, NGU, D}; pg8::StaticOrder S; S.init(M, NGU, F.G, (int)blockIdx.x);
        pg8::EpiSwiGLU E{ACT, FF, SSQ1, (LAS float*)(F.lds + TAB_OFF)};
        pg8::gemm_phase<pg8::EpiSwiGLU, pg8::StaticOrder, PG8_ALIGN, PG8_SP2>(F.lds + RING_OFF, g, S, E);
        if (BOTH(6)) GRID_BAR();
    }
    if (IN(7)) {
        pg8::Gemm g{ACT, (const bf16*)(ws + WS_WD), M, D, FF, X1B, (const bf16*)(ws + WS_IDENT), D, BM256}; pg8::StaticOrder S; S.init(M, D, F.G, (int)blockIdx.x);
        if (fuse_final) {
            pg8::EpiFinal E{P.out, SSQ2, P.g_final, (unsigned*)(ws + WS_RC), (unsigned*)(F.ctl + CW_BAR) + XB_TMO};
            pg8::gemm_phase<pg8::EpiFinal, pg8::StaticOrder, PG8_ALIGN, PG8_SP2>(F.lds + RING_OFF, g, S, E);
        } else {
            pg8::EpiResid<2> E{nullptr, nullptr, X2B, SSQ2};
            pg8::gemm_phase<pg8::EpiResid<2>, pg8::StaticOrder, PG8_ALIGN, PG8_SP2>(F.lds + RING_OFF, g, S, E);
            if (BOTH(7)) GRID_BAR();
        }
    }
    if (IN(8) && !fuse_final) { p8_final_norm(F, P); }
#undef IN
#undef BOTH
#undef GRID_BAR
}

extern "C" void kernel_launch(void* const* d_in, const int* in_sizes, int n_in, void* d_out, int out_size, void* d_ws, size_t ws_size, hipStream_t stream) {
    static int grid = 0;
    if (grid == 0) {
        if (n_in != 14 || in_sizes[0] != M * D || out_size != M * D || ws_size < WS_END) { fprintf(stderr, "kernel_launch: shape/workspace mismatch: n_in %d in0 %d out %d ws %zu (need %zu); nothing launched\n", n_in, n_in > 0 ? in_sizes[0] : -1, out_size, ws_size, (size_t)WS_END); grid = -1; return; }
        int dev = 0, cus = 0, per_cu = 0;
        if (hipGetDevice(&dev) != hipSuccess || hipDeviceGetAttribute(&cus, hipDeviceAttributeMultiprocessorCount, dev) != hipSuccess) { grid = -1; return; }
        if (hipFuncSetAttribute((const void*)skel_fwd, hipFuncAttributeMaxDynamicSharedMemorySize, LDS_BYTES) != hipSuccess) { fprintf(stderr, "kernel_launch: hipFuncSetAttribute failed\n"); grid = -1; return; }
        if (hipOccupancyMaxActiveBlocksPerMultiprocessor(&per_cu, (const void*)skel_fwd, NWAVES * 64, LDS_BYTES) != hipSuccess || per_cu < 1)
            fprintf(stderr, "kernel_launch: note: occupancy query reports %d workgroups per CU\n", per_cu);
        (void)hipGetLastError();
        grid = cus;
    }
    if (grid < 0) return;
    if (hipMemsetAsync((char*)d_ws + WS_CTL, 0, CTL_ZERO_BYTES, stream) != hipSuccess) { fprintf(stderr, "kernel_launch: hipMemsetAsync failed\n"); return; }
    Args a{};
    for (int i = 0; i < 14; ++i) a.in[i] = (const float*)d_in[i];
    a.out = (float*)d_out; a.ws = (unsigned char*)d_ws;
    for (int li = 0; li < N_LAUNCHES; ++li) {
        a.ph_lo = (N_LAUNCHES == PER_PHASE) ? li : 0; a.ph_hi = (N_LAUNCHES == PER_PHASE) ? li + 1 : PER_PHASE; a.li = li;
        hipLaunchKernelGGL(skel_fwd, dim3(grid), dim3(NWAVES * 64), LDS_BYTES, stream, a);
        const hipError_t le = hipPeekAtLastError();
        if (le != hipSuccess) { fprintf(stderr, "kernel_launch: launch %d failed: %s\n", li, hipGetErrorName(le)); break; }
    }
}
```

```cpp
#include <hip/hip_runtime.h>
#include <cstdio>
#include <cstdint>
namespace pg8 {
#define PG8_LAS __attribute__((address_space(3)))
typedef unsigned short bf16_t;
typedef short bf16x8 __attribute__((ext_vector_type(8)));
typedef float f32x4 __attribute__((ext_vector_type(4)));
typedef unsigned u32x4 __attribute__((ext_vector_type(4)));
constexpr int BM = 256, BK = 64, HALF = 128, HTB = HALF * BK * 2  , STAGE_BYTES = 8 * HTB, NXCD = 8, WGM = 8;

__host__ __device__ __forceinline__ int lds_byte(int r, int c) { const int st = (r >> 4) * 2 + (c >> 5), rr = r & 15, cc = c & 31, ob = rr * 64 + cc * 2; return st * 1024 + (ob ^ (((ob >> 9) & 1) << 5)); }
__host__ __device__ __forceinline__ void stage_rc(int b, int& R, int& C) { const int st = b / 1024, sb = b % 1024, swz = sb ^ (((sb >> 9) & 1) << 5); R = (st >> 1) * 16 + swz / 64; C = (st & 1) * 32 + (swz % 64) / 2; }
__host__ __device__ __forceinline__ int perm32(int rho) { const int n = rho >> 4, i = rho & 15; return 8 * (i >> 2) + 4 * n + (i & 3); }

typedef int pg8_v8i __attribute__((ext_vector_type(8)));
__device__ __forceinline__ pg8_v8i pg8_cat8(bf16x8 lo, bf16x8 hi) { typedef int v4i_ __attribute__((ext_vector_type(4))); const v4i_ a = __builtin_bit_cast(v4i_, lo), b = __builtin_bit_cast(v4i_, hi); return (pg8_v8i){a.x, a.y, a.z, a.w, b.x, b.y, b.z, b.w}; }
struct Unit { int pm, pn; };
struct Gemm { const bf16_t* A; const bf16_t* Bt; int M, N, K; const bf16_t* Ae = nullptr; const bf16_t* Bte = nullptr; int lde_a = 0, lde_b = 0; };

struct StaticOrder {
    int nM, nN, nwg, G, c;
    __host__ __device__ void init(int M, int N, int G_, int c_) { nM = M / BM; nN = N / BM; nwg = nM * nN; G = G_; c = c_; }
    __host__ __device__ bool next(int i, Unit& u) const {
        const long L = (long)i * G + c; if (L >= nwg) return false;
        int wgid = (int)L; { const int q = nwg / NXCD, r = nwg % NXCD, xcd = wgid % NXCD, off = wgid / NXCD; wgid = (xcd < r ? xcd * (q + 1) : r * (q + 1) + (xcd - r) * q) + off; }
        const int nig = WGM * nN, gid = wgid / nig, fm = gid * WGM, gsz = (nM - fm) < WGM ? (nM - fm) : WGM;
        u.pm = fm + ((wgid % nig) % gsz); u.pn = (wgid % nig) / gsz; return true;
    }
    __device__ __forceinline__ void a_ready(const Unit&) const {}
    __device__ __forceinline__ void done(const Unit&) const {}
};

typedef float f32x2_cv __attribute__((ext_vector_type(2))); typedef __bf16 bf16x2_cv __attribute__((ext_vector_type(2)));
__device__ __forceinline__ unsigned cvt_pk_bf16(float lo, float hi) { f32x2_cv v = {lo, hi}; bf16x2_cv b = __builtin_convertvector(v, bf16x2_cv); return __builtin_bit_cast(unsigned, b); }
typedef float f32x2 __attribute__((ext_vector_type(2)));
__device__ __forceinline__ f32x2 gelu_pk(f32x2 v) {
    const f32x2 av = __builtin_elementwise_abs(v), d = av * 0.2316418882f + 1.0f;
    f32x2 t; t.x = __builtin_amdgcn_rcpf(d.x); t.y = __builtin_amdgcn_rcpf(d.y);
    f32x2 q = t * 0.5307027145f + (-0.7265760135f); q = q * t + 0.7107068705f; q = q * t + (-0.142248368f); q = q * t + 0.127414796f; q = q * t;
    const f32x2 s = (v * v) * (-0.72134752044f);
    f32x2 e; e.x = __builtin_amdgcn_exp2f(s.x); e.y = __builtin_amdgcn_exp2f(s.y);
    const f32x2 m = v * (q * e), r = v - m;
    f32x2 o; o.x = v.x < 0.f ? m.x : r.x; o.y = v.y < 0.f ? m.y : r.y; return o;
}

template <int ACT  > struct EpiBf16 {
    static constexpr bool PERM = true, AFTER_DRAIN = false, HAS_PRE = false, HAS_MID = false, HAS_EXT = false, F8 = false; static_assert(ACT == 0 || ACT == 1, "EpiBf16: ACT is 0 (none) or 1 (gelu_pk)");
    static constexpr int NVM = 0;
    bf16_t* O; int ldc; const float* bias; int split_cols; size_t split_stride; float scale0;
    __device__ __forceinline__ void operator()(const f32x4 (&acc)[2][2][4][2], const Unit& u, int wr, int wc, int fr, int fq) const {
        const int row0 = u.pm * BM + wr * 64 + fr; int colt = u.pn * BM; bf16_t* base = O;
        float sc = 1.f; if (split_cols) { const int t = colt / split_cols; base += (size_t)t * split_stride; colt -= t * split_cols; if (t == 0) sc = scale0; }
        const int col0 = colt + wc * 32 + 8 * fq, bcol0 = u.pn * BM + wc * 32 + 8 * fq;
        f32x4 bv[2][2];
#pragma unroll
        for (int bj = 0; bj < 2; ++bj)
#pragma unroll
            for (int n = 0; n < 2; ++n) bv[bj][n] = bias ? *(const f32x4*)(bias + bcol0 + bj * HALF + 4 * n) : (f32x4){0.f, 0.f, 0.f, 0.f};
#pragma unroll
        for (int ai = 0; ai < 2; ++ai)
#pragma unroll
            for (int m = 0; m < 4; ++m) { bf16_t* rowp = base + (size_t)(row0 + ai * HALF + m * 16) * ldc + col0;
#pragma unroll
                for (int bj = 0; bj < 2; ++bj) { f32x4 v0 = acc[ai][bj][m][0] + bv[bj][0], v1 = acc[ai][bj][m][1] + bv[bj][1];
                    if (ACT == 1) { f32x2 a = gelu_pk((f32x2){v0[0], v0[1]}), b = gelu_pk((f32x2){v0[2], v0[3]}), c = gelu_pk((f32x2){v1[0], v1[1]}), d = gelu_pk((f32x2){v1[2], v1[3]});
                        v0 = (f32x4){a.x, a.y, b.x, b.y}; v1 = (f32x4){c.x, c.y, d.x, d.y}; }
                    v0 = v0 * sc; v1 = v1 * sc; u32x4 w; w.x = cvt_pk_bf16(v0[0], v0[1]); w.y = cvt_pk_bf16(v0[2], v0[3]); w.z = cvt_pk_bf16(v1[0], v1[1]); w.w = cvt_pk_bf16(v1[2], v1[3]);
                    *(u32x4*)(rowp + bj * HALF) = w; } }
    }
};

template <class Epi, class Sched, bool ALIGN_EPI = false, bool SP2 = false>
__device__ __forceinline__ void gemm_phase(PG8_LAS unsigned char* lds, const Gemm g, const Sched& S, const Epi& E) {
    const int tid = threadIdx.x, wid = __builtin_amdgcn_readfirstlane(tid >> 6), lane = tid & 63, wr = wid >> 2, wc = wid & 3, fr = lane & 15, fq = lane >> 4;
    const int K = g.K, ntm = K / BK, nt = ntm + (Epi::HAS_EXT ? BM / BK : 0);
    unsigned voffA[2], voffB[2];
#pragma unroll
    for (int i = 0; i < 2; ++i) { int R, C; stage_rc(tid * 16 + i * 8192, R, C); const int Rb = Epi::PERM ? ((R & ~31) + perm32(R & 31)) : R;
        voffA[i] = (unsigned)(R * K + C) * 2u; voffB[i] = (unsigned)(Rb * K + C) * 2u; }
    unsigned voffAe[2] = {0u, 0u}, voffBe[2] = {0u, 0u};
    if constexpr (Epi::HAS_EXT) {
#pragma unroll
        for (int i = 0; i < 2; ++i) { int R, C; stage_rc(tid * 16 + i * 8192, R, C); const int Rb = Epi::PERM ? ((R & ~31) + perm32(R & 31)) : R;
            voffAe[i] = (unsigned)(R * g.lde_a + C) * 2u; voffBe[i] = (unsigned)(Rb * g.lde_b + C) * 2u; } }
    const size_t hstepAe = (size_t)HALF * g.lde_a * 2, hstepBe = (size_t)HALF * g.lde_b * 2;
    const size_t kstep = (size_t)(BK * 2);
    const size_t hstep = (size_t)HALF * K * 2;
    const size_t tstep = 2 * hstep;
    const unsigned ldsw = (unsigned)wid * 1024u;
    const int aoff = lds_byte(wr * 64 + fr, fq * 8), boff = lds_byte(wc * 32 + fr, fq * 8);
#define PG8_SA(b, h) (((b) * 2 + (h)) * HTB)
#define PG8_SB(b, h) ((4 + (b) * 2 + (h)) * HTB)
#define PG8_STAGE(bufoff, gbase, voff) do { _Pragma("unroll") for (int _i = 0; _i < 2; ++_i) \
        __builtin_amdgcn_global_load_lds((const unsigned*)((const char*)(gbase) + (voff)[_i]), (PG8_LAS unsigned*)(lds + (bufoff) + ldsw + _i * 8192), 16, 0, 0); } while (0)
#define PG8_LDA(dst, b, h) do { if constexpr (Epi::F8) { _Pragma("unroll") for (int m = 0; m < 4; ++m) dst##8[m] = pg8_cat8(*(const PG8_LAS bf16x8*)(lds + PG8_SA(b, h) + aoff + m * 2048), *(const PG8_LAS bf16x8*)(lds + PG8_SA(b, h) + aoff + m * 2048 + 1024)); } \
        else { _Pragma("unroll") for (int m = 0; m < 4; ++m) _Pragma("unroll") for (int k = 0; k < 2; ++k) dst[m][k] = *(const PG8_LAS bf16x8*)(lds + PG8_SA(b, h) + aoff + m * 2048 + k * 1024); } } while (0)
#define PG8_LDB(dst, b, h) do { if constexpr (Epi::F8) { _Pragma("unroll") for (int n = 0; n < 2; ++n) dst##8[n] = pg8_cat8(*(const PG8_LAS bf16x8*)(lds + PG8_SB(b, h) + boff + n * 2048), *(const PG8_LAS bf16x8*)(lds + PG8_SB(b, h) + boff + n * 2048 + 1024)); } \
        else { _Pragma("unroll") for (int n = 0; n < 2; ++n) _Pragma("unroll") for (int k = 0; k < 2; ++k) dst[n][k] = *(const PG8_LAS bf16x8*)(lds + PG8_SB(b, h) + boff + n * 2048 + k * 1024); } } while (0)
#define PG8_MMA(ai, bj, At, Bt) do { __builtin_amdgcn_s_setprio(1); _Pragma("unroll") for (int m = 0; m < 4; ++m) _Pragma("unroll") for (int n = 0; n < 2; ++n) { \
        if constexpr (Epi::F8) asm volatile("v_mfma_scale_f32_16x16x128_f8f6f4 %0, %1, %2, %0, %3, %3 op_sel_hi:[0,0,0]" : "+v"(acc[ai][bj][m][n]) : "v"(Bt##8[n]), "v"(At##8[m]), "v"(f8scale));     \
        else { _Pragma("unroll") for (int k = 0; k < 2; ++k) acc[ai][bj][m][n] = __builtin_amdgcn_mfma_f32_16x16x32_bf16(Bt[n][k], At[m][k], acc[ai][bj][m][n], 0, 0, 0); } } __builtin_amdgcn_s_setprio(0); } while (0)
#define PG8_WAIT_V(n) asm volatile("s_waitcnt vmcnt(" #n ")" ::: "memory")
#define PG8_WAIT_VR do { if constexpr (Epi::NVM >= 32) asm volatile("s_waitcnt vmcnt(40)" ::: "memory"); else if constexpr (Epi::NVM >= 16) asm volatile("s_waitcnt vmcnt(24)" ::: "memory"); \
        else if constexpr (Epi::NVM >= 8) asm volatile("s_waitcnt vmcnt(16)" ::: "memory"); else asm volatile("s_waitcnt vmcnt(8)" ::: "memory"); } while (0)
#define PG8_WAIT_L(n) asm volatile("s_waitcnt lgkmcnt(" #n ")" ::: "memory")
#define PG8_BAR __builtin_amdgcn_s_barrier()
#define PG8_SCHED __builtin_amdgcn_sched_barrier(0)
    static_assert(SP2 || !Epi::HAS_EXT, "the K extension is wired into the SP2 loop only");
    Unit cur, nxt; int ui = 0;
    if (!S.next(0, cur)) return;
    f32x4 acc[2][2][4][2];
#pragma unroll
    for (int a = 0; a < 2; ++a)
#pragma unroll
        for (int b = 0; b < 2; ++b)
#pragma unroll
            for (int m = 0; m < 4; ++m)
#pragma unroll
                for (int n = 0; n < 2; ++n) acc[a][b][m][n] = (f32x4){0.f, 0.f, 0.f, 0.f};
    bf16x8 At[4][2], B0[2][2], B1[2][2];
    int f8scale = 0x7f7f7f7f; asm volatile("" : "+v"(f8scale));
    pg8_v8i At8[4], B08[2], B18[2];
    const char* cA = (const char*)g.A + (size_t)cur.pm * tstep; const char* cB = (const char*)g.Bt + (size_t)cur.pn * tstep;
    const char* eA = Epi::HAS_EXT ? (const char*)g.Ae + ((size_t)cur.pm * BM * g.lde_a + (size_t)cur.pn * BM) * 2 : nullptr; const char* eB = (const char*)g.Bte;
    S.a_ready(cur);
    float carry[8] = {0.f, 0.f, 0.f, 0.f, 0.f, 0.f, 0.f, 0.f};
    if constexpr (Epi::HAS_PRE) E.pre(cur, wr, fr, carry);
    if constexpr (SP2) {
        PG8_STAGE(PG8_SB(0, 0), cB, voffB); PG8_STAGE(PG8_SB(0, 1), cB + hstep, voffB); PG8_STAGE(PG8_SA(0, 0), cA, voffA); PG8_STAGE(PG8_SA(0, 1), cA + hstep, voffA);
        if (wr == 1) PG8_BAR;
        PG8_WAIT_V(2); PG8_BAR;
        PG8_STAGE(PG8_SB(1, 0), cB + kstep, voffB); PG8_STAGE(PG8_SA(1, 0), cA + kstep, voffA); PG8_STAGE(PG8_SB(1, 1), cB + hstep + kstep, voffB);
        PG8_WAIT_V(6); PG8_BAR;
    } else {
        PG8_STAGE(PG8_SB(0, 0), cB, voffB); PG8_STAGE(PG8_SA(0, 0), cA, voffA); PG8_STAGE(PG8_SB(0, 1), cB + hstep, voffB); PG8_STAGE(PG8_SA(0, 1), cA + hstep, voffA);
        if (wr == 1) PG8_BAR;
        PG8_WAIT_V(4); PG8_BAR;
        PG8_STAGE(PG8_SB(1, 0), cB + kstep, voffB); PG8_STAGE(PG8_SA(1, 0), cA + kstep, voffA); PG8_STAGE(PG8_SB(1, 1), cB + hstep + kstep, voffB);
        PG8_WAIT_V(6); PG8_BAR;
    }
    for (;;) {
        const bool has_next = S.next(ui + 1, nxt);
        const char* nA = has_next ? (const char*)g.A + (size_t)nxt.pm * tstep : cA; const char* nB = has_next ? (const char*)g.Bt + (size_t)nxt.pn * tstep : cB;
        int t0 = 0;
        if constexpr (SP2 && ALIGN_EPI && Epi::NVM > 0) { if (ui > 0) {
            const char* pa2 = cA + 2 * kstep; const char* pb2 = cB + 2 * kstep; const char* pa3 = pa2 + kstep; const char* pb3 = pb2 + kstep;


            PG8_LDB(B0, 0, 0); PG8_LDB(B1, 0, 1); PG8_SCHED; PG8_LDA(At, 0, 0);
            PG8_WAIT_VR; PG8_WAIT_L(0); PG8_BAR; PG8_MMA(0, 0, At, B0); PG8_MMA(0, 1, At, B1); PG8_BAR; PG8_SCHED;

            PG8_LDA(At, 0, 1); PG8_STAGE(PG8_SB(0, 0), pb2, voffB); PG8_STAGE(PG8_SB(0, 1), pb2 + hstep, voffB); PG8_STAGE(PG8_SA(0, 0), pa2, voffA);
            PG8_WAIT_VR; PG8_WAIT_L(0); PG8_BAR; PG8_MMA(1, 0, At, B0); PG8_MMA(1, 1, At, B1); PG8_BAR; PG8_SCHED;

            PG8_LDB(B0, 1, 0); PG8_LDB(B1, 1, 1); PG8_SCHED; PG8_LDA(At, 1, 0); PG8_STAGE(PG8_SA(0, 1), pa2 + hstep, voffA);
            PG8_WAIT_VR; PG8_WAIT_L(0); PG8_BAR; PG8_MMA(0, 0, At, B0); PG8_MMA(0, 1, At, B1); PG8_BAR; PG8_SCHED;

            PG8_LDA(At, 1, 1); PG8_STAGE(PG8_SB(1, 0), pb3, voffB); PG8_STAGE(PG8_SB(1, 1), pb3 + hstep, voffB); PG8_STAGE(PG8_SA(1, 0), pa3, voffA);
            PG8_WAIT_V(8); PG8_WAIT_L(0); PG8_BAR; PG8_MMA(1, 0, At, B0); PG8_MMA(1, 1, At, B1); PG8_BAR; PG8_SCHED;
            t0 = 2; } }
        for (int t = t0; t < nt; t += 2) {
            if constexpr (Epi::HAS_MID) { if (t == Epi::MID_T) { __builtin_amdgcn_sched_barrier(0); E.mid(acc, cur, wr, wc, fr, fq); __builtin_amdgcn_sched_barrier(0); } }
            const bool last = (t == nt - 2);
            const bool x1 = Epi::HAS_EXT && t >= ntm, x2 = Epi::HAS_EXT && !last && t + 2 >= ntm;
            const char* a1 = x1 ? eA + (size_t)(t + 1 - ntm) * kstep : cA + (size_t)(t + 1) * kstep;
            const char* a2 = last ? nA : (x2 ? eA + (size_t)(t + 2 - ntm) * kstep : cA + (size_t)(t + 2) * kstep);
            const char* b2 = last ? nB : (x2 ? eB + (size_t)(t + 2 - ntm) * kstep : cB + (size_t)(t + 2) * kstep);
            const char* a3 = a2 + kstep; const char* b3 = b2 + kstep;
            const size_t hA1 = x1 ? hstepAe : hstep, hA2 = x2 ? hstepAe : hstep, hB2 = x2 ? hstepBe : hstep;
            unsigned vA1[2], vA2[2], vB2[2];
#pragma unroll
            for (int i = 0; i < 2; ++i) { vA1[i] = x1 ? voffAe[i] : voffA[i]; vA2[i] = x2 ? voffAe[i] : voffA[i]; vB2[i] = x2 ? voffBe[i] : voffB[i]; }
            if (last && has_next) S.a_ready(nxt);
            if constexpr (SP2) {
            PG8_LDB(B0, 0, 0); PG8_LDB(B1, 0, 1); PG8_SCHED; PG8_LDA(At, 0, 0); PG8_STAGE(PG8_SA(1, 1), a1 + hA1, vA1);
            PG8_WAIT_V(8); PG8_WAIT_L(0); PG8_BAR; PG8_MMA(0, 0, At, B0); PG8_MMA(0, 1, At, B1); PG8_BAR; PG8_SCHED;
            PG8_LDA(At, 0, 1); PG8_STAGE(PG8_SB(0, 0), b2, vB2); PG8_STAGE(PG8_SB(0, 1), b2 + hB2, vB2); PG8_STAGE(PG8_SA(0, 0), a2, vA2);
            PG8_WAIT_V(8); PG8_WAIT_L(0); PG8_BAR; PG8_MMA(1, 0, At, B0); PG8_MMA(1, 1, At, B1); PG8_BAR; PG8_SCHED;
            PG8_LDB(B0, 1, 0); PG8_LDB(B1, 1, 1); PG8_SCHED; PG8_LDA(At, 1, 0); PG8_STAGE(PG8_SA(0, 1), a2 + hA2, vA2);
            PG8_WAIT_V(8); PG8_WAIT_L(0); PG8_BAR; PG8_MMA(0, 0, At, B0); PG8_MMA(0, 1, At, B1); PG8_BAR; PG8_SCHED;
            PG8_LDA(At, 1, 1); PG8_STAGE(PG8_SB(1, 0), b3, vB2); PG8_STAGE(PG8_SB(1, 1), b3 + hB2, vB2); PG8_STAGE(PG8_SA(1, 0), a3, vA2);
            PG8_WAIT_V(8); PG8_WAIT_L(0); PG8_BAR; PG8_MMA(1, 0, At, B0); PG8_MMA(1, 1, At, B1); PG8_BAR; PG8_SCHED;
            } else {
            PG8_LDB(B0, 0, 0); PG8_SCHED; PG8_LDA(At, 0, 0); PG8_STAGE(PG8_SA(1, 1), a1 + hstep, voffA);
            PG8_WAIT_L(8); PG8_BAR; PG8_WAIT_L(0); PG8_MMA(0, 0, At, B0); PG8_BAR; PG8_SCHED;
            PG8_LDB(B1, 0, 1); PG8_STAGE(PG8_SB(0, 0), b2, voffB);
            PG8_BAR; PG8_WAIT_L(0); PG8_MMA(0, 1, At, B1); PG8_BAR;
            PG8_LDA(At, 0, 1); PG8_STAGE(PG8_SA(0, 0), a2, voffA);
            PG8_BAR; PG8_WAIT_L(0); PG8_MMA(1, 0, At, B0); PG8_BAR; PG8_SCHED;
            PG8_STAGE(PG8_SB(0, 1), b2 + hstep, voffB);
            PG8_WAIT_V(6); PG8_BAR; PG8_MMA(1, 1, At, B1); PG8_BAR;
            PG8_LDB(B0, 1, 0); PG8_SCHED; PG8_LDA(At, 1, 0); PG8_STAGE(PG8_SA(0, 1), a2 + hstep, voffA);
            PG8_WAIT_L(8); PG8_BAR; PG8_WAIT_L(0); PG8_MMA(0, 0, At, B0); PG8_BAR; PG8_SCHED;
            PG8_LDB(B1, 1, 1); PG8_STAGE(PG8_SB(1, 0), b3, voffB);
            PG8_BAR; PG8_WAIT_L(0); PG8_MMA(0, 1, At, B1); PG8_BAR;
            PG8_LDA(At, 1, 1); PG8_STAGE(PG8_SA(1, 0), a3, voffA);
            PG8_BAR; PG8_WAIT_L(0); PG8_MMA(1, 0, At, B0); PG8_BAR; PG8_SCHED;
            PG8_STAGE(PG8_SB(1, 1), b3 + hstep, voffB);
            PG8_WAIT_V(6); PG8_BAR; PG8_MMA(1, 1, At, B1); PG8_BAR;
            }
        }
        if constexpr (Epi::F8) asm volatile("s_nop 15\n\ts_nop 15" ::: "memory");
        if constexpr (ALIGN_EPI) { if (wr == 0) PG8_BAR; }
        if constexpr (SP2 && ALIGN_EPI && Epi::NVM > 0) { if (has_next) PG8_STAGE(PG8_SA(1, 1), nA + kstep + hstep, voffA); asm volatile("" ::: "memory"); PG8_SCHED; }
        if constexpr (!Epi::AFTER_DRAIN) { if constexpr (Epi::HAS_PRE) { E.run(acc, cur, wr, wc, fr, fq, carry); if (has_next) E.pre(nxt, wr, fr, carry); } else E(acc, cur, wr, wc, fr, fq); S.done(cur); }
        if (!has_next) break;
#pragma unroll
        for (int a = 0; a < 2; ++a)
#pragma unroll
            for (int b = 0; b < 2; ++b)
#pragma unroll
                for (int m = 0; m < 4; ++m)
#pragma unroll
                    for (int n = 0; n < 2; ++n) { acc[a][b][m][n] = (f32x4){0.f, 0.f, 0.f, 0.f}; asm volatile("" : "+v"(acc[a][b][m][n])); }
        cur = nxt; cA = nA; cB = nB; ++ui;
        if constexpr (Epi::HAS_EXT) eA = (const char*)g.Ae + ((size_t)cur.pm * BM * g.lde_a + (size_t)cur.pn * BM) * 2;
        if constexpr (ALIGN_EPI) { if (wr == 1) PG8_BAR; }
    }
    PG8_WAIT_V(0);
    if constexpr (!ALIGN_EPI) { if (wr == 0) PG8_BAR; }
    PG8_BAR;
    if constexpr (Epi::AFTER_DRAIN) { E.fused(acc, cur, wr, wc, fr, fq, lds, wid, lane); S.done(cur); }
#undef PG8_SA
#undef PG8_SB
#undef PG8_STAGE
#undef PG8_LDA
#undef PG8_LDB
#undef PG8_MMA
#undef PG8_WAIT_V
#undef PG8_WAIT_L
#undef PG8_BAR
#undef PG8_SCHED
}
}

#ifndef PG8_SP2
#define PG8_SP2 true
#endif
#ifndef PG8_ALIGN
#define PG8_ALIGN true
#endif
#define GAS __attribute__((address_space(1)))
#define LAS __attribute__((address_space(3)))
typedef unsigned short bf16;
typedef unsigned v4u __attribute__((ext_vector_type(4)));
typedef float f32x4 __attribute__((ext_vector_type(4)));
typedef short bf16x8 __attribute__((ext_vector_type(8)));
typedef GAS unsigned gu32;
typedef GAS unsigned long long gu64;
#define RLX_AGENT __ATOMIC_RELAXED, __HIP_MEMORY_SCOPE_AGENT
#define LDS_WAIT() asm volatile("s_waitcnt lgkmcnt(0)" ::: "memory")
#define VM_WAIT() asm volatile("s_waitcnt vmcnt(0)" ::: "memory")
__device__ __forceinline__ unsigned long long rt() { return __builtin_amdgcn_s_memrealtime(); }
__device__ __forceinline__ unsigned f2bf(float f) { unsigned u = __builtin_bit_cast(unsigned, f); return (u + 0x7fffu + ((u >> 16) & 1u)) >> 16; }
__device__ __forceinline__ unsigned pk2(float lo, float hi) { return f2bf(lo) | (f2bf(hi) << 16); }

#define XB_TMO      128
#define XB_XCNT(j)  (256  + 64 * (j))
#define XB_XSUB(j)  (1280 + 64 * (j))
#define XB_XGEN(j)  (2304 + 64 * (j))
#define XB_TOP      3328
#define XB_TOPGEN   3392
#define XCD_BAR_WORDS 3456
#define XB_SPIN_CAP (1u << 18)

__device__ __forceinline__ unsigned xb_ld(unsigned* p)              { return __hip_atomic_load(p, __ATOMIC_RELAXED, __HIP_MEMORY_SCOPE_AGENT); }
__device__ __forceinline__ unsigned xb_add(unsigned* p, unsigned v) { return __hip_atomic_fetch_add(p, v, __ATOMIC_RELAXED, __HIP_MEMORY_SCOPE_AGENT); }
__device__ __forceinline__ unsigned xb_xcc_id() { return (unsigned)__builtin_amdgcn_s_getreg((3 << 11) | 20) & 0xFu; }
#define XB_SPIN(cond, bar) do { unsigned _sp = 0; while (cond) { __builtin_amdgcn_s_sleep(1); \
    if ((++_sp & 255u) == 0u) { if (xb_ld(&(bar)[XB_TMO])) break; if (_sp > XB_SPIN_CAP) { atomicAdd(&(bar)[XB_TMO], 1u); break; } } } } while (0)

struct XcdBarrier {
    unsigned* bar; unsigned x;
    volatile LAS unsigned* st;
};

__device__ __forceinline__ XcdBarrier xcd_barrier_post(unsigned* bar, volatile LAS unsigned* st) {
    XcdBarrier b; b.bar = bar; b.x = xb_xcc_id(); b.st = st;
    if (threadIdx.x == 0) (void)xb_add(&bar[XB_XCNT(b.x)], 1u);
    return b;
}
__device__ __forceinline__ void xcd_barrier_complete(unsigned* bar, unsigned x, unsigned& nloc, unsigned& nx) {
    const unsigned G = gridDim.x * gridDim.y * gridDim.z;
    unsigned sum, cnt, mine, sp = 0u;
    for (;;) {
        sum = 0u; cnt = 0u; mine = 0u;
#pragma unroll
        for (unsigned j = 0; j < 16; ++j) { const unsigned c = xb_ld(&bar[XB_XCNT(j)]); sum += c; cnt += (c > 0u) ? 1u : 0u; mine = (j == x) ? c : mine; }
        if (sum == G) break;
        __builtin_amdgcn_s_sleep(1);
        if ((++sp & 255u) == 0u) { if (xb_ld(&bar[XB_TMO])) break; if (sp > XB_SPIN_CAP) { atomicAdd(&bar[XB_TMO], 1u); break; } }
    }
    nloc = mine > 0u ? mine : 1u; nx = cnt > 0u ? cnt : 1u;
}

__device__ __forceinline__ void xcd_barrier(const XcdBarrier& b) {
    asm volatile("s_waitcnt vmcnt(0)" ::: "memory");
    __syncthreads();
    if (threadIdx.x == 0) {
        unsigned* bar = b.bar;
        __builtin_amdgcn_s_waitcnt(0);
        unsigned nloc = b.st[0], nx = b.st[1];
        if (nloc == 0u) { xcd_barrier_complete(bar, b.x, nloc, nx); b.st[0] = nloc; b.st[1] = nx; }
        const unsigned old = xb_add(&bar[XB_XSUB(b.x)], 1u);
        const unsigned gen = old / nloc;
        if (old + 1u == (gen + 1u) * nloc) {
            __builtin_amdgcn_fence(__ATOMIC_RELEASE, "agent");
            asm volatile("s_waitcnt vmcnt(0)" ::: "memory");
            const unsigned og = xb_add(&bar[XB_TOP], 1u);
            const unsigned tg = og / nx;
            if (og + 1u == (tg + 1u) * nx) xb_add(&bar[XB_TOPGEN], 1u);
            else XB_SPIN(xb_ld(&bar[XB_TOPGEN]) == tg, bar);
            __builtin_amdgcn_fence(__ATOMIC_ACQUIRE, "agent");
            xb_add(&bar[XB_XGEN(b.x)], 1u);
            asm volatile("s_waitcnt vmcnt(0)" ::: "memory");
        } else {
            XB_SPIN(xb_ld(&bar[XB_XGEN(b.x)]) == gen, bar);
            __builtin_amdgcn_fence(__ATOMIC_ACQUIRE, "agent");
            asm volatile("s_waitcnt vmcnt(0)" ::: "memory");
        }
    }
    __syncthreads();
}

constexpr int NWAVES = 8;
#ifndef MK_N_LAUNCHES
#define MK_N_LAUNCHES 1
#endif
constexpr int PER_PHASE = 9;
constexpr int N_LAUNCHES = MK_N_LAUNCHES;
static_assert(N_LAUNCHES == 1 || N_LAUNCHES == PER_PHASE, "MK_N_LAUNCHES is 1 or 9");

constexpr int BATCH = 8, SEQ = 4096, D = 1024, M = BATCH * SEQ;
constexpr int DCONV = 512, DATT = 512, NH = 8, HD = 64, FF = 2816, NGU = 2 * FF;
constexpr int NPROJ_SRC = 4808, NPROJ = 4864;
constexpr int PC_CB = 0, PC_CC = 512, PC_CX = 1024, PC_Q = 1536, PC_IQ = 2048, PC_KVI = 2560, PC_GA = 2816, PC_GB = 3840;
constexpr int KVP = 128, KV_K = 0, KV_V = 64;
constexpr float EPS = 1e-6f;
constexpr int TOPK = 256;

constexpr size_t MiB = 1u << 20;
constexpr size_t WS_CTL = 0, CTL_ZERO_BYTES = 1 * MiB;
constexpr size_t WS_SSQ1 = 256 * 1024, WS_SSQ2 = 512 * 1024;
constexpr size_t WS_RC = 896 * 1024;
constexpr size_t WS_IDENT = 768 * 1024;
constexpr int BM256 = 256;
constexpr size_t WS_WIN = 6 * MiB, WS_WA = 16 * MiB, WS_WB = 17 * MiB, WS_WOUT = 18 * MiB, WS_WGU = 20 * MiB, WS_WD = 31 * MiB;
constexpr size_t WS_XN = 40 * MiB;
constexpr size_t WS_CONV = 104 * MiB, WS_ATTN = 136 * MiB;
constexpr size_t WS_PROJ = 168 * MiB;
constexpr size_t WS_KVI = 472 * MiB;
constexpr size_t WS_IKF = 480 * MiB, WS_IW = 484 * MiB;
constexpr size_t WS_WG8 = 37 * MiB;
constexpr size_t WS_XB8 = WS_XN;
constexpr size_t WS_SSQ0 = WS_IW + 3 * MiB;
constexpr size_t WS_END = 488 * MiB;
static_assert(WS_WIN + (size_t)NPROJ * D * 2 <= WS_WA && WS_WGU + (size_t)NGU * D * 2 <= WS_WD && WS_WD + (size_t)D * FF * 2 <= WS_XN, "weights map");
static_assert(WS_PROJ + (size_t)M * NPROJ * 2 <= WS_KVI && WS_KVI + (size_t)M * KVP * 2 <= WS_IKF && WS_IKF + (size_t)M * 64 * 2 <= WS_IW && WS_IW + (size_t)M * 16 <= WS_END && WS_XN + (size_t)M * D * 2 <= WS_CONV && WS_ATTN + (size_t)M * 512 * 2 <= WS_PROJ, "activation map");
constexpr int CW_BAR = 4096;

constexpr int RING_OFF = 0, RING_BYTES = 131072;
constexpr int LDSCTL_OFF = RING_BYTES, MISC_OFF = LDSCTL_OFF + 320;
constexpr int TAB_OFF = RING_BYTES + 1024;
constexpr int LDS_BYTES = 147456;
static_assert(MISC_OFF + 128 <= TAB_OFF && TAB_OFF + 4096 <= LDS_BYTES, "LDS map");

struct Frame {
    LAS unsigned char* lds;
    volatile LAS unsigned* MISC;
    gu32* ctl;
    int tid, lane, wave;
    int vcu, G;
};

__device__ __forceinline__ float wave_sum(float v) {
#pragma unroll
    for (int o = 1; o < 64; o <<= 1) v += __shfl_xor(v, o);
    return v;
}
__device__ __forceinline__ float bf_lo(unsigned w) { return __builtin_bit_cast(float, w << 16); }
__device__ __forceinline__ float bf_hi(unsigned w) { return __builtin_bit_cast(float, w & 0xffff0000u); }
__device__ __forceinline__ float fast_sigmoid(float z) { return __builtin_amdgcn_rcpf(1.0f + __builtin_amdgcn_exp2f(-1.4426950408889634f * z)); }

__device__ __forceinline__ void p0_transpose_item(const float* W, int K, int N, int k0, int scol0, int nvalid, bf16* WT, int drow0, const float* kscale, LAS float* scr, int lane, int ldk = 0, int kd0 = -1, bool f8 = false) {
    if (ldk == 0) ldk = K; if (kd0 < 0) kd0 = k0;
    const int kr = lane >> 3, j4 = lane & 7;
    f32x4 v[8];
#pragma unroll
    for (int i = 0; i < 8; ++i) { v[i] = (f32x4){0.f, 0.f, 0.f, 0.f};
        if (4 * j4 < nvalid) v[i] = *(const GAS f32x4*)(W + (size_t)(k0 + 8 * i + kr) * N + scol0 + 4 * j4); }
    if (kscale) {
#pragma unroll
        for (int i = 0; i < 8; ++i) v[i] = v[i] * kscale[k0 + 8 * i + kr]; }
#pragma unroll
    for (int i = 0; i < 8; ++i) { LAS float* d = scr + (8 * i + kr) * 33 + 4 * j4; d[0] = v[i].x; d[1] = v[i].y; d[2] = v[i].z; d[3] = v[i].w; }
    LDS_WAIT(); asm volatile("" ::: "memory");
    const int c = lane & 7;
#pragma unroll
    for (int jj = 0; jj < 4; ++jj) { const int n = (lane >> 3) + 8 * jj; const LAS float* s = scr + (8 * c) * 33 + n;
        v4u o; o.x = pk2(s[0 * 33], s[1 * 33]); o.y = pk2(s[2 * 33], s[3 * 33]); o.z = pk2(s[4 * 33], s[5 * 33]); o.w = pk2(s[6 * 33], s[7 * 33]);
        if (!f8) *(GAS v4u*)(WT + (size_t)(drow0 + n) * ldk + kd0 + 8 * c) = o;
        else { typedef unsigned u32x2w __attribute__((ext_vector_type(2)));
            int q0 = __builtin_amdgcn_cvt_pk_fp8_f32(s[0 * 33], s[1 * 33], 0, false); q0 = __builtin_amdgcn_cvt_pk_fp8_f32(s[2 * 33], s[3 * 33], q0, true);
            int q1 = __builtin_amdgcn_cvt_pk_fp8_f32(s[4 * 33], s[5 * 33], 0, false); q1 = __builtin_amdgcn_cvt_pk_fp8_f32(s[6 * 33], s[7 * 33], q1, true);
            u32x2w o8; o8.x = (unsigned)q0; o8.y = (unsigned)q1; *(GAS u32x2w*)((unsigned char*)WT + (size_t)(drow0 + n) * ldk + kd0 + 8 * c) = o8; } }
    LDS_WAIT(); asm volatile("" ::: "memory");
}
__device__ __forceinline__ void rms_rows2_to_bf16(int lane, const float* xrow0, const float* xrow1, const float* g, bf16* orow0, bf16* orow1) {
    const GAS f32x4* xa = (const GAS f32x4*)xrow0 + lane; const GAS f32x4* xb = (const GAS f32x4*)xrow1 + lane; const GAS f32x4* gr = (const GAS f32x4*)g + lane;
    f32x4 va[4], vb[4]; float sa = 0.f, sb = 0.f;
#pragma unroll
    for (int j = 0; j < 4; ++j) { va[j] = xa[64 * j]; vb[j] = xb[64 * j]; }
#pragma unroll
    for (int j = 0; j < 4; ++j) { sa += (va[j].x * va[j].x + va[j].y * va[j].y) + (va[j].z * va[j].z + va[j].w * va[j].w); sb += (vb[j].x * vb[j].x + vb[j].y * vb[j].y) + (vb[j].z * vb[j].z + vb[j].w * vb[j].w); }
#pragma unroll
    for (int o = 1; o < 64; o <<= 1) { sa += __shfl_xor(sa, o); sb += __shfl_xor(sb, o); }
    const float ra = 1.f / sqrtf(sa * (1.f / D) + EPS), rb = 1.f / sqrtf(sb * (1.f / D) + EPS);
    GAS unsigned long long* oa = (GAS unsigned long long*)orow0 + lane; GAS unsigned long long* ob = (GAS unsigned long long*)orow1 + lane;
#pragma unroll
    for (int j = 0; j < 4; ++j) { const f32x4 gg = gr[64 * j];
        oa[64 * j] = (unsigned long long)pk2(va[j].x * ra * gg.x, va[j].y * ra * gg.y) | ((unsigned long long)pk2(va[j].z * ra * gg.z, va[j].w * ra * gg.w) << 32);
        ob[64 * j] = (unsigned long long)pk2(vb[j].x * rb * gg.x, vb[j].y * rb * gg.y) | ((unsigned long long)pk2(vb[j].z * rb * gg.z, vb[j].w * rb * gg.w) << 32); }
}

__device__ __forceinline__ void x_rows2_to_bf16(int lane, const float* xrow0, const float* xrow1, bf16* orow0, bf16* orow1, float* ss0, float* ss1, unsigned* o8row0, unsigned* o8row1) {
    const GAS f32x4* xa = (const GAS f32x4*)xrow0 + lane; const GAS f32x4* xb = (const GAS f32x4*)xrow1 + lane;
    f32x4 va[4], vb[4]; float sa = 0.f, sb = 0.f;
#pragma unroll
    for (int j = 0; j < 4; ++j) { va[j] = xa[64 * j]; vb[j] = xb[64 * j]; }
    GAS unsigned long long* oa = (GAS unsigned long long*)orow0 + lane; GAS unsigned long long* ob = (GAS unsigned long long*)orow1 + lane;
#pragma unroll
    for (int j = 0; j < 4; ++j) { sa += (va[j].x * va[j].x + va[j].y * va[j].y) + (va[j].z * va[j].z + va[j].w * va[j].w); sb += (vb[j].x * vb[j].x + vb[j].y * vb[j].y) + (vb[j].z * vb[j].z + vb[j].w * vb[j].w);
        oa[64 * j] = (unsigned long long)pk2(va[j].x, va[j].y) | ((unsigned long long)pk2(va[j].z, va[j].w) << 32);
        ob[64 * j] = (unsigned long long)pk2(vb[j].x, vb[j].y) | ((unsigned long long)pk2(vb[j].z, vb[j].w) << 32);
        { int q = __builtin_amdgcn_cvt_pk_fp8_f32(va[j].x, va[j].y, 0, false); q = __builtin_amdgcn_cvt_pk_fp8_f32(va[j].z, va[j].w, q, true); ((GAS unsigned*)o8row0)[lane + 64 * j] = (unsigned)q; }
        { int q = __builtin_amdgcn_cvt_pk_fp8_f32(vb[j].x, vb[j].y, 0, false); q = __builtin_amdgcn_cvt_pk_fp8_f32(vb[j].z, vb[j].w, q, true); ((GAS unsigned*)o8row1)[lane + 64 * j] = (unsigned)q; } }
#pragma unroll
    for (int o = 1; o < 64; o <<= 1) { sa += __shfl_xor(sa, o); sb += __shfl_xor(sb, o); }
    if (lane == 0) { *ss0 = sa; *ss1 = sb; }
}

struct Ptrs {
    const float *x, *g_mix, *w_in, *b_gate, *conv_w, *w_a, *w_b, *w_out, *rel_bias, *g_ffn, *w_g, *w_u, *w_d, *g_final;
    float* out; unsigned char* ws;
};

constexpr int PI_IN = (NPROJ / 32) * (D / 64), PI_A = (D / 32) * (DCONV / 64), PI_B = (D / 32) * (DATT / 64), PI_O = (D / 32) * (D / 64), PI_GU = (NGU / 32) * (D / 64), PI_D = (D / 32) * (FF / 64);
constexpr int PI_ALL = PI_IN + PI_A + PI_B + PI_O + PI_GU + PI_D;
__device__ __forceinline__ void p0_weight_items(Frame& F, const Ptrs& P, int lo, int hi, int gw, int NGW) {
    LAS float* scr = (LAS float*)(F.lds + RING_OFF + F.wave * 16384);
    bf16* WinT = (bf16*)(P.ws + WS_WIN); bf16* WaT = (bf16*)(P.ws + WS_WA); bf16* WbT = (bf16*)(P.ws + WS_WB); bf16* WoutT = (bf16*)(P.ws + WS_WOUT);
    bf16* WguT = (bf16*)(P.ws + WS_WGU); bf16* WdT = (bf16*)(P.ws + WS_WD);
    for (int it = lo + gw; it < hi; it += NGW) {
        int r = it;
        if (r < PI_IN) { const int db = r / (D / 64), kb = r % (D / 64), drow0 = 32 * db; int scol0, nvalid;
            if (drow0 < 2048) { scol0 = drow0; nvalid = 32; }
            else if (drow0 < 2560) { scol0 = drow0 + 128; nvalid = 32; }
            else if (drow0 < 2688) { scol0 = drow0 - 512; nvalid = 32; }
            else if (drow0 < 2752) { scol0 = drow0; nvalid = 32; }
            else if (drow0 == 2752) { scol0 = 2752; nvalid = 8; }
            else if (drow0 < PC_GA) { scol0 = 0; nvalid = 0; }
            else { scol0 = drow0 - 56; nvalid = 32; }
            if (drow0 >= PC_GA) p0_transpose_item(P.w_in, D, NPROJ_SRC, 64 * kb, scol0, nvalid, (bf16*)(P.ws + WS_WG8), drow0 - PC_GA + DATT, P.g_mix, scr, F.lane, D, 64 * kb, true);
            else if (drow0 >= PC_Q && drow0 < PC_IQ) p0_transpose_item(P.w_in, D, NPROJ_SRC, 64 * kb, scol0, nvalid, (bf16*)(P.ws + WS_WG8), drow0 - PC_Q, P.g_mix, scr, F.lane, D, 64 * kb, true);
            else p0_transpose_item(P.w_in, D, NPROJ_SRC, 64 * kb, scol0, nvalid, WinT, drow0 < PC_Q ? drow0 : drow0 - DATT, P.g_mix, scr, F.lane);
            continue; } r -= PI_IN;
        if (r < PI_A) { const int db = r / (DCONV / 64), kb = r % (DCONV / 64); p0_transpose_item(P.w_a, DCONV, D, 64 * kb, 32 * db, 32, WaT, 32 * db, nullptr, scr, F.lane, D, 64 * kb); continue; } r -= PI_A;
        if (r < PI_B) { const int db = r / (DATT / 64), kb = r % (DATT / 64); p0_transpose_item(P.w_b, DATT, D, 64 * kb, 32 * db, 32, WaT, 32 * db, nullptr, scr, F.lane, D, DCONV + 64 * kb); continue; } r -= PI_B;
        if (r < PI_O) { const int db = r / (D / 64), kb = r % (D / 64); p0_transpose_item(P.w_out, D, D, 64 * kb, 32 * db, 32, WoutT, 32 * db, nullptr, scr, F.lane); continue; } r -= PI_O;
        if (r < PI_GU) { const int db = r / (D / 64), kb = r % (D / 64), drow0 = 32 * db, p = drow0 >> 8, bj = (drow0 >> 7) & 1, q = (drow0 >> 5) & 3;
            p0_transpose_item(bj ? P.w_u : P.w_g, D, FF, 64 * kb, 128 * p + 32 * q, 32, WguT, drow0, P.g_ffn, scr, F.lane); continue; } r -= PI_GU;
        { const int db = r / (FF / 64), kb = r % (FF / 64); p0_transpose_item(P.w_d, FF, D, 64 * kb, 32 * db, 32, WdT, 32 * db, nullptr, scr, F.lane); }
    }
}
__device__ __forceinline__ void p0_prologue(Frame& F, const Ptrs& P, bool all_weights) {
    const int gw = F.vcu * NWAVES + F.wave, NGW = F.G * NWAVES;
    p0_weight_items(F, P, 0, all_weights ? PI_ALL : PI_IN, gw, NGW);
    bf16* XB = (bf16*)P.out; float* SSQ0 = (float*)(P.ws + WS_SSQ0);
    for (int m = gw; m < M; m += 2 * NGW) { const int m1 = (m + NGW < M) ? m + NGW : m;
        x_rows2_to_bf16(F.lane, P.x + (size_t)m * D, P.x + (size_t)m1 * D, XB + (size_t)m * D, XB + (size_t)m1 * D, SSQ0 + m, SSQ0 + m1, (unsigned*)(P.ws + WS_XB8) + (size_t)m * (D / 4), (unsigned*)(P.ws + WS_XB8) + (size_t)m1 * (D / 4)); }
}

namespace pg8 {
template <bool F8_> struct EpiProj {
    static constexpr bool PERM = true, AFTER_DRAIN = false, HAS_PRE = true, HAS_MID = false, HAS_EXT = false, F8 = F8_;
    static constexpr int NVM = 16;
    bf16_t* O; int ldc; bf16_t* KV; bf16_t* IKF; bf16_t* IW; int kv_tile; PG8_LAS const float* bgate; int gate_col0; bf16_t* JUNK; const float* SSQ; PG8_LAS float* RS; int pn_split, pn_off0, pn_off1;
    __device__ __forceinline__ void pre(const Unit& u, int wr, int fr, float (&carry)[8]) const {
        const int have = __builtin_amdgcn_readfirstlane(__builtin_bit_cast(int, carry[0])) - 1;
        if (u.pm != have) { const int par = __builtin_amdgcn_readfirstlane(__builtin_bit_cast(int, carry[1])) ^ 1; const int t = threadIdx.x;
            if (t < BM) RS[par * BM + t] = 1.0f / sqrtf(SSQ[u.pm * BM + t] * (1.0f / D) + 1e-6f);
            carry[0] = __builtin_bit_cast(float, u.pm + 1); carry[1] = __builtin_bit_cast(float, par); }
    }
    template <bool GATE> __device__ __forceinline__ void body(const f32x4 (&acc)[2][2][4][2], const Unit& u0, int wr, int wc, int fr, int fq, const float (&carry)[8]) const {
        Unit u; u.pm = u0.pm; u.pn = u0.pn + (u0.pn < pn_split ? pn_off0 : pn_off1);
        int row0 = u.pm * BM + wr * 64 + fr; const bool kv = !GATE && (u.pn == kv_tile); int cid = 4 * wc + fq;
        asm volatile("" : "+v"(row0), "+v"(cid));
        const PG8_LAS float* rs = RS + __builtin_amdgcn_readfirstlane(__builtin_bit_cast(int, carry[1])) * BM + wr * 64 + fr;
        float rst[8];
#pragma unroll
        for (int ai = 0; ai < 2; ++ai)
#pragma unroll
            for (int m = 0; m < 4; ++m) rst[4 * ai + m] = rs[ai * HALF + m * 16];
        f32x4 gb0[2], gb1[2];
#pragma unroll
        for (int bj = 0; bj < 2; ++bj) { gb0[bj] = (f32x4){0.f, 0.f, 0.f, 0.f}; gb1[bj] = gb0[bj];
            if (GATE) { PG8_LAS const float* bp = bgate + (u.pn * BM - gate_col0) + bj * HALF + 8 * cid; gb0[bj] = *(PG8_LAS const f32x4*)bp; gb1[bj] = *(PG8_LAS const f32x4*)(bp + 4); } }
#pragma unroll
        for (int ai = 0; ai < 2; ++ai)
#pragma unroll
            for (int m = 0; m < 4; ++m) { const int row = row0 + ai * HALF + m * 16;
#pragma unroll
                for (int bj = 0; bj < 2; ++bj) { f32x4 v0 = acc[ai][bj][m][0] * rst[4 * ai + m], v1 = acc[ai][bj][m][1] * rst[4 * ai + m];
                    if (GATE) {
                        v0 = v0 + gb0[bj]; v1 = v1 + gb1[bj]; unsigned q[8];
#pragma unroll
                        for (int k = 0; k < 4; ++k) { q[k] = (unsigned)__builtin_amdgcn_fmed3f(fast_sigmoid(v0[k]) * 256.0f + 0.5f, 1.0f, 255.0f); q[4 + k] = (unsigned)__builtin_amdgcn_fmed3f(fast_sigmoid(v1[k]) * 256.0f + 0.5f, 1.0f, 255.0f); }
                        typedef unsigned u32x2g __attribute__((ext_vector_type(2)));
                        u32x2g w8; w8.x = q[0] | (q[1] << 8) | (q[2] << 16) | (q[3] << 24); w8.y = q[4] | (q[5] << 8) | (q[6] << 16) | (q[7] << 24);
                        *(u32x2g*)((unsigned char*)(O + (size_t)row * ldc + gate_col0) + (u.pn * BM - gate_col0) + bj * HALF + 8 * cid) = w8;
                        continue; }
                    u32x4 w; w.x = cvt_pk_bf16(v0[0], v0[1]); w.y = cvt_pk_bf16(v0[2], v0[3]); w.z = cvt_pk_bf16(v1[0], v1[1]); w.w = cvt_pk_bf16(v1[2], v1[3]);
                    if (!kv) *(u32x4*)(O + (size_t)row * ldc + u.pn * BM + bj * HALF + 8 * cid) = w;
                    else if (bj == 0) { typedef unsigned u32x2k __attribute__((ext_vector_type(2)));
                        int k0 = __builtin_amdgcn_cvt_pk_fp8_f32(v0[0], v0[1], 0, false); k0 = __builtin_amdgcn_cvt_pk_fp8_f32(v0[2], v0[3], k0, true);
                        int k1 = __builtin_amdgcn_cvt_pk_fp8_f32(v1[0], v1[1], 0, false); k1 = __builtin_amdgcn_cvt_pk_fp8_f32(v1[2], v1[3], k1, true);
                        u32x2k w8; w8.x = (unsigned)k0; w8.y = (unsigned)k1; *(u32x2k*)((unsigned char*)KV + (size_t)row * 128 + 8 * cid) = w8; }
                    else if (cid < 8) { const int s = row & 4095; *(u32x4*)(IKF + (size_t)(row >> 12) * (4096 * 64) + (s >> 5) * 2048 + cid * 256 + (s & 31) * 8) = w; }
                    else if (cid == 8) *(u32x4*)(IW + (size_t)row * 8) = w;
                    else *(u32x4*)(JUNK + (size_t)(row & 1023) * 8) = w; } }
    }
    __device__ __forceinline__ void run(const f32x4 (&acc)[2][2][4][2], const Unit& u, int wr, int wc, int fr, int fq, const float (&carry)[8]) const {
        if ((u.pn + (u.pn < pn_split ? pn_off0 : pn_off1)) * BM >= gate_col0) body<true>(acc, u, wr, wc, fr, fq, carry); else body<false>(acc, u, wr, wc, fr, fq, carry);
    }
};
template <bool ACCUM> struct EpiGate {
    static constexpr bool PERM = true, AFTER_DRAIN = false, HAS_PRE = false, HAS_MID = false, HAS_EXT = false, F8 = false;
    static constexpr int NVM = 0;
    bf16_t* O; const bf16_t* G; int ldg; const float* bg;
    __device__ __forceinline__ void operator()(const f32x4 (&acc)[2][2][4][2], const Unit& u, int wr, int wc, int fr, int fq) const {
        const int row0 = u.pm * BM + wr * 64 + fr, col0 = u.pn * BM + wc * 32 + 8 * fq;
        f32x4 bv[2][2];
#pragma unroll
        for (int bj = 0; bj < 2; ++bj)
#pragma unroll
            for (int n = 0; n < 2; ++n) bv[bj][n] = *(const f32x4*)(bg + col0 + bj * HALF + 4 * n);
#pragma unroll
        for (int ai = 0; ai < 2; ++ai) {
            u32x4 gv[4][2], ov[4][2];
#pragma unroll
            for (int m = 0; m < 4; ++m) { const size_t row = (size_t)(row0 + ai * HALF + m * 16);
#pragma unroll
                for (int bj = 0; bj < 2; ++bj) { gv[m][bj] = *(const u32x4*)(G + row * ldg + col0 + bj * HALF); if (ACCUM) ov[m][bj] = *(const u32x4*)(O + row * D + col0 + bj * HALF); } }
#pragma unroll
            for (int m = 0; m < 4; ++m) { const size_t row = (size_t)(row0 + ai * HALF + m * 16);
#pragma unroll
                for (int bj = 0; bj < 2; ++bj) { const u32x4 g4 = gv[m][bj];
                    float g[8] = {bf_lo(g4.x), bf_hi(g4.x), bf_lo(g4.y), bf_hi(g4.y), bf_lo(g4.z), bf_hi(g4.z), bf_lo(g4.w), bf_hi(g4.w)};
                    float o[8];
#pragma unroll
                    for (int k = 0; k < 4; ++k) { o[k] = fast_sigmoid(g[k] + bv[bj][0][k]) * acc[ai][bj][m][0][k]; o[4 + k] = fast_sigmoid(g[4 + k] + bv[bj][1][k]) * acc[ai][bj][m][1][k]; }
                    if (ACCUM) { const u32x4 o4 = ov[m][bj];
                        o[0] += bf_lo(o4.x); o[1] += bf_hi(o4.x); o[2] += bf_lo(o4.y); o[3] += bf_hi(o4.y); o[4] += bf_lo(o4.z); o[5] += bf_hi(o4.z); o[6] += bf_lo(o4.w); o[7] += bf_hi(o4.w); }
                    u32x4 w; w.x = cvt_pk_bf16(o[0], o[1]); w.y = cvt_pk_bf16(o[2], o[3]); w.z = cvt_pk_bf16(o[4], o[5]); w.w = cvt_pk_bf16(o[6], o[7]);
                    *(u32x4*)(O + row * D + col0 + bj * HALF) = w; } }
            asm volatile("" ::: "memory"); }
    }
};
struct EpiGateMerged {
    static constexpr bool PERM = true, AFTER_DRAIN = false, HAS_PRE = false, HAS_MID = true, HAS_EXT = false, F8 = false; static constexpr int MID_T = 8;
    static constexpr int NVM = 16;
    bf16_t* O; const unsigned char* G8; int ldgb;
    typedef unsigned u32x2g __attribute__((ext_vector_type(2)));
    static __device__ __forceinline__ void unpack8(u32x2g g, float (&f)[8]) {
        f[0] = (float)(g.x & 255u); f[1] = (float)((g.x >> 8) & 255u); f[2] = (float)((g.x >> 16) & 255u); f[3] = (float)(g.x >> 24);
        f[4] = (float)(g.y & 255u); f[5] = (float)((g.y >> 8) & 255u); f[6] = (float)((g.y >> 16) & 255u); f[7] = (float)(g.y >> 24); }
    __device__ __forceinline__ void mid(f32x4 (&acc)[2][2][4][2], const Unit& u, int wr, int wc, int fr, int fq) const {
        int row0 = u.pm * BM + wr * 64 + fr, col0 = u.pn * BM + wc * 32 + 8 * fq;
        asm volatile("" : "+v"(row0), "+v"(col0));
#pragma unroll
        for (int bj = 0; bj < 2; ++bj) {
            u32x2g ga[2][4], gb[2][4];
#pragma unroll
            for (int ai = 0; ai < 2; ++ai)
#pragma unroll
                for (int m = 0; m < 4; ++m) { const unsigned char* gp = G8 + (size_t)(row0 + ai * HALF + m * 16) * ldgb + col0 + bj * HALF;
                    ga[ai][m] = *(const u32x2g*)gp; gb[ai][m] = *(const u32x2g*)(gp + D); }
#pragma unroll
            for (int ai = 0; ai < 2; ++ai)
#pragma unroll
                for (int m = 0; m < 4; ++m) { float xa[8], xb[8]; unpack8(ga[ai][m], xa); unpack8(gb[ai][m], xb);
#pragma unroll
                    for (int k = 0; k < 4; ++k) { acc[ai][bj][m][0][k] *= xa[k] * __builtin_amdgcn_rcpf(xb[k]); acc[ai][bj][m][1][k] *= xa[4 + k] * __builtin_amdgcn_rcpf(xb[4 + k]); } }
            asm volatile("" ::: "memory"); }
    }
    __device__ __forceinline__ void operator()(const f32x4 (&acc)[2][2][4][2], const Unit& u, int wr, int wc, int fr, int fq) const {
        int row0 = u.pm * BM + wr * 64 + fr, col0 = u.pn * BM + wc * 32 + 8 * fq;
        asm volatile("" : "+v"(row0), "+v"(col0));
        u32x2g gb[2][4][2];
#pragma unroll
        for (int ai = 0; ai < 2; ++ai)
#pragma unroll
            for (int m = 0; m < 4; ++m) { const unsigned char* gp = G8 + (size_t)(row0 + ai * HALF + m * 16) * ldgb + D + col0;
#pragma unroll
                for (int bj = 0; bj < 2; ++bj) gb[ai][m][bj] = *(const u32x2g*)(gp + bj * HALF); }
#pragma unroll
        for (int ai = 0; ai < 2; ++ai) {
#pragma unroll
            for (int m = 0; m < 4; ++m) { const size_t row = (size_t)(row0 + ai * HALF + m * 16);
#pragma unroll
                for (int bj = 0; bj < 2; ++bj) { float xb[8]; unpack8(gb[ai][m][bj], xb);
                    float o[8];
#pragma unroll
                    for (int k = 0; k < 4; ++k) { o[k] = (xb[k] * 0.00390625f) * acc[ai][bj][m][0][k]; o[4 + k] = (xb[4 + k] * 0.00390625f) * acc[ai][bj][m][1][k]; }
                    u32x4 w; w.x = cvt_pk_bf16(o[0], o[1]); w.y = cvt_pk_bf16(o[2], o[3]); w.z = cvt_pk_bf16(o[4], o[5]); w.w = cvt_pk_bf16(o[6], o[7]);
                    *(u32x4*)(O + row * D + col0 + bj * HALF) = w; } }
            asm volatile("" ::: "memory"); }
    }
};
template <int MODE> struct EpiResid {
    static constexpr bool PERM = false, AFTER_DRAIN = false, HAS_PRE = false, HAS_MID = false, HAS_EXT = (MODE == 2), F8 = false;
    static constexpr int NVM = 32;
    const float* base; const bf16_t* XBin; bf16_t* XB; float* SSQ;
    __device__ __forceinline__ void operator()(const f32x4 (&acc)[2][2][4][2], const Unit& u, int wr, int wc, int fr, int fq) const {
        typedef unsigned u32x2v __attribute__((ext_vector_type(2)));
        const int row0 = u.pm * BM + wr * 64 + fr, col0 = u.pn * BM + wc * 32 + 4 * fq;
#pragma unroll
        for (int ai = 0; ai < 2; ++ai) {
            f32x4 xf[4][2][2]; u32x2v xh[4][2][2];
#pragma unroll
            for (int m = 0; m < 4; ++m) { const size_t row = (size_t)(row0 + ai * HALF + m * 16);
#pragma unroll
                for (int bj = 0; bj < 2; ++bj)
#pragma unroll
                    for (int n = 0; n < 2; ++n) { const size_t off = row * D + col0 + bj * HALF + n * 16;
                        if (MODE == 0) xf[m][bj][n] = *(const f32x4*)(base + off); else if (MODE == 1) xh[m][bj][n] = *(const u32x2v*)(XBin + off); } }
#pragma unroll
            for (int m = 0; m < 4; ++m) { const size_t row = (size_t)(row0 + ai * HALF + m * 16); float ss = 0.f;
#pragma unroll
                for (int bj = 0; bj < 2; ++bj)
#pragma unroll
                    for (int n = 0; n < 2; ++n) { const size_t off = row * D + col0 + bj * HALF + n * 16;
                        f32x4 o;
                        if (MODE == 0) o = xf[m][bj][n] + acc[ai][bj][m][n];
                        else if (MODE == 2) o = acc[ai][bj][m][n];
                        else { const u32x2v xb = xh[m][bj][n]; o = (f32x4){bf_lo(xb.x), bf_hi(xb.x), bf_lo(xb.y), bf_hi(xb.y)} + acc[ai][bj][m][n]; }
                        u32x2v w; w.x = cvt_pk_bf16(o[0], o[1]); w.y = cvt_pk_bf16(o[2], o[3]); *(u32x2v*)(XB + off) = w;
                        ss += (o[0] * o[0] + o[1] * o[1]) + (o[2] * o[2] + o[3] * o[3]); }
                ss += __shfl_xor(ss, 16); ss += __shfl_xor(ss, 32);
                if (fq == 0) __hip_atomic_fetch_add(SSQ + row, ss, __ATOMIC_RELAXED, __HIP_MEMORY_SCOPE_AGENT); }
            asm volatile("" ::: "memory"); }
    }
};
struct EpiFinal {
    static constexpr bool PERM = false, AFTER_DRAIN = false, HAS_PRE = false, HAS_MID = false, HAS_EXT = true, F8 = false;
    static constexpr int NVM = 32;
    float* OUT; float* SSQ; const float* gfin; unsigned* RC; unsigned* tmo;
    __device__ __forceinline__ void operator()(const f32x4 (&acc)[2][2][4][2], const Unit& u, int wr, int wc, int fr, int fq) const {
        const int row0 = u.pm * BM + wr * 64 + fr, col0 = u.pn * BM + wc * 32 + 4 * fq;
#pragma unroll
        for (int ai = 0; ai < 2; ++ai)
#pragma unroll
            for (int m = 0; m < 4; ++m) { float ss = 0.f;
#pragma unroll
                for (int bj = 0; bj < 2; ++bj)
#pragma unroll
                    for (int n = 0; n < 2; ++n) { const f32x4 o = acc[ai][bj][m][n]; ss += (o[0] * o[0] + o[1] * o[1]) + (o[2] * o[2] + o[3] * o[3]); }
                ss += __shfl_xor(ss, 16); ss += __shfl_xor(ss, 32);
                if (fq == 0) __hip_atomic_fetch_add(SSQ + (size_t)(row0 + ai * HALF + m * 16), ss, __ATOMIC_RELAXED, __HIP_MEMORY_SCOPE_AGENT); }
        f32x4 gg[2][2];
#pragma unroll
        for (int bj = 0; bj < 2; ++bj)
#pragma unroll
            for (int n = 0; n < 2; ++n) gg[bj][n] = *(const f32x4*)(gfin + col0 + bj * HALF + n * 16);
        asm volatile("s_waitcnt vmcnt(0)" ::: "memory");
        __builtin_amdgcn_s_barrier();
        if (threadIdx.x == 0) { unsigned* rc = RC + u.pm; (void)__hip_atomic_fetch_add(rc, 1u, __ATOMIC_RELAXED, __HIP_MEMORY_SCOPE_AGENT);
            unsigned sp = 0;
            while (__hip_atomic_load(rc, __ATOMIC_RELAXED, __HIP_MEMORY_SCOPE_AGENT) < 4u) { __builtin_amdgcn_s_sleep(1);
                if ((++sp & 255u) == 0u) { if (__hip_atomic_load(tmo, __ATOMIC_RELAXED, __HIP_MEMORY_SCOPE_AGENT)) break; if (sp > (1u << 18)) { atomicAdd(tmo, 1u); break; } } } }
        __builtin_amdgcn_s_barrier();
        float rs[2][4];
#pragma unroll
        for (int ai = 0; ai < 2; ++ai)
#pragma unroll
            for (int m = 0; m < 4; ++m) { const unsigned b = __hip_atomic_load((const unsigned*)(SSQ + (size_t)(row0 + ai * HALF + m * 16)), __ATOMIC_RELAXED, __HIP_MEMORY_SCOPE_AGENT);
                rs[ai][m] = 1.f / sqrtf(__builtin_bit_cast(float, b) * (1.f / D) + EPS); }
#pragma unroll
        for (int ai = 0; ai < 2; ++ai) {
#pragma unroll
            for (int m = 0; m < 4; ++m) { const size_t row = (size_t)(row0 + ai * HALF + m * 16);
#pragma unroll
                for (int bj = 0; bj < 2; ++bj)
#pragma unroll
                    for (int n = 0; n < 2; ++n) *(f32x4*)(OUT + row * D + col0 + bj * HALF + n * 16) = acc[ai][bj][m][n] * rs[ai][m] * gg[bj][n]; }
            asm volatile("" ::: "memory"); }
    }
};
struct EpiSwiGLU {
    static constexpr bool PERM = true, AFTER_DRAIN = false, HAS_PRE = true, HAS_MID = false, HAS_EXT = false, F8 = false;
    static constexpr int NVM = 8;
    bf16_t* O; int ldc; const float* SSQ; PG8_LAS float* RS;
    __device__ __forceinline__ void pre(const Unit& u, int wr, int fr, float (&carry)[8]) const {
        const int have = __builtin_amdgcn_readfirstlane(__builtin_bit_cast(int, carry[0])) - 1;
        if (u.pm != have) { const int par = __builtin_amdgcn_readfirstlane(__builtin_bit_cast(int, carry[1])) ^ 1; const int t = threadIdx.x;
            if (t < BM) RS[par * BM + t] = 1.0f / sqrtf(SSQ[u.pm * BM + t] * (1.0f / D) + 1e-6f);
            carry[0] = __builtin_bit_cast(float, u.pm + 1); carry[1] = __builtin_bit_cast(float, par); }
    }
    __device__ __forceinline__ void run(const f32x4 (&acc)[2][2][4][2], const Unit& u, int wr, int wc, int fr, int fq, const float (&carry)[8]) const {
        int row0 = u.pm * BM + wr * 64 + fr, col0 = u.pn * HALF + wc * 32 + 8 * fq;
        asm volatile("" : "+v"(row0), "+v"(col0));
        const PG8_LAS float* rs = RS + __builtin_amdgcn_readfirstlane(__builtin_bit_cast(int, carry[1])) * BM + wr * 64 + fr;
        float rst[8];
#pragma unroll
        for (int ai = 0; ai < 2; ++ai)
#pragma unroll
            for (int m = 0; m < 4; ++m) rst[4 * ai + m] = rs[ai * HALF + m * 16];
#pragma unroll
        for (int ai = 0; ai < 2; ++ai)
#pragma unroll
            for (int m = 0; m < 4; ++m) { const size_t row = (size_t)(row0 + ai * HALF + m * 16);
                const float rstd = rst[4 * ai + m];
                float o[8];
#pragma unroll
                for (int n = 0; n < 2; ++n)
#pragma unroll
                    for (int k = 0; k < 4; ++k) { const float g = acc[ai][0][m][n][k] * rstd, up = acc[ai][1][m][n][k] * rstd; o[4 * n + k] = g * fast_sigmoid(g) * up; }
                u32x4 w; w.x = cvt_pk_bf16(o[0], o[1]); w.y = cvt_pk_bf16(o[2], o[3]); w.z = cvt_pk_bf16(o[4], o[5]); w.w = cvt_pk_bf16(o[6], o[7]);
                *(u32x4*)(O + row * ldc + col0) = w; }
    }
};
}

__device__ __forceinline__ void p2_conv(Frame& F, const Ptrs& P) {
    const bf16* PROJ = (const bf16*)(P.ws + WS_PROJ); bf16* CONV = (bf16*)(P.ws + WS_CONV);
    const int gt = F.vcu * (NWAVES * 64) + F.tid, NT = F.G * NWAVES * 64;
    for (int item = gt; item < (M / 16) * (DCONV / 8); item += NT) {
        const int cg = item & 63, rb = item >> 6, c0 = 8 * cg, m0 = 16 * rb, t0 = m0 & (SEQ - 1);
        float w[3][8];
#pragma unroll
        for (int j = 0; j < 3; ++j) { const f32x4 a = *(const GAS f32x4*)(P.conv_w + j * DCONV + c0), b = *(const GAS f32x4*)(P.conv_w + j * DCONV + c0 + 4);
            w[j][0] = a.x; w[j][1] = a.y; w[j][2] = a.z; w[j][3] = a.w; w[j][4] = b.x; w[j][5] = b.y; w[j][6] = b.z; w[j][7] = b.w; }
        float u2[8], u1[8];
#pragma unroll
        for (int k = 0; k < 8; ++k) { u2[k] = 0.f; u1[k] = 0.f; }
        if (t0 >= 2) {
#pragma unroll
            for (int d = 0; d < 2; ++d) { const bf16* rp = PROJ + (size_t)(m0 - 2 + d) * NPROJ;
                const v4u cc = *(const GAS v4u*)(rp + PC_CC + c0), cx = *(const GAS v4u*)(rp + PC_CX + c0);
                float* dst = d ? u1 : u2;
                dst[0] = bf_lo(cc.x) * bf_lo(cx.x); dst[1] = bf_hi(cc.x) * bf_hi(cx.x); dst[2] = bf_lo(cc.y) * bf_lo(cx.y); dst[3] = bf_hi(cc.y) * bf_hi(cx.y);
                dst[4] = bf_lo(cc.z) * bf_lo(cx.z); dst[5] = bf_hi(cc.z) * bf_hi(cx.z); dst[6] = bf_lo(cc.w) * bf_lo(cx.w); dst[7] = bf_hi(cc.w) * bf_hi(cx.w); }
        }
#pragma unroll 4
        for (int i = 0; i < 16; ++i) { const bf16* rp = PROJ + (size_t)(m0 + i) * NPROJ;
            const v4u cb = *(const GAS v4u*)(rp + PC_CB + c0), cc = *(const GAS v4u*)(rp + PC_CC + c0), cx = *(const GAS v4u*)(rp + PC_CX + c0);
            float u0[8], b[8];
            u0[0] = bf_lo(cc.x) * bf_lo(cx.x); u0[1] = bf_hi(cc.x) * bf_hi(cx.x); u0[2] = bf_lo(cc.y) * bf_lo(cx.y); u0[3] = bf_hi(cc.y) * bf_hi(cx.y);
            u0[4] = bf_lo(cc.z) * bf_lo(cx.z); u0[5] = bf_hi(cc.z) * bf_hi(cx.z); u0[6] = bf_lo(cc.w) * bf_lo(cx.w); u0[7] = bf_hi(cc.w) * bf_hi(cx.w);
            b[0] = bf_lo(cb.x); b[1] = bf_hi(cb.x); b[2] = bf_lo(cb.y); b[3] = bf_hi(cb.y); b[4] = bf_lo(cb.z); b[5] = bf_hi(cb.z); b[6] = bf_lo(cb.w); b[7] = bf_hi(cb.w);
            float o[8];
#pragma unroll
            for (int k = 0; k < 8; ++k) { o[k] = b[k] * (w[0][k] * u2[k] + w[1][k] * u1[k] + w[2][k] * u0[k]); u2[k] = u1[k]; u1[k] = u0[k]; }
            v4u ov; ov.x = pk2(o[0], o[1]); ov.y = pk2(o[2], o[3]); ov.z = pk2(o[4], o[5]); ov.w = pk2(o[6], o[7]);
            *(GAS v4u*)(CONV + (size_t)(m0 + i) * D + c0) = ov; }
    }
}

typedef float f32x16 __attribute__((ext_vector_type(16)));
typedef short v4i16_t __attribute__((ext_vector_type(4)));
__device__ __forceinline__ int mbcnt64(unsigned long long m) { return (int)__builtin_amdgcn_mbcnt_hi((unsigned)(m >> 32), __builtin_amdgcn_mbcnt_lo((unsigned)m, 0u)); }
__device__ __forceinline__ int wave_sum_i32(int c) {
    c += __builtin_amdgcn_update_dpp(0, c, 0xB1, 0xf, 0xf, true);
    c += __builtin_amdgcn_update_dpp(0, c, 0x4E, 0xf, 0xf, true);
    c += __builtin_amdgcn_update_dpp(0, c, 0x141, 0xf, 0xf, true);
    c += __builtin_amdgcn_update_dpp(0, c, 0x140, 0xf, 0xf, true);
    return __builtin_amdgcn_readlane(c, 0) + __builtin_amdgcn_readlane(c, 16) + __builtin_amdgcn_readlane(c, 32) + __builtin_amdgcn_readlane(c, 48);
}
__device__ __forceinline__ float z_upper(float p) {
    const bool fl = p > 0.5f; const float pp = fl ? 1.0f - p : p;
    const float t = sqrtf(-2.0f * __logf(pp)); const float z = t - (2.30753f + 0.27061f * t) / (1.0f + t * (0.99229f + 0.04481f * t));
    return fl ? -z : z;
}
constexpr int KPB_UNUSED = 144;
constexpr int VP_UNUSED = 160;
constexpr int SCR_VST = 0;
constexpr int IDX_OFF = TAB_OFF + 4096;
constexpr int CW_Q = 2048;
static_assert(IDX_OFF + 8 * 1280 <= LDS_BYTES, "LDS map (P2)");

__device__ __forceinline__ float fadd_np(float a, float b) { float r; asm("v_add_f32_e32 %0, %1, %2" : "=v"(r) : "v"(a), "v"(b)); return r; }
#define P2_DPPF(c, ctrl) ((c) + __builtin_bit_cast(float, __builtin_amdgcn_update_dpp(0, __builtin_bit_cast(int, (c)), (ctrl), 0xf, 0xf, true)))
__device__ __forceinline__ float wave_total_f32(float c) {
    c = P2_DPPF(c, 0xB1); c = P2_DPPF(c, 0x4E); c = P2_DPPF(c, 0x141); c = P2_DPPF(c, 0x140);
    return __builtin_bit_cast(float, __builtin_amdgcn_readlane(__builtin_bit_cast(int, c), 0)) + __builtin_bit_cast(float, __builtin_amdgcn_readlane(__builtin_bit_cast(int, c), 16)) +
           __builtin_bit_cast(float, __builtin_amdgcn_readlane(__builtin_bit_cast(int, c), 32)) + __builtin_bit_cast(float, __builtin_amdgcn_readlane(__builtin_bit_cast(int, c), 48));
}
template <int NR> __device__ __forceinline__ float lane_count_gt(const float (&v)[64], float tau) {
    const float BIG = 0x1p100f, nb = -tau * BIG; float c0 = 0.f, c1 = 0.f, c2 = 0.f, c3 = 0.f;
#pragma unroll
    for (int i = 0; i < NR; i += 4) {
        c0 = fadd_np(c0, __builtin_amdgcn_fmed3f(__builtin_fmaf(v[i], BIG, nb), 0.f, 1.f)); c1 = fadd_np(c1, __builtin_amdgcn_fmed3f(__builtin_fmaf(v[i + 1], BIG, nb), 0.f, 1.f));
        c2 = fadd_np(c2, __builtin_amdgcn_fmed3f(__builtin_fmaf(v[i + 2], BIG, nb), 0.f, 1.f)); c3 = fadd_np(c3, __builtin_amdgcn_fmed3f(__builtin_fmaf(v[i + 3], BIG, nb), 0.f, 1.f)); }
    return (c0 + c1) + (c2 + c3);
}
template <int NR> __device__ __forceinline__ float lane_count_valid(const float (&v)[64]) {
    float c = 0.f;
#pragma unroll
    for (int i = 0; i < NR; ++i) c += (v[i] > -INFINITY) ? 1.f : 0.f;
    return c;
}
constexpr int P2_MAXPROBE = 8;
template <int NR> __device__ __forceinline__ void topk_search(const float (&v)[64], int nv, float mu, float sg, float& lo_o, float& hi_o, int& need_o, float& nhi_o, float& nlo_o) {
    float tau = mu + z_upper((float)TOPK / (float)nv) * sg;
    float step = fmaxf(0.25f * sg, 1e-6f * (fabsf(mu) + 1e-6f));
    const float wmin = 1e-6f * sg;
    float lo = -INFINITY, hi = INFINITY; int clo = nv, chi = 0; int k = 0; bool found = false; float cl = 0.f, nhi = 0.f, nlo = -1.f;
    const float lt = __builtin_amdgcn_logf((float)TOPK + 0.5f);
    for (int it = 0; it < P2_MAXPROBE; ++it) {
        cl = lane_count_gt<NR>(v, tau);
        const int c = (int)(wave_total_f32(cl) + 0.5f);
        if (c == TOPK) { found = true; break; }
        if (c > TOPK) { lo = tau; clo = c; nlo = cl; } else { hi = tau; chi = c; nhi = cl; }
        if (lo == -INFINITY) { tau = hi - step; step *= 2.f; }
        else if (hi == INFINITY) { tau = lo + step; step *= 2.f; }
        else {
            if (hi - lo < wmin) break;
            ++k; float nt;
            if (k % 3 == 0) nt = 0.5f * (lo + hi);
            else { const float a = __builtin_amdgcn_logf((float)clo + 0.5f), bb = __builtin_amdgcn_logf((float)chi + 0.5f); float f = (a - lt) * __builtin_amdgcn_rcpf(a - bb); f = fminf(fmaxf(f, 0.1f), 0.9f); nt = lo + (hi - lo) * f; }
            if (!(nt > lo && nt < hi)) nt = 0.5f * (lo + hi);
            if (!(nt > lo && nt < hi)) break;
            tau = nt;
        }
    }
    if (found) { lo_o = tau; hi_o = tau; need_o = 0; nhi_o = cl; nlo_o = cl; }
    else { if (hi == INFINITY) { hi = 3.0e38f; chi = 0; nhi = 0.f; }
        if (nlo < 0.f) nlo = lane_count_valid<NR>(v);
        lo_o = lo; hi_o = hi; need_o = TOPK - chi; nhi_o = nhi; nlo_o = nlo; }
}
constexpr int IDXW = 320;
__device__ __forceinline__ int lane_scan_incl(int x, int lane) {
    x += __builtin_amdgcn_update_dpp(0, x, 0x111, 0xf, 0xf, true); x += __builtin_amdgcn_update_dpp(0, x, 0x112, 0xf, 0xf, true);
    x += __builtin_amdgcn_update_dpp(0, x, 0x114, 0xf, 0xf, true); x += __builtin_amdgcn_update_dpp(0, x, 0x118, 0xf, 0xf, true);
    const int r0 = __builtin_amdgcn_readlane(x, 15), r1 = __builtin_amdgcn_readlane(x, 31), r2 = __builtin_amdgcn_readlane(x, 47);
    return x + (lane >= 16 ? r0 : 0) + (lane >= 32 ? r1 : 0) + (lane >= 48 ? r2 : 0);
}
template <int NR> __device__ __forceinline__ void topk_compact_lane(const float (&v)[64], float thr, int cnt, LAS unsigned* IDX, int lane) {
    int k = lane_scan_incl(cnt, lane) - cnt; const int dump = 256 + lane;
#pragma unroll
    for (int i = 0; i < NR; ++i) { const bool a = v[i] > thr; IDX[a ? k : dump] = (unsigned)(512 * (i >> 3) + 8 * lane + (i & 7)); k += a ? 1 : 0; }
}
template <int NR> __device__ __forceinline__ void topk_compact_bracket(const float (&v)[64], float lo, float hi, int need, float nhi_f, float nlo_f, LAS unsigned* IDX, int lane) {
    const int nhi = (int)(nhi_f + 0.5f), nb = (int)(nlo_f + 0.5f) - nhi;
    const int pb = lane_scan_incl(nb, lane) - nb;
    int lim = need - pb; lim = lim < 0 ? 0 : lim; lim = lim > nb ? nb : lim;
    const bool full = (lim == nb), part = (lim > 0) && !full;
    topk_compact_lane<NR>(v, full ? lo : hi, nhi + (full ? nb : 0), IDX, lane);
    const unsigned long long pm = __ballot(part);
    if (pm != 0ull) {
        int k = TOPK - lim, kb = 0; const int dump = 256 + lane;
        asm volatile("" ::: "memory");
#pragma unroll
        for (int i = 0; i < NR; ++i) { const bool c = (v[i] > lo) && !(v[i] > hi); const bool take = part && c && (kb < lim);
            IDX[take ? k : dump] = (unsigned)(512 * (i >> 3) + 8 * lane + (i & 7)); k += take ? 1 : 0; kb += c ? 1 : 0; }
    }
}
typedef _Float16 f16x8 __attribute__((ext_vector_type(8)));
template <int NR> __device__ __forceinline__ int topk_select(const LAS unsigned char* row, int t, LAS unsigned* IDX, int lane) {
    float v[64]; float s1 = 0.f, s2 = 0.f; const int nv = t + 1;
    const int tb = t >> 9;
#pragma unroll
    for (int i = 0; i < NR / 8; ++i) { const f16x8 x = *(const LAS f16x8*)(row + 1024 * i + 16 * lane);
        if (i < tb) {
#pragma unroll
            for (int c = 0; c < 8; ++c) { const float xv = (float)x[c]; s1 += xv; s2 += xv * xv; v[8 * i + c] = xv; } }
        else {
#pragma unroll
            for (int c = 0; c < 8; ++c) { const bool ok = (512 * i + 8 * lane + c) <= t; const float xv = (float)x[c]; const float val = ok ? xv : 0.f; s1 += val; s2 += val * val; v[8 * i + c] = ok ? xv : -INFINITY; } } }
#pragma unroll
    for (int i = NR; i < 64; ++i) v[i] = -INFINITY;
    asm volatile("" ::: "memory");
    if (nv <= TOPK) { topk_compact_lane<NR>(v, -INFINITY, (int)(lane_count_valid<NR>(v) + 0.5f), IDX, lane); return nv; }
    s1 = wave_total_f32(s1); s2 = wave_total_f32(s2);
    const float mu = s1 / (float)nv, var = fmaxf(s2 / (float)nv - mu * mu, 0.f);
    float lo, hi, nhi, nlo; int need;
    topk_search<NR>(v, nv, mu, sqrtf(var), lo, hi, need, nhi, nlo);
    if (need == 0) topk_compact_lane<NR>(v, hi, (int)(nhi + 0.5f), IDX, lane);
    else topk_compact_bracket<NR>(v, lo, hi, need, nhi, nlo, IDX, lane);
    return TOPK;
}

__device__ __forceinline__ unsigned pk4_fp8(float a, float b, float c, float d) { int w = __builtin_amdgcn_cvt_pk_fp8_f32(a, b, 0, false); w = __builtin_amdgcn_cvt_pk_fp8_f32(c, d, w, true); return (unsigned)w; }
typedef int v2i_t __attribute__((ext_vector_type(2)));
typedef long v2l_t __attribute__((ext_vector_type(2)));
#ifndef P2_TR8
#define P2_TR8 1
#endif
__device__ __forceinline__ long p2_vfrag(const LAS unsigned char* buf, int vra, int coff, int fr, int fq) {
#if P2_TR8
    const v2i_t t = __builtin_amdgcn_ds_read_tr8_b64_v2i32((LAS v2i_t*)(buf + vra + coff));
    return (long)((unsigned long long)(unsigned)t.x | ((unsigned long long)(unsigned)t.y << 32));
#else
    unsigned long long r = 0ull;
#pragma unroll
    for (int j = 0; j < 8; ++j) { const int rho = 4 * fq + (j & 3) + 16 * (j >> 2); const int swz = ((rho >> 1) & 7) ^ (4 * (rho >> 4));
        const int chunk = (coff >> 4) ^ ((2 * fq + (((fr >> 1) >> 1) & 1)) ^ (4 * ((fr >> 1) >> 2)));
        r |= (unsigned long long)buf[rho * 128 + 16 * (chunk ^ swz) + fr] << (8 * j); }
    return (long)r;
#endif
}
__device__ __forceinline__ void half_barrier(volatile LAS unsigned* hb, int lane) {
    LDS_WAIT(); asm volatile("" ::: "memory");
    if (lane == 0) {
        const unsigned g = hb[1];
        const unsigned old = __hip_atomic_fetch_add((LAS unsigned*)hb, 1u, __ATOMIC_RELAXED, __HIP_MEMORY_SCOPE_WORKGROUP);
        if (old == 3u) { hb[0] = 0u; hb[1] = g + 1u; }
        else { unsigned sp = 0u; while (hb[1] == g) { __builtin_amdgcn_s_sleep(1); if (++sp > (1u << 22)) break; } }
    }
    asm volatile("" ::: "memory");
}

__device__ __forceinline__ void p2_attn(Frame& F, const Ptrs& P) {
    const bf16* PROJ = (const bf16*)(P.ws + WS_PROJ); const bf16* KVI = (const bf16*)(P.ws + WS_KVI); const bf16* IKFp = (const bf16*)(P.ws + WS_IKF); const bf16* IWp = (const bf16*)(P.ws + WS_IW); bf16* ATTN = (bf16*)(P.ws + WS_CONV);
    const int wave = F.wave, half = wave >> 2, w4 = wave & 3;
    LAS unsigned char* hrows = F.lds + RING_OFF + half * 65536;
    LAS _Float16* SC = (LAS _Float16*)hrows;
    LAS float* TAB = (LAS float*)(F.lds + TAB_OFF);
    for (int e = F.tid; e < 128 * 8; e += NWAVES * 64) { const int d = e >> 3, h = e & 7; int bk;
        if (d < 16) bk = d; else { bk = 16 + (int)(logf((float)d / 16.0f) / 2.0794415416798357f * 16.0f); bk = bk < 31 ? bk : 31; }
        TAB[e] = P.rel_bias[bk * 8 + h] * 1.4426950408889634f; }
    LAS unsigned* IDX = (LAS unsigned*)(F.lds + IDX_OFF + wave * (IDXW * 4));
    constexpr int NU = SEQ / 8;
    volatile LAS unsigned* TK = F.MISC + 16 + 4 * half;
    volatile LAS unsigned* HB = F.MISC + 24 + 2 * half;
    const bool tk_lane = (w4 == 0) && (F.lane == 0);
    int bcur = (int)(xb_xcc_id() & 7u), nexh = 0, parity = 0;
    if (tk_lane) TK[0] = xb_add((unsigned*)(F.ctl + CW_Q + 64 * bcur), 1u);
    __syncthreads();
    bool have = false;
    bf16x8 afr[2][4]; v4u wraw[2][2]; bf16x8 bfr[4][4];
#define P2_ZERO_Q() do { _Pragma("unroll") for (int mt = 0; mt < 2; ++mt) { _Pragma("unroll") for (int ks = 0; ks < 4; ++ks) afr[mt][ks] = (bf16x8){0, 0, 0, 0, 0, 0, 0, 0}; wraw[mt][0] = (v4u){0u, 0u, 0u, 0u}; wraw[mt][1] = (v4u){0u, 0u, 0u, 0u}; } \
        _Pragma("unroll") for (int u = 0; u < 4; ++u) { _Pragma("unroll") for (int ks = 0; ks < 4; ++ks) bfr[u][ks] = (bf16x8){0, 0, 0, 0, 0, 0, 0, 0}; } } while (0)
    P2_ZERO_Q();
#define P2_LOAD_Q(T0) do { _Pragma("unroll") for (int mt = 0; mt < 2; ++mt) { const bf16* qp = PB + (size_t)((T0) + 4 * mt + qrho) * NPROJ + PC_IQ + hrho * 64 + 8 * hh; \
        _Pragma("unroll") for (int ks = 0; ks < 4; ++ks) afr[mt][ks] = *(const GAS bf16x8*)(qp + 16 * ks); \
        _Pragma("unroll") for (int qq = 0; qq < 2; ++qq) wraw[mt][qq] = *(const GAS v4u*)(IWB + (size_t)((T0) + 4 * mt + 2 * hh + qq) * 8); } \
        _Pragma("unroll") for (int u = 0; u < 4; ++u) { const bf16* kp = IKB + (size_t)(w4 + 4 * u) * 2048 + hh * 256 + r32 * 8;     \
            _Pragma("unroll") for (int ks = 0; ks < 4; ++ks) bfr[u][ks] = *(const GAS bf16x8*)(kp + 512 * ks); } } while (0)
    for (;;) {
        const int tk = (int)__builtin_amdgcn_readfirstlane(TK[parity]);
        if (tk >= NU) {
            if (++nexh == BATCH) break;
            bcur = (bcur + 1) & 7;
            half_barrier(HB, F.lane);
            if (tk_lane) TK[parity] = xb_add((unsigned*)(F.ctl + CW_Q + 64 * bcur), 1u);
            half_barrier(HB, F.lane);
            have = false; P2_ZERO_Q();
            continue;
        }
        unsigned nxt = 0u;
        if (tk_lane) nxt = xb_add((unsigned*)(F.ctl + CW_Q + 64 * bcur), 1u);
        int lane = F.lane; asm volatile("" : "+v"(lane));
        const int r32 = lane & 31, hh = lane >> 5, fr = lane & 15, fq = lane >> 4;
        const int qrho = ((r32 >> 4) & 1) + 2 * ((r32 >> 2) & 1), hrho = (r32 & 3) + 4 * ((r32 >> 3) & 1);
        const int b = bcur, t0 = 8 * (NU - 1 - tk);
        const bf16* PB = PROJ + (size_t)b * SEQ * NPROJ; const GAS unsigned char* KB8 = (const GAS unsigned char*)KVI + (size_t)b * SEQ * 128; const bf16* IKB = IKFp + (size_t)b * SEQ * 64; const bf16* IWB = IWp + (size_t)b * SEQ * 8;
        if (!have) P2_LOAD_Q(t0);
        {
            float w[2][16];
#pragma unroll
            for (int mt = 0; mt < 2; ++mt)
#pragma unroll
                for (int qq = 0; qq < 2; ++qq) { const v4u wv = wraw[mt][qq];
                    const float sc = 0.04419417382415922f;
                    w[mt][8 * qq + 0] = bf_lo(wv.x) * sc; w[mt][8 * qq + 1] = bf_hi(wv.x) * sc; w[mt][8 * qq + 2] = bf_lo(wv.y) * sc; w[mt][8 * qq + 3] = bf_hi(wv.y) * sc;
                    w[mt][8 * qq + 4] = bf_lo(wv.z) * sc; w[mt][8 * qq + 5] = bf_hi(wv.z) * sc; w[mt][8 * qq + 6] = bf_lo(wv.w) * sc; w[mt][8 * qq + 7] = bf_hi(wv.w) * sc; }
            const int nkt = (t0 + 8 + 31) >> 5;
            for (int kt0 = w4; kt0 < nkt; kt0 += 16) {
#pragma unroll
                for (int u = 0; u < 4; ++u) { const int kt = kt0 + 4 * u;
                    if (kt < nkt) { const int s = 32 * kt + r32;
                        f32x16 acc0 = {}, acc1 = {};
#pragma unroll
                        for (int ks = 0; ks < 4; ++ks) { acc0 = __builtin_amdgcn_mfma_f32_32x32x16_bf16(afr[0][ks], bfr[u][ks], acc0, 0, 0, 0); acc1 = __builtin_amdgcn_mfma_f32_32x32x16_bf16(afr[1][ks], bfr[u][ks], acc1, 0, 0, 0); }
                        if (kt + 16 < nkt) { const bf16* kp = IKB + (size_t)(kt + 16) * 2048 + hh * 256 + r32 * 8;
#pragma unroll
                            for (int ks = 0; ks < 4; ++ks) bfr[u][ks] = *(const GAS bf16x8*)(kp + 512 * ks); }
                        float s0 = 0.f, s1 = 0.f, s2 = 0.f, s3 = 0.f;
#pragma unroll
                        for (int e = 0; e < 8; ++e) { s0 = __builtin_fmaf(w[0][e], __builtin_amdgcn_fmed3f(acc0[e], 0.f, 3.0e38f), s0); s1 = __builtin_fmaf(w[0][8 + e], __builtin_amdgcn_fmed3f(acc0[8 + e], 0.f, 3.0e38f), s1);
                            s2 = __builtin_fmaf(w[1][e], __builtin_amdgcn_fmed3f(acc1[e], 0.f, 3.0e38f), s2); s3 = __builtin_fmaf(w[1][8 + e], __builtin_amdgcn_fmed3f(acc1[8 + e], 0.f, 3.0e38f), s3); }
                        SC[(2 * hh) * 4096 + s] = (_Float16)s0; SC[(2 * hh + 1) * 4096 + s] = (_Float16)s1; SC[(4 + 2 * hh) * 4096 + s] = (_Float16)s2; SC[(4 + 2 * hh + 1) * 4096 + s] = (_Float16)s3; } }
            }
        }
        if (tk_lane) TK[parity ^ 1] = nxt;
        half_barrier(HB, F.lane);
#pragma nounroll
        for (int qi = 0; qi < 2; ++qi) {
        int lane = F.lane; asm volatile("" : "+v"(lane));
        const int fr = lane & 15, fq = lane >> 4;
        const int qrow = w4 + 4 * qi;
        LAS unsigned char* myrow = hrows + qrow * 8192;
        const int t = t0 + qrow;
        int nsel;
        if (t < 1024) nsel = topk_select<16>(myrow, t, IDX, lane);
        else if (t < 2048) nsel = topk_select<32>(myrow, t, IDX, lane);
        else if (t < 3072) nsel = topk_select<48>(myrow, t, IDX, lane);
        else nsel = topk_select<64>(myrow, t, IDX, lane);
#pragma unroll
        for (int k = 0; k < 4; ++k) { const int jx = lane + 64 * k; if (jx >= nsel) IDX[jx] = 0u; }
        asm volatile("" ::: "memory");
        {
            const float c2 = 0.125f * 1.4426950408889634f;
            long qf8[2];
            { const bf16* qp = PB + (size_t)t * NPROJ + PC_Q + (fr & 7) * 64 + 16 * fq; const v4u q0 = *(const GAS v4u*)qp, q1 = *(const GAS v4u*)(qp + 8);
              qf8[0] = (long)(unsigned long long)(pk4_fp8(bf_lo(q0.x), bf_hi(q0.x), bf_lo(q0.y), bf_hi(q0.y)) | ((unsigned long long)pk4_fp8(bf_lo(q0.z), bf_hi(q0.z), bf_lo(q0.w), bf_hi(q0.w)) << 32));
              qf8[1] = (long)(unsigned long long)(pk4_fp8(bf_lo(q1.x), bf_hi(q1.x), bf_lo(q1.y), bf_hi(q1.y)) | ((unsigned long long)pk4_fp8(bf_lo(q1.z), bf_hi(q1.z), bf_lo(q1.w), bf_hi(q1.w)) << 32)); }
            f32x4 S[8]; unsigned BI[8][2]; const int cls = fr >> 3;
            long vf[8][4];
            {
                v4u kvreg[8][4];
#pragma unroll
                for (int kb = 0; kb < 8; ++kb)
#pragma unroll
                    for (int i = 0; i < 4; ++i) { const unsigned kidx = IDX[32 * kb + 8 * i + (lane >> 3)]; kvreg[kb][i] = *(const GAS v4u*)(KB8 + ((kidx << 7) + (unsigned)(16 * (lane & 7)))); }
#pragma unroll
                for (int jo = 0; jo < 8; ++jo) { const int jt = 2 * jo + cls; const v4u kk = *(const LAS v4u*)(IDX + 16 * jt + 4 * fq); float bz[4];
#pragma unroll
                    for (int r = 0; r < 4; ++r) { const int slot = 16 * jt + 4 * fq + r; int dist = t - (int)kk[r]; dist = dist < 127 ? dist : 127; dist = dist > 0 ? dist : 0;
                        const float bias = TAB[dist * 8 + (fr & 7)]; bz[r] = (slot < nsel) ? bias : -INFINITY; }
                    BI[jo][0] = pg8::cvt_pk_bf16(bz[0], bz[1]); BI[jo][1] = pg8::cvt_pk_bf16(bz[2], bz[3]); }
                const int wsl = (lane >> 3) * 128 + 16 * ((lane & 7) ^ ((lane >> 4) & 3));
                const int rsw = (fr >> 1) & 7;
                const int kra = fr * 128;
                const int vj = fr >> 1, vrho = 4 * fq + (vj & 3) + 16 * (vj >> 2), vswz = (2 * fq + ((vj >> 1) & 1)) ^ (4 * (vj >> 2));
                const int vra = vrho * 128 + 8 * (fr & 1);
                v2l_t kf[2][2];
#define P2_KW(KB) do { LAS unsigned char* kbuf_ = myrow + ((KB) & 1) * 4096; _Pragma("unroll") for (int i = 0; i < 4; ++i) *(LAS v4u*)(kbuf_ + 1024 * i + (wsl ^ (64 * ((i & 1) ^ (i >> 1))))) = kvreg[KB][i]; asm volatile("" ::: "memory"); } while (0)
#define P2_KR(KB) do { const LAS unsigned char* kbuf_ = myrow + ((KB) & 1) * 4096; _Pragma("unroll") for (int tt = 0; tt < 2; ++tt) \
                    kf[(KB) & 1][tt] = *(const LAS v2l_t*)(kbuf_ + 2048 * tt + kra + 16 * ((fq ^ rsw) ^ (4 * tt))); \
                    _Pragma("unroll") for (int mt = 0; mt < 4; ++mt) vf[KB][mt] = p2_vfrag(kbuf_, vra, 16 * ((4 + mt) ^ vswz), fr, fq); asm volatile("" ::: "memory"); } while (0)
                P2_KW(0); P2_KR(0);
#pragma unroll
                for (int kb = 0; kb < 8; ++kb) {
                    if (kb < 7) { P2_KW(kb + 1); P2_KR(kb + 1); }
                    f32x4 a2[2];
#pragma unroll
                    for (int tt = 0; tt < 2; ++tt) { f32x4 a = {0.f, 0.f, 0.f, 0.f};
                        a = __builtin_amdgcn_mfma_f32_16x16x32_fp8_fp8(kf[kb & 1][tt][0], qf8[0], a, 0, 0, 0);
                        a = __builtin_amdgcn_mfma_f32_16x16x32_fp8_fp8(kf[kb & 1][tt][1], qf8[1], a, 0, 0, 0);
                        a2[tt] = a; }
                    S[kb] = cls ? a2[1] : a2[0]; }
#undef P2_KW
#undef P2_KR
            }
            __builtin_amdgcn_sched_barrier(0);
            f32x4 W[8];
            float mx = -INFINITY;
#pragma unroll
            for (int jo = 0; jo < 8; ++jo)
#pragma unroll
                for (int r = 0; r < 4; ++r) { const unsigned bw = BI[jo][r >> 1]; const float sv = S[jo][r];
                    const float l2 = sv * c2 + ((r & 1) ? bf_hi(bw) : bf_lo(bw)); W[jo][r] = l2; mx = fmaxf(mx, l2); }
            mx = fmaxf(mx, __shfl_xor(mx, 8)); mx = fmaxf(mx, __shfl_xor(mx, 16)); mx = fmaxf(mx, __shfl_xor(mx, 32));
            float sum = 0.f;
#pragma unroll
            for (int jo = 0; jo < 8; ++jo)
#pragma unroll
                for (int r = 0; r < 4; ++r) { const float p = __builtin_amdgcn_exp2f(W[jo][r] - mx); W[jo][r] = p; sum += p; }
            sum += __shfl_xor(sum, 8); sum += __shfl_xor(sum, 16); sum += __shfl_xor(sum, 32);
            const float rinv = 0.00390625f / sum;
            f32x4 O[4];
#pragma unroll
            for (int mt = 0; mt < 4; ++mt) O[mt] = (f32x4){0.f, 0.f, 0.f, 0.f};
#pragma unroll
            for (int kb = 0; kb < 8; ++kb) {
                const unsigned pq = pk4_fp8(W[kb][0] * 256.0f, W[kb][1] * 256.0f, W[kb][2] * 256.0f, W[kb][3] * 256.0f);
                const unsigned pp = (unsigned)__builtin_amdgcn_update_dpp(0, (int)pq, 0x128, 0xf, 0xf, true);
                const unsigned long long pf = cls ? ((unsigned long long)pp | ((unsigned long long)pq << 32)) : ((unsigned long long)pq | ((unsigned long long)pp << 32));
#pragma unroll
                for (int mt = 0; mt < 4; ++mt) O[mt] = __builtin_amdgcn_mfma_f32_16x16x32_fp8_fp8(vf[kb][mt], (long)pf, O[mt], 0, 0, 0);
            }
            if (fr < 8) { bf16* op = ATTN + (size_t)(b * SEQ + t) * D + DCONV + fr * 64 + 4 * fq;
#pragma unroll
                for (int mt = 0; mt < 4; ++mt) { typedef unsigned u32x2v __attribute__((ext_vector_type(2)));
                    u32x2v wv; wv.x = pg8::cvt_pk_bf16(O[mt][0] * rinv, O[mt][1] * rinv); wv.y = pg8::cvt_pk_bf16(O[mt][2] * rinv, O[mt][3] * rinv);
                    *(GAS u32x2v*)(op + 16 * mt) = wv; } }
        }
        asm volatile("" ::: "memory");
        }
        __builtin_amdgcn_sched_barrier(0);
        {
            const int tkn = (int)__builtin_amdgcn_readfirstlane(TK[parity ^ 1]);
            have = tkn < NU;
            if (have) { const int t0n = 8 * (NU - 1 - tkn); P2_LOAD_Q(t0n); }
            else P2_ZERO_Q();
        }
        half_barrier(HB, F.lane);
        parity ^= 1;
    }
#undef P2_LOAD_Q
#undef P2_ZERO_Q
    __syncthreads();
}

__device__ __forceinline__ void p8_final_norm(Frame& F, const Ptrs& P) {
    const int gw = F.vcu * NWAVES + F.wave, NGW = F.G * NWAVES; const float* SSQ = (const float*)(P.ws + WS_SSQ2); const bf16* X2B = (const bf16*)(P.ws + WS_XN);
    const GAS f32x4* gr = (const GAS f32x4*)P.g_final + F.lane;
    f32x4 gg[4];
#pragma unroll
    for (int j = 0; j < 4; ++j) gg[j] = gr[64 * j];
    typedef unsigned u32x2v __attribute__((ext_vector_type(2)));
    for (int m = gw; m < M; m += 2 * NGW) { const int m1 = (m + NGW < M) ? m + NGW : m;
        const GAS u32x2v* xa = (const GAS u32x2v*)(X2B + (size_t)m * D) + F.lane; const GAS u32x2v* xb = (const GAS u32x2v*)(X2B + (size_t)m1 * D) + F.lane;
        const float* spa = SSQ + m; const float* spb = SSQ + m1; asm volatile("" : "+v"(spa), "+v"(spb));
        const float pa = *spa, pb = *spb;
        u32x2v va[4], vb[4];
#pragma unroll
        for (int j = 0; j < 4; ++j) { va[j] = xa[64 * j]; vb[j] = xb[64 * j]; }
        const float ra = 1.f / sqrtf(pa * (1.f / D) + EPS), rb = 1.f / sqrtf(pb * (1.f / D) + EPS);
        GAS f32x4* oa = (GAS f32x4*)(P.out + (size_t)m * D) + F.lane; GAS f32x4* ob = (GAS f32x4*)(P.out + (size_t)m1 * D) + F.lane;
#pragma unroll
        for (int j = 0; j < 4; ++j) { oa[64 * j] = (f32x4){bf_lo(va[j].x), bf_hi(va[j].x), bf_lo(va[j].y), bf_hi(va[j].y)} * ra * gg[j];
            if (m1 != m) ob[64 * j] = (f32x4){bf_lo(vb[j].x), bf_hi(vb[j].x), bf_lo(vb[j].y), bf_hi(vb[j].y)} * rb * gg[j]; }
    }
}

struct Args { const float* in[14]; float* out; unsigned char* ws; int ph_lo, ph_hi, li, pad; };
__global__ void __launch_bounds__(NWAVES * 64, 2) skel_fwd(Args args) {
    extern __shared__ __attribute__((aligned(16))) unsigned char lds[];
    Frame F;
    F.lds = (LAS unsigned char*)lds;
    F.MISC = (volatile LAS unsigned*)(F.lds + MISC_OFF);
    F.tid = threadIdx.x; F.lane = F.tid & 63; F.wave = __builtin_amdgcn_readfirstlane(F.tid >> 6);
    F.G = gridDim.x; { const int bx = blockIdx.x; F.vcu = (F.G % 8 == 0) ? (bx % 8) * (F.G / 8) + bx / 8 : bx; }
    Ptrs P;
    P.x = args.in[0]; P.g_mix = args.in[1]; P.w_in = args.in[2]; P.b_gate = args.in[3]; P.conv_w = args.in[4]; P.w_a = args.in[5]; P.w_b = args.in[6]; P.w_out = args.in[7];
    P.rel_bias = args.in[8]; P.g_ffn = args.in[9]; P.w_g = args.in[10]; P.w_u = args.in[11]; P.w_d = args.in[12]; P.g_final = args.in[13];
    P.out = args.out; P.ws = args.ws;
    unsigned char* ws = args.ws;
    F.ctl = (gu32*)(ws + WS_CTL);
    for (int u = F.tid; u < (TAB_OFF - LDSCTL_OFF) / 4; u += NWAVES * 64) ((LAS unsigned*)(F.lds + LDSCTL_OFF))[u] = 0u;
    __syncthreads();
    XcdBarrier bar; bar.bar = (unsigned*)(F.ctl + CW_BAR); bar.x = 0; bar.st = nullptr;
    if (N_LAUNCHES == 1) bar = xcd_barrier_post((unsigned*)(F.ctl + CW_BAR), F.MISC + 8);
#define GRID_BAR() do { if (N_LAUNCHES == 1) { xcd_barrier(bar); } } while (0)
    const int lo = args.ph_lo, hi = args.ph_hi;
#define IN(k) (lo <= (k) && (k) < hi)
#define BOTH(k) (IN(k) && IN((k) + 1))
    bf16* XN = (bf16*)(ws + WS_XN); bf16* PROJ = (bf16*)(ws + WS_PROJ); bf16* CONV = (bf16*)(ws + WS_CONV); bf16* ATTN = (bf16*)(ws + WS_ATTN);
    bf16* MERGED = XN; bf16* X1B = CONV; bf16* ACT = PROJ; bf16* X2B = XN;
    float* SSQ1 = (float*)(ws + WS_SSQ1); float* SSQ2 = (float*)(ws + WS_SSQ2);

    const bool split_w = (N_LAUNCHES == 1) && (F.G == 256);
    const bool fuse_final = (N_LAUNCHES == 1) && (F.G == 256) && IN(7) && IN(8);
    if (IN(0)) { if (blockIdx.x == 0 && F.tid < 256) ((bf16*)(ws + WS_IDENT))[F.tid * 257] = (bf16)0x3F80;
        p0_prologue(F, P, !split_w); if (BOTH(0)) GRID_BAR(); }
    if (IN(1)) {
        LAS float* BGL = (LAS float*)(F.lds + TAB_OFF);
        for (int i = F.tid; i < 2 * D; i += NWAVES * 64) BGL[i] = P.b_gate[i];
        __syncthreads();
        {
            pg8::Gemm g{(const bf16*)P.out  , (const bf16*)(ws + WS_WIN), M, PC_GA - DATT, D}; pg8::StaticOrder S; S.init(M, PC_GA - DATT, F.G, (int)blockIdx.x);
            pg8::EpiProj<false> E{PROJ, NPROJ, (bf16*)(ws + WS_KVI), (bf16*)(ws + WS_IKF), (bf16*)(ws + WS_IW), PC_KVI / 256, BGL, PC_GA, (bf16*)(ws + WS_IW + MiB), (const float*)(ws + WS_SSQ0), (LAS float*)(F.lds + TAB_OFF + 8192), PC_Q / 256, 0, DATT / 256};
            pg8::gemm_phase<pg8::EpiProj<false>, pg8::StaticOrder, PG8_ALIGN, PG8_SP2>(F.lds + RING_OFF, g, S, E); }
        if (split_w && blockIdx.x >= 128) p0_weight_items(F, P, PI_IN, PI_ALL, ((int)blockIdx.x - 128) * NWAVES + F.wave, 128 * NWAVES);
        __syncthreads();
        {
            pg8::Gemm g{(const bf16*)(ws + WS_XB8), (const bf16*)(ws + WS_WG8), M, 2 * D + DATT, D / 2}; pg8::StaticOrder S; S.init(M, 2 * D + DATT, F.G, (int)blockIdx.x);
            pg8::EpiProj<true> E{PROJ, NPROJ, (bf16*)(ws + WS_KVI), (bf16*)(ws + WS_IKF), (bf16*)(ws + WS_IW), PC_KVI / 256, BGL, PC_GA, (bf16*)(ws + WS_IW + MiB), (const float*)(ws + WS_SSQ0), (LAS float*)(F.lds + TAB_OFF + 8192), DATT / 256, PC_Q / 256, PC_GA / 256 - DATT / 256};
            pg8::gemm_phase<pg8::EpiProj<true>, pg8::StaticOrder, PG8_ALIGN, PG8_SP2>(F.lds + RING_OFF, g, S, E); }
        if (BOTH(1)) GRID_BAR();
    }
    if (IN(2)) { p2_conv(F, P); p2_attn(F, P); if (BOTH(2)) GRID_BAR(); }
    if (IN(3)) {
        pg8::Gemm g{CONV, (const bf16*)(ws + WS_WA), M, D, D}; pg8::StaticOrder S; S.init(M, D, F.G, (int)blockIdx.x);
        pg8::EpiGateMerged E{MERGED, (const unsigned char*)(PROJ + PC_GA), NPROJ * 2};
        pg8::gemm_phase<pg8::EpiGateMerged, pg8::StaticOrder, PG8_ALIGN, PG8_SP2>(F.lds + RING_OFF, g, S, E);
        if (BOTH(4)) GRID_BAR();
    }
    if (IN(5)) {
        pg8::Gemm g{MERGED, (const bf16*)(ws + WS_WOUT), M, D, D, (const bf16*)P.out, (const bf16*)(ws + WS_IDENT), D, BM256}; pg8::StaticOrder S; S.init(M, D, F.G, (int)blockIdx.x);
        pg8::EpiResid<2> E{nullptr, nullptr, X1B, SSQ1};
        pg8::gemm_phase<pg8::EpiResid<2>, pg8::StaticOrder, PG8_ALIGN, PG8_SP2>(F.lds + RING_OFF, g, S, E);
        if (BOTH(5)) GRID_BAR();
    }
    if (IN(6)) {
        pg8::Gemm g{X1B, (const bf16*)(ws + WS_WGU), M, NGU, D}; pg8::StaticOrder S; S.init(M, NGU, F.G, (int)blockIdx.x);
        pg8::EpiSwiGLU E{ACT, FF, SSQ1, (LAS float*)(F.lds + TAB_OFF)};
        pg8::gemm_phase<pg8::EpiSwiGLU, pg8::StaticOrder, PG8_ALIGN, PG8_SP2>(F.lds + RING_OFF, g, S, E);
        if (BOTH(6)) GRID_BAR();
    }
    if (IN(7)) {
        pg8::Gemm g{ACT, (const bf16*)(ws + WS_WD), M, D, FF, X1B, (const bf16*)(ws + WS_IDENT), D, BM256}; pg8::StaticOrder S; S.init(M, D, F.G, (int)blockIdx.x);
        if (fuse_final) {
            pg8::EpiFinal E{P.out, SSQ2, P.g_final, (unsigned*)(ws + WS_RC), (unsigned*)(F.ctl + CW_BAR) + XB_TMO};
            pg8::gemm_phase<pg8::EpiFinal, pg8::StaticOrder, PG8_ALIGN, PG8_SP2>(F.lds + RING_OFF, g, S, E);
        } else {
            pg8::EpiResid<2> E{nullptr, nullptr, X2B, SSQ2};
            pg8::gemm_phase<pg8::EpiResid<2>, pg8::StaticOrder, PG8_ALIGN, PG8_SP2>(F.lds + RING_OFF, g, S, E);
            if (BOTH(7)) GRID_BAR();
        }
    }
    if (IN(8) && !fuse_final) { p8_final_norm(F, P); }
#undef IN
#undef BOTH
#undef GRID_BAR
}

extern "C" void kernel_launch(void* const* d_in, const int* in_sizes, int n_in, void* d_out, int out_size, void* d_ws, size_t ws_size, hipStream_t stream) {
    static int grid = 0;
    if (grid == 0) {
        if (n_in != 14 || in_sizes[0] != M * D || out_size != M * D || ws_size < WS_END) { fprintf(stderr, "kernel_launch: shape/workspace mismatch: n_in %d in0 %d out %d ws %zu (need %zu); nothing launched\n", n_in, n_in > 0 ? in_sizes[0] : -1, out_size, ws_size, (size_t)WS_END); grid = -1; return; }
        int dev = 0, cus = 0, per_cu = 0;
        if (hipGetDevice(&dev) != hipSuccess || hipDeviceGetAttribute(&cus, hipDeviceAttributeMultiprocessorCount, dev) != hipSuccess) { grid = -1; return; }
        if (hipFuncSetAttribute((const void*)skel_fwd, hipFuncAttributeMaxDynamicSharedMemorySize, LDS_BYTES) != hipSuccess) { fprintf(stderr, "kernel_launch: hipFuncSetAttribute failed\n"); grid = -1; return; }
        if (hipOccupancyMaxActiveBlocksPerMultiprocessor(&per_cu, (const void*)skel_fwd, NWAVES * 64, LDS_BYTES) != hipSuccess || per_cu < 1)
            fprintf(stderr, "kernel_launch: note: occupancy query reports %d workgroups per CU\n", per_cu);
        (void)hipGetLastError();
        grid = cus;
    }
    if (grid < 0) return;
    if (hipMemsetAsync((char*)d_ws + WS_CTL, 0, CTL_ZERO_BYTES, stream) != hipSuccess) { fprintf(stderr, "kernel_launch: hipMemsetAsync failed\n"); return; }
    Args a{};
    for (int i = 0; i < 14; ++i) a.in[i] = (const float*)d_in[i];
    a.out = (float*)d_out; a.ws = (unsigned char*)d_ws;
    for (int li = 0; li < N_LAUNCHES; ++li) {
        a.ph_lo = (N_LAUNCHES == PER_PHASE) ? li : 0; a.ph_hi = (N_LAUNCHES == PER_PHASE) ? li + 1 : PER_PHASE; a.li = li;
        hipLaunchKernelGGL(skel_fwd, dim3(grid), dim3(NWAVES * 64), LDS_BYTES, stream, a);
        const hipError_t le = hipPeekAtLastError();
        if (le != hipSuccess) { fprintf(stderr, "kernel_launch: launch %d failed: %s\n", li, hipGetErrorName(le)); break; }
    }
}
```

```cpp
#include <hip/hip_runtime.h>
#include <cstdio>
#include <cstdint>
namespace pg8 {
#define PG8_LAS __attribute__((address_space(3)))
typedef unsigned short bf16_t;
typedef short bf16x8 __attribute__((ext_vector_type(8)));
typedef float f32x4 __attribute__((ext_vector_type(4)));
typedef unsigned u32x4 __attribute__((ext_vector_type(4)));
constexpr int BM = 256, BK = 64, HALF = 128, HTB = HALF * BK * 2  , STAGE_BYTES = 8 * HTB, NXCD = 8, WGM = 8;

__host__ __device__ __forceinline__ int lds_byte(int r, int c) { const int st = (r >> 4) * 2 + (c >> 5), rr = r & 15, cc = c & 31, ob = rr * 64 + cc * 2; return st * 1024 + (ob ^ (((ob >> 9) & 1) << 5)); }
__host__ __device__ __forceinline__ void stage_rc(int b, int& R, int& C) { const int st = b / 1024, sb = b % 1024, swz = sb ^ (((sb >> 9) & 1) << 5); R = (st >> 1) * 16 + swz / 64; C = (st & 1) * 32 + (swz % 64) / 2; }
__host__ __device__ __forceinline__ int perm32(int rho) { const int n = rho >> 4, i = rho & 15; return 8 * (i >> 2) + 4 * n + (i & 3); }

typedef int pg8_v8i __attribute__((ext_vector_type(8)));
__device__ __forceinline__ pg8_v8i pg8_cat8(bf16x8 lo, bf16x8 hi) { typedef int v4i_ __attribute__((ext_vector_type(4))); const v4i_ a = __builtin_bit_cast(v4i_, lo), b = __builtin_bit_cast(v4i_, hi); return (pg8_v8i){a.x, a.y, a.z, a.w, b.x, b.y, b.z, b.w}; }
struct Unit { int pm, pn; };
struct Gemm { const bf16_t* A; const bf16_t* Bt; int M, N, K; const bf16_t* Ae = nullptr; const bf16_t* Bte = nullptr; int lde_a = 0, lde_b = 0; };

struct StaticOrder {
    int nM, nN, nwg, G, c;
    __host__ __device__ void init(int M, int N, int G_, int c_) { nM = M / BM; nN = N / BM; nwg = nM * nN; G = G_; c = c_; }
    __host__ __device__ bool next(int i, Unit& u) const {
        const long L = (long)i * G + c; if (L >= nwg) return false;
        int wgid = (int)L; { const int q = nwg / NXCD, r = nwg % NXCD, xcd = wgid % NXCD, off = wgid / NXCD; wgid = (xcd < r ? xcd * (q + 1) : r * (q + 1) + (xcd - r) * q) + off; }
        const int nig = WGM * nN, gid = wgid / nig, fm = gid * WGM, gsz = (nM - fm) < WGM ? (nM - fm) : WGM;
        u.pm = fm + ((wgid % nig) % gsz); u.pn = (wgid % nig) / gsz; return true;
    }
    __device__ __forceinline__ void a_ready(const Unit&) const {}
    __device__ __forceinline__ void done(const Unit&) const {}
};

typedef float f32x2_cv __attribute__((ext_vector_type(2))); typedef __bf16 bf16x2_cv __attribute__((ext_vector_type(2)));
__device__ __forceinline__ unsigned cvt_pk_bf16(float lo, float hi) { f32x2_cv v = {lo, hi}; bf16x2_cv b = __builtin_convertvector(v, bf16x2_cv); return __builtin_bit_cast(unsigned, b); }
typedef float f32x2 __attribute__((ext_vector_type(2)));
__device__ __forceinline__ f32x2 gelu_pk(f32x2 v) {
    const f32x2 av = __builtin_elementwise_abs(v), d = av * 0.2316418882f + 1.0f;
    f32x2 t; t.x = __builtin_amdgcn_rcpf(d.x); t.y = __builtin_amdgcn_rcpf(d.y);
    f32x2 q = t * 0.5307027145f + (-0.7265760135f); q = q * t + 0.7107068705f; q = q * t + (-0.142248368f); q = q * t + 0.127414796f; q = q * t;
    const f32x2 s = (v * v) * (-0.72134752044f);
    f32x2 e; e.x = __builtin_amdgcn_exp2f(s.x); e.y = __builtin_amdgcn_exp2f(s.y);
    const f32x2 m = v * (q * e), r = v - m;
    f32x2 o; o.x = v.x < 0.f ? m.x : r.x; o.y = v.y < 0.f ? m.y : r.y; return o;
}

template <int ACT  > struct EpiBf16 {
    static constexpr bool PERM = true, AFTER_DRAIN = false, HAS_PRE = false, HAS_MID = false, HAS_EXT = false, F8 = false; static_assert(ACT == 0 || ACT == 1, "EpiBf16: ACT is 0 (none) or 1 (gelu_pk)");
    static constexpr int NVM = 0;
    bf16_t* O; int ldc; const float* bias; int split_cols; size_t split_stride; float scale0;
    __device__ __forceinline__ void operator()(const f32x4 (&acc)[2][2][4][2], const Unit& u, int wr, int wc, int fr, int fq) const {
        const int row0 = u.pm * BM + wr * 64 + fr; int colt = u.pn * BM; bf16_t* base = O;
        float sc = 1.f; if (split_cols) { const int t = colt / split_cols; base += (size_t)t * split_stride; colt -= t * split_cols; if (t == 0) sc = scale0; }
        const int col0 = colt + wc * 32 + 8 * fq, bcol0 = u.pn * BM + wc * 32 + 8 * fq;
        f32x4 bv[2][2];
#pragma unroll
        for (int bj = 0; bj < 2; ++bj)
#pragma unroll
            for (int n = 0; n < 2; ++n) bv[bj][n] = bias ? *(const f32x4*)(bias + bcol0 + bj * HALF + 4 * n) : (f32x4){0.f, 0.f, 0.f, 0.f};
#pragma unroll
        for (int ai = 0; ai < 2; ++ai)
#pragma unroll
            for (int m = 0; m < 4; ++m) { bf16_t* rowp = base + (size_t)(row0 + ai * HALF + m * 16) * ldc + col0;
#pragma unroll
                for (int bj = 0; bj < 2; ++bj) { f32x4 v0 = acc[ai][bj][m][0] + bv[bj][0], v1 = acc[ai][bj][m][1] + bv[bj][1];
                    if (ACT == 1) { f32x2 a = gelu_pk((f32x2){v0[0], v0[1]}), b = gelu_pk((f32x2){v0[2], v0[3]}), c = gelu_pk((f32x2){v1[0], v1[1]}), d = gelu_pk((f32x2){v1[2], v1[3]});
                        v0 = (f32x4){a.x, a.y, b.x, b.y}; v1 = (f32x4){c.x, c.y, d.x, d.y}; }
                    v0 = v0 * sc; v1 = v1 * sc; u32x4 w; w.x = cvt_pk_bf16(v0[0], v0[1]); w.y = cvt_pk_bf16(v0[2], v0[3]); w.z = cvt_pk_bf16(v1[0], v1[1]); w.w = cvt_pk_bf16(v1[2], v1[3]);
                    *(u32x4*)(rowp + bj * HALF) = w; } }
    }
};

template <class Epi, class Sched, bool ALIGN_EPI = false, bool SP2 = false>
__device__ __forceinline__ void gemm_phase(PG8_LAS unsigned char* lds, const Gemm g, const Sched& S, const Epi& E) {
    const int tid = threadIdx.x, wid = __builtin_amdgcn_readfirstlane(tid >> 6), lane = tid & 63, wr = wid >> 2, wc = wid & 3, fr = lane & 15, fq = lane >> 4;
    const int K = g.K, ntm = K / BK, nt = ntm + (Epi::HAS_EXT ? BM / BK : 0);
    unsigned voffA[2], voffB[2];
#pragma unroll
    for (int i = 0; i < 2; ++i) { int R, C; stage_rc(tid * 16 + i * 8192, R, C); const int Rb = Epi::PERM ? ((R & ~31) + perm32(R & 31)) : R;
        voffA[i] = (unsigned)(R * K + C) * 2u; voffB[i] = (unsigned)(Rb * K + C) * 2u; }
    unsigned voffAe[2] = {0u, 0u}, voffBe[2] = {0u, 0u};
    if constexpr (Epi::HAS_EXT) {
#pragma unroll
        for (int i = 0; i < 2; ++i) { int R, C; stage_rc(tid * 16 + i * 8192, R, C); const int Rb = Epi::PERM ? ((R & ~31) + perm32(R & 31)) : R;
            voffAe[i] = (unsigned)(R * g.lde_a + C) * 2u; voffBe[i] = (unsigned)(Rb * g.lde_b + C) * 2u; } }
    const size_t hstepAe = (size_t)HALF * g.lde_a * 2, hstepBe = (size_t)HALF * g.lde_b * 2;
    const size_t kstep = (size_t)(BK * 2);
    const size_t hstep = (size_t)HALF * K * 2;
    const size_t tstep = 2 * hstep;
    const unsigned ldsw = (unsigned)wid * 1024u;
    const int aoff = lds_byte(wr * 64 + fr, fq * 8), boff = lds_byte(wc * 32 + fr, fq * 8);
#define PG8_SA(b, h) (((b) * 2 + (h)) * HTB)
#define PG8_SB(b, h) ((4 + (b) * 2 + (h)) * HTB)
#define PG8_STAGE(bufoff, gbase, voff) do { _Pragma("unroll") for (int _i = 0; _i < 2; ++_i) \
        __builtin_amdgcn_global_load_lds((const unsigned*)((const char*)(gbase) + (voff)[_i]), (PG8_LAS unsigned*)(lds + (bufoff) + ldsw + _i * 8192), 16, 0, 0); } while (0)
#define PG8_LDA(dst, b, h) do { if constexpr (Epi::F8) { _Pragma("unroll") for (int m = 0; m < 4; ++m) dst##8[m] = pg8_cat8(*(const PG8_LAS bf16x8*)(lds + PG8_SA(b, h) + aoff + m * 2048), *(const PG8_LAS bf16x8*)(lds + PG8_SA(b, h) + aoff + m * 2048 + 1024)); } \
        else { _Pragma("unroll") for (int m = 0; m < 4; ++m) _Pragma("unroll") for (int k = 0; k < 2; ++k) dst[m][k] = *(const PG8_LAS bf16x8*)(lds + PG8_SA(b, h) + aoff + m * 2048 + k * 1024); } } while (0)
#define PG8_LDB(dst, b, h) do { if constexpr (Epi::F8) { _Pragma("unroll") for (int n = 0; n < 2; ++n) dst##8[n] = pg8_cat8(*(const PG8_LAS bf16x8*)(lds + PG8_SB(b, h) + boff + n * 2048), *(const PG8_LAS bf16x8*)(lds + PG8_SB(b, h) + boff + n * 2048 + 1024)); } \
        else { _Pragma("unroll") for (int n = 0; n < 2; ++n) _Pragma("unroll") for (int k = 0; k < 2; ++k) dst[n][k] = *(const PG8_LAS bf16x8*)(lds + PG8_SB(b, h) + boff + n * 2048 + k * 1024); } } while (0)
#define PG8_MMA(ai, bj, At, Bt) do { __builtin_amdgcn_s_setprio(1); _Pragma("unroll") for (int m = 0; m < 4; ++m) _Pragma("unroll") for (int n = 0; n < 2; ++n) { \
        if constexpr (Epi::F8) asm volatile("v_mfma_scale_f32_16x16x128_f8f6f4 %0, %1, %2, %0, %3, %3 op_sel_hi:[0,0,0]" : "+v"(acc[ai][bj][m][n]) : "v"(Bt##8[n]), "v"(At##8[m]), "v"(f8scale));     \
        else { _Pragma("unroll") for (int k = 0; k < 2; ++k) acc[ai][bj][m][n] = __builtin_amdgcn_mfma_f32_16x16x32_bf16(Bt[n][k], At[m][k], acc[ai][bj][m][n], 0, 0, 0); } } __builtin_amdgcn_s_setprio(0); } while (0)
#define PG8_WAIT_V(n) asm volatile("s_waitcnt vmcnt(" #n ")" ::: "memory")
#define PG8_WAIT_VR do { if constexpr (Epi::NVM >= 32) asm volatile("s_waitcnt vmcnt(40)" ::: "memory"); else if constexpr (Epi::NVM >= 16) asm volatile("s_waitcnt vmcnt(24)" ::: "memory"); \
        else if constexpr (Epi::NVM >= 8) asm volatile("s_waitcnt vmcnt(16)" ::: "memory"); else asm volatile("s_waitcnt vmcnt(8)" ::: "memory"); } while (0)
#define PG8_WAIT_L(n) asm volatile("s_waitcnt lgkmcnt(" #n ")" ::: "memory")
#define PG8_BAR __builtin_amdgcn_s_barrier()
#define PG8_SCHED __builtin_amdgcn_sched_barrier(0)
    static_assert(SP2 || !Epi::HAS_EXT, "the K extension is wired into the SP2 loop only");
    Unit cur, nxt; int ui = 0;
    if (!S.next(0, cur)) return;
    f32x4 acc[2][2][4][2];
#pragma unroll
    for (int a = 0; a < 2; ++a)
#pragma unroll
        for (int b = 0; b < 2; ++b)
#pragma unroll
            for (int m = 0; m < 4; ++m)
#pragma unroll
                for (int n = 0; n < 2; ++n) acc[a][b][m][n] = (f32x4){0.f, 0.f, 0.f, 0.f};
    bf16x8 At[4][2], B0[2][2], B1[2][2];
    int f8scale = 0x7f7f7f7f; asm volatile("" : "+v"(f8scale));
    pg8_v8i At8[4], B08[2], B18[2];
    const char* cA = (const char*)g.A + (size_t)cur.pm * tstep; const char* cB = (const char*)g.Bt + (size_t)cur.pn * tstep;
    const char* eA = Epi::HAS_EXT ? (const char*)g.Ae + ((size_t)cur.pm * BM * g.lde_a + (size_t)cur.pn * BM) * 2 : nullptr; const char* eB = (const char*)g.Bte;
    S.a_ready(cur);
    float carry[8] = {0.f, 0.f, 0.f, 0.f, 0.f, 0.f, 0.f, 0.f};
    if constexpr (Epi::HAS_PRE) E.pre(cur, wr, fr, carry);
    if constexpr (SP2) {
        PG8_STAGE(PG8_SB(0, 0), cB, voffB); PG8_STAGE(PG8_SB(0, 1), cB + hstep, voffB); PG8_STAGE(PG8_SA(0, 0), cA, voffA); PG8_STAGE(PG8_SA(0, 1), cA + hstep, voffA);
        if (wr == 1) PG8_BAR;
        PG8_WAIT_V(2); PG8_BAR;
        PG8_STAGE(PG8_SB(1, 0), cB + kstep, voffB); PG8_STAGE(PG8_SA(1, 0), cA + kstep, voffA); PG8_STAGE(PG8_SB(1, 1), cB + hstep + kstep, voffB);
        PG8_WAIT_V(6); PG8_BAR;
    } else {
        PG8_STAGE(PG8_SB(0, 0), cB, voffB); PG8_STAGE(PG8_SA(0, 0), cA, voffA); PG8_STAGE(PG8_SB(0, 1), cB + hstep, voffB); PG8_STAGE(PG8_SA(0, 1), cA + hstep, voffA);
        if (wr == 1) PG8_BAR;
        PG8_WAIT_V(4); PG8_BAR;
        PG8_STAGE(PG8_SB(1, 0), cB + kstep, voffB); PG8_STAGE(PG8_SA(1, 0), cA + kstep, voffA); PG8_STAGE(PG8_SB(1, 1), cB + hstep + kstep, voffB);
        PG8_WAIT_V(6); PG8_BAR;
    }
    for (;;) {
        const bool has_next = S.next(ui + 1, nxt);
        const char* nA = has_next ? (const char*)g.A + (size_t)nxt.pm * tstep : cA; const char* nB = has_next ? (const char*)g.Bt + (size_t)nxt.pn * tstep : cB;
        int t0 = 0;
        if constexpr (SP2 && ALIGN_EPI && Epi::NVM > 0) { if (ui > 0) {
            const char* pa2 = cA + 2 * kstep; const char* pb2 = cB + 2 * kstep; const char* pa3 = pa2 + kstep; const char* pb3 = pb2 + kstep;


            PG8_LDB(B0, 0, 0); PG8_LDB(B1, 0, 1); PG8_SCHED; PG8_LDA(At, 0, 0);
            PG8_WAIT_VR; PG8_WAIT_L(0); PG8_BAR; PG8_MMA(0, 0, At, B0); PG8_MMA(0, 1, At, B1); PG8_BAR; PG8_SCHED;

            PG8_LDA(At, 0, 1); PG8_STAGE(PG8_SB(0, 0), pb2, voffB); PG8_STAGE(PG8_SB(0, 1), pb2 + hstep, voffB); PG8_STAGE(PG8_SA(0, 0), pa2, voffA);
            PG8_WAIT_VR; PG8_WAIT_L(0); PG8_BAR; PG8_MMA(1, 0, At, B0); PG8_MMA(1, 1, At, B1); PG8_BAR; PG8_SCHED;

            PG8_LDB(B0, 1, 0); PG8_LDB(B1, 1, 1); PG8_SCHED; PG8_LDA(At, 1, 0); PG8_STAGE(PG8_SA(0, 1), pa2 + hstep, voffA);
            PG8_WAIT_VR; PG8_WAIT_L(0); PG8_BAR; PG8_MMA(0, 0, At, B0); PG8_MMA(0, 1, At, B1); PG8_BAR; PG8_SCHED;

            PG8_LDA(At, 1, 1); PG8_STAGE(PG8_SB(1, 0), pb3, voffB); PG8_STAGE(PG8_SB(1, 1), pb3 + hstep, voffB); PG8_STAGE(PG8_SA(1, 0), pa3, voffA);
            PG8_WAIT_V(8); PG8_WAIT_L(0); PG8_BAR; PG8_MMA(1, 0, At, B0); PG8_MMA(1, 1, At, B1); PG8_BAR; PG8_SCHED;
            t0 = 2; } }
        for (int t = t0; t < nt; t += 2) {
            if constexpr (Epi::HAS_MID) { if (t == Epi::MID_T) { __builtin_amdgcn_sched_barrier(0); E.mid(acc, cur, wr, wc, fr, fq); __builtin_amdgcn_sched_barrier(0); } }
            const bool last = (t == nt - 2);
            const bool x1 = Epi::HAS_EXT && t >= ntm, x2 = Epi::HAS_EXT && !last && t + 2 >= ntm;
            const char* a1 = x1 ? eA + (size_t)(t + 1 - ntm) * kstep : cA + (size_t)(t + 1) * kstep;
            const char* a2 = last ? nA : (x2 ? eA + (size_t)(t + 2 - ntm) * kstep : cA + (size_t)(t + 2) * kstep);
            const char* b2 = last ? nB : (x2 ? eB + (size_t)(t + 2 - ntm) * kstep : cB + (size_t)(t + 2) * kstep);
            const char* a3 = a2 + kstep; const char* b3 = b2 + kstep;
            const size_t hA1 = x1 ? hstepAe : hstep, hA2 = x2 ? hstepAe : hstep, hB2 = x2 ? hstepBe : hstep;
            unsigned vA1[2], vA2[2], vB2[2];
#pragma unroll
            for (int i = 0; i < 2; ++i) { vA1[i] = x1 ? voffAe[i] : voffA[i]; vA2[i] = x2 ? voffAe[i] : voffA[i]; vB2[i] = x2 ? voffBe[i] : voffB[i]; }
            if (last && has_next) S.a_ready(nxt);
            if constexpr (SP2) {
            PG8_LDB(B0, 0, 0); PG8_LDB(B1, 0, 1); PG8_SCHED; PG8_LDA(At, 0, 0); PG8_STAGE(PG8_SA(1, 1), a1 + hA1, vA1);
            PG8_WAIT_V(8); PG8_WAIT_L(0); PG8_BAR; PG8_MMA(0, 0, At, B0); PG8_MMA(0, 1, At, B1); PG8_BAR; PG8_SCHED;
            PG8_LDA(At, 0, 1); PG8_STAGE(PG8_SB(0, 0), b2, vB2); PG8_STAGE(PG8_SB(0, 1), b2 + hB2, vB2); PG8_STAGE(PG8_SA(0, 0), a2, vA2);
            PG8_WAIT_V(8); PG8_WAIT_L(0); PG8_BAR; PG8_MMA(1, 0, At, B0); PG8_MMA(1, 1, At, B1); PG8_BAR; PG8_SCHED;
            PG8_LDB(B0, 1, 0); PG8_LDB(B1, 1, 1); PG8_SCHED; PG8_LDA(At, 1, 0); PG8_STAGE(PG8_SA(0, 1), a2 + hA2, vA2);
            PG8_WAIT_V(8); PG8_WAIT_L(0); PG8_BAR; PG8_MMA(0, 0, At, B0); PG8_MMA(0, 1, At, B1); PG8_BAR; PG8_SCHED;
            PG8_LDA(At, 1, 1); PG8_STAGE(PG8_SB(1, 0), b3, vB2); PG8_STAGE(PG8_SB(1, 1), b3 + hB2, vB2); PG8_STAGE(PG8_SA(1, 0), a3, vA2);
            PG8_WAIT_V(8); PG8_WAIT_L(0); PG8_BAR; PG8_MMA(1, 0, At, B0); PG8_MMA(1, 1, At, B1); PG8_BAR; PG8_SCHED;
            } else {
            PG8_LDB(B0, 0, 0); PG8_SCHED; PG8_LDA(At, 0, 0); PG8_STAGE(PG8_SA(1, 1), a1 + hstep, voffA);
            PG8_WAIT_L(8); PG8_BAR; PG8_WAIT_L(0); PG8_MMA(0, 0, At, B0); PG8_BAR; PG8_SCHED;
            PG8_LDB(B1, 0, 1); PG8_STAGE(PG8_SB(0, 0), b2, voffB);
            PG8_BAR; PG8_WAIT_L(0); PG8_MMA(0, 1, At, B1); PG8_BAR;
            PG8_LDA(At, 0, 1); PG8_STAGE(PG8_SA(0, 0), a2, voffA);
            PG8_BAR; PG8_WAIT_L(0); PG8_MMA(1, 0, At, B0); PG8_BAR; PG8_SCHED;
            PG8_STAGE(PG8_SB(0, 1), b2 + hstep, voffB);
            PG8_WAIT_V(6); PG8_BAR; PG8_MMA(1, 1, At, B1); PG8_BAR;
            PG8_LDB(B0, 1, 0); PG8_SCHED; PG8_LDA(At, 1, 0); PG8_STAGE(PG8_SA(0, 1), a2 + hstep, voffA);
            PG8_WAIT_L(8); PG8_BAR; PG8_WAIT_L(0); PG8_MMA(0, 0, At, B0); PG8_BAR; PG8_SCHED;
            PG8_LDB(B1, 1, 1); PG8_STAGE(PG8_SB(1, 0), b3, voffB);
            PG8_BAR; PG8_WAIT_L(0); PG8_MMA(0, 1, At, B1); PG8_BAR;
            PG8_LDA(At, 1, 1); PG8_STAGE(PG8_SA(1, 0), a3, voffA);
            PG8_BAR; PG8_WAIT_L(0); PG8_MMA(1, 0, At, B0); PG8_BAR; PG8_SCHED;
            PG8_STAGE(PG8_SB(1, 1), b3 + hstep, voffB);
            PG8_WAIT_V(6); PG8_BAR; PG8_MMA(1, 1, At, B1); PG8_BAR;
            }
        }
        if constexpr (Epi::F8) asm volatile("s_nop 15\n\ts_nop 15" ::: "memory");
        if constexpr (ALIGN_EPI) { if (wr == 0) PG8_BAR; }
        if constexpr (SP2 && ALIGN_EPI && Epi::NVM > 0) { if (has_next) PG8_STAGE(PG8_SA(1, 1), nA + kstep + hstep, voffA); asm volatile("" ::: "memory"); PG8_SCHED; }
        if constexpr (!Epi::AFTER_DRAIN) { if constexpr (Epi::HAS_PRE) { E.run(acc, cur, wr, wc, fr, fq, carry); if (has_next) E.pre(nxt, wr, fr, carry); } else E(acc, cur, wr, wc, fr, fq); S.done(cur); }
        if (!has_next) break;
#pragma unroll
        for (int a = 0; a < 2; ++a)
#pragma unroll
            for (int b = 0; b < 2; ++b)
#pragma unroll
                for (int m = 0; m < 4; ++m)
#pragma unroll
                    for (int n = 0; n < 2; ++n) { acc[a][b][m][n] = (f32x4){0.f, 0.f, 0.f, 0.f}; asm volatile("" : "+v"(acc[a][b][m][n])); }
        cur = nxt; cA = nA; cB = nB; ++ui;
        if constexpr (Epi::HAS_EXT) eA = (const char*)g.Ae + ((size_t)cur.pm * BM * g.lde_a + (size_t)cur.pn * BM) * 2;
        if constexpr (ALIGN_EPI) { if (wr == 1) PG8_BAR; }
    }
    PG8_WAIT_V(0);
    if constexpr (!ALIGN_EPI) { if (wr == 0) PG8_BAR; }
    PG8_BAR;
    if constexpr (Epi::AFTER_DRAIN) { E.fused(acc, cur, wr, wc, fr, fq, lds, wid, lane); S.done(cur); }
#undef PG8_SA
#undef PG8_SB
#undef PG8_STAGE
#undef PG8_LDA
#undef PG8_LDB
#undef PG8_MMA
#undef PG8_WAIT_V
#undef PG8_WAIT_L
#undef PG8_BAR
#undef PG8_SCHED
}
}

#ifndef PG8_SP2
#define PG8_SP2 true
#endif
#ifndef PG8_ALIGN
#define PG8_ALIGN true
#endif
#define GAS __attribute__((address_space(1)))
#define LAS __attribute__((address_space(3)))
typedef unsigned short bf16;
typedef unsigned v4u __attribute__((ext_vector_type(4)));
typedef float f32x4 __attribute__((ext_vector_type(4)));
typedef short bf16x8 __attribute__((ext_vector_type(8)));
typedef GAS unsigned gu32;
typedef GAS unsigned long long gu64;
#define RLX_AGENT __ATOMIC_RELAXED, __HIP_MEMORY_SCOPE_AGENT
#define LDS_WAIT() asm volatile("s_waitcnt lgkmcnt(0)" ::: "memory")
#define VM_WAIT() asm volatile("s_waitcnt vmcnt(0)" ::: "memory")
__device__ __forceinline__ unsigned long long rt() { return __builtin_amdgcn_s_memrealtime(); }
__device__ __forceinline__ unsigned f2bf(float f) { unsigned u = __builtin_bit_cast(unsigned, f); return (u + 0x7fffu + ((u >> 16) & 1u)) >> 16; }
__device__ __forceinline__ unsigned pk2(float lo, float hi) { return pg8::cvt_pk_bf16(lo, hi); }

#define XB_TMO      128
#define XB_XCNT(j)  (256  + 64 * (j))
#define XB_XSUB(j)  (1280 + 64 * (j))
#define XB_XGEN(j)  (2304 + 64 * (j))
#define XB_TOP      3328
#define XB_TOPGEN   3392
#define XCD_BAR_WORDS 3456
#define XB_SPIN_CAP (1u << 18)

__device__ __forceinline__ unsigned xb_ld(unsigned* p)              { return __hip_atomic_load(p, __ATOMIC_RELAXED, __HIP_MEMORY_SCOPE_AGENT); }
__device__ __forceinline__ unsigned xb_add(unsigned* p, unsigned v) { return __hip_atomic_fetch_add(p, v, __ATOMIC_RELAXED, __HIP_MEMORY_SCOPE_AGENT); }
__device__ __forceinline__ unsigned xb_xcc_id() { return (unsigned)__builtin_amdgcn_s_getreg((3 << 11) | 20) & 0xFu; }
#define XB_SPIN(cond, bar) do { unsigned _sp = 0; while (cond) { __builtin_amdgcn_s_sleep(1); \
    if ((++_sp & 255u) == 0u) { if (xb_ld(&(bar)[XB_TMO])) break; if (_sp > XB_SPIN_CAP) { atomicAdd(&(bar)[XB_TMO], 1u); break; } } } } while (0)

struct XcdBarrier {
    unsigned* bar; unsigned x;
    volatile LAS unsigned* st;
};

__device__ __forceinline__ XcdBarrier xcd_barrier_post(unsigned* bar, volatile LAS unsigned* st) {
    XcdBarrier b; b.bar = bar; b.x = xb_xcc_id(); b.st = st;
    if (threadIdx.x == 0) (void)xb_add(&bar[XB_XCNT(b.x)], 1u + ((b.x != (blockIdx.x & 7u)) ? 0x10000u : 0u));
    return b;
}
__device__ __forceinline__ void xcd_barrier_complete(unsigned* bar, unsigned x, unsigned& nloc, unsigned& nx, unsigned& lok) {
    const unsigned G = gridDim.x * gridDim.y * gridDim.z;
    unsigned sum, cnt, mine, bad, sp = 0u;
    for (;;) {
        sum = 0u; cnt = 0u; mine = 0u; bad = 0u;
#pragma unroll
        for (unsigned j = 0; j < 16; ++j) { const unsigned cw = xb_ld(&bar[XB_XCNT(j)]), c = cw & 0xffffu; sum += c; cnt += (c > 0u) ? 1u : 0u; mine = (j == x) ? c : mine;
            bad |= (cw >> 16) | ((c != (j < 8u ? G / 8u : 0u)) ? 1u : 0u); }
        if (sum == G) break;
        bad = 1u;
        __builtin_amdgcn_s_sleep(1);
        if ((++sp & 255u) == 0u) { if (xb_ld(&bar[XB_TMO])) break; if (sp > XB_SPIN_CAP) { atomicAdd(&bar[XB_TMO], 1u); break; } }
    }
    nloc = mine > 0u ? mine : 1u; nx = cnt > 0u ? cnt : 1u;
    lok = (bad == 0u && (G & 7u) == 0u) ? 2u : 1u;
}

__device__ __forceinline__ void xcd_barrier(const XcdBarrier& b, const bool local = false) {
    asm volatile("s_waitcnt vmcnt(0)" ::: "memory");
    __syncthreads();
    if (threadIdx.x == 0) {
        unsigned* bar = b.bar;
        __builtin_amdgcn_s_waitcnt(0);
        unsigned nloc = b.st[0], nx = b.st[1];
        if (nloc == 0u) { unsigned lok; xcd_barrier_complete(bar, b.x, nloc, nx, lok); b.st[0] = nloc; b.st[1] = nx; b.st[2] = lok; }
        const unsigned old = xb_add(&bar[XB_XSUB(b.x)], 1u);
        const unsigned gen = old / nloc;
        if (old + 1u == (gen + 1u) * nloc) {
            __builtin_amdgcn_fence(__ATOMIC_RELEASE, "agent");
            asm volatile("s_waitcnt vmcnt(0)" ::: "memory");
            if (!(local && b.st[2] == 2u)) {
            const unsigned og = xb_add(&bar[XB_TOP], 1u);
            const unsigned tg = og / nx;
            if (og + 1u == (tg + 1u) * nx) xb_add(&bar[XB_TOPGEN], 1u);
            else XB_SPIN(xb_ld(&bar[XB_TOPGEN]) == tg, bar);
            }
            __builtin_amdgcn_fence(__ATOMIC_ACQUIRE, "agent");
            xb_add(&bar[XB_XGEN(b.x)], 1u);
            asm volatile("s_waitcnt vmcnt(0)" ::: "memory");
        } else {
            XB_SPIN(xb_ld(&bar[XB_XGEN(b.x)]) == gen, bar);
            __builtin_amdgcn_fence(__ATOMIC_ACQUIRE, "agent");
            asm volatile("s_waitcnt vmcnt(0)" ::: "memory");
        }
    }
    __syncthreads();
}

constexpr int NWAVES = 8;
#ifndef MK_N_LAUNCHES
#define MK_N_LAUNCHES 1
#endif
constexpr int PER_PHASE = 9;
constexpr int N_LAUNCHES = MK_N_LAUNCHES;
static_assert(N_LAUNCHES == 1 || N_LAUNCHES == PER_PHASE, "MK_N_LAUNCHES is 1 or 9");

constexpr int BATCH = 8, SEQ = 4096, D = 1024, M = BATCH * SEQ;
constexpr int DCONV = 512, DATT = 512, NH = 8, HD = 64, FF = 2816, NGU = 2 * FF;
constexpr int NPROJ_SRC = 4808, NPROJ = 4864;
constexpr int PC_CB = 0, PC_CC = 512, PC_CX = 1024, PC_Q = 1536, PC_IQ = 2048, PC_KVI = 2560, PC_GA = 2816, PC_GB = 3840;
constexpr int KVP = 128, KV_K = 0, KV_V = 64;
constexpr float EPS = 1e-6f;
constexpr int TOPK = 256;

constexpr size_t MiB = 1u << 20;
constexpr size_t WS_CTL = 0, CTL_ZERO_BYTES = 1 * MiB;
constexpr size_t WS_SSQ1 = 256 * 1024, WS_SSQ2 = 512 * 1024;
constexpr size_t WS_RC = 896 * 1024;
constexpr size_t WS_IDENT = 768 * 1024;
constexpr int BM256 = 256;
constexpr size_t WS_WIN = 6 * MiB, WS_WA = 16 * MiB, WS_WB = 17 * MiB, WS_WOUT = 18 * MiB, WS_WGU = 20 * MiB, WS_WD = 31 * MiB;
constexpr size_t WS_XN = 40 * MiB;
constexpr size_t WS_CONV = 104 * MiB, WS_ATTN = 136 * MiB;
constexpr size_t WS_PROJ = 168 * MiB;
constexpr size_t WS_KVI = 472 * MiB;
constexpr size_t WS_IKF = 480 * MiB, WS_IW = 484 * MiB;
constexpr size_t WS_WG8 = 37 * MiB;
constexpr size_t WS_XB8 = WS_XN;
constexpr size_t WS_SSQ0 = WS_IW + 3 * MiB;
constexpr size_t WS_END = 488 * MiB;
static_assert(WS_WIN + (size_t)NPROJ * D * 2 <= WS_WA && WS_WGU + (size_t)NGU * D * 2 <= WS_WD && WS_WD + (size_t)D * FF * 2 <= WS_XN, "weights map");
static_assert(WS_PROJ + (size_t)M * NPROJ * 2 <= WS_KVI && WS_KVI + (size_t)M * KVP * 2 <= WS_IKF && WS_IKF + (size_t)M * 64 * 2 <= WS_IW && WS_IW + (size_t)M * 16 <= WS_END && WS_XN + (size_t)M * D * 2 <= WS_CONV && WS_ATTN + (size_t)M * 512 * 2 <= WS_PROJ, "activation map");
constexpr int CW_BAR = 4096;

constexpr int RING_OFF = 0, RING_BYTES = 131072;
constexpr int LDSCTL_OFF = RING_BYTES, MISC_OFF = LDSCTL_OFF + 320;
constexpr int TAB_OFF = RING_BYTES + 1024;
constexpr int LDS_BYTES = 147456;
static_assert(MISC_OFF + 128 <= TAB_OFF && TAB_OFF + 4096 <= LDS_BYTES, "LDS map");

struct Frame {
    LAS unsigned char* lds;
    volatile LAS unsigned* MISC;
    gu32* ctl;
    int tid, lane, wave;
    int vcu, G;
};

__device__ __forceinline__ float wave_sum(float v) {
#pragma unroll
    for (int o = 1; o < 64; o <<= 1) v += __shfl_xor(v, o);
    return v;
}
__device__ __forceinline__ float bf_lo(unsigned w) { return __builtin_bit_cast(float, w << 16); }
__device__ __forceinline__ float bf_hi(unsigned w) { return __builtin_bit_cast(float, w & 0xffff0000u); }
__device__ __forceinline__ float fast_sigmoid(float z) { return __builtin_amdgcn_rcpf(1.0f + __builtin_amdgcn_exp2f(-1.4426950408889634f * z)); }

__device__ __forceinline__ void p0_transpose_item(const float* W, int K, int N, int k0, int scol0, int nvalid, bf16* WT, int drow0, const float* kscale, LAS float* scr, int lane, int ldk = 0, int kd0 = -1, bool f8 = false) {
    if (ldk == 0) ldk = K; if (kd0 < 0) kd0 = k0;
    asm volatile("" : "+v"(lane));
    const int kr = lane >> 3, j4 = lane & 7;
    f32x4 v[8];
#pragma unroll
    for (int i = 0; i < 8; ++i) { v[i] = (f32x4){0.f, 0.f, 0.f, 0.f};
        if (4 * j4 < nvalid) v[i] = *(const GAS f32x4*)(W + (size_t)(k0 + 8 * i + kr) * N + scol0 + 4 * j4); }
    if (kscale) {
#pragma unroll
        for (int i = 0; i < 8; ++i) v[i] = v[i] * kscale[k0 + 8 * i + kr]; }
#pragma unroll
    for (int i = 0; i < 8; ++i) { LAS float* d = scr + (8 * i + kr) * 33 + 4 * j4; d[0] = v[i].x; d[1] = v[i].y; d[2] = v[i].z; d[3] = v[i].w; }
    LDS_WAIT(); asm volatile("" ::: "memory");
    const int c = lane & 7;
#pragma unroll
    for (int jj = 0; jj < 4; ++jj) { const int n = (lane >> 3) + 8 * jj; const LAS float* s = scr + (8 * c) * 33 + n;
        v4u o; o.x = pk2(s[0 * 33], s[1 * 33]); o.y = pk2(s[2 * 33], s[3 * 33]); o.z = pk2(s[4 * 33], s[5 * 33]); o.w = pk2(s[6 * 33], s[7 * 33]);
        if (!f8) *(GAS v4u*)(WT + (size_t)(drow0 + n) * ldk + kd0 + 8 * c) = o;
        else { typedef unsigned u32x2w __attribute__((ext_vector_type(2)));
            int q0 = __builtin_amdgcn_cvt_pk_fp8_f32(s[0 * 33], s[1 * 33], 0, false); q0 = __builtin_amdgcn_cvt_pk_fp8_f32(s[2 * 33], s[3 * 33], q0, true);
            int q1 = __builtin_amdgcn_cvt_pk_fp8_f32(s[4 * 33], s[5 * 33], 0, false); q1 = __builtin_amdgcn_cvt_pk_fp8_f32(s[6 * 33], s[7 * 33], q1, true);
            u32x2w o8; o8.x = (unsigned)q0; o8.y = (unsigned)q1; *(GAS u32x2w*)((unsigned char*)WT + (size_t)(drow0 + n) * ldk + kd0 + 8 * c) = o8; } }
    LDS_WAIT(); asm volatile("" ::: "memory");
}
__device__ __forceinline__ void rms_rows2_to_bf16(int lane, const float* xrow0, const float* xrow1, const float* g, bf16* orow0, bf16* orow1) {
    const GAS f32x4* xa = (const GAS f32x4*)xrow0 + lane; const GAS f32x4* xb = (const GAS f32x4*)xrow1 + lane; const GAS f32x4* gr = (const GAS f32x4*)g + lane;
    f32x4 va[4], vb[4]; float sa = 0.f, sb = 0.f;
#pragma unroll
    for (int j = 0; j < 4; ++j) { va[j] = xa[64 * j]; vb[j] = xb[64 * j]; }
#pragma unroll
    for (int j = 0; j < 4; ++j) { sa += (va[j].x * va[j].x + va[j].y * va[j].y) + (va[j].z * va[j].z + va[j].w * va[j].w); sb += (vb[j].x * vb[j].x + vb[j].y * vb[j].y) + (vb[j].z * vb[j].z + vb[j].w * vb[j].w); }
#pragma unroll
    for (int o = 1; o < 64; o <<= 1) { sa += __shfl_xor(sa, o); sb += __shfl_xor(sb, o); }
    const float ra = 1.f / sqrtf(sa * (1.f / D) + EPS), rb = 1.f / sqrtf(sb * (1.f / D) + EPS);
    GAS unsigned long long* oa = (GAS unsigned long long*)orow0 + lane; GAS unsigned long long* ob = (GAS unsigned long long*)orow1 + lane;
#pragma unroll
    for (int j = 0; j < 4; ++j) { const f32x4 gg = gr[64 * j];
        oa[64 * j] = (unsigned long long)pk2(va[j].x * ra * gg.x, va[j].y * ra * gg.y) | ((unsigned long long)pk2(va[j].z * ra * gg.z, va[j].w * ra * gg.w) << 32);
        ob[64 * j] = (unsigned long long)pk2(vb[j].x * rb * gg.x, vb[j].y * rb * gg.y) | ((unsigned long long)pk2(vb[j].z * rb * gg.z, vb[j].w * rb * gg.w) << 32); }
}

__device__ __forceinline__ void x_rows2_to_bf16(int lane, const float* xrow0, const float* xrow1, bf16* orow0, bf16* orow1, float* ss0, float* ss1, unsigned* o8row0, unsigned* o8row1) {
    const GAS f32x4* xa = (const GAS f32x4*)xrow0 + lane; const GAS f32x4* xb = (const GAS f32x4*)xrow1 + lane;
    f32x4 va[4], vb[4]; float sa = 0.f, sb = 0.f;
#pragma unroll
    for (int j = 0; j < 4; ++j) { va[j] = xa[64 * j]; vb[j] = xb[64 * j]; }
    GAS unsigned long long* oa = (GAS unsigned long long*)orow0 + lane; GAS unsigned long long* ob = (GAS unsigned long long*)orow1 + lane;
#pragma unroll
    for (int j = 0; j < 4; ++j) { sa += (va[j].x * va[j].x + va[j].y * va[j].y) + (va[j].z * va[j].z + va[j].w * va[j].w); sb += (vb[j].x * vb[j].x + vb[j].y * vb[j].y) + (vb[j].z * vb[j].z + vb[j].w * vb[j].w);
        oa[64 * j] = (unsigned long long)pk2(va[j].x, va[j].y) | ((unsigned long long)pk2(va[j].z, va[j].w) << 32);
        ob[64 * j] = (unsigned long long)pk2(vb[j].x, vb[j].y) | ((unsigned long long)pk2(vb[j].z, vb[j].w) << 32);
        { int q = __builtin_amdgcn_cvt_pk_fp8_f32(va[j].x, va[j].y, 0, false); q = __builtin_amdgcn_cvt_pk_fp8_f32(va[j].z, va[j].w, q, true); ((GAS unsigned*)o8row0)[lane + 64 * j] = (unsigned)q; }
        { int q = __builtin_amdgcn_cvt_pk_fp8_f32(vb[j].x, vb[j].y, 0, false); q = __builtin_amdgcn_cvt_pk_fp8_f32(vb[j].z, vb[j].w, q, true); ((GAS unsigned*)o8row1)[lane + 64 * j] = (unsigned)q; } }
#pragma unroll
    for (int o = 1; o < 64; o <<= 1) { sa += __shfl_xor(sa, o); sb += __shfl_xor(sb, o); }
    if (lane == 0) { *ss0 = sa; *ss1 = sb; }
}

struct Ptrs {
    const float *x, *g_mix, *w_in, *b_gate, *conv_w, *w_a, *w_b, *w_out, *rel_bias, *g_ffn, *w_g, *w_u, *w_d, *g_final;
    float* out; unsigned char* ws;
};

constexpr int PI_IN = (NPROJ / 32) * (D / 64), PI_A = (D / 32) * (DCONV / 64), PI_B = (D / 32) * (DATT / 64), PI_O = (D / 32) * (D / 64), PI_GU = (NGU / 32) * (D / 64), PI_D = (D / 32) * (FF / 64);
constexpr int PI_ALL = PI_IN + PI_A + PI_B + PI_O + PI_GU + PI_D;
__device__ __forceinline__ void p0_weight_items(Frame& F, const Ptrs& P, int lo, int hi, int gw, int NGW) {
    LAS float* scr = (LAS float*)(F.lds + RING_OFF + F.wave * 16384);
    bf16* WinT = (bf16*)(P.ws + WS_WIN); bf16* WaT = (bf16*)(P.ws + WS_WA); bf16* WbT = (bf16*)(P.ws + WS_WB); bf16* WoutT = (bf16*)(P.ws + WS_WOUT);
    bf16* WguT = (bf16*)(P.ws + WS_WGU); bf16* WdT = (bf16*)(P.ws + WS_WD);
    for (int it = lo + gw; it < hi; it += NGW) {
        int r = it;
        if (r < PI_IN) { const int db = r / (D / 64), kb = r % (D / 64), drow0 = 32 * db; int scol0, nvalid;
            if (drow0 < 2048) { scol0 = drow0; nvalid = 32; }
            else if (drow0 < 2560) { scol0 = drow0 + 128; nvalid = 32; }
            else if (drow0 < 2688) { scol0 = drow0 - 512; nvalid = 32; }
            else if (drow0 < 2752) { scol0 = drow0; nvalid = 32; }
            else if (drow0 == 2752) { scol0 = 2752; nvalid = 8; }
            else if (drow0 < PC_GA) { scol0 = 0; nvalid = 0; }
            else { scol0 = drow0 - 56; nvalid = 32; }
            if (drow0 >= PC_GA) p0_transpose_item(P.w_in, D, NPROJ_SRC, 64 * kb, scol0, nvalid, (bf16*)(P.ws + WS_WG8), drow0 - PC_GA + DATT, P.g_mix, scr, F.lane, D, 64 * kb, true);
            else if (drow0 >= PC_Q && drow0 < PC_IQ) p0_transpose_item(P.w_in, D, NPROJ_SRC, 64 * kb, scol0, nvalid, (bf16*)(P.ws + WS_WG8), drow0 - PC_Q, P.g_mix, scr, F.lane, D, 64 * kb, true);
            else p0_transpose_item(P.w_in, D, NPROJ_SRC, 64 * kb, scol0, nvalid, WinT, drow0 < PC_Q ? drow0 : drow0 - DATT, P.g_mix, scr, F.lane);
            continue; } r -= PI_IN;
        if (r < PI_A) { const int db = r / (DCONV / 64), kb = r % (DCONV / 64); p0_transpose_item(P.w_a, DCONV, D, 64 * kb, 32 * db, 32, WaT, 32 * db, nullptr, scr, F.lane, D, 64 * kb); continue; } r -= PI_A;
        if (r < PI_B) { const int db = r / (DATT / 64), kb = r % (DATT / 64); p0_transpose_item(P.w_b, DATT, D, 64 * kb, 32 * db, 32, WaT, 32 * db, nullptr, scr, F.lane, D, DCONV + 64 * kb); continue; } r -= PI_B;
        if (r < PI_O) { const int db = r / (D / 64), kb = r % (D / 64); p0_transpose_item(P.w_out, D, D, 64 * kb, 32 * db, 32, WoutT, 32 * db, nullptr, scr, F.lane); continue; } r -= PI_O;
        if (r < PI_GU) { const int db = r / (D / 64), kb = r % (D / 64), drow0 = 32 * db, p = drow0 >> 8, bj = (drow0 >> 7) & 1, q = (drow0 >> 5) & 3;
            p0_transpose_item(bj ? P.w_u : P.w_g, D, FF, 64 * kb, 128 * p + 32 * q, 32, WguT, drow0, P.g_ffn, scr, F.lane); continue; } r -= PI_GU;
        { const int db = r / (FF / 64), kb = r % (FF / 64); p0_transpose_item(P.w_d, FF, D, 64 * kb, 32 * db, 32, WdT, 32 * db, nullptr, scr, F.lane); }
    }
}
__device__ __forceinline__ void p0_prologue(Frame& F, const Ptrs& P, bool all_weights) {
    const int gw = F.vcu * NWAVES + F.wave, NGW = F.G * NWAVES;
    p0_weight_items(F, P, 0, all_weights ? PI_ALL : PI_IN, gw, NGW);
    bf16* XB = (bf16*)P.out; float* SSQ0 = (float*)(P.ws + WS_SSQ0);
    for (int m = gw; m < M; m += 2 * NGW) { const int m1 = (m + NGW < M) ? m + NGW : m;
        x_rows2_to_bf16(F.lane, P.x + (size_t)m * D, P.x + (size_t)m1 * D, XB + (size_t)m * D, XB + (size_t)m1 * D, SSQ0 + m, SSQ0 + m1, (unsigned*)(P.ws + WS_XB8) + (size_t)m * (D / 4), (unsigned*)(P.ws + WS_XB8) + (size_t)m1 * (D / 4)); }
}

namespace pg8 {
template <bool F8_> struct EpiProj {
    static constexpr bool PERM = true, AFTER_DRAIN = false, HAS_PRE = true, HAS_MID = false, HAS_EXT = false, F8 = F8_;
    static constexpr int NVM = 16;
    bf16_t* O; int ldc; bf16_t* KV; bf16_t* IKF; bf16_t* IW; int kv_tile; PG8_LAS const float* bgate; int gate_col0; bf16_t* JUNK; const float* SSQ; PG8_LAS float* RS; int pn_split, pn_off0, pn_off1;
    __device__ __forceinline__ void pre(const Unit& u, int wr, int fr, float (&carry)[8]) const {
        const int have = __builtin_amdgcn_readfirstlane(__builtin_bit_cast(int, carry[0])) - 1;
        if (u.pm != have) { const int par = __builtin_amdgcn_readfirstlane(__builtin_bit_cast(int, carry[1])) ^ 1; const int t = threadIdx.x;
            if (t < BM) RS[par * BM + t] = __builtin_amdgcn_rsqf(SSQ[u.pm * BM + t] * (1.0f / D) + 1e-6f);
            carry[0] = __builtin_bit_cast(float, u.pm + 1); carry[1] = __builtin_bit_cast(float, par); }
    }
    template <bool GATE> __device__ __forceinline__ void body(const f32x4 (&acc)[2][2][4][2], const Unit& u0, int wr, int wc, int fr, int fq, const float (&carry)[8]) const {
        Unit u; u.pm = u0.pm; u.pn = u0.pn + (u0.pn < pn_split ? pn_off0 : pn_off1);
        int row0 = u.pm * BM + wr * 64 + fr; const bool kv = !GATE && (u.pn == kv_tile); int cid = 4 * wc + fq;
        asm volatile("" : "+v"(row0), "+v"(cid));
        const PG8_LAS float* rs = RS + __builtin_amdgcn_readfirstlane(__builtin_bit_cast(int, carry[1])) * BM + wr * 64 + fr;
        float rst[8];
#pragma unroll
        for (int ai = 0; ai < 2; ++ai)
#pragma unroll
            for (int m = 0; m < 4; ++m) rst[4 * ai + m] = rs[ai * HALF + m * 16];
        f32x4 gb0[2], gb1[2];
#pragma unroll
        for (int bj = 0; bj < 2; ++bj) { gb0[bj] = (f32x4){0.f, 0.f, 0.f, 0.f}; gb1[bj] = gb0[bj];
            if (GATE) { PG8_LAS const float* bp = bgate + (u.pn * BM - gate_col0) + bj * HALF + 8 * cid; gb0[bj] = *(PG8_LAS const f32x4*)bp; gb1[bj] = *(PG8_LAS const f32x4*)(bp + 4); } }
        f32x4 gbn0[2], gbn1[2];
#pragma unroll
        for (int bj = 0; bj < 2; ++bj) { gbn0[bj] = gb0[bj] * -1.4426950408889634f; gbn1[bj] = gb1[bj] * -1.4426950408889634f; }
#pragma unroll
        for (int ai = 0; ai < 2; ++ai)
#pragma unroll
            for (int m = 0; m < 4; ++m) { const int row = row0 + ai * HALF + m * 16;
#pragma unroll
                for (int bj = 0; bj < 2; ++bj) { f32x4 v0 = acc[ai][bj][m][0] * rst[4 * ai + m], v1 = acc[ai][bj][m][1] * rst[4 * ai + m];
                    if (GATE) {
                        const float rn = -1.4426950408889634f * rst[4 * ai + m];
#pragma unroll
                        for (int k = 0; k < 4; ++k) { float t0, t1;
                            asm("v_fma_f32 %0, %1, %2, %3" : "=v"(t0) : "v"(acc[ai][bj][m][0][k]), "v"(rn), "v"(gbn0[bj][k])); asm("v_fma_f32 %0, %1, %2, %3" : "=v"(t1) : "v"(acc[ai][bj][m][1][k]), "v"(rn), "v"(gbn1[bj][k]));
                            v0[k] = t0; v1[k] = t1; }
                        typedef unsigned u32x2g __attribute__((ext_vector_type(2)));
                        u32x2g w8; w8.x = 0u; w8.y = 0u;
#pragma unroll
                        for (int k = 0; k < 4; ++k) {
                            const float x0 = __builtin_rintf(__builtin_amdgcn_fmed3f(__builtin_amdgcn_rcpf(__builtin_fmaf(__builtin_amdgcn_exp2f(v0[k]), 0.00390625f, 0.00390625f)), 1.0f, 255.0f));
                            const float x1 = __builtin_rintf(__builtin_amdgcn_fmed3f(__builtin_amdgcn_rcpf(__builtin_fmaf(__builtin_amdgcn_exp2f(v1[k]), 0.00390625f, 0.00390625f)), 1.0f, 255.0f));
                            w8.x = __builtin_amdgcn_cvt_pk_u8_f32(x0, (unsigned)k, w8.x); w8.y = __builtin_amdgcn_cvt_pk_u8_f32(x1, (unsigned)k, w8.y); }
                        *(u32x2g*)((unsigned char*)(O + (size_t)row * ldc + gate_col0) + (u.pn * BM - gate_col0) + bj * HALF + 8 * cid) = w8;
                        continue; }
                    u32x4 w; w.x = cvt_pk_bf16(v0[0], v0[1]); w.y = cvt_pk_bf16(v0[2], v0[3]); w.z = cvt_pk_bf16(v1[0], v1[1]); w.w = cvt_pk_bf16(v1[2], v1[3]);
                    if (!kv) *(u32x4*)(O + (size_t)row * ldc + u.pn * BM + bj * HALF + 8 * cid) = w;
                    else if (bj == 0) { typedef unsigned u32x2k __attribute__((ext_vector_type(2)));
                        int k0 = __builtin_amdgcn_cvt_pk_fp8_f32(v0[0], v0[1], 0, false); k0 = __builtin_amdgcn_cvt_pk_fp8_f32(v0[2], v0[3], k0, true);
                        int k1 = __builtin_amdgcn_cvt_pk_fp8_f32(v1[0], v1[1], 0, false); k1 = __builtin_amdgcn_cvt_pk_fp8_f32(v1[2], v1[3], k1, true);
                        u32x2k w8; w8.x = (unsigned)k0; w8.y = (unsigned)k1; *(u32x2k*)((unsigned char*)KV + (size_t)row * 128 + 8 * cid) = w8; }
                    else if (cid < 8) { const int s = row & 4095; *(u32x4*)(IKF + (size_t)(row >> 12) * (4096 * 64) + (s >> 5) * 2048 + cid * 256 + (s & 31) * 8) = w; }
                    else if (cid == 8) *(u32x4*)(IW + (size_t)row * 8) = w;
                    else *(u32x4*)(JUNK + (size_t)(row & 1023) * 8) = w; } }
    }
    __device__ __forceinline__ void run(const f32x4 (&acc)[2][2][4][2], const Unit& u, int wr, int wc, int fr, int fq, const float (&carry)[8]) const {
        if ((u.pn + (u.pn < pn_split ? pn_off0 : pn_off1)) * BM >= gate_col0) body<true>(acc, u, wr, wc, fr, fq, carry); else body<false>(acc, u, wr, wc, fr, fq, carry);
    }
};
template <bool ACCUM> struct EpiGate {
    static constexpr bool PERM = true, AFTER_DRAIN = false, HAS_PRE = false, HAS_MID = false, HAS_EXT = false, F8 = false;
    static constexpr int NVM = 0;
    bf16_t* O; const bf16_t* G; int ldg; const float* bg;
    __device__ __forceinline__ void operator()(const f32x4 (&acc)[2][2][4][2], const Unit& u, int wr, int wc, int fr, int fq) const {
        const int row0 = u.pm * BM + wr * 64 + fr, col0 = u.pn * BM + wc * 32 + 8 * fq;
        f32x4 bv[2][2];
#pragma unroll
        for (int bj = 0; bj < 2; ++bj)
#pragma unroll
            for (int n = 0; n < 2; ++n) bv[bj][n] = *(const f32x4*)(bg + col0 + bj * HALF + 4 * n);
#pragma unroll
        for (int ai = 0; ai < 2; ++ai) {
            u32x4 gv[4][2], ov[4][2];
#pragma unroll
            for (int m = 0; m < 4; ++m) { const size_t row = (size_t)(row0 + ai * HALF + m * 16);
#pragma unroll
                for (int bj = 0; bj < 2; ++bj) { gv[m][bj] = *(const u32x4*)(G + row * ldg + col0 + bj * HALF); if (ACCUM) ov[m][bj] = *(const u32x4*)(O + row * D + col0 + bj * HALF); } }
#pragma unroll
            for (int m = 0; m < 4; ++m) { const size_t row = (size_t)(row0 + ai * HALF + m * 16);
#pragma unroll
                for (int bj = 0; bj < 2; ++bj) { const u32x4 g4 = gv[m][bj];
                    float g[8] = {bf_lo(g4.x), bf_hi(g4.x), bf_lo(g4.y), bf_hi(g4.y), bf_lo(g4.z), bf_hi(g4.z), bf_lo(g4.w), bf_hi(g4.w)};
                    float o[8];
#pragma unroll
                    for (int k = 0; k < 4; ++k) { o[k] = fast_sigmoid(g[k] + bv[bj][0][k]) * acc[ai][bj][m][0][k]; o[4 + k] = fast_sigmoid(g[4 + k] + bv[bj][1][k]) * acc[ai][bj][m][1][k]; }
                    if (ACCUM) { const u32x4 o4 = ov[m][bj];
                        o[0] += bf_lo(o4.x); o[1] += bf_hi(o4.x); o[2] += bf_lo(o4.y); o[3] += bf_hi(o4.y); o[4] += bf_lo(o4.z); o[5] += bf_hi(o4.z); o[6] += bf_lo(o4.w); o[7] += bf_hi(o4.w); }
                    u32x4 w; w.x = cvt_pk_bf16(o[0], o[1]); w.y = cvt_pk_bf16(o[2], o[3]); w.z = cvt_pk_bf16(o[4], o[5]); w.w = cvt_pk_bf16(o[6], o[7]);
                    *(u32x4*)(O + row * D + col0 + bj * HALF) = w; } }
            asm volatile("" ::: "memory"); }
    }
};
struct EpiGateMerged {
    static constexpr bool PERM = true, AFTER_DRAIN = false, HAS_PRE = false, HAS_MID = true, HAS_EXT = false, F8 = false; static constexpr int MID_T = 8;
    static constexpr int NVM = 16;
    bf16_t* O; const unsigned char* G8; int ldgb;
    typedef unsigned u32x2g __attribute__((ext_vector_type(2)));
    static __device__ __forceinline__ void unpack8(u32x2g g, float (&f)[8]) {
        f[0] = (float)(g.x & 255u); f[1] = (float)((g.x >> 8) & 255u); f[2] = (float)((g.x >> 16) & 255u); f[3] = (float)(g.x >> 24);
        f[4] = (float)(g.y & 255u); f[5] = (float)((g.y >> 8) & 255u); f[6] = (float)((g.y >> 16) & 255u); f[7] = (float)(g.y >> 24); }
    __device__ __forceinline__ void mid(f32x4 (&acc)[2][2][4][2], const Unit& u, int wr, int wc, int fr, int fq) const {
        int row0 = u.pm * BM + wr * 64 + fr, col0 = u.pn * BM + wc * 32 + 8 * fq;
        asm volatile("" : "+v"(row0), "+v"(col0));
#pragma unroll
        for (int bj = 0; bj < 2; ++bj) {
            u32x2g ga[2][4], gb[2][4];
#pragma unroll
            for (int ai = 0; ai < 2; ++ai)
#pragma unroll
                for (int m = 0; m < 4; ++m) { const unsigned char* gp = G8 + (size_t)(row0 + ai * HALF + m * 16) * ldgb + col0 + bj * HALF;
                    ga[ai][m] = *(const u32x2g*)gp; gb[ai][m] = *(const u32x2g*)(gp + D); }
#pragma unroll
            for (int ai = 0; ai < 2; ++ai)
#pragma unroll
                for (int m = 0; m < 4; ++m) { float xa[8], xb[8]; unpack8(ga[ai][m], xa); unpack8(gb[ai][m], xb);
#pragma unroll
                    for (int k = 0; k < 4; ++k) { acc[ai][bj][m][0][k] *= xa[k] * __builtin_amdgcn_rcpf(xb[k]); acc[ai][bj][m][1][k] *= xa[4 + k] * __builtin_amdgcn_rcpf(xb[4 + k]); } }
            asm volatile("" ::: "memory"); }
    }
    __device__ __forceinline__ void operator()(const f32x4 (&acc)[2][2][4][2], const Unit& u, int wr, int wc, int fr, int fq) const {
        int row0 = u.pm * BM + wr * 64 + fr, col0 = u.pn * BM + wc * 32 + 8 * fq;
        asm volatile("" : "+v"(row0), "+v"(col0));
        u32x2g gb[2][4][2];
#pragma unroll
        for (int ai = 0; ai < 2; ++ai)
#pragma unroll
            for (int m = 0; m < 4; ++m) { const unsigned char* gp = G8 + (size_t)(row0 + ai * HALF + m * 16) * ldgb + D + col0;
#pragma unroll
                for (int bj = 0; bj < 2; ++bj) gb[ai][m][bj] = *(const u32x2g*)(gp + bj * HALF); }
#pragma unroll
        for (int ai = 0; ai < 2; ++ai) {
#pragma unroll
            for (int m = 0; m < 4; ++m) { const size_t row = (size_t)(row0 + ai * HALF + m * 16);
#pragma unroll
                for (int bj = 0; bj < 2; ++bj) { float xb[8]; unpack8(gb[ai][m][bj], xb);
                    float o[8];
#pragma unroll
                    for (int k = 0; k < 4; ++k) { o[k] = (xb[k] * 0.00390625f) * acc[ai][bj][m][0][k]; o[4 + k] = (xb[4 + k] * 0.00390625f) * acc[ai][bj][m][1][k]; }
                    u32x4 w; w.x = cvt_pk_bf16(o[0], o[1]); w.y = cvt_pk_bf16(o[2], o[3]); w.z = cvt_pk_bf16(o[4], o[5]); w.w = cvt_pk_bf16(o[6], o[7]);
                    *(u32x4*)(O + row * D + col0 + bj * HALF) = w; } }
            asm volatile("" ::: "memory"); }
    }
};
template <int MODE> struct EpiResid {
    static constexpr bool PERM = false, AFTER_DRAIN = false, HAS_PRE = false, HAS_MID = false, HAS_EXT = (MODE == 2), F8 = false;
    static constexpr int NVM = 32;
    const float* base; const bf16_t* XBin; bf16_t* XB; float* SSQ;
    __device__ __forceinline__ void operator()(const f32x4 (&acc)[2][2][4][2], const Unit& u, int wr, int wc, int fr, int fq) const {
        typedef unsigned u32x2v __attribute__((ext_vector_type(2)));
        const int row0 = u.pm * BM + wr * 64 + fr, col0 = u.pn * BM + wc * 32 + 4 * fq;
#pragma unroll
        for (int ai = 0; ai < 2; ++ai) {
            f32x4 xf[4][2][2]; u32x2v xh[4][2][2];
#pragma unroll
            for (int m = 0; m < 4; ++m) { const size_t row = (size_t)(row0 + ai * HALF + m * 16);
#pragma unroll
                for (int bj = 0; bj < 2; ++bj)
#pragma unroll
                    for (int n = 0; n < 2; ++n) { const size_t off = row * D + col0 + bj * HALF + n * 16;
                        if (MODE == 0) xf[m][bj][n] = *(const f32x4*)(base + off); else if (MODE == 1) xh[m][bj][n] = *(const u32x2v*)(XBin + off); } }
#pragma unroll
            for (int m = 0; m < 4; ++m) { const size_t row = (size_t)(row0 + ai * HALF + m * 16); float ss = 0.f;
#pragma unroll
                for (int bj = 0; bj < 2; ++bj)
#pragma unroll
                    for (int n = 0; n < 2; ++n) { const size_t off = row * D + col0 + bj * HALF + n * 16;
                        f32x4 o;
                        if (MODE == 0) o = xf[m][bj][n] + acc[ai][bj][m][n];
                        else if (MODE == 2) o = acc[ai][bj][m][n];
                        else { const u32x2v xb = xh[m][bj][n]; o = (f32x4){bf_lo(xb.x), bf_hi(xb.x), bf_lo(xb.y), bf_hi(xb.y)} + acc[ai][bj][m][n]; }
                        u32x2v w; w.x = cvt_pk_bf16(o[0], o[1]); w.y = cvt_pk_bf16(o[2], o[3]); *(u32x2v*)(XB + off) = w;
                        ss += (o[0] * o[0] + o[1] * o[1]) + (o[2] * o[2] + o[3] * o[3]); }
                ss += __shfl_xor(ss, 16); ss += __shfl_xor(ss, 32);
                if (fq == 0) __hip_atomic_fetch_add(SSQ + row, ss, __ATOMIC_RELAXED, __HIP_MEMORY_SCOPE_AGENT); }
            asm volatile("" ::: "memory"); }
    }
};
struct EpiFinal {
    static constexpr bool PERM = false, AFTER_DRAIN = false, HAS_PRE = false, HAS_MID = false, HAS_EXT = true, F8 = false;
    static constexpr int NVM = 32;
    float* OUT; float* SSQ; const float* gfin; unsigned* RC; unsigned* tmo;
    __device__ __forceinline__ void operator()(const f32x4 (&acc)[2][2][4][2], const Unit& u, int wr, int wc, int fr, int fq) const {
        const int row0 = u.pm * BM + wr * 64 + fr, col0 = u.pn * BM + wc * 32 + 4 * fq;
#pragma unroll
        for (int ai = 0; ai < 2; ++ai)
#pragma unroll
            for (int m = 0; m < 4; ++m) { float ss = 0.f;
#pragma unroll
                for (int bj = 0; bj < 2; ++bj)
#pragma unroll
                    for (int n = 0; n < 2; ++n) { const f32x4 o = acc[ai][bj][m][n]; ss += (o[0] * o[0] + o[1] * o[1]) + (o[2] * o[2] + o[3] * o[3]); }
                ss += __shfl_xor(ss, 16); ss += __shfl_xor(ss, 32);
                if (fq == 0) __hip_atomic_fetch_add(SSQ + (size_t)(row0 + ai * HALF + m * 16), ss, __ATOMIC_RELAXED, __HIP_MEMORY_SCOPE_AGENT); }
        f32x4 gg[2][2];
#pragma unroll
        for (int bj = 0; bj < 2; ++bj)
#pragma unroll
            for (int n = 0; n < 2; ++n) gg[bj][n] = *(const f32x4*)(gfin + col0 + bj * HALF + n * 16);
        asm volatile("s_waitcnt vmcnt(0)" ::: "memory");
        __builtin_amdgcn_s_barrier();
        if (threadIdx.x == 0) { unsigned* rc = RC + u.pm; (void)__hip_atomic_fetch_add(rc, 1u, __ATOMIC_RELAXED, __HIP_MEMORY_SCOPE_AGENT);
            unsigned sp = 0;
            while (__hip_atomic_load(rc, __ATOMIC_RELAXED, __HIP_MEMORY_SCOPE_AGENT) < 4u) { __builtin_amdgcn_s_sleep(1);
                if ((++sp & 255u) == 0u) { if (__hip_atomic_load(tmo, __ATOMIC_RELAXED, __HIP_MEMORY_SCOPE_AGENT)) break; if (sp > (1u << 18)) { atomicAdd(tmo, 1u); break; } } } }
        __builtin_amdgcn_s_barrier();
        float rs[2][4];
#pragma unroll
        for (int ai = 0; ai < 2; ++ai)
#pragma unroll
            for (int m = 0; m < 4; ++m) { const unsigned b = __hip_atomic_load((const unsigned*)(SSQ + (size_t)(row0 + ai * HALF + m * 16)), __ATOMIC_RELAXED, __HIP_MEMORY_SCOPE_AGENT);
                rs[ai][m] = __builtin_amdgcn_rsqf(__builtin_bit_cast(float, b) * (1.f / D) + EPS); }
#pragma unroll
        for (int ai = 0; ai < 2; ++ai) {
#pragma unroll
            for (int m = 0; m < 4; ++m) { const size_t row = (size_t)(row0 + ai * HALF + m * 16);
#pragma unroll
                for (int bj = 0; bj < 2; ++bj)
#pragma unroll
                    for (int n = 0; n < 2; ++n) *(f32x4*)(OUT + row * D + col0 + bj * HALF + n * 16) = acc[ai][bj][m][n] * rs[ai][m] * gg[bj][n]; }
            asm volatile("" ::: "memory"); }
    }
};
struct EpiSwiGLU {
    static constexpr bool PERM = true, AFTER_DRAIN = false, HAS_PRE = true, HAS_MID = false, HAS_EXT = false, F8 = false;
    static constexpr int NVM = 8;
    bf16_t* O; int ldc; const float* SSQ; PG8_LAS float* RS;
    __device__ __forceinline__ void pre(const Unit& u, int wr, int fr, float (&carry)[8]) const {
        const int have = __builtin_amdgcn_readfirstlane(__builtin_bit_cast(int, carry[0])) - 1;
        if (u.pm != have) { const int par = __builtin_amdgcn_readfirstlane(__builtin_bit_cast(int, carry[1])) ^ 1; const int t = threadIdx.x;
            if (t < BM) RS[par * BM + t] = __builtin_amdgcn_rsqf(SSQ[u.pm * BM + t] * (1.0f / D) + 1e-6f);
            carry[0] = __builtin_bit_cast(float, u.pm + 1); carry[1] = __builtin_bit_cast(float, par); }
    }
    __device__ __forceinline__ void run(const f32x4 (&acc)[2][2][4][2], const Unit& u, int wr, int wc, int fr, int fq, const float (&carry)[8]) const {
        int row0 = u.pm * BM + wr * 64 + fr, col0 = u.pn * HALF + wc * 32 + 8 * fq;
        asm volatile("" : "+v"(row0), "+v"(col0));
        const PG8_LAS float* rs = RS + __builtin_amdgcn_readfirstlane(__builtin_bit_cast(int, carry[1])) * BM + wr * 64 + fr;
        float rst[8];
#pragma unroll
        for (int ai = 0; ai < 2; ++ai)
#pragma unroll
            for (int m = 0; m < 4; ++m) rst[4 * ai + m] = rs[ai * HALF + m * 16];
#pragma unroll
        for (int ai = 0; ai < 2; ++ai)
#pragma unroll
            for (int m = 0; m < 4; ++m) { const size_t row = (size_t)(row0 + ai * HALF + m * 16);
                const float rstd = rst[4 * ai + m]; const float k1 = -1.4426950408889634f * rstd, ir2 = __builtin_amdgcn_rcpf(rstd * rstd);
                float o[8];
#pragma unroll
                for (int n = 0; n < 2; ++n)
#pragma unroll
                    for (int k = 0; k < 4; ++k) { const float ag = acc[ai][0][m][n][k], au = acc[ai][1][m][n][k];
                        const float e = __builtin_amdgcn_exp2f(ag * k1); o[4 * n + k] = (ag * au) * __builtin_amdgcn_rcpf(__builtin_fmaf(e, ir2, ir2)); }
                u32x4 w; w.x = cvt_pk_bf16(o[0], o[1]); w.y = cvt_pk_bf16(o[2], o[3]); w.z = cvt_pk_bf16(o[4], o[5]); w.w = cvt_pk_bf16(o[6], o[7]);
                *(u32x4*)(O + row * ldc + col0) = w; }
    }
};
}

__device__ __forceinline__ void p2_conv(Frame& F, const Ptrs& P) {
    const bf16* PROJ = (const bf16*)(P.ws + WS_PROJ); bf16* CONV = (bf16*)(P.ws + WS_CONV);
    const int gt = F.vcu * (NWAVES * 64) + F.tid, NT = F.G * NWAVES * 64;
    for (int item = gt; item < (M / 16) * (DCONV / 8); item += NT) {
        const int cg = item & 63, rb = item >> 6, c0 = 8 * cg, m0 = 16 * rb, t0 = m0 & (SEQ - 1);
        float w[3][8];
#pragma unroll
        for (int j = 0; j < 3; ++j) { const f32x4 a = *(const GAS f32x4*)(P.conv_w + j * DCONV + c0), b = *(const GAS f32x4*)(P.conv_w + j * DCONV + c0 + 4);
            w[j][0] = a.x; w[j][1] = a.y; w[j][2] = a.z; w[j][3] = a.w; w[j][4] = b.x; w[j][5] = b.y; w[j][6] = b.z; w[j][7] = b.w; }
        float u2[8], u1[8];
#pragma unroll
        for (int k = 0; k < 8; ++k) { u2[k] = 0.f; u1[k] = 0.f; }
        if (t0 >= 2) {
#pragma unroll
            for (int d = 0; d < 2; ++d) { const bf16* rp = PROJ + (size_t)(m0 - 2 + d) * NPROJ;
                const v4u cc = *(const GAS v4u*)(rp + PC_CC + c0), cx = *(const GAS v4u*)(rp + PC_CX + c0);
                float* dst = d ? u1 : u2;
                dst[0] = bf_lo(cc.x) * bf_lo(cx.x); dst[1] = bf_hi(cc.x) * bf_hi(cx.x); dst[2] = bf_lo(cc.y) * bf_lo(cx.y); dst[3] = bf_hi(cc.y) * bf_hi(cx.y);
                dst[4] = bf_lo(cc.z) * bf_lo(cx.z); dst[5] = bf_hi(cc.z) * bf_hi(cx.z); dst[6] = bf_lo(cc.w) * bf_lo(cx.w); dst[7] = bf_hi(cc.w) * bf_hi(cx.w); }
        }
#pragma unroll 4
        for (int i = 0; i < 16; ++i) { const bf16* rp = PROJ + (size_t)(m0 + i) * NPROJ;
            const v4u cb = *(const GAS v4u*)(rp + PC_CB + c0), cc = *(const GAS v4u*)(rp + PC_CC + c0), cx = *(const GAS v4u*)(rp + PC_CX + c0);
            float u0[8], b[8];
            u0[0] = bf_lo(cc.x) * bf_lo(cx.x); u0[1] = bf_hi(cc.x) * bf_hi(cx.x); u0[2] = bf_lo(cc.y) * bf_lo(cx.y); u0[3] = bf_hi(cc.y) * bf_hi(cx.y);
            u0[4] = bf_lo(cc.z) * bf_lo(cx.z); u0[5] = bf_hi(cc.z) * bf_hi(cx.z); u0[6] = bf_lo(cc.w) * bf_lo(cx.w); u0[7] = bf_hi(cc.w) * bf_hi(cx.w);
            b[0] = bf_lo(cb.x); b[1] = bf_hi(cb.x); b[2] = bf_lo(cb.y); b[3] = bf_hi(cb.y); b[4] = bf_lo(cb.z); b[5] = bf_hi(cb.z); b[6] = bf_lo(cb.w); b[7] = bf_hi(cb.w);
            float o[8];
#pragma unroll
            for (int k = 0; k < 8; ++k) { o[k] = b[k] * (w[0][k] * u2[k] + w[1][k] * u1[k] + w[2][k] * u0[k]); u2[k] = u1[k]; u1[k] = u0[k]; }
            v4u ov; ov.x = pk2(o[0], o[1]); ov.y = pk2(o[2], o[3]); ov.z = pk2(o[4], o[5]); ov.w = pk2(o[6], o[7]);
            *(GAS v4u*)(CONV + (size_t)(m0 + i) * D + c0) = ov; }
    }
}

typedef float f32x16 __attribute__((ext_vector_type(16)));
typedef short v4i16_t __attribute__((ext_vector_type(4)));
__device__ __forceinline__ int mbcnt64(unsigned long long m) { return (int)__builtin_amdgcn_mbcnt_hi((unsigned)(m >> 32), __builtin_amdgcn_mbcnt_lo((unsigned)m, 0u)); }
__device__ __forceinline__ int wave_sum_i32(int c) {
    c += __builtin_amdgcn_update_dpp(0, c, 0xB1, 0xf, 0xf, true);
    c += __builtin_amdgcn_update_dpp(0, c, 0x4E, 0xf, 0xf, true);
    c += __builtin_amdgcn_update_dpp(0, c, 0x141, 0xf, 0xf, true);
    c += __builtin_amdgcn_update_dpp(0, c, 0x140, 0xf, 0xf, true);
    return __builtin_amdgcn_readlane(c, 0) + __builtin_amdgcn_readlane(c, 16) + __builtin_amdgcn_readlane(c, 32) + __builtin_amdgcn_readlane(c, 48);
}
__device__ __forceinline__ float z_upper(float p) {
    const bool fl = p > 0.5f; const float pp = fl ? 1.0f - p : p;
    const float t = __builtin_amdgcn_sqrtf(-2.0f * __logf(pp)); const float z = t - (2.30753f + 0.27061f * t) * __builtin_amdgcn_rcpf(1.0f + t * (0.99229f + 0.04481f * t));
    return fl ? -z : z;
}
constexpr int KPB_UNUSED = 144;
constexpr int VP_UNUSED = 160;
constexpr int SCR_VST = 0;
constexpr int IDX_OFF = TAB_OFF + 4096;
constexpr int CW_Q = 2048;
static_assert(IDX_OFF + 8 * 1280 <= LDS_BYTES, "LDS map (P2)");

__device__ __forceinline__ float fadd_np(float a, float b) { float r; asm("v_add_f32_e32 %0, %1, %2" : "=v"(r) : "v"(a), "v"(b)); return r; }
#define P2_DPPF(c, ctrl) ((c) + __builtin_bit_cast(float, __builtin_amdgcn_update_dpp(0, __builtin_bit_cast(int, (c)), (ctrl), 0xf, 0xf, true)))
__device__ __forceinline__ float wave_total_f32(float c) {
    c = P2_DPPF(c, 0xB1); c = P2_DPPF(c, 0x4E); c = P2_DPPF(c, 0x141); c = P2_DPPF(c, 0x140);
    return __builtin_bit_cast(float, __builtin_amdgcn_readlane(__builtin_bit_cast(int, c), 0)) + __builtin_bit_cast(float, __builtin_amdgcn_readlane(__builtin_bit_cast(int, c), 16)) +
           __builtin_bit_cast(float, __builtin_amdgcn_readlane(__builtin_bit_cast(int, c), 32)) + __builtin_bit_cast(float, __builtin_amdgcn_readlane(__builtin_bit_cast(int, c), 48));
}
template <int NR> __device__ __forceinline__ float lane_count_gt(const float (&v)[64], float tau) {
    const float BIG = 0x1p100f, nb = -tau * BIG; float c0 = 0.f, c1 = 0.f, c2 = 0.f, c3 = 0.f;
#pragma unroll
    for (int i = 0; i < NR; i += 4) {
        c0 = fadd_np(c0, __builtin_amdgcn_fmed3f(__builtin_fmaf(v[i], BIG, nb), 0.f, 1.f)); c1 = fadd_np(c1, __builtin_amdgcn_fmed3f(__builtin_fmaf(v[i + 1], BIG, nb), 0.f, 1.f));
        c2 = fadd_np(c2, __builtin_amdgcn_fmed3f(__builtin_fmaf(v[i + 2], BIG, nb), 0.f, 1.f)); c3 = fadd_np(c3, __builtin_amdgcn_fmed3f(__builtin_fmaf(v[i + 3], BIG, nb), 0.f, 1.f)); }
    return fadd_np(fadd_np(c0, c1), fadd_np(c2, c3));
}
template <int NR> __device__ __forceinline__ float lane_count_valid(const float (&v)[64]) {
    float c = 0.f;
#pragma unroll
    for (int i = 0; i < NR; ++i) c += (v[i] > -INFINITY) ? 1.f : 0.f;
    return c;
}
constexpr int P2_MAXPROBE = 8;
template <int NR> __device__ __forceinline__ void topk_search(const float (&v)[64], int nv, float mu, float sg, float& lo_o, float& hi_o, int& need_o, float& nhi_o, float& nlo_o) {
    float tau = mu + z_upper((float)TOPK * __builtin_amdgcn_rcpf((float)nv)) * sg;
    float step = fmaxf(0.25f * sg, 1e-6f * (fabsf(mu) + 1e-6f));
    const float wmin = 1e-6f * sg;
    float lo = -INFINITY, hi = INFINITY; int clo = nv, chi = 0; int k = 0; bool found = false; float cl = 0.f, nhi = 0.f, nlo = -1.f;
    const float lt = __builtin_amdgcn_logf((float)TOPK + 0.5f);
    for (int it = 0; it < P2_MAXPROBE; ++it) {
        cl = lane_count_gt<NR>(v, tau);
        const int c = (int)(wave_total_f32(cl) + 0.5f);
        if (c == TOPK) { found = true; break; }
        if (c > TOPK) { lo = tau; clo = c; nlo = cl; } else { hi = tau; chi = c; nhi = cl; }
        if (lo == -INFINITY) { tau = hi - step; step *= 2.f; }
        else if (hi == INFINITY) { tau = lo + step; step *= 2.f; }
        else {
            if (hi - lo < wmin) break;
            ++k; float nt;
            if (k % 3 == 0) nt = 0.5f * (lo + hi);
            else { const float a = __builtin_amdgcn_logf((float)clo + 0.5f), bb = __builtin_amdgcn_logf((float)chi + 0.5f); float f = (a - lt) * __builtin_amdgcn_rcpf(a - bb); f = fminf(fmaxf(f, 0.1f), 0.9f); nt = lo + (hi - lo) * f; }
            if (!(nt > lo && nt < hi)) nt = 0.5f * (lo + hi);
            if (!(nt > lo && nt < hi)) break;
            tau = nt;
        }
    }
    if (found) { lo_o = tau; hi_o = tau; need_o = 0; nhi_o = cl; nlo_o = cl; }
    else { if (hi == INFINITY) { hi = 3.0e38f; chi = 0; nhi = 0.f; }
        if (nlo < 0.f) nlo = lane_count_valid<NR>(v);
        lo_o = lo; hi_o = hi; need_o = TOPK - chi; nhi_o = nhi; nlo_o = nlo; }
}
constexpr int IDXW = 320;
__device__ __forceinline__ int lane_scan_incl(int x, int lane) {
    x += __builtin_amdgcn_update_dpp(0, x, 0x111, 0xf, 0xf, true); x += __builtin_amdgcn_update_dpp(0, x, 0x112, 0xf, 0xf, true);
    x += __builtin_amdgcn_update_dpp(0, x, 0x114, 0xf, 0xf, true); x += __builtin_amdgcn_update_dpp(0, x, 0x118, 0xf, 0xf, true);
    const int r0 = __builtin_amdgcn_readlane(x, 15), r1 = __builtin_amdgcn_readlane(x, 31), r2 = __builtin_amdgcn_readlane(x, 47);
    return x + (lane >= 16 ? r0 : 0) + (lane >= 32 ? r1 : 0) + (lane >= 48 ? r2 : 0);
}
template <int NR> __device__ __forceinline__ void topk_compact_lane(const float (&v)[64], float thr, int cnt, LAS unsigned* IDX, int lane) {
    const unsigned base = (unsigned)(size_t)IDX;
    unsigned k4 = base + 4u * (unsigned)(lane_scan_incl(cnt, lane) - cnt); const unsigned dump = base + 4u * (unsigned)(256 + lane);
#pragma unroll
    for (int i = 0; i < NR; ++i) { const bool a = v[i] > thr; *(LAS unsigned*)(size_t)(a ? k4 : dump) = 32u * (unsigned)(512 * (i >> 3) + 8 * lane + (i & 7)); k4 += a ? 4u : 0u; }
}
template <int NR> __device__ __forceinline__ void topk_compact_bracket(const float (&v)[64], float lo, float hi, int need, float nhi_f, float nlo_f, LAS unsigned* IDX, int lane) {
    const int nhi = (int)(nhi_f + 0.5f), nb = (int)(nlo_f + 0.5f) - nhi;
    const int pb = lane_scan_incl(nb, lane) - nb;
    int lim = need - pb; lim = lim < 0 ? 0 : lim; lim = lim > nb ? nb : lim;
    const bool full = (lim == nb), part = (lim > 0) && !full;
    topk_compact_lane<NR>(v, full ? lo : hi, nhi + (full ? nb : 0), IDX, lane);
    const unsigned long long pm = __ballot(part);
    if (pm != 0ull) {
        int k = TOPK - lim, kb = 0; const int dump = 256 + lane;
        asm volatile("" ::: "memory");
#pragma unroll
        for (int i = 0; i < NR; ++i) { const bool c = (v[i] > lo) && !(v[i] > hi); const bool take = part && c && (kb < lim);
            IDX[take ? k : dump] = 32u * (unsigned)(512 * (i >> 3) + 8 * lane + (i & 7)); k += take ? 1 : 0; kb += c ? 1 : 0; }
    }
}
typedef _Float16 f16x8 __attribute__((ext_vector_type(8)));
template <int NR> __device__ __forceinline__ int topk_select(const LAS unsigned char* row, int t, LAS unsigned* IDX, int lane) {
    float v[64]; float s1 = 0.f, s2 = 0.f; const int nv = t + 1;
    const int tb = t >> 9;
#pragma unroll
    for (int i = 0; i < NR / 8; ++i) { const f16x8 x = *(const LAS f16x8*)(row + 1024 * i + 16 * lane);
        if (i < tb) {
#pragma unroll
            for (int c = 0; c < 8; ++c) { const float xv = (float)x[c]; if (c == 0) { s1 += xv; s2 += xv * xv; } v[8 * i + c] = xv; } }
        else {
#pragma unroll
            for (int c = 0; c < 8; ++c) { const bool ok = (512 * i + 8 * lane + c) <= t; const float xv = (float)x[c]; if (c == 0) { const float val = ok ? xv : 0.f; s1 += val; s2 += val * val; } v[8 * i + c] = ok ? xv : -INFINITY; } } }
#pragma unroll
    for (int i = NR; i < 64; ++i) v[i] = -INFINITY;
    asm volatile("" ::: "memory");
    if (nv <= TOPK) { topk_compact_lane<NR>(v, -INFINITY, (int)(lane_count_valid<NR>(v) + 0.5f), IDX, lane); return nv; }
    s1 = wave_total_f32(s1); s2 = wave_total_f32(s2);
    const float ns = (float)((t >> 3) + 1);
    const float ins = __builtin_amdgcn_rcpf(ns); const float mu = s1 * ins, var = fmaxf(s2 * ins - mu * mu, 0.f);
    float lo, hi, nhi, nlo; int need;
    topk_search<NR>(v, nv, mu, __builtin_amdgcn_sqrtf(var), lo, hi, need, nhi, nlo);
    if (need == 0) topk_compact_lane<NR>(v, hi, (int)(nhi + 0.5f), IDX, lane);
    else topk_compact_bracket<NR>(v, lo, hi, need, nhi, nlo, IDX, lane);
    return TOPK;
}

__device__ __forceinline__ unsigned pk4_fp8(float a, float b, float c, float d) { int w = __builtin_amdgcn_cvt_pk_fp8_f32(a, b, 0, false); w = __builtin_amdgcn_cvt_pk_fp8_f32(c, d, w, true); return (unsigned)w; }
typedef int v2i_t __attribute__((ext_vector_type(2)));
typedef long v2l_t __attribute__((ext_vector_type(2)));
#ifndef P2_TR8
#define P2_TR8 1
#endif
__device__ __forceinline__ long p2_vfrag(const LAS unsigned char* buf, int vra, int coff, int fr, int fq) {
#if P2_TR8
    const v2i_t t = __builtin_amdgcn_ds_read_tr8_b64_v2i32((LAS v2i_t*)(buf + vra + coff));
    return (long)((unsigned long long)(unsigned)t.x | ((unsigned long long)(unsigned)t.y << 32));
#else
    unsigned long long r = 0ull;
#pragma unroll
    for (int j = 0; j < 8; ++j) { const int rho = 4 * fq + (j & 3) + 16 * (j >> 2); const int swz = ((rho >> 1) & 7) ^ (4 * (rho >> 4));
        const int chunk = (coff >> 4) ^ ((2 * fq + (((fr >> 1) >> 1) & 1)) ^ (4 * ((fr >> 1) >> 2)));
        r |= (unsigned long long)buf[rho * 128 + 16 * (chunk ^ swz) + fr] << (8 * j); }
    return (long)r;
#endif
}
__device__ __forceinline__ float p2_x8(float x) { return __builtin_bit_cast(float, __builtin_amdgcn_update_dpp(0, __builtin_bit_cast(int, x), 0x128, 0xf, 0xf, true)); }
__device__ __forceinline__ void p2_sw16(float& a, float& b) { asm volatile("s_nop 1\n\tv_permlane16_swap_b32 %0, %1" : "+v"(a), "+v"(b)); }
__device__ __forceinline__ void p2_sw32(float& a, float& b) { asm volatile("s_nop 1\n\tv_permlane32_swap_b32 %0, %1" : "+v"(a), "+v"(b)); }
__device__ __forceinline__ float p2_allmax4(float x) { x = fmaxf(x, p2_x8(x)); float a = x, b = x; p2_sw16(a, b); x = fmaxf(a, b); a = x; b = x; p2_sw32(a, b); return fmaxf(a, b); }
__device__ __forceinline__ float p2_allsum4(float x) { x += p2_x8(x); float a = x, b = x; p2_sw16(a, b); x = a + b; a = x; b = x; p2_sw32(a, b); return a + b; }
__device__ __forceinline__ void half_barrier(volatile LAS unsigned* hb, int lane) {
    LDS_WAIT(); asm volatile("" ::: "memory");
    if (lane == 0) {
        const unsigned g = hb[1];
        const unsigned old = __hip_atomic_fetch_add((LAS unsigned*)hb, 1u, __ATOMIC_RELAXED, __HIP_MEMORY_SCOPE_WORKGROUP);
        if (old == 3u) { hb[0] = 0u; hb[1] = g + 1u; }
        else { unsigned sp = 0u; while (hb[1] == g) { __builtin_amdgcn_s_sleep(1); if (++sp > (1u << 22)) break; } }
    }
    asm volatile("" ::: "memory");
}

__device__ __forceinline__ void p2_attn(Frame& F, const Ptrs& P) {
    const bf16* PROJ = (const bf16*)(P.ws + WS_PROJ); const bf16* KVI = (const bf16*)(P.ws + WS_KVI); const bf16* IKFp = (const bf16*)(P.ws + WS_IKF); const bf16* IWp = (const bf16*)(P.ws + WS_IW); bf16* ATTN = (bf16*)(P.ws + WS_CONV);
    const int wave = F.wave, half = wave >> 2, w4 = wave & 3;
    LAS unsigned char* hrows = F.lds + RING_OFF + half * 65536;
    LAS _Float16* SC = (LAS _Float16*)hrows;
    LAS float* TAB = (LAS float*)(F.lds + TAB_OFF);
    for (int e = F.tid; e < 128 * 8; e += NWAVES * 64) { const int d = e >> 3, h = e & 7; int bk;
        if (d < 16) bk = d; else { bk = 16 + (int)(logf((float)d / 16.0f) / 2.0794415416798357f * 16.0f); bk = bk < 31 ? bk : 31; }
        TAB[e] = P.rel_bias[bk * 8 + h] * 1.4426950408889634f; }
    LAS unsigned* IDX = (LAS unsigned*)(F.lds + IDX_OFF + wave * (IDXW * 4));
    constexpr int NU = SEQ / 8;
    volatile LAS unsigned* TK = F.MISC + 16 + 4 * half;
    volatile LAS unsigned* HB = F.MISC + 24 + 2 * half;
    volatile LAS unsigned* NB = F.MISC + 28 + half;
    const bool tk_lane = (w4 == 0) && (F.lane == 0);
    int bcur = (int)(xb_xcc_id() & 7u), parity = 0;
    unsigned tk1 = 0u; if (tk_lane) tk1 = xb_add((unsigned*)(F.ctl + CW_Q + 64 * bcur), 1u);
    p2_conv(F, P);
    if (tk_lane) TK[0] = tk1;
    __syncthreads();
    bool have = false;
    bf16x8 afr[2][4]; v4u wraw[2][2]; bf16x8 bfr[4][4];
#define P2_ZERO_Q() do { _Pragma("unroll") for (int mt = 0; mt < 2; ++mt) { _Pragma("unroll") for (int ks = 0; ks < 4; ++ks) afr[mt][ks] = (bf16x8){0, 0, 0, 0, 0, 0, 0, 0}; wraw[mt][0] = (v4u){0u, 0u, 0u, 0u}; wraw[mt][1] = (v4u){0u, 0u, 0u, 0u}; } \
        _Pragma("unroll") for (int u = 0; u < 4; ++u) { _Pragma("unroll") for (int ks = 0; ks < 4; ++ks) bfr[u][ks] = (bf16x8){0, 0, 0, 0, 0, 0, 0, 0}; } } while (0)
    P2_ZERO_Q();
#define P2_LOAD_Q(T0) do { _Pragma("unroll") for (int mt = 0; mt < 2; ++mt) { const bf16* qp = PB + (size_t)((T0) + 4 * mt + qrho) * NPROJ + PC_IQ + hrho * 64 + 8 * hh; \
        _Pragma("unroll") for (int ks = 0; ks < 4; ++ks) afr[mt][ks] = *(const GAS bf16x8*)(qp + 16 * ks); \
        _Pragma("unroll") for (int qq = 0; qq < 2; ++qq) wraw[mt][qq] = *(const GAS v4u*)(IWB + (size_t)((T0) + 4 * mt + 2 * hh + qq) * 8); } \
        _Pragma("unroll") for (int u = 0; u < 4; ++u) { const bf16* kp = IKB + (size_t)(w4 + 4 * u) * 2048 + hh * 256 + r32 * 8;     \
            _Pragma("unroll") for (int ks = 0; ks < 4; ++ks) bfr[u][ks] = *(const GAS bf16x8*)(kp + 512 * ks); } } while (0)
    for (;;) {
        const int tk = (int)__builtin_amdgcn_readfirstlane(TK[parity]);
        if (tk >= NU) {
            half_barrier(HB, F.lane);
            if (tk_lane) { unsigned live = 0u;
#pragma unroll
                for (int j = 0; j < BATCH; ++j) live |= (xb_ld((unsigned*)(F.ctl + CW_Q + 64 * j)) < (unsigned)NU ? 1u : 0u) << j;
                const unsigned rot = ((live | (live << 8)) >> (bcur + 1)) & 0x7fu;
                unsigned nb = 8u, newt = (unsigned)NU;
                if (rot != 0u) { nb = (unsigned)(bcur + 1 + __builtin_ctz(rot)) & 7u; newt = xb_add((unsigned*)(F.ctl + CW_Q + 64 * nb), 1u); }
                TK[parity] = newt; NB[0] = nb; }
            half_barrier(HB, F.lane);
            const int nbr = (int)__builtin_amdgcn_readfirstlane(NB[0]);
            if (nbr >= BATCH) break;
            bcur = nbr;
            have = false; P2_ZERO_Q();
            continue;
        }
        unsigned nxt = 0u;
        if (tk_lane) nxt = xb_add((unsigned*)(F.ctl + CW_Q + 64 * bcur), 1u);
        int lane = F.lane; asm volatile("" : "+v"(lane));
        const int r32 = lane & 31, hh = lane >> 5, fr = lane & 15, fq = lane >> 4;
        const int qrho = ((r32 >> 4) & 1) + 2 * ((r32 >> 2) & 1), hrho = (r32 & 3) + 4 * ((r32 >> 3) & 1);
        const int b = bcur, t0 = 8 * (NU - 1 - tk);
        const bf16* PB = PROJ + (size_t)b * SEQ * NPROJ; const GAS unsigned char* KB8 = (const GAS unsigned char*)KVI + (size_t)b * SEQ * 128; const bf16* IKB = IKFp + (size_t)b * SEQ * 64; const bf16* IWB = IWp + (size_t)b * SEQ * 8;
        if (!have) P2_LOAD_Q(t0);
        {
            float w[2][16];
#pragma unroll
            for (int mt = 0; mt < 2; ++mt)
#pragma unroll
                for (int qq = 0; qq < 2; ++qq) { const v4u wv = wraw[mt][qq];
                    const float sc = 0.04419417382415922f;
                    w[mt][8 * qq + 0] = bf_lo(wv.x) * sc; w[mt][8 * qq + 1] = bf_hi(wv.x) * sc; w[mt][8 * qq + 2] = bf_lo(wv.y) * sc; w[mt][8 * qq + 3] = bf_hi(wv.y) * sc;
                    w[mt][8 * qq + 4] = bf_lo(wv.z) * sc; w[mt][8 * qq + 5] = bf_hi(wv.z) * sc; w[mt][8 * qq + 6] = bf_lo(wv.w) * sc; w[mt][8 * qq + 7] = bf_hi(wv.w) * sc; }
            const int nkt = (t0 + 8 + 31) >> 5;
            for (int kt0 = w4; kt0 < nkt; kt0 += 16) {
#pragma unroll
                for (int u = 0; u < 4; ++u) { const int kt = kt0 + 4 * u;
                    if (kt < nkt) { const int s = 32 * kt + r32;
                        f32x16 acc0 = {}, acc1 = {};
#pragma unroll
                        for (int ks = 0; ks < 4; ++ks) { acc0 = __builtin_amdgcn_mfma_f32_32x32x16_bf16(afr[0][ks], bfr[u][ks], acc0, 0, 0, 0); acc1 = __builtin_amdgcn_mfma_f32_32x32x16_bf16(afr[1][ks], bfr[u][ks], acc1, 0, 0, 0); }
                        if (kt + 16 < nkt) { const bf16* kp = IKB + (size_t)(kt + 16) * 2048 + hh * 256 + r32 * 8;
#pragma unroll
                            for (int ks = 0; ks < 4; ++ks) bfr[u][ks] = *(const GAS bf16x8*)(kp + 512 * ks); }
                        float s0 = 0.f, s1 = 0.f, s2 = 0.f, s3 = 0.f;
#pragma unroll
                        for (int e = 0; e < 8; ++e) { s0 = __builtin_fmaf(w[0][e], __builtin_amdgcn_fmed3f(acc0[e], 0.f, 3.0e38f), s0); s1 = __builtin_fmaf(w[0][8 + e], __builtin_amdgcn_fmed3f(acc0[8 + e], 0.f, 3.0e38f), s1);
                            s2 = __builtin_fmaf(w[1][e], __builtin_amdgcn_fmed3f(acc1[e], 0.f, 3.0e38f), s2); s3 = __builtin_fmaf(w[1][8 + e], __builtin_amdgcn_fmed3f(acc1[8 + e], 0.f, 3.0e38f), s3); }
                        asm("" : "+v"(s0), "+v"(s1), "+v"(s2), "+v"(s3));
                        SC[(2 * hh) * 4096 + s] = (_Float16)s0; SC[(2 * hh + 1) * 4096 + s] = (_Float16)s1; SC[(4 + 2 * hh) * 4096 + s] = (_Float16)s2; SC[(4 + 2 * hh + 1) * 4096 + s] = (_Float16)s3; } }
            }
        }
        if (tk_lane) TK[parity ^ 1] = nxt;
        half_barrier(HB, F.lane);
#pragma nounroll
        for (int qi = 0; qi < 2; ++qi) {
        int lane = F.lane; asm volatile("" : "+v"(lane));
        const int fr = lane & 15, fq = lane >> 4;
        const int qrow = w4 + 4 * qi;
        LAS unsigned char* myrow = hrows + qrow * 8192;
        const int t = t0 + qrow;
        int nsel;
        if (t < 1024) nsel = topk_select<16>(myrow, t, IDX, lane);
        else if (t < 2048) nsel = topk_select<32>(myrow, t, IDX, lane);
        else if (t < 3072) nsel = topk_select<48>(myrow, t, IDX, lane);
        else nsel = topk_select<64>(myrow, t, IDX, lane);
        if (nsel < TOPK) {
#pragma unroll
        for (int k = 0; k < 4; ++k) { const int jx = lane + 64 * k; if (jx >= nsel) IDX[jx] = 0u; } }
        asm volatile("" ::: "memory");
        {
            const float c2 = 0.125f * 1.4426950408889634f;
            long qf8[2];
            { const bf16* qp = PB + (size_t)t * NPROJ + PC_Q + (fr & 7) * 64 + 16 * fq; const v4u q0 = *(const GAS v4u*)qp, q1 = *(const GAS v4u*)(qp + 8);
              qf8[0] = (long)(unsigned long long)(pk4_fp8(bf_lo(q0.x), bf_hi(q0.x), bf_lo(q0.y), bf_hi(q0.y)) | ((unsigned long long)pk4_fp8(bf_lo(q0.z), bf_hi(q0.z), bf_lo(q0.w), bf_hi(q0.w)) << 32));
              qf8[1] = (long)(unsigned long long)(pk4_fp8(bf_lo(q1.x), bf_hi(q1.x), bf_lo(q1.y), bf_hi(q1.y)) | ((unsigned long long)pk4_fp8(bf_lo(q1.z), bf_hi(q1.z), bf_lo(q1.w), bf_hi(q1.w)) << 32)); }
            f32x4 S[8]; unsigned BI[8][2]; const int cls = fr >> 3;
            long vf[8][4];
            {
                v4u kvreg[8][4];
#pragma unroll
                for (int kb = 0; kb < 8; ++kb)
#pragma unroll
                    for (int i = 0; i < 4; ++i) { const unsigned kidx = IDX[32 * kb + 8 * i + (lane >> 3)]; kvreg[kb][i] = *(const GAS v4u*)(KB8 + ((kidx << 2) + (unsigned)(16 * (lane & 7)))); }
                const LAS float* TABh = TAB + (fr & 7);
                const int t32b = t * 32 + (int)(unsigned)(size_t)TABh, capb = 127 * 32 + (int)(unsigned)(size_t)TABh;
                if (nsel >= TOPK) {
#pragma unroll
                    for (int jo = 0; jo < 8; ++jo) { const int jt = 2 * jo + cls; const v4u kk = *(const LAS v4u*)(IDX + 16 * jt + 4 * fq); float bz[4];
#pragma unroll
                        for (int r = 0; r < 4; ++r) { int a = t32b - (int)kk[r]; a = a < capb ? a : capb; bz[r] = *(const LAS float*)(size_t)(unsigned)a; }
                        BI[jo][0] = pg8::cvt_pk_bf16(bz[0], bz[1]); BI[jo][1] = pg8::cvt_pk_bf16(bz[2], bz[3]); }
                } else {
#pragma unroll
                    for (int jo = 0; jo < 8; ++jo) { const int jt = 2 * jo + cls; const v4u kk = *(const LAS v4u*)(IDX + 16 * jt + 4 * fq); float bz[4];
#pragma unroll
                        for (int r = 0; r < 4; ++r) { const int slot = 16 * jt + 4 * fq + r; int dist = t - (int)(kk[r] >> 5); dist = dist < 127 ? dist : 127;
                            const float bias = TABh[dist * 8]; bz[r] = (slot < nsel) ? bias : -INFINITY; }
                        BI[jo][0] = pg8::cvt_pk_bf16(bz[0], bz[1]); BI[jo][1] = pg8::cvt_pk_bf16(bz[2], bz[3]); }
                }
                const int wsl = (lane >> 3) * 128 + 16 * ((lane & 7) ^ ((lane >> 4) & 3));
                const int rsw = (fr >> 1) & 7;
                const int kra = fr * 128;
                const int vj = fr >> 1, vrho = 4 * fq + (vj & 3) + 16 * (vj >> 2), vswz = (2 * fq + ((vj >> 1) & 1)) ^ (4 * (vj >> 2));
                const int vra = vrho * 128 + 8 * (fr & 1);
                v2l_t kf[2][2];
#define P2_KW(KB) do { LAS unsigned char* kbuf_ = myrow + ((KB) & 1) * 4096; _Pragma("unroll") for (int i = 0; i < 4; ++i) *(LAS v4u*)(kbuf_ + 1024 * i + (wsl ^ (64 * ((i & 1) ^ (i >> 1))))) = kvreg[KB][i]; asm volatile("" ::: "memory"); } while (0)
#define P2_KR(KB) do { const LAS unsigned char* kbuf_ = myrow + ((KB) & 1) * 4096; _Pragma("unroll") for (int tt = 0; tt < 2; ++tt) \
                    kf[(KB) & 1][tt] = *(const LAS v2l_t*)(kbuf_ + 2048 * tt + kra + 16 * ((fq ^ rsw) ^ (4 * tt))); \
                    _Pragma("unroll") for (int mt = 0; mt < 4; ++mt) vf[KB][mt] = p2_vfrag(kbuf_, vra, 16 * ((4 + mt) ^ vswz), fr, fq); asm volatile("" ::: "memory"); } while (0)
                P2_KW(0); P2_KR(0);
#pragma unroll
                for (int kb = 0; kb < 8; ++kb) {
                    if (kb < 7) { P2_KW(kb + 1); P2_KR(kb + 1); }
                    f32x4 a2[2];
#pragma unroll
                    for (int tt = 0; tt < 2; ++tt) { f32x4 a = {0.f, 0.f, 0.f, 0.f};
                        a = __builtin_amdgcn_mfma_f32_16x16x32_fp8_fp8(kf[kb & 1][tt][0], qf8[0], a, 0, 0, 0);
                        a = __builtin_amdgcn_mfma_f32_16x16x32_fp8_fp8(kf[kb & 1][tt][1], qf8[1], a, 0, 0, 0);
                        a2[tt] = a; }
                    S[kb] = cls ? a2[1] : a2[0]; }
#undef P2_KW
#undef P2_KR
            }
            __builtin_amdgcn_sched_barrier(0);
            f32x4 W[8];
            float mx = -INFINITY;
#pragma unroll
            for (int jo = 0; jo < 8; ++jo)
#pragma unroll
                for (int r = 0; r < 4; ++r) { const unsigned bw = BI[jo][r >> 1]; const float sv = S[jo][r];
                    const float l2 = sv * c2 + ((r & 1) ? bf_hi(bw) : bf_lo(bw)); W[jo][r] = l2; mx = fmaxf(mx, l2); }
            mx = p2_allmax4(mx);
            float sum = 0.f; const float mx8 = mx - 8.0f;
#pragma unroll
            for (int jo = 0; jo < 8; ++jo)
#pragma unroll
                for (int r = 0; r < 4; ++r) { const float p = __builtin_amdgcn_exp2f(W[jo][r] - mx8); W[jo][r] = p; sum += p; }
            sum = p2_allsum4(sum);
            const float rinv = __builtin_amdgcn_rcpf(sum);
            f32x4 O[4];
#pragma unroll
            for (int mt = 0; mt < 4; ++mt) O[mt] = (f32x4){0.f, 0.f, 0.f, 0.f};
#pragma unroll
            for (int kb = 0; kb < 8; ++kb) {
                const unsigned pq = pk4_fp8(W[kb][0], W[kb][1], W[kb][2], W[kb][3]);
                const unsigned pp = (unsigned)__builtin_amdgcn_update_dpp(0, (int)pq, 0x128, 0xf, 0xf, true);
                const unsigned long long pf = cls ? ((unsigned long long)pp | ((unsigned long long)pq << 32)) : ((unsigned long long)pq | ((unsigned long long)pp << 32));
#pragma unroll
                for (int mt = 0; mt < 4; ++mt) O[mt] = __builtin_amdgcn_mfma_f32_16x16x32_fp8_fp8(vf[kb][mt], (long)pf, O[mt], 0, 0, 0);
            }
            if (fr < 8) { bf16* op = ATTN + (size_t)(b * SEQ + t) * D + DCONV + fr * 64 + 4 * fq;
#pragma unroll
                for (int mt = 0; mt < 4; ++mt) { typedef unsigned u32x2v __attribute__((ext_vector_type(2)));
                    u32x2v wv; wv.x = pg8::cvt_pk_bf16(O[mt][0] * rinv, O[mt][1] * rinv); wv.y = pg8::cvt_pk_bf16(O[mt][2] * rinv, O[mt][3] * rinv);
                    *(GAS u32x2v*)(op + 16 * mt) = wv; } }
        }
        asm volatile("" ::: "memory");
        }
        __builtin_amdgcn_sched_barrier(0);
        {
            const int tkn = (int)__builtin_amdgcn_readfirstlane(TK[parity ^ 1]);
            have = tkn < NU;
            if (have) { const int t0n = 8 * (NU - 1 - tkn); P2_LOAD_Q(t0n); }
            else P2_ZERO_Q();
        }
        half_barrier(HB, F.lane);
        parity ^= 1;
    }
#undef P2_LOAD_Q
#undef P2_ZERO_Q
    __syncthreads();
}

__device__ __forceinline__ void p8_final_norm(Frame& F, const Ptrs& P) {
    const int gw = F.vcu * NWAVES + F.wave, NGW = F.G * NWAVES; const float* SSQ = (const float*)(P.ws + WS_SSQ2); const bf16* X2B = (const bf16*)(P.ws + WS_XN);
    const GAS f32x4* gr = (const GAS f32x4*)P.g_final + F.lane;
    f32x4 gg[4];
#pragma unroll
    for (int j = 0; j < 4; ++j) gg[j] = gr[64 * j];
    typedef unsigned u32x2v __attribute__((ext_vector_type(2)));
    for (int m = gw; m < M; m += 2 * NGW) { const int m1 = (m + NGW < M) ? m + NGW : m;
        const GAS u32x2v* xa = (const GAS u32x2v*)(X2B + (size_t)m * D) + F.lane; const GAS u32x2v* xb = (const GAS u32x2v*)(X2B + (size_t)m1 * D) + F.lane;
        const float* spa = SSQ + m; const float* spb = SSQ + m1; asm volatile("" : "+v"(spa), "+v"(spb));
        const float pa = *spa, pb = *spb;
        u32x2v va[4], vb[4];
#pragma unroll
        for (int j = 0; j < 4; ++j) { va[j] = xa[64 * j]; vb[j] = xb[64 * j]; }
        const float ra = 1.f / sqrtf(pa * (1.f / D) + EPS), rb = 1.f / sqrtf(pb * (1.f / D) + EPS);
        GAS f32x4* oa = (GAS f32x4*)(P.out + (size_t)m * D) + F.lane; GAS f32x4* ob = (GAS f32x4*)(P.out + (size_t)m1 * D) + F.lane;
#pragma unroll
        for (int j = 0; j < 4; ++j) { oa[64 * j] = (f32x4){bf_lo(va[j].x), bf_hi(va[j].x), bf_lo(va[j].y), bf_hi(va[j].y)} * ra * gg[j];
            if (m1 != m) ob[64 * j] = (f32x4){bf_lo(vb[j].x), bf_hi(vb[j].x), bf_lo(vb[j].y), bf_hi(vb[j].y)} * rb * gg[j]; }
    }
}

struct Args { const float* in[14]; float* out; unsigned char* ws; int ph_lo, ph_hi, li, pad; };
__global__ void __launch_bounds__(NWAVES * 64, 2) skel_fwd(Args args) {
    extern __shared__ __attribute__((aligned(16))) unsigned char lds[];
    Frame F;
    F.lds = (LAS unsigned char*)lds;
    F.MISC = (volatile LAS unsigned*)(F.lds + MISC_OFF);
    F.tid = threadIdx.x; F.lane = F.tid & 63; F.wave = __builtin_amdgcn_readfirstlane(F.tid >> 6);
    F.G = gridDim.x; { const int bx = blockIdx.x; F.vcu = (F.G % 8 == 0) ? (bx % 8) * (F.G / 8) + bx / 8 : bx; }
    Ptrs P;
    P.x = args.in[0]; P.g_mix = args.in[1]; P.w_in = args.in[2]; P.b_gate = args.in[3]; P.conv_w = args.in[4]; P.w_a = args.in[5]; P.w_b = args.in[6]; P.w_out = args.in[7];
    P.rel_bias = args.in[8]; P.g_ffn = args.in[9]; P.w_g = args.in[10]; P.w_u = args.in[11]; P.w_d = args.in[12]; P.g_final = args.in[13];
    P.out = args.out; P.ws = args.ws;
    unsigned char* ws = args.ws;
    F.ctl = (gu32*)(ws + WS_CTL);
    for (int u = F.tid; u < (TAB_OFF - LDSCTL_OFF) / 4; u += NWAVES * 64) ((LAS unsigned*)(F.lds + LDSCTL_OFF))[u] = 0u;
    __syncthreads();
    XcdBarrier bar; bar.bar = (unsigned*)(F.ctl + CW_BAR); bar.x = 0; bar.st = nullptr;
    if (N_LAUNCHES == 1) bar = xcd_barrier_post((unsigned*)(F.ctl + CW_BAR), F.MISC + 8);
#define GRID_BAR() do { if (N_LAUNCHES == 1) { xcd_barrier(bar); } } while (0)
#define GRID_BAR_L() do { if (N_LAUNCHES == 1) { xcd_barrier(bar, true); } } while (0)
    const int lo = args.ph_lo, hi = args.ph_hi;
#define IN(k) (lo <= (k) && (k) < hi)
#define BOTH(k) (IN(k) && IN((k) + 1))
    bf16* XN = (bf16*)(ws + WS_XN); bf16* PROJ = (bf16*)(ws + WS_PROJ); bf16* CONV = (bf16*)(ws + WS_CONV); bf16* ATTN = (bf16*)(ws + WS_ATTN);
    bf16* MERGED = XN; bf16* X1B = CONV; bf16* ACT = PROJ; bf16* X2B = XN;
    float* SSQ1 = (float*)(ws + WS_SSQ1); float* SSQ2 = (float*)(ws + WS_SSQ2);

    const bool split_w = (N_LAUNCHES == 1) && (F.G == 256);
    const bool fuse_final = (N_LAUNCHES == 1) && (F.G == 256) && IN(7) && IN(8);
    if (IN(0)) { if (blockIdx.x == 0 && F.tid < 256) ((bf16*)(ws + WS_IDENT))[F.tid * 257] = (bf16)0x3F80;
        p0_prologue(F, P, !split_w); if (BOTH(0)) GRID_BAR(); }
    if (IN(1)) {
        LAS float* BGL = (LAS float*)(F.lds + TAB_OFF);
        for (int i = F.tid; i < 2 * D; i += NWAVES * 64) BGL[i] = P.b_gate[i];
        __syncthreads();
        {
            pg8::Gemm g{(const bf16*)P.out  , (const bf16*)(ws + WS_WIN), M, PC_GA - DATT, D}; pg8::StaticOrder S; S.init(M, PC_GA - DATT, F.G, (int)blockIdx.x);
            pg8::EpiProj<false> E{PROJ, NPROJ, (bf16*)(ws + WS_KVI), (bf16*)(ws + WS_IKF), (bf16*)(ws + WS_IW), PC_KVI / 256, BGL, PC_GA, (bf16*)(ws + WS_IW + MiB), (const float*)(ws + WS_SSQ0), (LAS float*)(F.lds + TAB_OFF + 8192), PC_Q / 256, 0, DATT / 256};
            pg8::gemm_phase<pg8::EpiProj<false>, pg8::StaticOrder, PG8_ALIGN, PG8_SP2>(F.lds + RING_OFF, g, S, E); }
        if (split_w && blockIdx.x >= 128) p0_weight_items(F, P, PI_IN, PI_ALL, ((int)blockIdx.x - 128) * NWAVES + F.wave, 128 * NWAVES);
        __syncthreads();
        {
            pg8::Gemm g{(const bf16*)(ws + WS_XB8), (const bf16*)(ws + WS_WG8), M, DATT, D / 2}; pg8::StaticOrder S; S.init(M, DATT, F.G, (int)blockIdx.x);
            pg8::EpiProj<true> E{PROJ, NPROJ, (bf16*)(ws + WS_KVI), (bf16*)(ws + WS_IKF), (bf16*)(ws + WS_IW), PC_KVI / 256, BGL, PC_GA, (bf16*)(ws + WS_IW + MiB), (const float*)(ws + WS_SSQ0), (LAS float*)(F.lds + TAB_OFF + 8192), DATT / 256, PC_Q / 256, 0};
            pg8::gemm_phase<pg8::EpiProj<true>, pg8::StaticOrder, PG8_ALIGN, PG8_SP2>(F.lds + RING_OFF, g, S, E); }
        if (BOTH(1)) GRID_BAR();
    }
    if (IN(2)) { p2_attn(F, P);
        {
            LAS float* BGL = (LAS float*)(F.lds + TAB_OFF);
            for (int i = F.tid; i < 2 * D; i += NWAVES * 64) BGL[i] = P.b_gate[i];
            __syncthreads();
            pg8::Gemm g{(const bf16*)(ws + WS_XB8), (const bf16*)(ws + WS_WG8 + (size_t)DATT * D), M, 2 * D, D / 2}; pg8::StaticOrder S; S.init(M, 2 * D, F.G, (int)blockIdx.x);
            pg8::EpiProj<true> E{PROJ, NPROJ, (bf16*)(ws + WS_KVI), (bf16*)(ws + WS_IKF), (bf16*)(ws + WS_IW), PC_KVI / 256, BGL, PC_GA, (bf16*)(ws + WS_IW + MiB), (const float*)(ws + WS_SSQ0), (LAS float*)(F.lds + TAB_OFF + 8192), 0, 0, PC_GA / 256};
            pg8::gemm_phase<pg8::EpiProj<true>, pg8::StaticOrder, PG8_ALIGN, PG8_SP2>(F.lds + RING_OFF, g, S, E); }
        if (BOTH(2)) GRID_BAR(); }
    if (IN(3)) {
        pg8::Gemm g{CONV, (const bf16*)(ws + WS_WA), M, D, D}; pg8::StaticOrder S; S.init(M, D, F.G, (int)blockIdx.x);
        pg8::EpiGateMerged E{MERGED, (const unsigned char*)(PROJ + PC_GA), NPROJ * 2};
        pg8::gemm_phase<pg8::EpiGateMerged, pg8::StaticOrder, PG8_ALIGN, PG8_SP2>(F.lds + RING_OFF, g, S, E);
        if (BOTH(4)) { if (split_w) GRID_BAR_L(); else GRID_BAR(); }
    }
    if (IN(5)) {
        pg8::Gemm g{MERGED, (const bf16*)(ws + WS_WOUT), M, D, D, (const bf16*)P.out, (const bf16*)(ws + WS_IDENT), D, BM256}; pg8::StaticOrder S; S.init(M, D, F.G, (int)blockIdx.x);
        pg8::EpiResid<2> E{nullptr, nullptr, X1B, SSQ1};
        pg8::gemm_phase<pg8::EpiResid<2>, pg8::StaticOrder, PG8_ALIGN, PG8_SP2>(F.lds + RING_OFF, g, S, E);
        if (BOTH(5)) GRID_BAR();
    }
    if (IN(6)) {
        pg8::Gemm g{X1B, (const bf16*)(ws + WS_WGU), M, NGU, D}; pg8::StaticOrder S; S.init(M, NGU, F.G, (int)blockIdx.x);
        pg8::EpiSwiGLU E{ACT, FF, SSQ1, (LAS float*)(F.lds + TAB_OFF)};
        pg8::gemm_phase<pg8::EpiSwiGLU, pg8::StaticOrder, PG8_ALIGN, PG8_SP2>(F.lds + RING_OFF, g, S, E);
        if (BOTH(6)) { if (split_w) GRID_BAR_L(); else GRID_BAR(); }
    }
    if (IN(7)) {
        pg8::Gemm g{ACT, (const bf16*)(ws + WS_WD), M, D, FF, X1B, (const bf16*)(ws + WS_IDENT), D, BM256}; pg8::StaticOrder S; S.init(M, D, F.G, (int)blockIdx.x);
        if (fuse_final) {
            pg8::EpiFinal E{P.out, SSQ2, P.g_final, (unsigned*)(ws + WS_RC), (unsigned*)(F.ctl + CW_BAR) + XB_TMO};
            pg8::gemm_phase<pg8::EpiFinal, pg8::StaticOrder, PG8_ALIGN, PG8_SP2>(F.lds + RING_OFF, g, S, E);
        } else {
            pg8::EpiResid<2> E{nullptr, nullptr, X2B, SSQ2};
            pg8::gemm_phase<pg8::EpiResid<2>, pg8::StaticOrder, PG8_ALIGN, PG8_SP2>(F.lds + RING_OFF, g, S, E);
            if (BOTH(7)) GRID_BAR();
        }
    }
    if (IN(8) && !fuse_final) { p8_final_norm(F, P); }
#undef IN
#undef BOTH
#undef GRID_BAR
#undef GRID_BAR_L
}

extern "C" void kernel_launch(void* const* d_in, const int* in_sizes, int n_in, void* d_out, int out_size, void* d_ws, size_t ws_size, hipStream_t stream) {
    static int grid = 0;
    if (grid == 0) {
        if (n_in != 14 || in_sizes[0] != M * D || out_size != M * D || ws_size < WS_END) { fprintf(stderr, "kernel_launch: shape/workspace mismatch: n_in %d in0 %d out %d ws %zu (need %zu); nothing launched\n", n_in, n_in > 0 ? in_sizes[0] : -1, out_size, ws_size, (size_t)WS_END); grid = -1; return; }
        int dev = 0, cus = 0, per_cu = 0;
        if (hipGetDevice(&dev) != hipSuccess || hipDeviceGetAttribute(&cus, hipDeviceAttributeMultiprocessorCount, dev) != hipSuccess) { grid = -1; return; }
        if (hipFuncSetAttribute((const void*)skel_fwd, hipFuncAttributeMaxDynamicSharedMemorySize, LDS_BYTES) != hipSuccess) { fprintf(stderr, "kernel_launch: hipFuncSetAttribute failed\n"); grid = -1; return; }
        if (hipOccupancyMaxActiveBlocksPerMultiprocessor(&per_cu, (const void*)skel_fwd, NWAVES * 64, LDS_BYTES) != hipSuccess || per_cu < 1)
            fprintf(stderr, "kernel_launch: note: occupancy query reports %d workgroups per CU\n", per_cu);
        (void)hipGetLastError();
        grid = cus;
    }
    if (grid < 0) return;
    if (hipMemsetAsync((char*)d_ws + WS_CTL, 0, CTL_ZERO_BYTES, stream) != hipSuccess) { fprintf(stderr, "kernel_launch: hipMemsetAsync failed\n"); return; }
    Args a{};
    for (int i = 0; i < 14; ++i) a.in[i] = (const float*)d_in[i];
    a.out = (float*)d_out; a.ws = (unsigned char*)d_ws;
    for (int li = 0; li < N_LAUNCHES; ++li) {
        a.ph_lo = (N_LAUNCHES == PER_PHASE) ? li : 0; a.ph_hi = (N_LAUNCHES == PER_PHASE) ? li + 1 : PER_PHASE; a.li = li;
        hipLaunchKernelGGL(skel_fwd, dim3(grid), dim3(NWAVES * 64), LDS_BYTES, stream, a);
        const hipError_t le = hipPeekAtLastError();
        if (le != hipSuccess) { fprintf(stderr, "kernel_launch: launch %d failed: %s\n", li, hipGetErrorName(le)); break; }
    }
}
```
